# Optimizing an MI355X kernel written in HIP

```python
import numpy as np
import jax
import jax.numpy as jnp
from jax import lax

D_MODEL = 1024
BATCH = 8
SEQ = 4096
DEPTH = 1

HEAD_DIM = 64
ROPE_THETA = 500000.0
LN_EPS = 1e-5

NSA_HEADS = 8
NSA_KV_HEADS = 2
CMP_LEN = 32
CMP_STRIDE = 16
CMP_HIDDEN = 128
SEL_BLOCK = 64
SEL_COUNT = 16
WINDOW = 512
NSA_Q_CHUNK = 64
FORCE_BONUS = 1e4

DSA_HEADS = 4
IDX_HEADS = 8
IDX_DIM = 32
DSA_TOPK_MAX = 256
DSA_Q_CHUNK = 128

MEM_HEADS = 4
MEM_LEN = 256

PEER_HEADS = 8
PEER_N_KEYS = 128
PEER_KEY_DIM = 256
PEER_TOPK = 16
PEER_CHUNK = 128
PEER_N_EXPERTS = PEER_N_KEYS * PEER_N_KEYS

DEEPNORM_ALPHA = (2.0 * DEPTH) ** 0.25
DEEPNORM_BETA = (8.0 * DEPTH) ** -0.25

IN_SPLITS = (
    NSA_HEADS * HEAD_DIM,
    6 * NSA_KV_HEADS * HEAD_DIM,
    3 * NSA_HEADS,
    DSA_HEADS * HEAD_DIM,
    2 * HEAD_DIM,
    IDX_HEADS * IDX_DIM,
    IDX_DIM,
    IDX_HEADS,
    MEM_HEADS * HEAD_DIM,
)
IN_WIDTH = sum(IN_SPLITS)

kernel_name = 'hybrid_nsa_dsa_mem_peer_deepnorm'


def layer_norm(x, g, b):
    xf = x.astype(jnp.float32)
    mu = jnp.mean(xf, axis=-1, keepdims=True)
    var = jnp.mean(jnp.square(xf - mu), axis=-1, keepdims=True)
    return ((xf - mu) * lax.rsqrt(var + LN_EPS) * g + b).astype(x.dtype)


def rope_partial(x, pos):
    r = x.shape[-1] // 4
    half = r // 2
    freqs = jnp.power(ROPE_THETA, -jnp.arange(half, dtype=jnp.float32) * 2.0 / r)
    ang = pos.astype(jnp.float32)[..., None] * freqs
    cos = jnp.cos(ang)[:, :, None, :]
    sin = jnp.sin(ang)[:, :, None, :]
    xf = x.astype(jnp.float32)
    x1 = xf[..., :half]
    x2 = xf[..., half:r]
    out = jnp.concatenate([x1 * cos - x2 * sin, x2 * cos + x1 * sin, xf[..., r:]], axis=-1)
    return out.astype(x.dtype)


def masked_softmax(s, mask):
    s = jnp.where(mask, s.astype(jnp.float32), -jnp.inf)
    m = jnp.max(s, axis=-1, keepdims=True)
    m = jnp.where(jnp.isfinite(m), m, 0.0)
    e = jnp.exp(s - m)
    den = jnp.sum(e, axis=-1, keepdims=True)
    return e / jnp.where(den > 0, den, 1.0)


def compress_blocks(kv, pe, w1, w2):
    B, S, G, d = kv.shape
    nc = (S - CMP_LEN) // CMP_STRIDE + 1
    idx = jnp.arange(nc)[:, None] * CMP_STRIDE + jnp.arange(CMP_LEN)[None, :]
    blocks = kv[:, idx] + pe[:, None, :]
    flat = blocks.transpose(0, 1, 3, 2, 4).reshape(B, nc, G, CMP_LEN * d)
    return jax.nn.gelu(flat @ w1, approximate=False) @ w2


def nsa_attention(q, kc, vc, ks, vs, kw, vw, gates):
    B, S, H, d = q.shape
    G = ks.shape[2]
    hpg = H // G
    C = NSA_Q_CHUNK
    scale = d ** -0.5
    nc = kc.shape[1]
    n_blocks = S // SEL_BLOCK
    n_pick = min(SEL_COUNT, n_blocks)
    qg = q.reshape(B, S, G, hpg, d).transpose(0, 2, 3, 1, 4)
    gg = gates.reshape(B, S, G, hpg, 3).transpose(0, 2, 3, 1, 4)
    kc = kc.transpose(0, 2, 1, 3)
    vc = vc.transpose(0, 2, 1, 3)
    ks_b = ks.transpose(0, 2, 1, 3).reshape(B, G, n_blocks, SEL_BLOCK, d)
    vs_b = vs.transpose(0, 2, 1, 3).reshape(B, G, n_blocks, SEL_BLOCK, d)
    pad = ((0, 0), (0, 0), (WINDOW, 0), (0, 0))
    kw_p = jnp.pad(kw.transpose(0, 2, 1, 3), pad)
    vw_p = jnp.pad(vw.transpose(0, 2, 1, 3), pad)
    c_start = jnp.arange(nc) * CMP_STRIDE
    cmp_end = c_start + CMP_LEN - 1
    blk_ids = jnp.arange(n_blocks)
    s_start = blk_ids * SEL_BLOCK
    overlap = jnp.clip(jnp.minimum(c_start[:, None] + CMP_LEN, s_start[None, :] + SEL_BLOCK)
                       - jnp.maximum(c_start[:, None], s_start[None, :]), 0).astype(jnp.float32) / CMP_LEN
    in_blk = jnp.arange(SEL_BLOCK)
    b_ix = jnp.arange(B)[:, None, None, None]
    g_ix = jnp.arange(G)[None, :, None, None]

    def chunk(c):
        t0 = c * C
        t = t0 + jnp.arange(C)
        qc = lax.dynamic_slice_in_dim(qg, t0, C, axis=3)
        gc = lax.dynamic_slice_in_dim(gg, t0, C, axis=3)
        s_cmp = jnp.einsum('bghcd,bgnd->bghcn', qc, kc) * scale
        p_cmp = masked_softmax(s_cmp, cmp_end[None, :] <= t[:, None])
        o_cmp = jnp.einsum('bghcn,bgnd->bghcd', p_cmp, vc)
        imp = jnp.einsum('bghcn,nm->bgcm', p_cmp, overlap)
        cur = t // SEL_BLOCK
        forced = (blk_ids[None, :] == 0) | (blk_ids[None, :] == cur[:, None]) | (blk_ids[None, :] == cur[:, None] - 1)
        visible = s_start[None, :] <= t[:, None]
        sel_score = jnp.where(visible, imp + FORCE_BONUS * forced, -jnp.inf)
        _, sel = lax.top_k(sel_score, n_pick)
        k_sel = ks_b[b_ix, g_ix, sel].reshape(B, G, C, n_pick * SEL_BLOCK, d)
        v_sel = vs_b[b_ix, g_ix, sel].reshape(B, G, C, n_pick * SEL_BLOCK, d)
        pos_sel = (sel[..., None] * SEL_BLOCK + in_blk).reshape(B, G, C, n_pick * SEL_BLOCK)
        s_sel = jnp.einsum('bghcd,bgckd->bghck', qc, k_sel) * scale
        p_sel = masked_softmax(s_sel, (pos_sel <= t[:, None])[:, :, None])
        o_sel = jnp.einsum('bghck,bgckd->bghcd', p_sel, v_sel)
        kwc = lax.dynamic_slice_in_dim(kw_p, t0, WINDOW + C, axis=2)
        vwc = lax.dynamic_slice_in_dim(vw_p, t0, WINDOW + C, axis=2)
        pos_w = t0 - WINDOW + jnp.arange(WINDOW + C)
        win_mask = (pos_w[None, :] <= t[:, None]) & (pos_w[None, :] > t[:, None] - WINDOW) & (pos_w[None, :] >= 0)
        s_win = jnp.einsum('bghcd,bgkd->bghck', qc, kwc) * scale
        p_win = masked_softmax(s_win, win_mask)
        o_win = jnp.einsum('bghck,bgkd->bghcd', p_win, vwc)
        return gc[..., 0:1] * o_cmp + gc[..., 1:2] * o_sel + gc[..., 2:3] * o_win

    out = lax.map(chunk, jnp.arange(S // C))
    return out.transpose(1, 0, 4, 2, 3, 5).reshape(B, S, H * d)


def dsa_attention(q, k, v, q_idx, k_idx, w_idx):
    B, S, H, d = q.shape
    C = DSA_Q_CHUNK
    topk = min(DSA_TOPK_MAX, S // 4)
    scale = d ** -0.5
    w = w_idx * (IDX_HEADS ** -0.5 * IDX_DIM ** -0.5)
    key_pos = jnp.arange(S)
    b_ix = jnp.arange(B)[:, None, None]

    def chunk(c):
        t0 = c * C
        t = t0 + jnp.arange(C)
        qi = lax.dynamic_slice_in_dim(q_idx, t0, C, axis=1)
        wi = lax.dynamic_slice_in_dim(w, t0, C, axis=1)
        logits = jax.nn.relu(jnp.einsum('bchd,bsd->bchs', qi, k_idx))
        score = jnp.einsum('bchs,bch->bcs', logits, wi).astype(jnp.float32)
        score = jnp.where(key_pos[None, :] <= t[:, None], score, -jnp.inf)
        _, sel = lax.top_k(score, topk)
        k_sel = k[b_ix, sel]
        v_sel = v[b_ix, sel]
        qc = lax.dynamic_slice_in_dim(q, t0, C, axis=1)
        s = jnp.einsum('bchd,bckd->bchk', qc, k_sel) * scale
        p = masked_softmax(s, (sel <= t[:, None])[:, :, None, :])
        return jnp.einsum('bchk,bckd->bchd', p, v_sel)

    out = lax.map(chunk, jnp.arange(S // C))
    return out.transpose(1, 0, 2, 3, 4).reshape(B, S, H * d)


def memory_attention(q, mem_k, mem_v):
    B, S, H, d = q.shape
    s = jnp.einsum('bshd,bmhd->bhsm', q, mem_k) * (d ** -0.5)
    p = jax.nn.softmax(s.astype(jnp.float32), axis=-1)
    return jnp.einsum('bhsm,bmhd->bshd', p, mem_v).reshape(B, S, H * d)


def peer(x, w_query, sub_keys_1, sub_keys_2, expert_u, expert_v):
    B, S, D = x.shape
    T = B * S
    half = PEER_KEY_DIM // 2
    xt = x.reshape(T, D)
    qh = (xt @ w_query).reshape(T, PEER_HEADS, PEER_KEY_DIM)
    s1 = jnp.einsum('thd,nd->thn', qh[..., :half], sub_keys_1)
    s2 = jnp.einsum('thd,nd->thn', qh[..., half:], sub_keys_2)
    v1, i1 = lax.top_k(s1, PEER_TOPK)
    v2, i2 = lax.top_k(s2, PEER_TOPK)
    cand = (v1[..., :, None] + v2[..., None, :]).reshape(T, PEER_HEADS, PEER_TOPK * PEER_TOPK)
    cand_idx = (i1[..., :, None] * PEER_N_KEYS + i2[..., None, :]).reshape(T, PEER_HEADS, PEER_TOPK * PEER_TOPK)
    top_s, top_j = lax.top_k(cand, PEER_TOPK)
    experts = jnp.take_along_axis(cand_idx, top_j, axis=-1).reshape(T, PEER_HEADS * PEER_TOPK)
    gate = jax.nn.softmax(top_s.astype(jnp.float32), axis=-1).reshape(T, PEER_HEADS * PEER_TOPK)
    C = PEER_CHUNK

    def chunk(c):
        t0 = c * C
        xc = lax.dynamic_slice_in_dim(xt, t0, C, axis=0)
        ec = lax.dynamic_slice_in_dim(experts, t0, C, axis=0)
        gc = lax.dynamic_slice_in_dim(gate, t0, C, axis=0)
        u = expert_u[ec]
        a = jax.nn.gelu(jnp.einsum('cd,ced->ce', xc, u).astype(jnp.float32), approximate=False)
        return jnp.einsum('ce,ced->cd', (gc * a).astype(x.dtype), expert_v[ec])

    y = lax.map(chunk, jnp.arange(T // C))
    return y.reshape(B, S, D)


def setup_inputs(seed: int = 0) -> dict:
    key = jax.random.key(seed)
    ks = jax.random.split(key, 24)
    f32 = jnp.float32
    d = HEAD_DIM
    nrm = lambda k, shape, s: jax.random.normal(k, shape, f32) * s
    x = nrm(ks[0], (BATCH, SEQ, D_MODEL), 1.0)
    mem = nrm(ks[1], (BATCH, MEM_LEN, D_MODEL), 1.0)
    start = jax.random.randint(ks[2], (BATCH, 1), 0, 2048)
    positions = (start + jnp.arange(SEQ)[None, :]).astype(jnp.int32)
    half = PEER_KEY_DIM // 2
    return {
        'x': x,
        'mem': mem,
        'positions': positions,
        'w_in': nrm(ks[3], (DEPTH, D_MODEL, IN_WIDTH), D_MODEL ** -0.5),
        'nsa_pe_k': nrm(ks[4], (DEPTH, CMP_LEN, d), 0.1),
        'nsa_pe_v': nrm(ks[5], (DEPTH, CMP_LEN, d), 0.1),
        'nsa_cmp_w1_k': nrm(ks[6], (DEPTH, CMP_LEN * d, CMP_HIDDEN), (CMP_LEN * d) ** -0.5),
        'nsa_cmp_w2_k': nrm(ks[7], (DEPTH, CMP_HIDDEN, d), CMP_HIDDEN ** -0.5),
        'nsa_cmp_w1_v': nrm(ks[8], (DEPTH, CMP_LEN * d, CMP_HIDDEN), (CMP_LEN * d) ** -0.5),
        'nsa_cmp_w2_v': nrm(ks[9], (DEPTH, CMP_HIDDEN, d), CMP_HIDDEN ** -0.5),
        'w_mem_kv': nrm(ks[10], (DEPTH, D_MODEL, 2 * MEM_HEADS * d), D_MODEL ** -0.5),
        'w_out': nrm(ks[11], (DEPTH, D_MODEL, D_MODEL), D_MODEL ** -0.5 * DEEPNORM_BETA),
        'ln1_g': 1.0 + nrm(ks[12], (DEPTH, D_MODEL), 0.02),
        'ln1_b': nrm(ks[13], (DEPTH, D_MODEL), 0.02),
        'peer_w_query': nrm(ks[14], (DEPTH, D_MODEL, PEER_HEADS * PEER_KEY_DIM), D_MODEL ** -0.5),
        'peer_sub_keys_1': nrm(ks[15], (DEPTH, PEER_N_KEYS, half), half ** -0.5),
        'peer_sub_keys_2': nrm(ks[16], (DEPTH, PEER_N_KEYS, half), half ** -0.5),
        'peer_u': nrm(ks[17], (DEPTH, PEER_N_EXPERTS, D_MODEL), D_MODEL ** -0.5),
        'peer_v': nrm(ks[18], (DEPTH, PEER_N_EXPERTS, D_MODEL), DEEPNORM_BETA),
        'ln2_g': 1.0 + nrm(ks[19], (DEPTH, D_MODEL), 0.02),
        'ln2_b': nrm(ks[20], (DEPTH, D_MODEL), 0.02),
    }


def reference(x, mem, positions, w_in, nsa_pe_k, nsa_pe_v, nsa_cmp_w1_k, nsa_cmp_w2_k,
              nsa_cmp_w1_v, nsa_cmp_w2_v, w_mem_kv, w_out, ln1_g, ln1_b, peer_w_query,
              peer_sub_keys_1, peer_sub_keys_2, peer_u, peer_v, ln2_g, ln2_b):
    B, S, _ = x.shape
    M = mem.shape[1]
    d = HEAD_DIM
    G = NSA_KV_HEADS
    split_points = np.cumsum(IN_SPLITS)[:-1].tolist()
    for layer in range(DEPTH):
        h = x @ w_in[layer]
        nsa_q, nsa_kv, nsa_gate, dsa_q, dsa_kv, idx_q, idx_k, idx_w, mem_q = jnp.split(h, split_points, axis=-1)
        q_n = rope_partial(nsa_q.reshape(B, S, NSA_HEADS, d), positions)
        kv_n = nsa_kv.reshape(B, S, 6, G, d)
        kc = compress_blocks(rope_partial(kv_n[:, :, 0], positions), nsa_pe_k[layer],
                             nsa_cmp_w1_k[layer], nsa_cmp_w2_k[layer])
        vc = compress_blocks(kv_n[:, :, 1], nsa_pe_v[layer], nsa_cmp_w1_v[layer], nsa_cmp_w2_v[layer])
        k_slc = rope_partial(kv_n[:, :, 2], positions)
        k_win = rope_partial(kv_n[:, :, 4], positions)
        gates = jax.nn.sigmoid(nsa_gate.reshape(B, S, NSA_HEADS, 3).astype(jnp.float32))
        o_nsa = nsa_attention(q_n, kc, vc, k_slc, kv_n[:, :, 3], k_win, kv_n[:, :, 5], gates)
        q_d = rope_partial(dsa_q.reshape(B, S, DSA_HEADS, d), positions)
        k_d = rope_partial(dsa_kv[..., :d][:, :, None, :], positions)[:, :, 0]
        v_d = dsa_kv[..., d:]
        qi = rope_partial(idx_q.reshape(B, S, IDX_HEADS, IDX_DIM), positions)
        ki = rope_partial(idx_k[:, :, None, :], positions)[:, :, 0]
        o_dsa = dsa_attention(q_d, k_d, v_d, qi, ki, idx_w)
        mkv = (mem @ w_mem_kv[layer]).reshape(B, M, 2, MEM_HEADS, d)
        o_mem = memory_attention(mem_q.reshape(B, S, MEM_HEADS, d), mkv[:, :, 0], mkv[:, :, 1])
        mix = jnp.concatenate([o_nsa, o_dsa, o_mem], axis=-1).astype(x.dtype) @ w_out[layer]
        x = layer_norm(DEEPNORM_ALPHA * x + mix, ln1_g[layer], ln1_b[layer])
        y = peer(x, peer_w_query[layer], peer_sub_keys_1[layer], peer_sub_keys_2[layer],
                 peer_u[layer], peer_v[layer])
        x = layer_norm(DEEPNORM_ALPHA * x + y, ln2_g[layer], ln2_b[layer])
    return x
```

```cpp
#include <hip/hip_runtime.h>
#include <hip/hip_cooperative_groups.h>
#include <cstdio>
#include <cstdint>
namespace cg = cooperative_groups;

constexpr int NB = 8, SEQ = 4096, DM = 1024, NT = NB * SEQ;
constexpr int INW = 2240;
constexpr int NC = 255;
constexpr int MEML = 256;
constexpr int C_NSAQ = 0, C_NSAKV = 512, C_GATE = 1280, C_DSAQ = 1304, C_DSAK = 1560, C_DSAV = 1624,
              C_IDXQ = 1688, C_IDXK = 1944, C_IDXW = 1976, C_MEMQ = 1984;
constexpr float ALPHA = 1.189207115002721f;

struct Params {
  const float *x, *mem; const int* pos;
  const float *w_in, *pe_k, *pe_v, *w1k, *w2k, *w1v, *w2v, *w_mem_kv, *w_out, *ln1g, *ln1b,
              *wq, *sk1, *sk2, *pu, *pv, *ln2g, *ln2b;
  float* out;
  float *H;
  float *concat;
  float *kc, *vc;
  float *mkv;
  int   *pexp;
  float *pgate;
};

__device__ __forceinline__ float wave_sum(float v) {
#pragma unroll
  for (int o = 32; o > 0; o >>= 1) v += __shfl_xor(v, o);
  return v;
}
__device__ __forceinline__ float wave_max(float v) {
#pragma unroll
  for (int o = 32; o > 0; o >>= 1) v = fmaxf(v, __shfl_xor(v, o));
  return v;
}
__device__ __forceinline__ float gelu_exact(float x) { return 0.5f * x * (1.f + erff(x * 0.7071067811865476f)); }

__device__ void gemm_f32_phase(const float* __restrict__ A, int lda, const float* __restrict__ Bm, int ldb,
                               float* __restrict__ C, int ldc, int M, int N, int K,
                               unsigned char* smem, int bid, int nblk) {
  float (*sA)[68] = (float (*)[68])smem;
  float (*sB)[68] = (float (*)[68])(smem + 16 * 68 * 4);
  const int tid = threadIdx.x, ty = tid >> 4, tx = tid & 15;
  const int tn = N / 64, tm = M / 64;
  for (int tile = bid; tile < tm * tn; tile += nblk) {
    const int m0 = (tile / tn) * 64, n0 = (tile % tn) * 64;
    float acc[4][4];
#pragma unroll
    for (int i = 0; i < 4; i++)
#pragma unroll
      for (int j = 0; j < 4; j++) acc[i][j] = 0.f;
    for (int k0 = 0; k0 < K; k0 += 16) {
      {
        const int r = tid >> 2, kk = (tid & 3) * 4;
        const float4 v = *(const float4*)(A + (size_t)(m0 + r) * lda + k0 + kk);
        sA[kk + 0][r] = v.x; sA[kk + 1][r] = v.y; sA[kk + 2][r] = v.z; sA[kk + 3][r] = v.w;
        const int kr = tid >> 4, nn = (tid & 15) * 4;
        const float4 w = *(const float4*)(Bm + (size_t)(k0 + kr) * ldb + n0 + nn);
        *(float4*)&sB[kr][nn] = w;
      }
      __syncthreads();
#pragma unroll
      for (int k = 0; k < 16; k++) {
        const float4 a = *(const float4*)&sA[k][ty * 4];
        const float4 b = *(const float4*)&sB[k][tx * 4];
        const float av[4] = {a.x, a.y, a.z, a.w}, bv[4] = {b.x, b.y, b.z, b.w};
#pragma unroll
        for (int i = 0; i < 4; i++)
#pragma unroll
          for (int j = 0; j < 4; j++) acc[i][j] = fmaf(av[i], bv[j], acc[i][j]);
      }
      __syncthreads();
    }
#pragma unroll
    for (int i = 0; i < 4; i++) {
      float4 o = {acc[i][0], acc[i][1], acc[i][2], acc[i][3]};
      *(float4*)(C + (size_t)(m0 + ty * 4 + i) * ldc + n0 + tx * 4) = o;
    }
  }
}

__device__ __forceinline__ void rope_cs(int pos, float freq, float& c, float& s) {
  double ang = (double)pos * (double)freq;
  double rev = ang * 0.15915494309189535;
  rev -= floor(rev + 0.5);
  float r = (float)(rev * 6.283185307179586);
  c = __cosf(r); s = __sinf(r);
}
__device__ void rope_phase(const Params& p, int bid, int nblk) {
  const float f16[8] = {1.0f, 0.19392274474868576f, 0.03760603093086393f, 0.007292664737217109f,
                        0.001414213562373095f, 0.0002742481756762073f, 5.318295896944988e-05f, 1.031338537721246e-05f};
  const int tid = threadIdx.x;
  for (int tok = bid; tok < NT; tok += nblk) {
    float* h = p.H + (size_t)tok * INW;
    const int pos = p.pos[tok];
    if (tid < 152) {
      const int v = tid >> 3, j = tid & 7;
      int base;
      if (v < 8) base = C_NSAQ + v * 64;
      else if (v < 10) base = C_NSAKV + 0 * 128 + (v - 8) * 64;
      else if (v < 12) base = C_NSAKV + 2 * 128 + (v - 10) * 64;
      else if (v < 14) base = C_NSAKV + 4 * 128 + (v - 12) * 64;
      else if (v < 18) base = C_DSAQ + (v - 14) * 64;
      else base = C_DSAK;
      float c, s; rope_cs(pos, f16[j], c, s);
      const float x1 = h[base + j], x2 = h[base + 8 + j];
      h[base + j] = x1 * c - x2 * s; h[base + 8 + j] = x2 * c + x1 * s;
    } else if (tid < 188) {
      const int u = tid - 152, v = u >> 2, j = u & 3;
      const int base = (v < 8) ? C_IDXQ + v * 32 : C_IDXK;
      float c, s; rope_cs(pos, f16[2 * j], c, s);
      const float x1 = h[base + j], x2 = h[base + 4 + j];
      h[base + j] = x1 * c - x2 * s; h[base + 4 + j] = x2 * c + x1 * s;
    } else if (tid < 212) {
      const int u = tid - 188;
      const float g = h[C_GATE + u];
      h[C_GATE + u] = 1.f / (1.f + expf(-g));
    }
  }
}

__device__ void compress_phase(const Params& p, unsigned char* smem, int bid, int nblk) {
  float* hid = (float*)smem;
  const int tid = threadIdx.x;
  const int which = tid >> 7, j = tid & 127;
  for (int item = bid; item < NB * 2 * NC; item += nblk) {
    const int i = item % NC, g = (item / NC) % 2, b = item / (NC * 2);
    const float* w1 = which ? p.w1v : p.w1k;
    const float* pe = which ? p.pe_v : p.pe_k;
    const int col = C_NSAKV + which * 128 + g * 64;
    float acc = 0.f;
    for (int l = 0; l < 32; l++) {
      const float* row = p.H + (size_t)(b * SEQ + i * 16 + l) * INW + col;
      for (int d = 0; d < 64; d++) acc = fmaf(row[d] + pe[l * 64 + d], w1[(size_t)(l * 64 + d) * 128 + j], acc);
    }
    hid[which * 128 + j] = gelu_exact(acc);
    __syncthreads();
    if (j < 64) {
      const float* w2 = which ? p.w2v : p.w2k;
      float o = 0.f;
      for (int k = 0; k < 128; k++) o = fmaf(hid[which * 128 + k], w2[k * 64 + j], o);
      float* dst = which ? p.vc : p.kc;
      dst[((size_t)(b * 2 + g) * NC + i) * 64 + j] = o;
    }
    __syncthreads();
  }
}

__device__ void softmax4(float* sc, int ld, int n) {
  const int w = threadIdx.x >> 6, lane = threadIdx.x & 63;
  float* s = sc + w * ld;
  float m = -INFINITY;
  for (int i = lane; i < n; i += 64) m = fmaxf(m, s[i]);
  m = wave_max(m);
  if (m == -INFINITY) m = 0.f;
  float sum = 0.f;
  for (int i = lane; i < n; i += 64) { float e = expf(s[i] - m); s[i] = e; sum += e; }
  sum = wave_sum(sum);
  const float inv = 1.f / (sum > 0.f ? sum : 1.f);
  for (int i = lane; i < n; i += 64) s[i] *= inv;
}

__device__ void nsa_phase(const Params& p, unsigned char* smem, int bid, int nblk) {
  float* q = (float*)smem;
  float* sc = q + 256;
  float* o3 = sc + 4096;
  float* imp = o3 + 768;
  int* sel = (int*)(imp + 64);
  int* nselp = sel + 16;
  const int tid = threadIdx.x, h = tid >> 6, d = tid & 63;
  for (int item = bid; item < NT * 2; item += nblk) {
    const int g = item & 1, tok = item >> 1, b = tok / SEQ, t = tok % SEQ;
    const float* Hb = p.H + (size_t)b * SEQ * INW;
    q[tid] = Hb[(size_t)t * INW + C_NSAQ + (g * 4 + h) * 64 + d];
    __syncthreads();
    const int nv = (t >= 31) ? (t - 31) / 16 + 1 : 0;
    const float* kcb = p.kc + (size_t)(b * 2 + g) * NC * 64;
    const float* vcb = p.vc + (size_t)(b * 2 + g) * NC * 64;
    for (int idx = tid; idx < 4 * 256; idx += 256) {
      const int hh = idx >> 8, i = idx & 255;
      float s = -INFINITY;
      if (i < nv) {
        s = 0.f;
        for (int e = 0; e < 64; e++) s = fmaf(q[hh * 64 + e], kcb[i * 64 + e], s);
        s *= 0.125f;
      }
      sc[hh * 1024 + i] = s;
    }
    __syncthreads();
    softmax4(sc, 1024, 256);
    __syncthreads();
    {
      float o = 0.f;
      for (int i = 0; i < nv; i++) o = fmaf(sc[h * 1024 + i], vcb[i * 64 + d], o);
      o3[0 * 256 + tid] = o;
    }
    const int cur = t / 64;
    if (tid < 64) {
      const int m = tid;
      float a = 0.f;
      const int n0 = max(0, 4 * m - 2), n1 = min(NC - 1, 4 * m + 4);
      for (int n = n0; n <= n1; n++) {
        const int ov = min(16 * n + 32, 64 * m + 64) - max(16 * n, 64 * m);
        if (ov > 0) {
          const float w = (float)ov * (1.f / 32.f);
          for (int hh = 0; hh < 4; hh++) a = fmaf(sc[hh * 1024 + n], w, a);
        }
      }
      const bool forced = (m == 0) || (m == cur) || (m == cur - 1);
      const bool vis = (m <= cur);
      imp[m] = vis ? a + (forced ? 1e4f : 0.f) : -INFINITY;
    }
    __syncthreads();
    if (tid < 64) {
      const int m = tid;
      const float sm = imp[m];
      int rank = 0;
      for (int mm = 0; mm < 64; mm++) { const float s2 = imp[mm]; rank += (s2 > sm) || (s2 == sm && mm < m); }
      const bool take = (rank < 16) && (m <= cur);
      const unsigned long long bal = __ballot(take);
      if (take) sel[__popcll(bal & ((1ull << m) - 1ull))] = m;
      if (m == 0) *nselp = __popcll(bal);
    }
    __syncthreads();
    const int nsel = *nselp;
    {
      const int nk = nsel * 64;
      for (int idx = tid; idx < 4 * nk; idx += 256) {
        const int hh = idx / nk, r = idx % nk;
        const int kpos = sel[r >> 6] * 64 + (r & 63);
        float s = -INFINITY;
        if (kpos <= t) {
          const float* kr = Hb + (size_t)kpos * INW + C_NSAKV + 2 * 128 + g * 64;
          s = 0.f;
          for (int e = 0; e < 64; e++) s = fmaf(q[hh * 64 + e], kr[e], s);
          s *= 0.125f;
        }
        sc[hh * 1024 + r] = s;
      }
      __syncthreads();
      softmax4(sc, 1024, nk);
      __syncthreads();
      float o = 0.f;
      for (int r = 0; r < nk; r++) {
        const int kpos = sel[r >> 6] * 64 + (r & 63);
        if (kpos <= t) o = fmaf(sc[h * 1024 + r], Hb[(size_t)kpos * INW + C_NSAKV + 3 * 128 + g * 64 + d], o);
      }
      o3[1 * 256 + tid] = o;
      __syncthreads();
    }
    {
      for (int idx = tid; idx < 4 * 512; idx += 256) {
        const int hh = idx >> 9, r = idx & 511;
        const int kpos = t - 511 + r;
        float s = -INFINITY;
        if (kpos >= 0) {
          const float* kr = Hb + (size_t)kpos * INW + C_NSAKV + 4 * 128 + g * 64;
          s = 0.f;
          for (int e = 0; e < 64; e++) s = fmaf(q[hh * 64 + e], kr[e], s);
          s *= 0.125f;
        }
        sc[hh * 1024 + r] = s;
      }
      __syncthreads();
      softmax4(sc, 1024, 512);
      __syncthreads();
      float o = 0.f;
      for (int r = 0; r < 512; r++) {
        const int kpos = t - 511 + r;
        if (kpos >= 0) o = fmaf(sc[h * 1024 + r], Hb[(size_t)kpos * INW + C_NSAKV + 5 * 128 + g * 64 + d], o);
      }
      o3[2 * 256 + tid] = o;
    }
    {
      const float* gt = Hb + (size_t)t * INW + C_GATE + (g * 4 + h) * 3;
      const float r = gt[0] * o3[tid] + gt[1] * o3[256 + tid] + gt[2] * o3[512 + tid];
      p.concat[(size_t)tok * DM + g * 256 + tid] = r;
    }
    __syncthreads();
  }
}

__device__ __forceinline__ unsigned f2key(float f) {
  unsigned u = __float_as_uint(f);
  return (u & 0x80000000u) ? ~u : (u | 0x80000000u);
}
__device__ void dsa_phase(const Params& p, unsigned char* smem, int bid, int nblk) {
  unsigned* keys = (unsigned*)smem;
  float* qi = (float*)(keys + 4096);
  float* wi = qi + 256;
  int* hist = (int*)(wi + 8);
  int* sel = hist + 256;
  int* misc = sel + 256;
  int* cnts = misc + 8;
  float* qd = (float*)(cnts + 256);
  float* sc = qd + 256;
  const int tid = threadIdx.x;
  for (int tok = bid; tok < NT; tok += nblk) {
    const int b = tok / SEQ, t = tok % SEQ;
    const float* Hb = p.H + (size_t)b * SEQ * INW;
    const float* ht = Hb + (size_t)t * INW;
    qi[tid] = ht[C_IDXQ + tid];
    if (tid < 8) wi[tid] = ht[C_IDXW + tid] * 0.0625f;
    qd[tid] = ht[C_DSAQ + tid];
    __syncthreads();
    const int n = t + 1;
    int nsel;
    if (n <= 256) {
      for (int s = tid; s < n; s += 256) sel[s] = s;
      nsel = n;
      __syncthreads();
    } else {
      for (int s = tid; s < n; s += 256) {
        const float* kr = Hb + (size_t)s * INW + C_IDXK;
        float kv[32];
#pragma unroll
        for (int e = 0; e < 32; e++) kv[e] = kr[e];
        float score = 0.f;
        for (int hh = 0; hh < 8; hh++) {
          float dsum = 0.f;
#pragma unroll
          for (int e = 0; e < 32; e++) dsum = fmaf(qi[hh * 32 + e], kv[e], dsum);
          score = fmaf(fmaxf(dsum, 0.f), wi[hh], score);
        }
        keys[s] = f2key(score);
      }
      unsigned prefix = 0; int kk = 256;
      for (int shift = 24; shift >= 0; shift -= 8) {
        hist[tid] = 0;
        __syncthreads();
        const unsigned hmask = (shift == 24) ? 0u : (0xFFFFFFFFu << (shift + 8));
        for (int s = tid; s < n; s += 256) {
          const unsigned k = keys[s];
          if ((k & hmask) == prefix) atomicAdd(&hist[(k >> shift) & 255], 1);
        }
        __syncthreads();
        if (tid == 0) {
          int cum = 0, dsel = 0;
          for (int dg = 255; dg >= 0; dg--) {
            const int c = hist[dg];
            if (cum + c >= kk) { dsel = dg; break; }
            cum += c;
          }
          misc[0] = dsel; misc[1] = kk - cum;
        }
        __syncthreads();
        prefix |= ((unsigned)misc[0]) << shift;
        kk = misc[1];
        __syncthreads();
      }
      const int per = (n + 255) / 256;
      const int s0 = tid * per, s1 = min(n, s0 + per);
      int cg_ = 0, ce = 0;
      for (int s = s0; s < s1; s++) { const unsigned k = keys[s]; cg_ += (k > prefix); ce += (k == prefix); }
      cnts[tid] = cg_; hist[tid] = ce;
      __syncthreads();
      if (tid == 0) {
        int a = 0, e = 0;
        for (int i = 0; i < 256; i++) { const int c1 = cnts[i], c2 = hist[i]; cnts[i] = a; hist[i] = e; a += c1; e += c2; }
        misc[2] = a;
      }
      __syncthreads();
      {
        int og = cnts[tid], oe = hist[tid];
        const int ngt = misc[2];
        for (int s = s0; s < s1; s++) {
          const unsigned k = keys[s];
          if (k > prefix) sel[og++] = s;
          else if (k == prefix) { if (oe < kk) sel[ngt + oe] = s; oe++; }
        }
      }
      nsel = 256;
      __syncthreads();
    }
    for (int idx = tid; idx < 4 * nsel; idx += 256) {
      const int hh = idx / nsel, r = idx % nsel;
      const float* kr = Hb + (size_t)sel[r] * INW + C_DSAK;
      float s = 0.f;
      for (int e = 0; e < 64; e++) s = fmaf(qd[hh * 64 + e], kr[e], s);
      sc[hh * 256 + r] = s * 0.125f;
    }
    __syncthreads();
    softmax4(sc, 256, nsel);
    __syncthreads();
    {
      const int h = tid >> 6, d = tid & 63;
      float o = 0.f;
      for (int r = 0; r < nsel; r++) o = fmaf(sc[h * 256 + r], Hb[(size_t)sel[r] * INW + C_DSAV + d], o);
      p.concat[(size_t)tok * DM + 512 + tid] = o;
    }
    __syncthreads();
  }
}

__device__ void mem_phase(const Params& p, unsigned char* smem, int bid, int nblk) {
  float* q = (float*)smem;
  float* sc = q + 256;
  const int tid = threadIdx.x;
  for (int tok = bid; tok < NT; tok += nblk) {
    const int b = tok / SEQ;
    q[tid] = p.H[(size_t)tok * INW + C_MEMQ + tid];
    __syncthreads();
    const float* kvb = p.mkv + (size_t)b * MEML * 512;
    for (int idx = tid; idx < 4 * 256; idx += 256) {
      const int hh = idx >> 8, m = idx & 255;
      const float* kr = kvb + (size_t)m * 512 + hh * 64;
      float s = 0.f;
      for (int e = 0; e < 64; e++) s = fmaf(q[hh * 64 + e], kr[e], s);
      sc[hh * 256 + m] = s * 0.125f;
    }
    __syncthreads();
    softmax4(sc, 256, 256);
    __syncthreads();
    {
      const int h = tid >> 6, d = tid & 63;
      float o = 0.f;
      for (int m = 0; m < 256; m++) o = fmaf(sc[h * 256 + m], kvb[(size_t)m * 512 + 256 + h * 64 + d], o);
      p.concat[(size_t)tok * DM + 768 + tid] = o;
    }
    __syncthreads();
  }
}

__device__ void ln_phase(const float* xin, const float* add, const float* gam, const float* bet, float* outp,
                         unsigned char* smem, int bid, int nblk) {
  float* red = (float*)smem;
  const int tid = threadIdx.x, w = tid >> 6, lane = tid & 63;
  for (int tok = bid; tok < NT; tok += nblk) {
    const float4 a = *(const float4*)(xin + (size_t)tok * DM + tid * 4);
    const float4 m = *(const float4*)(add + (size_t)tok * DM + tid * 4);
    float v[4] = {ALPHA * a.x + m.x, ALPHA * a.y + m.y, ALPHA * a.z + m.z, ALPHA * a.w + m.w};
    float s = wave_sum(v[0] + v[1] + v[2] + v[3]);
    if (lane == 0) red[w] = s;
    __syncthreads();
    const float mu = (red[0] + red[1] + red[2] + red[3]) * (1.f / DM);
    float qv = 0.f;
#pragma unroll
    for (int i = 0; i < 4; i++) { v[i] -= mu; qv += v[i] * v[i]; }
    qv = wave_sum(qv);
    if (lane == 0) red[4 + w] = qv;
    __syncthreads();
    const float rs = rsqrtf((red[4] + red[5] + red[6] + red[7]) * (1.f / DM) + 1e-5f);
    const float4 gg = *(const float4*)(gam + tid * 4), bb = *(const float4*)(bet + tid * 4);
    float4 o = {v[0] * rs * gg.x + bb.x, v[1] * rs * gg.y + bb.y, v[2] * rs * gg.z + bb.z, v[3] * rs * gg.w + bb.w};
    *(float4*)(outp + (size_t)tok * DM + tid * 4) = o;
    __syncthreads();
  }
}

__device__ void peer_route_phase(const Params& p, const float* Q, unsigned char* smem, int bid, int nblk) {
  float* q = (float*)smem;
  float* s12 = q + 512;
  float* tv = s12 + 512;
  int* ti = (int*)(tv + 64);
  float* cand = (float*)(ti + 64);
  float* topv = cand + 512;
  const int tid = threadIdx.x, hh = tid >> 7, n = tid & 127;
  for (int item = bid; item < NT * 4; item += nblk) {
    const int tok = item >> 2, hp = item & 3, head = hp * 2 + hh;
    q[tid] = Q[(size_t)tok * 2048 + hp * 512 + tid];
    q[256 + tid] = Q[(size_t)tok * 2048 + hp * 512 + 256 + tid];
    __syncthreads();
    {
      const float* qq = q + hh * 256;
      const float* k1 = p.sk1 + (size_t)n * 128;
      const float* k2 = p.sk2 + (size_t)n * 128;
      float a = 0.f, c = 0.f;
      for (int e = 0; e < 128; e++) { a = fmaf(qq[e], k1[e], a); c = fmaf(qq[128 + e], k2[e], c); }
      s12[(hh * 2 + 0) * 128 + n] = a; s12[(hh * 2 + 1) * 128 + n] = c;
    }
    __syncthreads();
    for (int which = 0; which < 2; which++) {
      const float* s = s12 + (hh * 2 + which) * 128;
      const float me = s[n];
      int rank = 0;
      for (int m = 0; m < 128; m++) { const float o = s[m]; rank += (o > me) || (o == me && m < n); }
      if (rank < 16) { tv[(hh * 2 + which) * 16 + rank] = me; ti[(hh * 2 + which) * 16 + rank] = n; }
    }
    __syncthreads();
    for (int c = n; c < 256; c += 128)
      cand[hh * 256 + c] = tv[(hh * 2 + 0) * 16 + (c >> 4)] + tv[(hh * 2 + 1) * 16 + (c & 15)];
    __syncthreads();
    for (int c = n; c < 256; c += 128) {
      const float me = cand[hh * 256 + c];
      int rank = 0;
      for (int m = 0; m < 256; m++) { const float o = cand[hh * 256 + m]; rank += (o > me) || (o == me && m < c); }
      if (rank < 16) {
        topv[hh * 16 + rank] = me;
        p.pexp[(size_t)tok * 128 + head * 16 + rank] = ti[(hh * 2 + 0) * 16 + (c >> 4)] * 128 + ti[(hh * 2 + 1) * 16 + (c & 15)];
      }
    }
    __syncthreads();
    if (n < 16) {
      const float mx = topv[hh * 16 + 0];
      float sum = 0.f;
      for (int k = 0; k < 16; k++) sum += expf(topv[hh * 16 + k] - mx);
      p.pgate[(size_t)tok * 128 + head * 16 + n] = expf(topv[hh * 16 + n] - mx) / sum;
    }
    __syncthreads();
  }
}

__device__ void peer_expert_phase(const Params& p, unsigned char* smem, int bid, int nblk) {
  float* xs = (float*)smem;
  float* aw = xs + 1024;
  int* ex = (int*)(aw + 128);
  float* red = (float*)(ex + 128);
  const int tid = threadIdx.x, w = tid >> 6, lane = tid & 63;
  for (int tok = bid; tok < NT; tok += nblk) {
    const float4 xv = *(const float4*)(p.out + (size_t)tok * DM + tid * 4);
    *(float4*)(xs + tid * 4) = xv;
    if (tid < 128) ex[tid] = p.pexp[(size_t)tok * 128 + tid];
    __syncthreads();
    for (int e = w; e < 128; e += 4) {
      const float* u = p.pu + (size_t)ex[e] * DM;
      float a = 0.f;
      for (int i = lane; i < DM; i += 64) a = fmaf(xs[i], u[i], a);
      a = wave_sum(a);
      if (lane == 0) aw[e] = p.pgate[(size_t)tok * 128 + e] * gelu_exact(a);
    }
    __syncthreads();
    float y[4] = {0.f, 0.f, 0.f, 0.f};
    for (int e = 0; e < 128; e++) {
      const float4 vv = *(const float4*)(p.pv + (size_t)ex[e] * DM + tid * 4);
      const float a = aw[e];
      y[0] = fmaf(a, vv.x, y[0]); y[1] = fmaf(a, vv.y, y[1]); y[2] = fmaf(a, vv.z, y[2]); y[3] = fmaf(a, vv.w, y[3]);
    }
    float v[4] = {ALPHA * xv.x + y[0], ALPHA * xv.y + y[1], ALPHA * xv.z + y[2], ALPHA * xv.w + y[3]};
    float s = wave_sum(v[0] + v[1] + v[2] + v[3]);
    if (lane == 0) red[w] = s;
    __syncthreads();
    const float mu = (red[0] + red[1] + red[2] + red[3]) * (1.f / DM);
    float qv = 0.f;
#pragma unroll
    for (int i = 0; i < 4; i++) { v[i] -= mu; qv += v[i] * v[i]; }
    qv = wave_sum(qv);
    if (lane == 0) red[4 + w] = qv;
    __syncthreads();
    const float rs = rsqrtf((red[4] + red[5] + red[6] + red[7]) * (1.f / DM) + 1e-5f);
    const float4 gg = *(const float4*)(p.ln2g + tid * 4), bb = *(const float4*)(p.ln2b + tid * 4);
    float4 o = {v[0] * rs * gg.x + bb.x, v[1] * rs * gg.y + bb.y, v[2] * rs * gg.z + bb.z, v[3] * rs * gg.w + bb.w};
    __syncthreads();
    *(float4*)(p.out + (size_t)tok * DM + tid * 4) = o;
  }
}

constexpr int SMEM_BYTES = 40960;
#define PHASE_KERNEL(name, body) \
  __global__ void __launch_bounds__(256) name(Params p) { \
    __shared__ __align__(16) unsigned char smem[SMEM_BYTES]; \
    const int bid = blockIdx.x, nblk = gridDim.x; (void)smem; (void)bid; (void)nblk; \
    body; \
  }
PHASE_KERNEL(k_gemm_in,  gemm_f32_phase(p.x, DM, p.w_in, INW, p.H, INW, NT, INW, DM, smem, bid, nblk))
PHASE_KERNEL(k_gemm_mem, gemm_f32_phase(p.mem, DM, p.w_mem_kv, 512, p.mkv, 512, NB * MEML, 512, DM, smem, bid, nblk))
PHASE_KERNEL(k_rope,     rope_phase(p, bid, nblk))
PHASE_KERNEL(k_compress, compress_phase(p, smem, bid, nblk))
PHASE_KERNEL(k_nsa,      nsa_phase(p, smem, bid, nblk))
PHASE_KERNEL(k_dsa,      dsa_phase(p, smem, bid, nblk))
PHASE_KERNEL(k_mem,      mem_phase(p, smem, bid, nblk))
PHASE_KERNEL(k_gemm_out, gemm_f32_phase(p.concat, DM, p.w_out, DM, p.out, DM, NT, DM, DM, smem, bid, nblk))
PHASE_KERNEL(k_ln1,      ln_phase(p.x, p.out, p.ln1g, p.ln1b, p.out, smem, bid, nblk))
PHASE_KERNEL(k_gemm_q,   gemm_f32_phase(p.out, DM, p.wq, 2048, p.H, 2048, NT, 2048, DM, smem, bid, nblk))
PHASE_KERNEL(k_route,    peer_route_phase(p, p.H, smem, bid, nblk))
PHASE_KERNEL(k_expert,   peer_expert_phase(p, smem, bid, nblk))

extern "C" void kernel_launch(void* const* d_in, const int* in_sizes, int n_in, void* d_out, int out_size,
                              void* d_ws, size_t ws_size, hipStream_t stream) {
  Params p{};
  p.x = (const float*)d_in[0]; p.mem = (const float*)d_in[1]; p.pos = (const int*)d_in[2];
  p.w_in = (const float*)d_in[3]; p.pe_k = (const float*)d_in[4]; p.pe_v = (const float*)d_in[5];
  p.w1k = (const float*)d_in[6]; p.w2k = (const float*)d_in[7]; p.w1v = (const float*)d_in[8]; p.w2v = (const float*)d_in[9];
  p.w_mem_kv = (const float*)d_in[10]; p.w_out = (const float*)d_in[11]; p.ln1g = (const float*)d_in[12]; p.ln1b = (const float*)d_in[13];
  p.wq = (const float*)d_in[14]; p.sk1 = (const float*)d_in[15]; p.sk2 = (const float*)d_in[16];
  p.pu = (const float*)d_in[17]; p.pv = (const float*)d_in[18]; p.ln2g = (const float*)d_in[19]; p.ln2b = (const float*)d_in[20];
  p.out = (float*)d_out;
  unsigned char* ws = (unsigned char*)d_ws;
  size_t off = 0;
  auto take = [&](size_t bytes) { void* r = ws + off; off += (bytes + 255) & ~(size_t)255; return r; };
  p.H = (float*)take((size_t)NT * INW * 4);
  p.concat = (float*)take((size_t)NT * DM * 4);
  p.kc = (float*)take((size_t)NB * 2 * NC * 64 * 4);
  p.vc = (float*)take((size_t)NB * 2 * NC * 64 * 4);
  p.mkv = (float*)take((size_t)NB * MEML * 512 * 4);
  p.pexp = (int*)take((size_t)NT * 128 * 4);
  p.pgate = (float*)take((size_t)NT * 128 * 4);
  if (off > ws_size) { fprintf(stderr, "workspace too small: need %zu have %zu\n", off, ws_size); return; }
  const int G = 256 * 8;
  k_gemm_in<<<G, 256, 0, stream>>>(p);
  k_gemm_mem<<<G, 256, 0, stream>>>(p);
  k_rope<<<G, 256, 0, stream>>>(p);
  k_compress<<<G, 256, 0, stream>>>(p);
  k_nsa<<<G, 256, 0, stream>>>(p);
  k_dsa<<<G, 256, 0, stream>>>(p);
  k_mem<<<G, 256, 0, stream>>>(p);
  k_gemm_out<<<G, 256, 0, stream>>>(p);
  k_ln1<<<G, 256, 0, stream>>>(p);
  k_gemm_q<<<G, 256, 0, stream>>>(p);
  k_route<<<G, 256, 0, stream>>>(p);
  k_expert<<<G, 256, 0, stream>>>(p);
}
```

```cpp
#include <hip/hip_runtime.h>
#include <hip/hip_cooperative_groups.h>
#include <cstdio>
#include <cstdint>
namespace cg = cooperative_groups;

constexpr int NB = 8, SEQ = 4096, DM = 1024, NT = NB * SEQ;
constexpr int INW = 2240;
constexpr int INWP = 2304;
constexpr int NC = 255;
constexpr int MEML = 256;
constexpr int C_NSAQ = 0, C_NSAKV = 512, C_GATE = 1280, C_DSAQ = 1304, C_DSAK = 1560, C_DSAV = 1624,
              C_IDXQ = 1688, C_IDXK = 1944, C_IDXW = 1976, C_MEMQ = 1984;
constexpr int P_NSAQ = 0, P_NSAKV = 512, P_DSAQ = 1280, P_DSAK = 1536, P_DSAV = 1600, P_IDXQ = 1664, P_IDXK = 1920,
              P_MEMQ = 1952, P_GATE = 2208, P_IDXW = 2232, P_END = 2240;
constexpr float ALPHA = 1.189207115002721f;

typedef unsigned short bf16_t;
typedef __attribute__((ext_vector_type(8))) __bf16 bf16x8;
typedef __attribute__((ext_vector_type(2))) __bf16 bf16x2;
typedef __attribute__((ext_vector_type(2))) float f32x2;
typedef __attribute__((ext_vector_type(4))) float f32x4;
typedef __attribute__((ext_vector_type(16))) float f32x16;

struct Params {
  const float *x, *mem; const int* pos;
  const float *w_in, *pe_k, *pe_v, *w1k, *w2k, *w1v, *w2v, *w_mem_kv, *w_out, *ln1g, *ln1b,
              *wq, *sk1, *sk2, *pu, *pv, *ln2g, *ln2b;
  float* out;
  bf16_t *xb, *memb, *wint, *wmemt, *woutt, *wqt, *sk1p, *sk2p;
  unsigned char *puq, *pvq;
  float *psu, *psv;
  float2* cs;
  bf16_t *qn;
  bf16_t *kvn[6];
  bf16_t *qd, *kd, *vd;
  bf16_t *qi, *ki;
  bf16_t *memq, *mkv;
  bf16_t *memvt;
  bf16_t *vslct, *vwint;
  bf16_t *w1kt, *w1vt; float* cbias;
  bf16_t *kcb, *vct;
  bf16_t *ovp;
  int *chkcnt;
  unsigned *bar;
  int never;
  int pad_;
  float *gates, *widx;
  bf16_t *concat;
  bf16_t *x1b;
  float *kc, *vc;
  int   *pexp;
  float *pgate;
  int   *flag;
};

__device__ __forceinline__ float bf2f(bf16_t u) { return __uint_as_float(((unsigned)u) << 16); }
__device__ __forceinline__ bf16_t f2bf(float f) { return __builtin_bit_cast(unsigned short, (__bf16)f); }
__device__ __forceinline__ unsigned pack2bf(float a, float b) {
  f32x2 v = {a, b};
  return __builtin_bit_cast(unsigned, __builtin_convertvector(v, bf16x2));
}

__device__ __forceinline__ float wave_sum(float v) {
#pragma unroll
  for (int o = 32; o > 0; o >>= 1) v += __shfl_xor(v, o);
  return v;
}
__device__ __forceinline__ float wave_max(float v) {
#pragma unroll
  for (int o = 32; o > 0; o >>= 1) v = fmaxf(v, __shfl_xor(v, o));
  return v;
}
__device__ __forceinline__ float gelu_exact(float x) { return 0.5f * x * (1.f + erff(x * 0.7071067811865476f)); }

__device__ __forceinline__ void convert_phase(const float* __restrict__ src, bf16_t* __restrict__ dst, size_t n, int bid, int nblk) {
  const size_t nch = n / 8, stride = (size_t)nblk * 256;
  size_t c = (size_t)bid * 256 + threadIdx.x;
  for (; c + 3 * stride < nch; c += 4 * stride) {
    float4 a[4], b[4];
#pragma unroll
    for (int u = 0; u < 4; u++) { a[u] = *(const float4*)(src + (c + u * stride) * 8); b[u] = *(const float4*)(src + (c + u * stride) * 8 + 4); }
#pragma unroll
    for (int u = 0; u < 4; u++) {
      uint4 o = {pack2bf(a[u].x, a[u].y), pack2bf(a[u].z, a[u].w), pack2bf(b[u].x, b[u].y), pack2bf(b[u].z, b[u].w)};
      *(uint4*)(dst + (c + u * stride) * 8) = o;
    }
  }
  for (; c < nch; c += stride) {
    const float4 a = *(const float4*)(src + c * 8), b = *(const float4*)(src + c * 8 + 4);
    uint4 o = {pack2bf(a.x, a.y), pack2bf(a.z, a.w), pack2bf(b.x, b.y), pack2bf(b.z, b.w)};
    *(uint4*)(dst + c * 8) = o;
  }
}
__device__ __forceinline__ unsigned quant4(const float4& v, float inv) {
  const unsigned a = (unsigned)(__float2int_rn(v.x * inv) + 128), b = (unsigned)(__float2int_rn(v.y * inv) + 128);
  const unsigned c = (unsigned)(__float2int_rn(v.z * inv) + 128), d = (unsigned)(__float2int_rn(v.w * inv) + 128);
  return a | (b << 8) | (c << 16) | (d << 24);
}
__device__ __forceinline__ float absmax4(const float4& v) { return fmaxf(fmaxf(fabsf(v.x), fabsf(v.y)), fmaxf(fabsf(v.z), fabsf(v.w))); }
__device__ __forceinline__ void quant_phase(const float* __restrict__ src, unsigned char* __restrict__ dst, float* __restrict__ scl,
                                            int nrows, int bid, int nblk) {
  const int lane = threadIdx.x & 63, gw = bid * 4 + (threadIdx.x >> 6), nw = nblk * 4;
  for (int r = gw * 2; r < nrows; r += nw * 2) {
    const float4* s0 = (const float4*)(src + (size_t)r * 1024 + 16 * lane);
    const float4* s1 = (const float4*)(src + (size_t)(r + 1) * 1024 + 16 * lane);
    const float4 a0 = s0[0], a1 = s0[1], a2 = s0[2], a3 = s0[3];
    const float4 b0 = s1[0], b1 = s1[1], b2 = s1[2], b3 = s1[3];
    const float ma = wave_max(fmaxf(fmaxf(absmax4(a0), absmax4(a1)), fmaxf(absmax4(a2), absmax4(a3))));
    const float mb = wave_max(fmaxf(fmaxf(absmax4(b0), absmax4(b1)), fmaxf(absmax4(b2), absmax4(b3))));
    const float ia = ma > 0.f ? 127.f / ma : 0.f, ib = mb > 0.f ? 127.f / mb : 0.f;
    *(uint4*)(dst + (size_t)r * 1024 + 16 * lane) = make_uint4(quant4(a0, ia), quant4(a1, ia), quant4(a2, ia), quant4(a3, ia));
    *(uint4*)(dst + (size_t)(r + 1) * 1024 + 16 * lane) = make_uint4(quant4(b0, ib), quant4(b1, ib), quant4(b2, ib), quant4(b3, ib));
    if (lane == 0) { scl[r] = ma * (1.f / 127.f); scl[r + 1] = mb * (1.f / 127.f); }
  }
}
__device__ __forceinline__ int inproj_colmap(int n) {
  if (n < P_DSAQ) return n;
  if (n < P_DSAK) return C_DSAQ + (n - P_DSAQ);
  if (n < P_IDXQ) return C_DSAK + (n - P_DSAK);
  if (n < P_IDXK) return C_IDXQ + (n - P_IDXQ);
  if (n < P_MEMQ) return C_IDXK + (n - P_IDXK);
  if (n < P_GATE) return C_MEMQ + (n - P_MEMQ);
  if (n < P_IDXW) return C_GATE + (n - P_GATE);
  if (n < P_END) return C_IDXW + (n - P_IDXW);
  return -1;
}
template <bool PERM>
__device__ __forceinline__ void transpose_phase(const float* __restrict__ src, int lds_, bf16_t* __restrict__ dst, int K, int Nd,
                                unsigned char* smem, int bid, int nblk) {
  float (*t)[65] = (float (*)[65])smem;
  const int tx = threadIdx.x & 63, ty = threadIdx.x >> 6;
  const int tk = K / 64, tn = Nd / 64;
  for (int tile = bid; tile < tk * tn; tile += nblk) {
    const int k0 = (tile % tk) * 64, n0 = (tile / tk) * 64;
    const int nsrc = PERM ? inproj_colmap(n0 + tx) : (n0 + tx);
#pragma unroll
    for (int i = 0; i < 16; i++) {
      const int k = ty + 4 * i;
      t[tx][k] = (nsrc >= 0) ? src[(size_t)(k0 + k) * lds_ + nsrc] : 0.f;
    }
    __syncthreads();
#pragma unroll
    for (int i = 0; i < 16; i++) {
      const int n = ty + 4 * i;
      dst[(size_t)(n0 + n) * K + k0 + tx] = f2bf(t[n][tx]);
    }
    __syncthreads();
  }
}
__device__ __forceinline__ void subkey_phase(const float* __restrict__ src, bf16_t* __restrict__ dst, int bid, int nblk) {
  for (int i = bid * 256 + threadIdx.x; i < 128 * 128; i += nblk * 256) {
    const int n = i >> 7, pos = i & 127, g16 = pos & ~15, pp = pos & 15, h = pp >> 3, j = pp & 7;
    dst[i] = f2bf(src[n * 128 + g16 + 8 * (j >> 2) + 4 * h + (j & 3)]);
  }
}
__device__ __forceinline__ void rope_cs(int pos, float freq, float& c, float& s) {
  double ang = (double)pos * (double)freq;
  double rev = ang * 0.15915494309189535;
  rev -= floor(rev + 0.5);
  float r = (float)(rev * 6.283185307179586);
  c = __cosf(r); s = __sinf(r);
}
__device__ __forceinline__ void cs_phase(const Params& p, int bid, int nblk) {
  const float f16[8] = {1.0f, 0.19392274474868576f, 0.03760603093086393f, 0.007292664737217109f,
                        0.001414213562373095f, 0.0002742481756762073f, 5.318295896944988e-05f, 1.031338537721246e-05f};
  for (int i = bid * 256 + threadIdx.x; i < NT * 8; i += nblk * 256) {
    float c, s; rope_cs(p.pos[i >> 3], f16[i & 7], c, s);
    p.cs[i] = make_float2(c, s);
  }
}

template <int WM, int WN>
struct Gemm {
  static constexpr int BM = 64 * WM, BN = 64 * WN;
  static constexpr int A_BYTES = BM * 128, B_BYTES = BN * 128, STAGE = A_BYTES + B_BYTES;
  static constexpr int SMEM = 2 * STAGE;
  static constexpr int NA = BM / 32, NBK = BN / 32;

  struct Stage8 { uint4 a0, a1, a2, a3, b0, b1, b2, b3; };
  static __device__ __forceinline__ Stage8 ld_stage(const bf16_t* ap0, const bf16_t* ap1, const bf16_t* ap2, const bf16_t* ap3,
                                                    const bf16_t* bp0, const bf16_t* bp1, const bf16_t* bp2, const bf16_t* bp3, int ko) {
    Stage8 r;
    r.a0 = *(const uint4*)(ap0 + ko); r.a1 = *(const uint4*)(ap1 + ko);
    if (NA > 2) { r.a2 = *(const uint4*)(ap2 + ko); r.a3 = *(const uint4*)(ap3 + ko); } else { r.a2 = r.a0; r.a3 = r.a0; }
    r.b0 = *(const uint4*)(bp0 + ko); r.b1 = *(const uint4*)(bp1 + ko);
    if (NBK > 2) { r.b2 = *(const uint4*)(bp2 + ko); r.b3 = *(const uint4*)(bp3 + ko); } else { r.b2 = r.b0; r.b3 = r.b0; }
    return r;
  }
  static __device__ __forceinline__ void st_stage(const Stage8 r, unsigned char* dst, int wofs) {
    *(uint4*)(dst + wofs) = r.a0; *(uint4*)(dst + wofs + 4096) = r.a1;
    if (NA > 2) { *(uint4*)(dst + wofs + 8192) = r.a2; *(uint4*)(dst + wofs + 12288) = r.a3; }
    *(uint4*)(dst + A_BYTES + wofs) = r.b0; *(uint4*)(dst + A_BYTES + wofs + 4096) = r.b1;
    if (NBK > 2) { *(uint4*)(dst + A_BYTES + wofs + 8192) = r.b2; *(uint4*)(dst + A_BYTES + wofs + 12288) = r.b3; }
  }
  static __device__ __forceinline__ void compute_stage(f32x16 (&acc)[WM][WN], const unsigned char* cur, int wm, int wn, int fr, int fh) {
#pragma unroll
    for (int s = 0; s < 4; s++) {
      const int chunk = 2 * s + fh;
      bf16x8 af[WM], bfr[WN];
#pragma unroll
      for (int i = 0; i < WM; i++) {
        const int row = (wm * WM + i) * 32 + fr;
        af[i] = *(const bf16x8*)(cur + row * 128 + ((chunk ^ ((row >> 1) & 7)) << 4));
      }
#pragma unroll
      for (int j = 0; j < WN; j++) {
        const int row = (wn * WN + j) * 32 + fr;
        bfr[j] = *(const bf16x8*)(cur + A_BYTES + row * 128 + ((chunk ^ ((row >> 1) & 7)) << 4));
      }
#pragma unroll
      for (int i = 0; i < WM; i++)
#pragma unroll
        for (int j = 0; j < WN; j++) acc[i][j] = __builtin_amdgcn_mfma_f32_32x32x16_bf16(af[i], bfr[j], acc[i][j], 0, 0, 0);
    }
  }
  template <class ARow, class BRow>
  static __device__ __forceinline__ void mainloop(f32x16 (&acc)[WM][WN], ARow arow, BRow brow, int K, unsigned char* smem) {
    const int tid = threadIdx.x, lane = tid & 63, w = tid >> 6, wm = w >> 1, wn = w & 1;
    const int lrow = tid >> 3, lchunk = tid & 7;
    const bf16_t* ap0 = arow(lrow) + lchunk * 8;
    const bf16_t* ap1 = arow(lrow + 32) + lchunk * 8;
    const bf16_t* ap2 = (NA > 2) ? arow(lrow + 64) + lchunk * 8 : ap0;
    const bf16_t* ap3 = (NA > 2) ? arow(lrow + 96) + lchunk * 8 : ap0;
    const bf16_t* bp0 = brow(lrow) + lchunk * 8;
    const bf16_t* bp1 = brow(lrow + 32) + lchunk * 8;
    const bf16_t* bp2 = (NBK > 2) ? brow(lrow + 64) + lchunk * 8 : bp0;
    const bf16_t* bp3 = (NBK > 2) ? brow(lrow + 96) + lchunk * 8 : bp0;
    const int wofs = lrow * 128 + ((lchunk ^ ((lrow >> 1) & 7)) << 4);
    const int fr = lane & 31, fh = lane >> 5;
    const int nk = K / 64;
    Stage8 rA = ld_stage(ap0, ap1, ap2, ap3, bp0, bp1, bp2, bp3, 0);
    Stage8 rB = ld_stage(ap0, ap1, ap2, ap3, bp0, bp1, bp2, bp3, 64);
    st_stage(rA, smem, wofs);
    rA = ld_stage(ap0, ap1, ap2, ap3, bp0, bp1, bp2, bp3, (nk > 2 ? 2 : 0) * 64);
    __syncthreads();
#pragma unroll 1
    for (int kt = 0; kt < nk; kt += 2) {
      compute_stage(acc, smem, wm, wn, fr, fh);
      st_stage(rB, smem + STAGE, wofs);
      if (kt + 3 < nk) rB = ld_stage(ap0, ap1, ap2, ap3, bp0, bp1, bp2, bp3, (kt + 3) * 64);
      __syncthreads();
      compute_stage(acc, smem + STAGE, wm, wn, fr, fh);
      if (kt + 2 < nk) {
        st_stage(rA, smem, wofs);
        if (kt + 4 < nk) rA = ld_stage(ap0, ap1, ap2, ap3, bp0, bp1, bp2, bp3, (kt + 4) * 64);
      }
      __syncthreads();
    }
  }
};

__device__ __forceinline__ int perm16(int k) { return (k & ~12) | ((k & 4) << 1) | ((k & 8) >> 1); }
constexpr float LOG2E = 1.4426950408889634f;
constexpr int FL_TILE = 8192;
constexpr int FL_STAGE = 2 * FL_TILE;
struct FlashAcc {
  f32x16 o[2];
  float m, l;
};
__device__ __forceinline__ void flash_init(FlashAcc& a) {
#pragma unroll
  for (int i = 0; i < 2; i++)
#pragma unroll
    for (int r = 0; r < 16; r++) a.o[i][r] = 0.f;
  a.m = -INFINITY; a.l = 0.f;
}
struct Tile2 { uint4 a, b; };
template <class RowF>
__device__ __forceinline__ Tile2 tile_fetch(RowF rowp) {
  const int tid = threadIdx.x;
  Tile2 t;
  t.a = *(const uint4*)(rowp(tid >> 3) + (tid & 7) * 8);
  t.b = *(const uint4*)(rowp((tid >> 3) + 32) + (tid & 7) * 8);
  return t;
}
__device__ __forceinline__ void tile_store(const Tile2& t, unsigned char* dst) {
  const int tid = threadIdx.x, row = tid >> 3, ch = tid & 7;
  const int ofs = row * 128 + ((ch ^ ((row >> 1) & 7)) << 4);
  *(uint4*)(dst + ofs) = t.a;
  *(uint4*)(dst + ofs + 4096) = t.b;
}
__device__ __forceinline__ bf16x8 lds_frag(const unsigned char* tile, int row, int chunk) {
  return *(const bf16x8*)(tile + row * 128 + ((chunk ^ ((row >> 1) & 7)) << 4));
}
__device__ __forceinline__ void flash_qk(f32x16 (&s)[2], const unsigned char* ktile, const bf16x8 (&qf)[4]) {
  const int lane = threadIdx.x & 63, fr = lane & 31, fh = lane >> 5;
#pragma unroll
  for (int kt = 0; kt < 2; kt++) {
#pragma unroll
    for (int r = 0; r < 16; r++) s[kt][r] = 0.f;
#pragma unroll
    for (int ks = 0; ks < 4; ks++)
      s[kt] = __builtin_amdgcn_mfma_f32_32x32x16_bf16(lds_frag(ktile, kt * 32 + fr, 2 * ks + fh), qf[ks], s[kt], 0, 0, 0);
    asm volatile("" ::: "memory");
  }
}
__device__ __forceinline__ bf16x8 pack_frag(const f32x16& s, int half8) {
  uint4 u = {pack2bf(s[8 * half8 + 0], s[8 * half8 + 1]), pack2bf(s[8 * half8 + 2], s[8 * half8 + 3]),
             pack2bf(s[8 * half8 + 4], s[8 * half8 + 5]), pack2bf(s[8 * half8 + 6], s[8 * half8 + 7])};
  return __builtin_bit_cast(bf16x8, u);
}
__device__ __forceinline__ void flash_update(FlashAcc& a, f32x16 (&s)[2], const unsigned char* vtile, bool colvalid = true) {
  const int lane = threadIdx.x & 63, fr = lane & 31, fh = lane >> 5;
  float mx = fmaxf(s[0][0], s[1][0]);
#pragma unroll
  for (int r = 1; r < 16; r += 1) mx = __builtin_fmaxf(mx, __builtin_fmaxf(s[0][r], s[1][r]));
  mx = fmaxf(mx, __shfl_xor(mx, 32));
  mx = colvalid ? mx : -INFINITY;
  const float mnew = fmaxf(a.m, mx);
  const float muse = (mnew == -INFINITY) ? 0.f : mnew;
  if (__any(mnew != a.m)) {
    const float alpha = __builtin_amdgcn_exp2f((a.m - muse) * LOG2E);
    a.l *= alpha;
#pragma unroll
    for (int dt = 0; dt < 2; dt++)
#pragma unroll
      for (int r = 0; r < 16; r++) a.o[dt][r] *= alpha;
    a.m = mnew;
  }
  const float cb = colvalid ? -muse * LOG2E : -INFINITY;
  float sum0 = 0.f, sum1 = 0.f;
#pragma unroll
  for (int r = 0; r < 16; r++) {
    const float p0 = __builtin_amdgcn_exp2f(fmaf(s[0][r], LOG2E, cb));
    const float p1 = __builtin_amdgcn_exp2f(fmaf(s[1][r], LOG2E, cb));
    s[0][r] = p0; s[1][r] = p1; sum0 += p0; sum1 += p1;
  }
  a.l += sum0 + sum1;
#pragma unroll
  for (int kt = 0; kt < 2; kt++)
#pragma unroll
    for (int h8 = 0; h8 < 2; h8++) {
      const bf16x8 pf = pack_frag(s[kt], h8);
#pragma unroll
      for (int dt = 0; dt < 2; dt++)
        a.o[dt] = __builtin_amdgcn_mfma_f32_32x32x16_bf16(lds_frag(vtile, dt * 32 + fr, 4 * kt + 2 * h8 + fh), pf, a.o[dt], 0, 0, 0);
      asm volatile("" ::: "memory");
    }
}
__device__ __forceinline__ float flash_inv_l(const FlashAcc& a) {
  const float lt = a.l + __shfl_xor(a.l, 32);
  return lt > 0.f ? 1.f / lt : 0.f;
}
__device__ __forceinline__ void flash_load_q(bf16x8 (&qf)[4], const bf16_t* qrow, float scale) {
  const int fh = (threadIdx.x & 63) >> 5;
#pragma unroll
  for (int ks = 0; ks < 4; ks++) {
    const uint4 u = *(const uint4*)(qrow + ks * 16 + fh * 8);
    const unsigned w[4] = {u.x, u.y, u.z, u.w};
    uint4 o;
    o.x = pack2bf(__uint_as_float(w[0] << 16) * scale, __uint_as_float(w[0] & 0xFFFF0000u) * scale);
    o.y = pack2bf(__uint_as_float(w[1] << 16) * scale, __uint_as_float(w[1] & 0xFFFF0000u) * scale);
    o.z = pack2bf(__uint_as_float(w[2] << 16) * scale, __uint_as_float(w[2] & 0xFFFF0000u) * scale);
    o.w = pack2bf(__uint_as_float(w[3] << 16) * scale, __uint_as_float(w[3] & 0xFFFF0000u) * scale);
    qf[ks] = __builtin_bit_cast(bf16x8, o);
  }
}
__device__ __forceinline__ void flash_store_o(const FlashAcc& a, bf16_t* orow, float scale) {
  const int fh = (threadIdx.x & 63) >> 5;
#pragma unroll
  for (int dt = 0; dt < 2; dt++)
#pragma unroll
    for (int g4 = 0; g4 < 4; g4++) {
      uint2 o = {pack2bf(a.o[dt][4 * g4 + 0] * scale, a.o[dt][4 * g4 + 1] * scale),
                 pack2bf(a.o[dt][4 * g4 + 2] * scale, a.o[dt][4 * g4 + 3] * scale)};
      *(uint2*)(orow + dt * 32 + 8 * g4 + 4 * fh) = o;
    }
}

__device__ __forceinline__ void mem_flash_item(const Params& p, unsigned char* smem, int item) {
  const int tid = threadIdx.x, lane = tid & 63, w = tid >> 6, fr = lane & 31;
  const int chunk = item & 31, h = (item >> 5) & 3, b = item >> 7;
  const int tok = b * SEQ + chunk * 128 + w * 32 + fr;
  bf16x8 qf[4];
  flash_load_q(qf, p.memq + (size_t)tok * 256 + h * 64, 0.125f);
  FlashAcc acc; flash_init(acc);
  const bf16_t* kbase = p.mkv + (size_t)b * MEML * 512 + h * 64;
  const bf16_t* vbase = p.memvt + (size_t)(b * 4 + h) * 64 * MEML;
  Tile2 rk = tile_fetch([&](int r) { return kbase + (size_t)r * 512; });
  Tile2 rv = tile_fetch([&](int r) { return vbase + (size_t)r * MEML; });
  __syncthreads();
  tile_store(rk, smem); tile_store(rv, smem + FL_TILE);
  __syncthreads();
#pragma unroll 1
  for (int kb = 0; kb < 4; kb++) {
    unsigned char* cur = smem + (kb & 1) * FL_STAGE;
    if (kb + 1 < 4) {
      rk = tile_fetch([&](int r) { return kbase + (size_t)((kb + 1) * 64 + r) * 512; });
      rv = tile_fetch([&](int r) { return vbase + (size_t)r * MEML + (kb + 1) * 64; });
    }
    {
      f32x16 s[2];
      flash_qk(s, cur, qf);
      flash_update(acc, s, cur + FL_TILE);
    }
    if (kb + 1 < 4) { unsigned char* nxt = smem + ((kb + 1) & 1) * FL_STAGE; tile_store(rk, nxt); tile_store(rv, nxt + FL_TILE); }
    __syncthreads();
  }
  flash_store_o(acc, p.concat + (size_t)tok * DM + 768 + h * 64, flash_inv_l(acc));
}
__device__ __forceinline__ void mem_phase(const Params& p, unsigned char* smem, int bid, int nblk) {
  for (int item = bid; item < NB * 4 * 32; item += nblk) mem_flash_item(p, smem, item);
}

__device__ __forceinline__ void ovp_phase(const Params& p, int bid, int nblk) {
  for (int i = bid * 256 + threadIdx.x; i < 64 * 256; i += nblk * 256) {
    const int m = i >> 8, n = i & 255;
    int ov = min(16 * n + 32, 64 * m + 64) - max(16 * n, 64 * m);
    if (ov < 0 || n >= NC) ov = 0;
    p.ovp[m * 256 + perm16(n)] = f2bf((float)ov * (1.f / 32.f));
  }
}

struct TileDest { bf16_t* ptr; int stride; int kind; };
__device__ __forceinline__ TileDest inproj_dest(const Params& p, int cb, int b) {
  TileDest d; d.kind = 0;
  if (cb < P_NSAKV) { d.ptr = p.qn + cb; d.stride = 512; d.kind = ((cb & 63) == 0) ? 1 : 0; }
  else if (cb < P_DSAQ) {
    const int o = cb - P_NSAKV, j = o >> 7, g = (o >> 6) & 1;
    if (j == 3 || j == 5) {
      d.ptr = (j == 3 ? p.vslct : p.vwint) + ((size_t)(b * 2 + g) * 64 + (o & 63)) * SEQ; d.stride = 0; d.kind = 5;
    } else {
      bf16_t* base = (j == 0) ? p.kvn[0] : (j == 1) ? p.kvn[1] : (j == 2) ? p.kvn[2] : p.kvn[4];
      d.ptr = base + ((size_t)g * SEQ + (size_t)b * SEQ) * 64 + (o & 63); d.stride = 64;
      d.kind = (((j & 1) == 0) && ((o & 63) == 0)) ? 1 : 0;
    }
  }
  else if (cb < P_DSAK) { d.ptr = p.qd + (cb - P_DSAQ); d.stride = 256; d.kind = ((cb & 63) == 0) ? 1 : 0; }
  else if (cb < P_DSAV) { d.ptr = p.kd + (cb - P_DSAK); d.stride = 64; d.kind = (cb == P_DSAK) ? 1 : 0; }
  else if (cb < P_IDXQ) { d.ptr = p.vd + (cb - P_DSAV); d.stride = 64; }
  else if (cb < P_IDXK) { d.ptr = p.qi + (cb - P_IDXQ); d.stride = 256; d.kind = 2; }
  else if (cb < P_MEMQ) { d.ptr = p.ki; d.stride = 32; d.kind = 2; }
  else if (cb < P_GATE) { d.ptr = p.memq + (cb - P_MEMQ); d.stride = 256; }
  else if (cb < P_END) { d.ptr = nullptr; d.stride = 0; d.kind = 3; }
  else { d.ptr = nullptr; d.stride = 0; d.kind = 4; }
  return d;
}
__device__ __forceinline__ void inproj_phase(const Params& p, unsigned char* smem, int bid, int nblk) {
  typedef Gemm<2, 2> G;
  const int lane = threadIdx.x & 63, w = threadIdx.x >> 6, wm = w >> 1, wn = w & 1;
  const int c = lane & 31, fh = lane >> 5;
  constexpr int TN = INWP / 128, TM = NT / 128;
  constexpr int TN2 = 512 / 128, TM2 = NB * MEML / 128;
  for (int tile = bid; tile < TM * TN + TM2 * TN2; tile += nblk) {
    f32x16 acc[2][2];
#pragma unroll
    for (int i = 0; i < 2; i++)
#pragma unroll
      for (int j = 0; j < 2; j++)
#pragma unroll
        for (int r = 0; r < 16; r++) acc[i][j][r] = 0.f;
    if (tile < TM * TN) {
      const int m0 = (tile / TN) * 128, n0 = (tile % TN) * 128;
      const bf16_t* A = p.xb + (size_t)m0 * DM;
      const bf16_t* Bt = p.wint + (size_t)n0 * DM;
      G::mainloop(acc, [&](int r) { return A + (size_t)r * DM; }, [&](int r) { return Bt + (size_t)r * DM; }, DM, smem);
      const int b = m0 / SEQ;
      unsigned char* wt = smem + w * 9216;
      const TileDest d0 = inproj_dest(p, n0 + (wn * 2 + 0) * 32, b);
      const TileDest d1 = inproj_dest(p, n0 + (wn * 2 + 1) * 32, b);
#pragma unroll
      for (int j = 0; j < 2; j++) {
        const TileDest d = j ? d1 : d0;
        if (d.kind == 4) continue;
        if (d.kind == 5) {
#pragma unroll
          for (int i = 0; i < 2; i++)
#pragma unroll
            for (int g4 = 0; g4 < 4; g4++) {
              const int tloc = (m0 & (SEQ - 1)) + (wm * 2 + i) * 32 + 8 * g4 + 4 * fh;
              uint2 o = {pack2bf(acc[i][j][4 * g4 + 0], acc[i][j][4 * g4 + 1]), pack2bf(acc[i][j][4 * g4 + 2], acc[i][j][4 * g4 + 3])};
              *(uint2*)(d.ptr + (size_t)c * SEQ + perm16(tloc)) = o;
            }
          continue;
        }
        if (d.kind == 3) {
#pragma unroll
          for (int i = 0; i < 2; i++)
#pragma unroll
            for (int r = 0; r < 16; r++) {
              const int tok = m0 + (wm * 2 + i) * 32 + (r & 3) + 8 * (r >> 2) + 4 * fh;
              const float v = acc[i][j][r];
              if (c < 24) p.gates[(size_t)tok * 24 + c] = 1.f / (1.f + __expf(-v));
              else p.widx[(size_t)tok * 8 + (c - 24)] = v * 0.0625f;
            }
          continue;
        }
#pragma unroll
        for (int i = 0; i < 2; i++) {
#pragma unroll
          for (int r = 0; r < 16; r++) {
            const int tok = m0 + (wm * 2 + i) * 32 + (r & 3) + 8 * (r >> 2) + 4 * fh;
            float v = acc[i][j][r];
            if (d.kind == 1) {
              const float pv = __shfl_xor(v, 8);
              if (c < 16) {
                const float2 cs = p.cs[(size_t)tok * 8 + (c & 7)];
                v = (c & 8) ? (v * cs.x + pv * cs.y) : (v * cs.x - pv * cs.y);
              }
            } else if (d.kind == 2) {
              const float pv = __shfl_xor(v, 4);
              if (c < 8) {
                const float2 cs = p.cs[(size_t)tok * 8 + 2 * (c & 3)];
                v = (c & 4) ? (v * cs.x + pv * cs.y) : (v * cs.x - pv * cs.y);
              }
            }
            acc[i][j][r] = v;
          }
#pragma unroll
          for (int r = 0; r < 16; r += 2) {
            const float va = acc[i][j][r], vb = acc[i][j][r + 1];
            const float na = __builtin_bit_cast(float, __builtin_amdgcn_update_dpp(0, __builtin_bit_cast(int, va), 0xB1, 0xF, 0xF, true));
            const float nb = __builtin_bit_cast(float, __builtin_amdgcn_update_dpp(0, __builtin_bit_cast(int, vb), 0xB1, 0xF, 0xF, true));
            const bool odd = c & 1;
            const unsigned pk = pack2bf(odd ? nb : va, odd ? vb : na);
            const int row = i * 32 + (r & 3) + 8 * (r >> 2) + 4 * fh + (odd ? 1 : 0);
            *(unsigned*)(wt + row * 144 + j * 64 + (c & ~1) * 2) = pk;
          }
        }
      }
      __builtin_amdgcn_wave_barrier();
      {
        const int chunk = lane & 7, jt = chunk >> 2;
        const TileDest d = jt ? d1 : d0;
        if (d.kind <= 2) {
#pragma unroll
          for (int it = 0; it < 8; it++) {
            const int row = it * 8 + (lane >> 3);
            const uint4 v = *(const uint4*)(wt + row * 144 + chunk * 16);
            const int tok = m0 + wm * 64 + row;
            *(uint4*)(d.ptr + (size_t)tok * d.stride + (chunk & 3) * 8) = v;
          }
        }
      }
      __syncthreads();
    } else {
      const int t2 = tile - TM * TN;
      const int m0 = (t2 / TN2) * 128, n0 = (t2 % TN2) * 128;
      const bf16_t* A = p.memb + (size_t)m0 * DM;
      const bf16_t* Bt = p.wmemt + (size_t)n0 * DM;
      G::mainloop(acc, [&](int r) { return A + (size_t)r * DM; }, [&](int r) { return Bt + (size_t)r * DM; }, DM, smem);
#pragma unroll
      for (int i = 0; i < 2; i++)
#pragma unroll
        for (int j = 0; j < 2; j++)
          {
            const int cb = n0 + (wn * 2 + j) * 32;
            if (cb < 256) {
#pragma unroll
              for (int r = 0; r < 16; r++) {
                const int row = m0 + (wm * 2 + i) * 32 + (r & 3) + 8 * (r >> 2) + 4 * fh;
                p.mkv[(size_t)row * 512 + cb + c] = f2bf(acc[i][j][r]);
              }
            } else {
              const int dfull = cb + c - 256, head = dfull >> 6, d = dfull & 63;
              const int rowb = m0 + (wm * 2 + i) * 32, b = rowb >> 8, ml = rowb & 255;
              bf16_t* vrow = p.memvt + ((size_t)(b * 4 + head) * 64 + d) * MEML;
#pragma unroll
              for (int g4 = 0; g4 < 4; g4++) {
                uint2 o = {pack2bf(acc[i][j][4 * g4 + 0], acc[i][j][4 * g4 + 1]), pack2bf(acc[i][j][4 * g4 + 2], acc[i][j][4 * g4 + 3])};
                *(uint2*)(vrow + perm16(ml + 8 * g4 + 4 * fh)) = o;
              }
            }
          }
    }
  }
}

__device__ __forceinline__ unsigned f2key(float f) {
  unsigned u = __float_as_uint(f);
  return (u & 0x80000000u) ? ~u : (u | 0x80000000u);
}
__device__ __forceinline__ float key2f(unsigned k) {
  return __uint_as_float((k & 0x80000000u) ? (k ^ 0x80000000u) : ~k);
}
#define CE_DESC(a, b) { const unsigned _h = max(a, b); const unsigned _l = min(a, b); a = _h; b = _l; }
__device__ __forceinline__ void bitonic_merge16(unsigned (&m)[16]) {
#pragma unroll
  for (int st = 8; st >= 1; st >>= 1)
#pragma unroll
    for (int k = 0; k < 16; k++)
      if ((k & st) == 0) CE_DESC(m[k], m[k + st]);
}
__device__ __forceinline__ void insert16(unsigned (&L)[16], unsigned x) {
#pragma unroll
  for (int k = 0; k < 16; k++) { const unsigned hi = max(L[k], x); x = min(L[k], x); L[k] = hi; }
}
__device__ __forceinline__ void merge4_lists(unsigned (&L)[16], unsigned* lists, int t, int q) {
#pragma unroll
  for (int k = 0; k < 16; k++) lists[(q * 16 + k) * 64 + t] = L[k];
  __syncthreads();
  if (q < 2) {
#pragma unroll
    for (int k = 0; k < 16; k++) L[k] = max(lists[((2 * q) * 16 + k) * 64 + t], lists[((2 * q + 1) * 16 + 15 - k) * 64 + t]);
    bitonic_merge16(L);
#pragma unroll
    for (int k = 0; k < 16; k++) lists[((2 * q) * 16 + k) * 64 + t] = L[k];
  }
  __syncthreads();
  if (q == 0) {
#pragma unroll
    for (int k = 0; k < 16; k++) L[k] = max(L[k], lists[(2 * 16 + 15 - k) * 64 + t]);
    bitonic_merge16(L);
  }
}
__device__ __forceinline__ float dpp_rowsum(float x) {
  x += __builtin_bit_cast(float, __builtin_amdgcn_update_dpp(0, __builtin_bit_cast(int, x), 0xB1, 0xF, 0xF, true));
  x += __builtin_bit_cast(float, __builtin_amdgcn_update_dpp(0, __builtin_bit_cast(int, x), 0x4E, 0xF, 0xF, true));
  x += __builtin_bit_cast(float, __builtin_amdgcn_update_dpp(0, __builtin_bit_cast(int, x), 0x141, 0xF, 0xF, true));
  x += __builtin_bit_cast(float, __builtin_amdgcn_update_dpp(0, __builtin_bit_cast(int, x), 0x140, 0xF, 0xF, true));
  return x;
}
__device__ __forceinline__ float readlane_f(float v, int l) {
  return __int_as_float(__builtin_amdgcn_readlane(__float_as_int(v), l));
}
__device__ __forceinline__ float wave_sum_uniform(float x) {
  x = dpp_rowsum(x);
  return (readlane_f(x, 0) + readlane_f(x, 16)) + (readlane_f(x, 32) + readlane_f(x, 48));
}
__device__ __forceinline__ float dot8_bf16(const uint4& a, const uint4& b, float acc) {
  acc = __builtin_amdgcn_fdot2_f32_bf16(__builtin_bit_cast(bf16x2, a.x), __builtin_bit_cast(bf16x2, b.x), acc, false);
  acc = __builtin_amdgcn_fdot2_f32_bf16(__builtin_bit_cast(bf16x2, a.y), __builtin_bit_cast(bf16x2, b.y), acc, false);
  acc = __builtin_amdgcn_fdot2_f32_bf16(__builtin_bit_cast(bf16x2, a.z), __builtin_bit_cast(bf16x2, b.z), acc, false);
  acc = __builtin_amdgcn_fdot2_f32_bf16(__builtin_bit_cast(bf16x2, a.w), __builtin_bit_cast(bf16x2, b.w), acc, false);
  return acc;
}
__device__ __forceinline__ void fma8_bf16(float (&y)[8], const uint4& v, float w) {
  y[0] = fmaf(w, __uint_as_float(v.x << 16), y[0]); y[1] = fmaf(w, __uint_as_float(v.x & 0xFFFF0000u), y[1]);
  y[2] = fmaf(w, __uint_as_float(v.y << 16), y[2]); y[3] = fmaf(w, __uint_as_float(v.y & 0xFFFF0000u), y[3]);
  y[4] = fmaf(w, __uint_as_float(v.z << 16), y[4]); y[5] = fmaf(w, __uint_as_float(v.z & 0xFFFF0000u), y[5]);
  y[6] = fmaf(w, __uint_as_float(v.w << 16), y[6]); y[7] = fmaf(w, __uint_as_float(v.w & 0xFFFF0000u), y[7]);
}
__device__ const unsigned char cand_tab[52] = {
  0x00,0x01,0x02,0x03,0x04,0x05,0x06,0x07,0x08,0x09,0x0A,0x0B,0x0C,0x0D,0x0E,0x0F,
  0x10,0x11,0x12,0x13,0x14,0x15,0x16,0x17,
  0x20,0x21,0x22,0x23,0x24,
  0x30,0x31,0x32,0x33,
  0x40,0x41,0x42,
  0x50,0x51, 0x60,0x61, 0x70,0x71,
  0x80,0x90,0xA0,0xB0,0xC0,0xD0,0xE0,0xF0, 0xF0,0xF0};

typedef __attribute__((ext_vector_type(2))) _Float16 f16x2;
__device__ __forceinline__ f16x2 bytes01_h2(unsigned w) { return __builtin_bit_cast(f16x2, __builtin_amdgcn_perm(w, 0x64646464u, 0x00050004u)); }
__device__ __forceinline__ f16x2 bytes23_h2(unsigned w) { return __builtin_bit_cast(f16x2, __builtin_amdgcn_perm(w, 0x64646464u, 0x00070006u)); }
constexpr int PE_EXPERT_DEPTH = 8;

__device__ __forceinline__ void peer_block_phase(const Params& p, unsigned char* smem, int bid, int nblk) {
  const int tid = threadIdx.x, lane = tid & 63, w = tid >> 6, wm = w >> 1, wn = w & 1;
  const int c = lane & 31, fh = lane >> 5;
  float* S = (float*)smem;
  unsigned* lists = (unsigned*)(smem + 32768);
  unsigned* ablist = (unsigned*)(smem + 49152);
  int* fin_e = (int*)(smem + 57344);
  float* fin_g = (float*)(smem + 57344 + 4096);
  for (int blk = bid; blk < NT / 64; blk += nblk) {
    const int t0 = blk * 64;
#pragma unroll 1
    for (int nt = 0; nt < 8; nt++) {
      f32x16 acc[1][2];
#pragma unroll
      for (int j = 0; j < 2; j++)
#pragma unroll
        for (int r = 0; r < 16; r++) acc[0][j][r] = 0.f;
      const bf16_t* A = p.concat + (size_t)t0 * DM;
      const bf16_t* Bt = p.woutt + (size_t)nt * 128 * DM;
      Gemm<1, 2>::mainloop(acc, [&](int r) { return A + (size_t)r * DM; }, [&](int r) { return Bt + (size_t)r * DM; }, DM, smem);
      {
        const unsigned ebase = (unsigned)(t0 + wm * 32 + 4 * fh) * DM + nt * 128 + wn * 64 + c;
#pragma unroll
        for (int j = 0; j < 2; j++) {
#pragma unroll
          for (int r = 0; r < 16; r++) {
            const unsigned idx = ebase + (unsigned)(((r & 3) + 8 * (r >> 2)) * DM + j * 32);
            p.out[idx] = acc[0][j][r] + ALPHA * p.x[idx];
          }
          asm volatile("" ::: "memory");
        }
      }
    }
    __syncthreads();
#pragma unroll 1
    for (int rr = 0; rr < 16; rr++) {
      const int tok = t0 + w * 16 + rr;
      float* row = p.out + (size_t)tok * DM;
      float v[16];
      {
        const float4 a0 = *(const float4*)(row + 8 * lane), a1 = *(const float4*)(row + 8 * lane + 4);
        const float4 a2 = *(const float4*)(row + 512 + 8 * lane), a3 = *(const float4*)(row + 512 + 8 * lane + 4);
        v[0] = a0.x; v[1] = a0.y; v[2] = a0.z; v[3] = a0.w; v[4] = a1.x; v[5] = a1.y; v[6] = a1.z; v[7] = a1.w;
        v[8] = a2.x; v[9] = a2.y; v[10] = a2.z; v[11] = a2.w; v[12] = a3.x; v[13] = a3.y; v[14] = a3.z; v[15] = a3.w;
      }
      float s = 0.f;
#pragma unroll
      for (int i = 0; i < 16; i++) s += v[i];
      const float mu = wave_sum(s) * (1.f / DM);
      float qv = 0.f;
#pragma unroll
      for (int i = 0; i < 16; i++) { v[i] -= mu; qv += v[i] * v[i]; }
      const float rs = rsqrtf(wave_sum(qv) * (1.f / DM) + 1e-5f);
#pragma unroll
      for (int hf = 0; hf < 2; hf++) {
        const int e0 = hf * 512 + 8 * lane;
        const float4 g0 = *(const float4*)(p.ln1g + e0), g1 = *(const float4*)(p.ln1g + e0 + 4);
        const float4 b0 = *(const float4*)(p.ln1b + e0), b1 = *(const float4*)(p.ln1b + e0 + 4);
        float o[8];
        o[0] = v[hf * 8 + 0] * rs * g0.x + b0.x; o[1] = v[hf * 8 + 1] * rs * g0.y + b0.y;
        o[2] = v[hf * 8 + 2] * rs * g0.z + b0.z; o[3] = v[hf * 8 + 3] * rs * g0.w + b0.w;
        o[4] = v[hf * 8 + 4] * rs * g1.x + b1.x; o[5] = v[hf * 8 + 5] * rs * g1.y + b1.y;
        o[6] = v[hf * 8 + 6] * rs * g1.z + b1.z; o[7] = v[hf * 8 + 7] * rs * g1.w + b1.w;
        *(float4*)(row + e0) = make_float4(o[0], o[1], o[2], o[3]);
        *(float4*)(row + e0 + 4) = make_float4(o[4], o[5], o[6], o[7]);
        uint4 pk = {pack2bf(o[0], o[1]), pack2bf(o[2], o[3]), pack2bf(o[4], o[5]), pack2bf(o[6], o[7])};
        *(uint4*)(p.x1b + (size_t)tok * DM + e0) = pk;
      }
    }
    __syncthreads();
    const int ts = tid & 63, qs = tid >> 6;
#pragma unroll 1
    for (int hh = 0; hh < 8; hh++) {
#pragma unroll 1
      for (int half = 0; half < 2; half++) {
        f32x16 acc[2][1];
#pragma unroll
        for (int i = 0; i < 2; i++)
#pragma unroll
          for (int r = 0; r < 16; r++) acc[i][0][r] = 0.f;
        const bf16_t* A = p.wqt + (size_t)(hh * 256 + half * 128) * DM;
        const bf16_t* Bt = p.x1b + (size_t)t0 * DM;
        Gemm<2, 1>::mainloop(acc, [&](int r) { return A + (size_t)r * DM; }, [&](int r) { return Bt + (size_t)r * DM; }, DM, smem);
        f32x16 sp[4];
#pragma unroll
        for (int nn = 0; nn < 4; nn++)
#pragma unroll
          for (int r = 0; r < 16; r++) sp[nn][r] = 0.f;
        const bf16_t* skp = half ? p.sk2p : p.sk1p;
#pragma unroll
        for (int i = 0; i < 2; i++)
#pragma unroll
          for (int s = 0; s < 2; s++) {
            uint4 qb = {pack2bf(acc[i][0][8 * s + 0], acc[i][0][8 * s + 1]), pack2bf(acc[i][0][8 * s + 2], acc[i][0][8 * s + 3]),
                        pack2bf(acc[i][0][8 * s + 4], acc[i][0][8 * s + 5]), pack2bf(acc[i][0][8 * s + 6], acc[i][0][8 * s + 7])};
            const bf16x8 qf = __builtin_bit_cast(bf16x8, qb);
#pragma unroll
            for (int nn = 0; nn < 4; nn++) {
              const bf16x8 kf = *(const bf16x8*)(skp + (size_t)(nn * 32 + c) * 128 + wm * 64 + i * 32 + s * 16 + fh * 8);
              sp[nn] = __builtin_amdgcn_mfma_f32_32x32x16_bf16(kf, qf, sp[nn], 0, 0, 0);
            }
          }
        if (wm == 0) {
#pragma unroll
          for (int nn = 0; nn < 4; nn++)
#pragma unroll
            for (int r = 0; r < 16; r++) S[(nn * 32 + (r & 3) + 8 * (r >> 2) + 4 * fh) * 64 + wn * 32 + c] = sp[nn][r];
        }
        __syncthreads();
        if (wm == 1) {
#pragma unroll
          for (int nn = 0; nn < 4; nn++)
#pragma unroll
            for (int r = 0; r < 16; r++) S[(nn * 32 + (r & 3) + 8 * (r >> 2) + 4 * fh) * 64 + wn * 32 + c] += sp[nn][r];
        }
        __syncthreads();
        unsigned L[16];
#pragma unroll
        for (int k = 0; k < 16; k++) L[k] = 0u;
#pragma unroll 4
        for (int i = 0; i < 32; i++) {
          const int n = qs * 32 + i;
          insert16(L, (f2key(S[n * 64 + ts]) & ~127u) | (unsigned)n);
        }
        merge4_lists(L, lists, ts, qs);
        if (qs == 0) {
#pragma unroll
          for (int k = 0; k < 16; k++) ablist[(half * 16 + k) * 64 + ts] = L[k];
        }
        __syncthreads();
      }
      {
        unsigned L[16];
#pragma unroll
        for (int k = 0; k < 16; k++) L[k] = 0u;
#pragma unroll 1
        for (int cc = qs; cc < 50; cc += 4) {
          const unsigned code = cand_tab[cc];
          const float sum = key2f(ablist[(code >> 4) * 64 + ts]) + key2f(ablist[(16 + (code & 15)) * 64 + ts]);
          insert16(L, (f2key(sum) & ~255u) | code);
        }
        merge4_lists(L, lists, ts, qs);
        if (qs == 0) {
          const float mx = key2f(L[0]);
          float e[16], sum = 0.f;
#pragma unroll
          for (int k = 0; k < 16; k++) { e[k] = __expf(key2f(L[k]) - mx); sum += e[k]; }
          const float inv = 1.f / sum;
#pragma unroll
          for (int k = 0; k < 16; k++) {
            const unsigned code = L[k] & 255u;
            const unsigned ia = ablist[(code >> 4) * 64 + ts] & 127u, ib = ablist[(16 + (code & 15)) * 64 + ts] & 127u;
            fin_e[ts * 16 + k] = (int)(ia * 128u + ib);
            fin_g[ts * 16 + k] = e[k] * inv;
          }
        }
        __syncthreads();
        {
          const int tt = tid >> 2, k4 = (tid & 3) * 4;
          *(int4*)(p.pexp + (size_t)(t0 + tt) * 128 + hh * 16 + k4) = *(const int4*)(fin_e + tt * 16 + k4);
          *(float4*)(p.pgate + (size_t)(t0 + tt) * 128 + hh * 16 + k4) = *(const float4*)(fin_g + tt * 16 + k4);
        }
        __syncthreads();
      }
    }
#pragma unroll 1
    for (int rr = 0; rr < 16; rr++) {
      const int tok = t0 + w * 16 + rr;
      const int id0 = p.pexp[(size_t)tok * 128 + lane], id1 = p.pexp[(size_t)tok * 128 + 64 + lane];
      const float g0 = p.pgate[(size_t)tok * 128 + lane], g1 = p.pgate[(size_t)tok * 128 + 64 + lane];
      float* row = p.out + (size_t)tok * DM + 16 * lane;
      float xv[16];
      {
        const float4 r0 = *(const float4*)(row), r1 = *(const float4*)(row + 4), r2 = *(const float4*)(row + 8), r3 = *(const float4*)(row + 12);
        xv[0] = r0.x; xv[1] = r0.y; xv[2] = r0.z; xv[3] = r0.w; xv[4] = r1.x; xv[5] = r1.y; xv[6] = r1.z; xv[7] = r1.w;
        xv[8] = r2.x; xv[9] = r2.y; xv[10] = r2.z; xv[11] = r2.w; xv[12] = r3.x; xv[13] = r3.y; xv[14] = r3.z; xv[15] = r3.w;
      }
      f16x2 xh[8];
      float xs = 0.f;
#pragma unroll
      for (int i = 0; i < 8; i++) {
        xh[i] = f16x2{(_Float16)xv[2 * i], (_Float16)xv[2 * i + 1]};
        xs += (float)xh[i][0] + (float)xh[i][1];
      }
      const float xsum128 = 1152.f * wave_sum_uniform(xs);
      const float su0 = p.psu[id0], su1 = p.psu[id1];
      float a0 = 0.f, a1 = 0.f;
      {
        uint4 bu[PE_EXPERT_DEPTH];
#pragma unroll
        for (int d = 0; d < PE_EXPERT_DEPTH; d++) {
          const int id = __builtin_amdgcn_readlane(id0, d);
          bu[d] = *(const uint4*)(p.puq + (size_t)id * DM + 16 * lane);
        }
#pragma unroll 1
        for (int e0 = 0; e0 < 128; e0 += PE_EXPERT_DEPTH) {
#pragma unroll
          for (int d = 0; d < PE_EXPERT_DEPTH; d++) {
            const int e = e0 + d;
            const float sce = readlane_f((e & 64) ? su1 : su0, e & 63);
            const unsigned qw[4] = {bu[d].x, bu[d].y, bu[d].z, bu[d].w};
            float s0 = 0.f, s1 = 0.f;
#pragma unroll
            for (int i = 0; i < 4; i++) {
              s0 = __builtin_amdgcn_fdot2(bytes01_h2(qw[i]), xh[2 * i], s0, false);
              s1 = __builtin_amdgcn_fdot2(bytes23_h2(qw[i]), xh[2 * i + 1], s1, false);
            }
            float s = s0 + s1;
            if (e + PE_EXPERT_DEPTH < 128) {
              const int en = e + PE_EXPERT_DEPTH;
              const int id = __builtin_amdgcn_readlane((en & 64) ? id1 : id0, en & 63);
              bu[d] = *(const uint4*)(p.puq + (size_t)id * DM + 16 * lane);
            }
            s = (wave_sum_uniform(s) - xsum128) * sce;
            a0 = ((e & 64) == 0 && lane == (e & 63)) ? s : a0;
            a1 = ((e & 64) != 0 && lane == (e & 63)) ? s : a1;
          }
        }
      }
      const float w0 = g0 * gelu_exact(a0) * p.psv[id0], w1 = g1 * gelu_exact(a1) * p.psv[id1];
      const float csum128 = 1152.f * wave_sum_uniform(w0 + w1);
      float y[16];
#pragma unroll
      for (int i = 0; i < 16; i++) y[i] = 0.f;
      {
        uint4 bv[PE_EXPERT_DEPTH];
#pragma unroll
        for (int d = 0; d < PE_EXPERT_DEPTH; d++) {
          const int id = __builtin_amdgcn_readlane(id0, d);
          bv[d] = *(const uint4*)(p.pvq + (size_t)id * DM + 16 * lane);
        }
#pragma unroll 1
        for (int e0 = 0; e0 < 128; e0 += PE_EXPERT_DEPTH) {
#pragma unroll
          for (int d = 0; d < PE_EXPERT_DEPTH; d++) {
            const int e = e0 + d;
            const float wgt = readlane_f((e & 64) ? w1 : w0, e & 63);
            const unsigned qw[4] = {bv[d].x, bv[d].y, bv[d].z, bv[d].w};
#pragma unroll
            for (int i = 0; i < 4; i++) {
              const f16x2 h01 = bytes01_h2(qw[i]), h23 = bytes23_h2(qw[i]);
              y[4 * i + 0] = fmaf(wgt, (float)h01[0], y[4 * i + 0]);
              y[4 * i + 1] = fmaf(wgt, (float)h01[1], y[4 * i + 1]);
              y[4 * i + 2] = fmaf(wgt, (float)h23[0], y[4 * i + 2]);
              y[4 * i + 3] = fmaf(wgt, (float)h23[1], y[4 * i + 3]);
            }
            if (e + PE_EXPERT_DEPTH < 128) {
              const int en = e + PE_EXPERT_DEPTH;
              const int id = __builtin_amdgcn_readlane((en & 64) ? id1 : id0, en & 63);
              bv[d] = *(const uint4*)(p.pvq + (size_t)id * DM + 16 * lane);
            }
          }
        }
      }
      float v[16];
#pragma unroll
      for (int i = 0; i < 16; i++) v[i] = ALPHA * xv[i] + (y[i] - csum128);
      float s = 0.f;
#pragma unroll
      for (int i = 0; i < 16; i++) s += v[i];
      const float mu = wave_sum(s) * (1.f / DM);
      float qv = 0.f;
#pragma unroll
      for (int i = 0; i < 16; i++) { v[i] -= mu; qv += v[i] * v[i]; }
      const float rs = rsqrtf(wave_sum(qv) * (1.f / DM) + 1e-5f);
#pragma unroll
      for (int i4 = 0; i4 < 4; i4++) {
        const float4 gg = *(const float4*)(p.ln2g + 16 * lane + 4 * i4), bb = *(const float4*)(p.ln2b + 16 * lane + 4 * i4);
        *(float4*)(row + 4 * i4) = make_float4(v[4 * i4 + 0] * rs * gg.x + bb.x, v[4 * i4 + 1] * rs * gg.y + bb.y,
                                               v[4 * i4 + 2] * rs * gg.z + bb.z, v[4 * i4 + 3] * rs * gg.w + bb.w);
      }
    }
    __syncthreads();
  }
}

__device__ __forceinline__ void cbias_phase(const Params& p, int bid, int nblk) {
  const int which = threadIdx.x >> 7, j = threadIdx.x & 127;
  const float* w1 = which ? p.w1v : p.w1k;
  const float* pe = which ? p.pe_v : p.pe_k;
  for (int ch = bid; ch < 64; ch += nblk) {
    float a = 0.f;
#pragma unroll 8
    for (int r = ch * 32; r < ch * 32 + 32; r++) a = fmaf(pe[r], w1[(size_t)r * 128 + j], a);
    p.cbias[ch * 256 + which * 128 + j] = a;
  }
}
__device__ __forceinline__ void compress_phase(const Params& p, unsigned char* smem, int bid, int nblk) {
  typedef Gemm<1, 2> G;
  const int tid = threadIdx.x, lane = tid & 63, w = tid >> 6, wm = w >> 1, wn = w & 1, c = lane & 31, fh = lane >> 5;
  float* hid = (float*)smem;
  float* cb = (float*)(smem + 49152);
  if (bid < NB * 2 * 2 * 4) {
    float a = 0.f;
    for (int ch = 0; ch < 64; ch++) a += p.cbias[ch * 256 + tid];
    cb[tid] = a;
  }
  __syncthreads();
  for (int item = bid; item < NB * 2 * 2 * 4; item += nblk) {
    const int mt = item & 3, which = (item >> 2) & 1, bgi = item >> 3;
    const int m0 = mt * 64;
    const bf16_t* A = (which ? p.kvn[1] : p.kvn[0]) + (size_t)bgi * SEQ * 64;
    const bf16_t* Bt = which ? p.w1vt : p.w1kt;
    f32x16 acc[1][2];
#pragma unroll
    for (int j = 0; j < 2; j++)
#pragma unroll
      for (int r = 0; r < 16; r++) acc[0][j][r] = 0.f;
    G::mainloop(acc, [&](int r) { const int i = min(m0 + r, NC - 1); return A + (size_t)i * 1024; },
                [&](int r) { return Bt + (size_t)r * 2048; }, 2048, smem);
#pragma unroll
    for (int j = 0; j < 2; j++)
#pragma unroll
      for (int r = 0; r < 16; r++) {
        const int row = wm * 32 + (r & 3) + 8 * (r >> 2) + 4 * fh, col = (wn * 2 + j) * 32 + c;
        hid[row * 129 + col] = gelu_exact(acc[0][j][r] + cb[which * 128 + col]);
      }
    __syncthreads();
    {
      const int row = tid >> 2, dq = (tid & 3) * 16;
      const float* w2 = which ? p.w2v : p.w2k;
      float o[16];
#pragma unroll
      for (int i = 0; i < 16; i++) o[i] = 0.f;
      for (int k = 0; k < 128; k++) {
        const float h = hid[row * 129 + k];
        const float4 w0 = *(const float4*)(w2 + k * 64 + dq), w1_ = *(const float4*)(w2 + k * 64 + dq + 4);
        const float4 w2_ = *(const float4*)(w2 + k * 64 + dq + 8), w3 = *(const float4*)(w2 + k * 64 + dq + 12);
        o[0] = fmaf(h, w0.x, o[0]); o[1] = fmaf(h, w0.y, o[1]); o[2] = fmaf(h, w0.z, o[2]); o[3] = fmaf(h, w0.w, o[3]);
        o[4] = fmaf(h, w1_.x, o[4]); o[5] = fmaf(h, w1_.y, o[5]); o[6] = fmaf(h, w1_.z, o[6]); o[7] = fmaf(h, w1_.w, o[7]);
        o[8] = fmaf(h, w2_.x, o[8]); o[9] = fmaf(h, w2_.y, o[9]); o[10] = fmaf(h, w2_.z, o[10]); o[11] = fmaf(h, w2_.w, o[11]);
        o[12] = fmaf(h, w3.x, o[12]); o[13] = fmaf(h, w3.y, o[13]); o[14] = fmaf(h, w3.z, o[14]); o[15] = fmaf(h, w3.w, o[15]);
      }
      const int i = m0 + row;
      const bool valid = i < NC;
      if (which == 0) {
        bf16_t* dst = p.kcb + ((size_t)bgi * 256 + i) * 64 + dq;
        uint4 u0 = {pack2bf(o[0], o[1]), pack2bf(o[2], o[3]), pack2bf(o[4], o[5]), pack2bf(o[6], o[7])};
        uint4 u1 = {pack2bf(o[8], o[9]), pack2bf(o[10], o[11]), pack2bf(o[12], o[13]), pack2bf(o[14], o[15])};
        if (!valid) { u0 = make_uint4(0, 0, 0, 0); u1 = u0; }
        *(uint4*)dst = u0; *(uint4*)(dst + 8) = u1;
      } else {
#pragma unroll
        for (int e = 0; e < 16; e++) p.vct[((size_t)bgi * 64 + dq + e) * 256 + perm16(i)] = valid ? f2bf(o[e]) : (bf16_t)0;
      }
    }
    __syncthreads();
  }
}

__device__ __forceinline__ void softmax4(float* sc, int ld, int n) {
  const int w = threadIdx.x >> 6, lane = threadIdx.x & 63;
  float* s = sc + w * ld;
  float m = -INFINITY;
  for (int i = lane; i < n; i += 64) m = fmaxf(m, s[i]);
  m = wave_max(m);
  if (m == -INFINITY) m = 0.f;
  float sum = 0.f;
  for (int i = lane; i < n; i += 64) { float e = expf(s[i] - m); s[i] = e; sum += e; }
  sum = wave_sum(sum);
  const float inv = 1.f / (sum > 0.f ? sum : 1.f);
  for (int i = lane; i < n; i += 64) s[i] *= inv;
}
__device__ __forceinline__ float dot64_bf(const float* q, const bf16_t* k) {
  float s = 0.f;
#pragma unroll
  for (int e = 0; e < 64; e += 8) {
    const uint4 v = *(const uint4*)(k + e);
    const unsigned u[4] = {v.x, v.y, v.z, v.w};
#pragma unroll
    for (int i = 0; i < 4; i++) {
      s = fmaf(q[e + 2 * i], __uint_as_float(u[i] << 16), s);
      s = fmaf(q[e + 2 * i + 1], __uint_as_float(u[i] & 0xFFFF0000u), s);
    }
  }
  return s;
}

template <class KRow, class VRow, class Body>
__device__ __forceinline__ void flash_stream(unsigned char* smem, int j0, int j1, KRow krow, VRow vrow, Body body) {
  if (j0 >= j1) return;
  Tile2 rk = tile_fetch([&](int r) __attribute__((always_inline)) { return krow(j0, r); });
  Tile2 rv = tile_fetch([&](int r) __attribute__((always_inline)) { return vrow(j0, r); });
  __syncthreads();
  tile_store(rk, smem); tile_store(rv, smem + FL_TILE);
  __syncthreads();
#pragma unroll 1
  for (int j = j0; j < j1; j++) {
    unsigned char* cur = smem + ((j - j0) & 1) * FL_STAGE;
    if (j + 1 < j1) {
      rk = tile_fetch([&](int r) __attribute__((always_inline)) { return krow(j + 1, r); });
      rv = tile_fetch([&](int r) __attribute__((always_inline)) { return vrow(j + 1, r); });
    }
    body(cur, j);
    if (j + 1 < j1) { unsigned char* nxt = smem + ((j - j0 + 1) & 1) * FL_STAGE; tile_store(rk, nxt); tile_store(rv, nxt + FL_TILE); }
    __syncthreads();
  }
}
__device__ __forceinline__ float quad_sum(float x) {
  x += __builtin_bit_cast(float, __builtin_amdgcn_update_dpp(0, __builtin_bit_cast(int, x), 0xB1, 0xF, 0xF, true));
  x += __builtin_bit_cast(float, __builtin_amdgcn_update_dpp(0, __builtin_bit_cast(int, x), 0x4E, 0xF, 0xF, true));
  return x;
}
__device__ __forceinline__ void nsa_flash_item(const Params& p, unsigned char* smem, int item) {
  const int tid = threadIdx.x, lane = tid & 63, w = tid >> 6, fr = lane & 31, fh = lane >> 5;
  const int cc = item & 127, g = (item >> 7) & 1, b = item >> 8;
  const int c64 = cc >> 1;
  const int t0 = cc * 32;
  const int tl = 8 * w + (fr >> 2), hq = fr & 3;
  const int t = t0 + tl, tok = b * SEQ + t;
  const int t64 = t & 63;
  float* impS = (float*)smem;
  unsigned* selm = (unsigned*)(smem + 32 * 65 * 4);
  float* stash = (float*)(smem + 2 * FL_STAGE) + w * 2048 + lane;
  bf16x8 qf[4];
  flash_load_q(qf, p.qn + (size_t)tok * 512 + g * 256 + hq * 64, 0.125f);
  const float* gt = p.gates + (size_t)tok * 24 + (g * 4 + hq) * 3;
  const float g_cmp = gt[0], g_sel = gt[1], g_win = gt[2];
  const size_t bg = (size_t)(b * 2 + g);
  {
    const int nvmax = 2 * cc + 1, nkb = (nvmax + 63) >> 6;
    const int nvl = (t >= 31) ? ((t - 31) >> 4) + 1 : 0;
    const bf16_t* kcb = p.kcb + bg * 256 * 64;
    const bf16_t* vct = p.vct + bg * 64 * 256;
    auto krow = [&](int j, int r) __attribute__((always_inline)) { return kcb + (size_t)(j * 64 + r) * 64; };
    auto vrow = [&](int j, int r) __attribute__((always_inline)) { return vct + (size_t)r * 256 + j * 64; };
    float m = -INFINITY, l = 0.f;
    flash_stream(smem, 0, nkb, krow, vrow, [&](unsigned char* cur, int j) __attribute__((always_inline)) {
      f32x16 s[2];
      flash_qk(s, cur, qf);
      float mx = -INFINITY;
#pragma unroll
      for (int kt = 0; kt < 2; kt++)
#pragma unroll
        for (int r = 0; r < 16; r++) {
          const int n = j * 64 + kt * 32 + (r & 3) + 8 * (r >> 2) + 4 * fh;
          s[kt][r] = (n < nvl) ? s[kt][r] : -INFINITY;
          mx = fmaxf(mx, s[kt][r]);
        }
      mx = fmaxf(mx, __shfl_xor(mx, 32));
      const float mnew = fmaxf(m, mx);
      const float muse = (mnew == -INFINITY) ? 0.f : mnew;
      float sum = 0.f;
#pragma unroll
      for (int kt = 0; kt < 2; kt++)
#pragma unroll
        for (int r = 0; r < 16; r++) sum += __builtin_amdgcn_exp2f((s[kt][r] - muse) * LOG2E);
      l = l * __builtin_amdgcn_exp2f((m - muse) * LOG2E) + sum;
      m = mnew;
    });
    const float lt = l + __shfl_xor(l, 32);
    const float il = lt > 0.f ? 1.f / lt : 0.f;
    const float muse = (m == -INFINITY) ? 0.f : m;
    {
      f32x16 oc[2];
#pragma unroll
      for (int i = 0; i < 2; i++)
#pragma unroll
        for (int r = 0; r < 16; r++) oc[i][r] = 0.f;
      flash_stream(smem, 0, nkb, krow, vrow, [&](unsigned char* cur, int j) __attribute__((always_inline)) {
        f32x16 s[2];
        flash_qk(s, cur, qf);
#pragma unroll
        for (int kt = 0; kt < 2; kt++)
#pragma unroll
          for (int r = 0; r < 16; r++) {
            const int n = j * 64 + kt * 32 + (r & 3) + 8 * (r >> 2) + 4 * fh;
            s[kt][r] = (n < nvl) ? __builtin_amdgcn_exp2f((s[kt][r] - muse) * LOG2E) * il : 0.f;
          }
#pragma unroll
        for (int kt = 0; kt < 2; kt++)
#pragma unroll
          for (int h8 = 0; h8 < 2; h8++) {
            const bf16x8 pf = pack_frag(s[kt], h8);
#pragma unroll
            for (int dt = 0; dt < 2; dt++)
              oc[dt] = __builtin_amdgcn_mfma_f32_32x32x16_bf16(lds_frag(cur + FL_TILE, dt * 32 + fr, 4 * kt + 2 * h8 + fh), pf, oc[dt], 0, 0, 0);
          }
      });
#pragma unroll
      for (int dt = 0; dt < 2; dt++)
#pragma unroll
        for (int r = 0; r < 16; r++) stash[(dt * 16 + r) * 64] = g_cmp * oc[dt][r];
    }
    f32x16 imp[2];
#pragma unroll
    for (int i = 0; i < 2; i++)
#pragma unroll
      for (int r = 0; r < 16; r++) imp[i][r] = 0.f;
    flash_stream(smem, 0, nkb, krow, vrow, [&](unsigned char* cur, int j) __attribute__((always_inline)) {
      f32x16 s[2];
      flash_qk(s, cur, qf);
#pragma unroll
      for (int kt = 0; kt < 2; kt++)
#pragma unroll
        for (int r = 0; r < 16; r++) {
          const int n = j * 64 + kt * 32 + (r & 3) + 8 * (r >> 2) + 4 * fh;
          s[kt][r] = (n < nvl) ? __builtin_amdgcn_exp2f((s[kt][r] - muse) * LOG2E) * il : 0.f;
        }
#pragma unroll
      for (int kt = 0; kt < 2; kt++)
#pragma unroll
        for (int h8 = 0; h8 < 2; h8++) {
          const bf16x8 pf = pack_frag(s[kt], h8);
#pragma unroll
          for (int mt = 0; mt < 2; mt++) {
            const bf16x8 of = *(const bf16x8*)(p.ovp + (size_t)(mt * 32 + fr) * 256 + j * 64 + kt * 32 + h8 * 16 + fh * 8);
            imp[mt] = __builtin_amdgcn_mfma_f32_32x32x16_bf16(of, pf, imp[mt], 0, 0, 0);
          }
        }
    });
#pragma unroll
    for (int mt = 0; mt < 2; mt++)
#pragma unroll
      for (int r = 0; r < 16; r++) imp[mt][r] = quad_sum(imp[mt][r]);
#pragma unroll
    for (int mt = 0; mt < 2; mt++)
#pragma unroll
      for (int g4 = 0; g4 < 4; g4++) {
        const float v = (hq == 0) ? imp[mt][4 * g4 + 0] : (hq == 1) ? imp[mt][4 * g4 + 1] : (hq == 2) ? imp[mt][4 * g4 + 2] : imp[mt][4 * g4 + 3];
        impS[tl * 65 + mt * 32 + hq + 8 * g4 + 4 * fh] = v;
      }
    __syncthreads();
    {
      const int tk = tid >> 3, part = tid & 7;
      const float* row = impS + tk * 65;
      unsigned bits = 0;
#pragma unroll 1
      for (int i = 0; i < 8; i++) {
        const int mb = part * 8 + i;
        const bool vis = mb <= c64;
        const bool forced = (mb == 0) || (mb == c64) || (mb == c64 - 1);
        const float sm = vis ? row[mb] + (forced ? 1e4f : 0.f) : -INFINITY;
        int rank = 0;
        for (int m2 = 0; m2 < 64; m2++) {
          const bool vis2 = m2 <= c64;
          const bool f2 = (m2 == 0) || (m2 == c64) || (m2 == c64 - 1);
          const float s2 = vis2 ? row[m2] + (f2 ? 1e4f : 0.f) : -INFINITY;
          rank += (s2 > sm) || (s2 == sm && m2 < mb);
        }
        if (rank < 16 && vis) bits |= 1u << i;
      }
      unsigned lo = (part < 4) ? (bits << (8 * part)) : 0u, hi = (part >= 4) ? (bits << (8 * (part - 4))) : 0u;
      lo |= __shfl_xor(lo, 1); hi |= __shfl_xor(hi, 1);
      lo |= __shfl_xor(lo, 2); hi |= __shfl_xor(hi, 2);
      lo |= __shfl_xor(lo, 4); hi |= __shfl_xor(hi, 4);
      if (part == 0) { selm[tk * 2] = lo; selm[tk * 2 + 1] = hi; }
    }
    __syncthreads();
  }
  const unsigned sel_lo = selm[tl * 2], sel_hi = selm[tl * 2 + 1];
  {
    const bf16_t* kb_ = p.kvn[2] + bg * SEQ * 64;
    const bf16_t* vt_ = p.vslct + bg * 64 * SEQ;
    FlashAcc acc; flash_init(acc);
    flash_stream(smem, 0, c64 + 1,
      [&](int j, int r) __attribute__((always_inline)) { return kb_ + (size_t)(j * 64 + r) * 64; },
      [&](int j, int r) __attribute__((always_inline)) { return vt_ + (size_t)r * SEQ + j * 64; },
      [&](unsigned char* cur, int j) __attribute__((always_inline)) {
        f32x16 s[2];
        flash_qk(s, cur, qf);
        const bool selj = ((j < 32) ? (sel_lo >> j) : (sel_hi >> (j - 32))) & 1u;
        if (j == c64) {
#pragma unroll
          for (int kt = 0; kt < 2; kt++)
#pragma unroll
            for (int r = 0; r < 16; r++) {
              const int kl = kt * 32 + (r & 3) + 8 * (r >> 2) + 4 * fh;
              s[kt][r] = (kl <= t64) ? s[kt][r] : -INFINITY;
            }
        }
        flash_update(acc, s, cur + FL_TILE, selj);
      });
    const float sc_ = g_sel * flash_inv_l(acc);
#pragma unroll
    for (int dt = 0; dt < 2; dt++)
#pragma unroll
      for (int r = 0; r < 16; r++) stash[(dt * 16 + r) * 64] += sc_ * acc.o[dt][r];
  }
  {
    const bf16_t* kb_ = p.kvn[4] + bg * SEQ * 64;
    const bf16_t* vt_ = p.vwint + bg * 64 * SEQ;
    FlashAcc acc; flash_init(acc);
    const int jlo = c64 - 8;
    flash_stream(smem, jlo < 0 ? 0 : jlo, c64 + 1,
      [&](int j, int r) __attribute__((always_inline)) { return kb_ + (size_t)(j * 64 + r) * 64; },
      [&](int j, int r) __attribute__((always_inline)) { return vt_ + (size_t)r * SEQ + j * 64; },
      [&](unsigned char* cur, int j) __attribute__((always_inline)) {
        f32x16 s[2];
        flash_qk(s, cur, qf);
        if (j == c64) {
#pragma unroll
          for (int kt = 0; kt < 2; kt++)
#pragma unroll
            for (int r = 0; r < 16; r++) {
              const int kl = kt * 32 + (r & 3) + 8 * (r >> 2) + 4 * fh;
              s[kt][r] = (kl <= t64) ? s[kt][r] : -INFINITY;
            }
        } else if (j == jlo) {
#pragma unroll
          for (int kt = 0; kt < 2; kt++)
#pragma unroll
            for (int r = 0; r < 16; r++) {
              const int kl = kt * 32 + (r & 3) + 8 * (r >> 2) + 4 * fh;
              s[kt][r] = (kl > t64) ? s[kt][r] : -INFINITY;
            }
        }
        flash_update(acc, s, cur + FL_TILE);
      });
    const float sc_ = g_win * flash_inv_l(acc);
    bf16_t* orow = p.concat + (size_t)tok * DM + g * 256 + hq * 64;
#pragma unroll
    for (int dt = 0; dt < 2; dt++)
#pragma unroll
      for (int g4 = 0; g4 < 4; g4++) {
        float o4[4];
#pragma unroll
        for (int i = 0; i < 4; i++) o4[i] = stash[(dt * 16 + 4 * g4 + i) * 64] + sc_ * acc.o[dt][4 * g4 + i];
        uint2 o = {pack2bf(o4[0], o4[1]), pack2bf(o4[2], o4[3])};
        *(uint2*)(orow + dt * 32 + 8 * g4 + 4 * fh) = o;
      }
  }
}
__device__ __forceinline__ void nsa_phase(const Params& p, unsigned char* smem, int bid, int nblk) {
  for (int it = bid; it < NB * 2 * 128; it += nblk) {
    const int cc = 127 - (it >> 4), bgi = it & 15;
    nsa_flash_item(p, smem, (bgi << 7) | cc);
  }
}

typedef __attribute__((ext_vector_type(4))) float f32x4v;
typedef __attribute__((ext_vector_type(4))) short s16x4;
__device__ __forceinline__ int dsa_vswz(int row) { return ((row >> 1) & 1) | ((row >> 2) & 2); }
__device__ __forceinline__ void dsa_item(const Params& p, unsigned char* smem, int b, int tg) {
  unsigned* keys = (unsigned*)smem;
  unsigned char* vst = smem;
  int* hist = (int*)(smem + 32768);
  int* sel = hist + 3584;
  int* cnt = sel + 512;
  float* sc = (float*)(cnt + 16);
  float* part = sc + 2048;
  const int tid = threadIdx.x, lane = tid & 63, w = tid >> 6;
  const int row16 = lane & 15, kg = lane >> 4;
  const int t0 = 2 * tg;
  const size_t tokb = (size_t)b * SEQ;
  const bf16_t* kib = p.ki + tokb * 32;
  const bf16_t* kdb = p.kd + tokb * 64;
  const bf16_t* vdb = p.vd + tokb * 64;
  const int n = t0 + 2;
  if (n > 256) {
#pragma unroll
    for (int i = 0; i < 14; i++) hist[tid + 256 * i] = 0;
    {
      const bf16x8 af = *(const bf16x8*)(p.qi + (tokb + t0 + (row16 >> 3)) * 256 + (row16 & 7) * 32 + kg * 8);
      const int tk = lane >> 5;
      const float4 wv = *(const float4*)(p.widx + (tokb + t0 + tk) * 8 + 4 * (kg & 1));
      const int ntile = (n + 15) >> 4;
#pragma unroll 1
      for (int kt0 = w * 4; kt0 < ntile; kt0 += 16) {
        bf16x8 bfr[4];
#pragma unroll
        for (int u = 0; u < 4; u++) {
          const int key = min(kt0 + u, ntile - 1) * 16 + row16;
          bfr[u] = *(const bf16x8*)(kib + (size_t)key * 32 + kg * 8);
        }
#pragma unroll
        for (int u = 0; u < 4; u++) {
          f32x4v acc = {0.f, 0.f, 0.f, 0.f};
          acc = __builtin_amdgcn_mfma_f32_16x16x32_bf16(af, bfr[u], acc, 0, 0, 0);
          float s = wv.x * fmaxf(acc[0], 0.f) + wv.y * fmaxf(acc[1], 0.f) + wv.z * fmaxf(acc[2], 0.f) + wv.w * fmaxf(acc[3], 0.f);
          s += __shfl_xor(s, 16);
          const int key = (kt0 + u) * 16 + row16;
          if ((kg & 1) == 0 && kt0 + u < ntile) keys[tk * 4096 + key] = (key <= t0 + tk) ? f2key(s) : 0u;
        }
      }
    }
    __syncthreads();
    const int tk = w >> 1, hf = w & 1;
    const int npad = ((n + 15) >> 4) << 4, nh = npad >> 1;
    const unsigned* kt_ = keys + tk * 4096;
    const int i0 = hf * nh, i1 = i0 + nh;
    unsigned prefix = 0; int kk = 256;
#pragma unroll 1
    for (int pass = 0; pass < 4; pass++) {
      const int shift = 24 - 8 * pass;
      int* hp = (pass == 0) ? hist + 1536 + tk * 1024 : hist + (pass - 1) * 512 + tk * 256;
      int* hpa = (pass == 0) ? hp + (lane & 3) * 256 : hp;
      const unsigned hmask = (shift == 24) ? 0u : (0xFFFFFFFFu << (shift + 8));
#pragma unroll 2
      for (int base = i0 + 4 * lane; base < i1; base += 256) {
        const uint4 k4 = *(const uint4*)(kt_ + base);
        if ((k4.x & hmask) == prefix) atomicAdd(&hpa[(k4.x >> shift) & 255], 1);
        if ((k4.y & hmask) == prefix) atomicAdd(&hpa[(k4.y >> shift) & 255], 1);
        if ((k4.z & hmask) == prefix) atomicAdd(&hpa[(k4.z >> shift) & 255], 1);
        if ((k4.w & hmask) == prefix) atomicAdd(&hpa[(k4.w >> shift) & 255], 1);
      }
      __syncthreads();
      {
        int4 c4 = *(const int4*)(hp + lane * 4);
        if (pass == 0) {
#pragma unroll
          for (int cp = 1; cp < 4; cp++) {
            const int4 d4 = *(const int4*)(hp + cp * 256 + lane * 4);
            c4.x += d4.x; c4.y += d4.y; c4.z += d4.z; c4.w += d4.w;
          }
        }
        const int tl_ = c4.x + c4.y + c4.z + c4.w;
        int P = tl_;
        P += __builtin_amdgcn_update_dpp(0, P, 0x111, 0xF, 0xF, false);
        P += __builtin_amdgcn_update_dpp(0, P, 0x112, 0xF, 0xF, false);
        P += __builtin_amdgcn_update_dpp(0, P, 0x114, 0xF, 0xF, false);
        P += __builtin_amdgcn_update_dpp(0, P, 0x118, 0xF, 0xF, false);
        P += __builtin_amdgcn_update_dpp(0, P, 0x142, 0xA, 0xF, false);
        P += __builtin_amdgcn_update_dpp(0, P, 0x143, 0xC, 0xF, false);
        const int total = __builtin_amdgcn_readlane(P, 63);
        const int R = total - P + tl_;
        const int a3 = R - tl_, a2 = a3 + c4.w, a1 = a2 + c4.z, a0 = a1 + c4.y;
        const bool found = (a3 < kk) && (kk <= R);
        int dloc, above;
        if (kk <= a2) { dloc = 3; above = a3; } else if (kk <= a1) { dloc = 2; above = a2; } else if (kk <= a0) { dloc = 1; above = a1; } else { dloc = 0; above = a0; }
        const unsigned long long bm = __ballot(found);
        const int src = __ffsll((long long)bm) - 1;
        const int dsel = __builtin_amdgcn_readlane(lane * 4 + dloc, src);
        const int abv = __builtin_amdgcn_readlane(above, src);
        prefix |= ((unsigned)dsel) << shift;
        kk -= abv;
      }
    }
    {
      int cg_ = 0, ce = 0;
#pragma unroll 2
      for (int base = i0 + 4 * lane; base < i1; base += 256) {
        const uint4 k4 = *(const uint4*)(kt_ + base);
        cg_ += (k4.x > prefix) + (k4.y > prefix) + (k4.z > prefix) + (k4.w > prefix);
        ce += (k4.x == prefix) + (k4.y == prefix) + (k4.z == prefix) + (k4.w == prefix);
      }
      cg_ = (int)wave_sum_uniform((float)cg_); ce = (int)wave_sum_uniform((float)ce);
      if (lane == 0) { cnt[(tk * 2 + hf) * 2] = cg_; cnt[(tk * 2 + hf) * 2 + 1] = ce; }
    }
    __syncthreads();
    {
      int bgt = hf ? cnt[(tk * 2) * 2] : 0, beq = hf ? cnt[(tk * 2) * 2 + 1] : 0;
      const int ngt = 256 - kk;
      const unsigned long long lt = (1ull << lane) - 1ull;
#pragma unroll 1
      for (int base = i0 + 4 * lane; base < i1; base += 256) {
        const uint4 k4 = *(const uint4*)(kt_ + base);
        const unsigned kq[4] = {k4.x, k4.y, k4.z, k4.w};
        unsigned long long mg[4], me[4];
#pragma unroll
        for (int j = 0; j < 4; j++) { mg[j] = __ballot(kq[j] > prefix); me[j] = __ballot(kq[j] == prefix); }
        int pg = bgt + __popcll(mg[0] & lt) + __popcll(mg[1] & lt) + __popcll(mg[2] & lt) + __popcll(mg[3] & lt);
        int pe = beq + __popcll(me[0] & lt) + __popcll(me[1] & lt) + __popcll(me[2] & lt) + __popcll(me[3] & lt);
#pragma unroll
        for (int j = 0; j < 4; j++) {
          if (kq[j] > prefix) { sel[tk * 256 + pg] = base + j; pg++; }
          else if (kq[j] == prefix) { if (pe < kk) sel[tk * 256 + ngt + pe] = base + j; pe++; }
        }
        bgt += __popcll(mg[0]) + __popcll(mg[1]) + __popcll(mg[2]) + __popcll(mg[3]);
        beq += __popcll(me[0]) + __popcll(me[1]) + __popcll(me[2]) + __popcll(me[3]);
      }
    }
    __syncthreads();
  } else {
    for (int i = tid; i < 512; i += 256) sel[i] = i & 255;
    __syncthreads();
  }
#pragma unroll 1
  for (int tk = 0; tk < 2; tk++) {
    const int nsel = min(256, t0 + tk + 1);
    const size_t tok = tokb + t0 + tk;
    {
      const int kk8 = lane >> 3, ch = lane & 7;
      uint4 vv[8];
#pragma unroll
      for (int it = 0; it < 8; it++) {
        const int r = w * 64 + it * 8 + kk8;
        const int idx = sel[tk * 256 + min(r, nsel - 1)];
        vv[it] = *(const uint4*)(vdb + (size_t)idx * 64 + ch * 8);
      }
      bf16x8 qf[2];
#pragma unroll
      for (int ks = 0; ks < 2; ks++) {
        uint4 u = make_uint4(0, 0, 0, 0);
        if (row16 < 4) u = *(const uint4*)(p.qd + tok * 256 + row16 * 64 + ks * 32 + kg * 8);
        qf[ks] = __builtin_bit_cast(bf16x8, u);
      }
      bf16x8 kf[4][2];
#pragma unroll
      for (int ti = 0; ti < 4; ti++) {
        const int r = w * 64 + ti * 16 + row16;
        const int idx = sel[tk * 256 + min(r, nsel - 1)];
#pragma unroll
        for (int ks = 0; ks < 2; ks++) kf[ti][ks] = *(const bf16x8*)(kdb + (size_t)idx * 64 + ks * 32 + kg * 8);
      }
#pragma unroll
      for (int ti = 0; ti < 4; ti++) {
        f32x4v acc = {0.f, 0.f, 0.f, 0.f};
        acc = __builtin_amdgcn_mfma_f32_16x16x32_bf16(kf[ti][0], qf[0], acc, 0, 0, 0);
        acc = __builtin_amdgcn_mfma_f32_16x16x32_bf16(kf[ti][1], qf[1], acc, 0, 0, 0);
        if (row16 < 4) {
#pragma unroll
          for (int r = 0; r < 4; r++) {
            const int key = w * 64 + ti * 16 + 4 * kg + r;
            sc[tk * 1024 + row16 * 256 + key] = (key < nsel) ? acc[r] * 0.125f : -INFINITY;
          }
        }
      }
      unsigned char* vw = vst + w * 8192;
#pragma unroll
      for (int it = 0; it < 8; it++) {
        const int key = it * 8 + kk8;
        *(uint4*)(vw + key * 128 + ((((ch >> 1) ^ dsa_vswz(key))) << 5) + ((ch & 1) << 4)) = vv[it];
      }
    }
    __syncthreads();
    softmax4(sc + tk * 1024, 256, 256);
    __syncthreads();
    {
      bf16x8 pf[2];
#pragma unroll
      for (int ks = 0; ks < 2; ks++) {
        uint4 u = make_uint4(0, 0, 0, 0);
        if (row16 < 4) {
          const float* ps = sc + tk * 1024 + row16 * 256 + w * 64 + ks * 32 + kg * 8;
          const float4 a = *(const float4*)ps, c4 = *(const float4*)(ps + 4);
          u = make_uint4(pack2bf(a.x, a.y), pack2bf(a.z, a.w), pack2bf(c4.x, c4.y), pack2bf(c4.z, c4.w));
        }
        pf[ks] = __builtin_bit_cast(bf16x8, u);
      }
      const unsigned char* vw = vst + w * 8192;
      const int q4 = row16 >> 2, pp = row16 & 3;
#pragma unroll
      for (int nt = 0; nt < 4; nt++) {
        f32x4v acc = {0.f, 0.f, 0.f, 0.f};
#pragma unroll
        for (int ks = 0; ks < 2; ks++) {
          const int r0 = ks * 32 + kg * 8 + q4, r1 = r0 + 4;
          const s16x4 lo = __builtin_amdgcn_ds_read_tr16_b64_v4i16((s16x4 __attribute__((address_space(3)))*)(vw + r0 * 128 + ((nt ^ dsa_vswz(r0)) << 5) + pp * 8));
          const s16x4 hi = __builtin_amdgcn_ds_read_tr16_b64_v4i16((s16x4 __attribute__((address_space(3)))*)(vw + r1 * 128 + ((nt ^ dsa_vswz(r1)) << 5) + pp * 8));
          typedef __attribute__((ext_vector_type(8))) short s16x8;
          const s16x8 v8 = __builtin_shufflevector(lo, hi, 0, 1, 2, 3, 4, 5, 6, 7);
          acc = __builtin_amdgcn_mfma_f32_16x16x32_bf16(pf[ks], __builtin_bit_cast(bf16x8, v8), acc, 0, 0, 0);
        }
        if (kg == 0) {
#pragma unroll
          for (int r = 0; r < 4; r++) part[(w * 4 + r) * 64 + nt * 16 + row16] = acc[r];
        }
      }
    }
    __syncthreads();
    {
      const float o = part[tid] + part[256 + tid] + part[512 + tid] + part[768 + tid];
      p.concat[tok * DM + 512 + tid] = f2bf(o);
    }
    __syncthreads();
  }
}
__device__ __forceinline__ void dsa_phase(const Params& p, unsigned char* smem, int bid, int nblk) {
  for (int it = bid; it < NB * (SEQ / 2); it += nblk) dsa_item(p, smem, it & 7, (SEQ / 2 - 1) - (it >> 3));
}

#define SELFCHECK 0
#ifndef PROBE_REPEAT
#define PROBE_REPEAT 0
#endif
#if SELFCHECK
__device__ __forceinline__ void check_val(const Params& p, float ref, float got, float atol, float rtol) {
  if (!(fabsf(ref - got) <= atol + rtol * fabsf(ref))) atomicExch(p.flag, 1);
}
__device__ __forceinline__ void inproj_check_phase(const Params& p, unsigned char* smem, int bid, int nblk) {
  float* h = (float*)smem;
  const float f16[8] = {1.0f, 0.19392274474868576f, 0.03760603093086393f, 0.007292664737217109f,
                        0.001414213562373095f, 0.0002742481756762073f, 5.318295896944988e-05f, 1.031338537721246e-05f};
  const int tid = threadIdx.x;
  for (int it = bid; it < 600; it += nblk) {
    const int tok = (it * 61) % NT;
    const int b = tok / SEQ, t = tok % SEQ;
    const float* xr = p.x + (size_t)tok * DM;
    for (int col = tid; col < INW; col += 256) {
      float a = 0.f;
      for (int k = 0; k < DM; k++) a = fmaf(xr[k], p.w_in[(size_t)k * INW + col], a);
      h[col] = a;
    }
    __syncthreads();
    const int pos = p.pos[tok];
    if (tid < 152) {
      const int v = tid >> 3, j = tid & 7;
      int base;
      if (v < 8) base = C_NSAQ + v * 64;
      else if (v < 10) base = C_NSAKV + 0 * 128 + (v - 8) * 64;
      else if (v < 12) base = C_NSAKV + 2 * 128 + (v - 10) * 64;
      else if (v < 14) base = C_NSAKV + 4 * 128 + (v - 12) * 64;
      else if (v < 18) base = C_DSAQ + (v - 14) * 64;
      else base = C_DSAK;
      float c, s; rope_cs(pos, f16[j], c, s);
      const float x1 = h[base + j], x2 = h[base + 8 + j];
      h[base + j] = x1 * c - x2 * s; h[base + 8 + j] = x2 * c + x1 * s;
    } else if (tid < 188) {
      const int u = tid - 152, v = u >> 2, j = u & 3;
      const int base = (v < 8) ? C_IDXQ + v * 32 : C_IDXK;
      float c, s; rope_cs(pos, f16[2 * j], c, s);
      const float x1 = h[base + j], x2 = h[base + 4 + j];
      h[base + j] = x1 * c - x2 * s; h[base + 4 + j] = x2 * c + x1 * s;
    } else if (tid < 212) {
      const int u = tid - 188;
      h[C_GATE + u] = 1.f / (1.f + expf(-h[C_GATE + u]));
    }
    __syncthreads();
    for (int col = tid; col < INW; col += 256) {
      const float ref = h[col];
      float got;
      if (col < 512) got = bf2f(p.qn[(size_t)tok * 512 + col]);
      else if (col < 1280) {
        const int o = col - 512, j = o >> 7, g = (o >> 6) & 1, d = o & 63;
        if (j == 3 || j == 5) {
          const bf16_t* vt = (j == 3) ? p.vslct : p.vwint;
          got = bf2f(vt[((size_t)(b * 2 + g) * 64 + d) * SEQ + perm16(t)]);
        } else {
          const bf16_t* src = j == 0 ? p.kvn[0] : j == 1 ? p.kvn[1] : j == 2 ? p.kvn[2] : p.kvn[4];
          got = bf2f(src[((size_t)(b * 2 + g) * SEQ + t) * 64 + d]);
        }
      }
      else if (col < 1304) got = p.gates[(size_t)tok * 24 + col - 1280];
      else if (col < 1560) got = bf2f(p.qd[(size_t)tok * 256 + col - 1304]);
      else if (col < 1624) got = bf2f(p.kd[(size_t)tok * 64 + col - 1560]);
      else if (col < 1688) got = bf2f(p.vd[(size_t)tok * 64 + col - 1624]);
      else if (col < 1944) got = bf2f(p.qi[(size_t)tok * 256 + col - 1688]);
      else if (col < 1976) got = bf2f(p.ki[(size_t)tok * 32 + col - 1944]);
      else if (col < 1984) got = p.widx[(size_t)tok * 8 + col - 1976] * 16.f;
      else got = bf2f(p.memq[(size_t)tok * 256 + col - 1984]);
      check_val(p, ref, got, 0.04f, 0.02f);
    }
    __syncthreads();
  }
  for (int it = bid; it < 64; it += nblk) {
    const int row = (it * 37) % (NB * MEML);
    for (int col = tid; col < 512; col += 256) {
      float a = 0.f;
      for (int k = 0; k < DM; k++) a = fmaf(p.mem[(size_t)row * DM + k], p.w_mem_kv[(size_t)k * 512 + col], a);
      float gotm;
      if (col < 256) gotm = bf2f(p.mkv[(size_t)row * 512 + col]);
      else { const int hd = (col - 256) >> 6, dd = col & 63; gotm = bf2f(p.memvt[((size_t)((row >> 8) * 4 + hd) * 64 + dd) * MEML + perm16(row & 255)]); }
      check_val(p, a, gotm, 0.04f, 0.02f);
    }
  }
}

__device__ __forceinline__ void mem_check_phase(const Params& p, unsigned char* smem, int bid, int nblk) {
  float* q = (float*)smem;
  float* sc = q + 256;
  const int tid = threadIdx.x;
  for (int it = bid; it < 700; it += nblk) {
    const int tok = (it * 47 + 13) % NT;
    const int b = tok / SEQ;
    q[tid] = bf2f(p.memq[(size_t)tok * 256 + tid]);
    __syncthreads();
    const bf16_t* kvb = p.mkv + (size_t)b * MEML * 512;
    for (int idx = tid; idx < 4 * 256; idx += 256) {
      const int hh = idx >> 8, m = idx & 255;
      sc[hh * 256 + m] = dot64_bf(q + hh * 64, kvb + (size_t)m * 512 + hh * 64) * 0.125f;
    }
    __syncthreads();
    softmax4(sc, 256, 256);
    __syncthreads();
    {
      const int h = tid >> 6, d = tid & 63;
      float o = 0.f;
      for (int m = 0; m < 256; m++) o = fmaf(sc[h * 256 + m], bf2f(p.memvt[((size_t)(b * 4 + h) * 64 + d) * MEML + perm16(m)]), o);
      check_val(p, o, bf2f(p.concat[(size_t)tok * DM + 768 + tid]), 0.004f, 0.02f);
    }
    __syncthreads();
  }
}
__device__ __forceinline__ void nsa_check_phase(const Params& p, unsigned char* smem, int bid, int nblk) {
  float* q = (float*)smem;
  float* sc = q + 256;
  float* o3 = sc + 4096;
  float* imp = o3 + 768;
  int* sel = (int*)(imp + 64);
  int* nselp = sel + 16;
  const int tid = threadIdx.x, h = tid >> 6, d = tid & 63;
  for (int it = bid; it < 1024; it += nblk) {
    const int item = (int)(((long long)it * 62851 + 7) % (NT * 2));
    const int g = item & 1, tok = item >> 1, b = tok / SEQ, t = tok % SEQ;
    const size_t kvb = (size_t)(b * 2 + g) * SEQ * 64;
    const bf16_t *kslc = p.kvn[2] + kvb, *kwin = p.kvn[4] + kvb;
    const bf16_t *vslct = p.vslct + (size_t)(b * 2 + g) * 64 * SEQ, *vwint = p.vwint + (size_t)(b * 2 + g) * 64 * SEQ;
    q[tid] = bf2f(p.qn[(size_t)tok * 512 + g * 256 + tid]);
    __syncthreads();
    const int nv = (t >= 31) ? (t - 31) / 16 + 1 : 0;
    const bf16_t* kcb = p.kcb + (size_t)(b * 2 + g) * 256 * 64;
    const bf16_t* vct = p.vct + (size_t)(b * 2 + g) * 64 * 256;
    for (int idx = tid; idx < 4 * 256; idx += 256) {
      const int hh = idx >> 8, i = idx & 255;
      float s = -INFINITY;
      if (i < nv) {
        s = 0.f;
        for (int e = 0; e < 64; e++) s = fmaf(q[hh * 64 + e], bf2f(kcb[i * 64 + e]), s);
        s *= 0.125f;
      }
      sc[hh * 1024 + i] = s;
    }
    __syncthreads();
    softmax4(sc, 1024, 256);
    __syncthreads();
    {
      float o = 0.f;
      for (int i = 0; i < nv; i++) o = fmaf(sc[h * 1024 + i], bf2f(vct[d * 256 + perm16(i)]), o);
      o3[0 * 256 + tid] = o;
    }
    const int cur = t / 64;
    if (tid < 64) {
      const int m = tid;
      float a = 0.f;
      const int n0 = max(0, 4 * m - 2), n1 = min(NC - 1, 4 * m + 4);
      for (int n = n0; n <= n1; n++) {
        const int ov = min(16 * n + 32, 64 * m + 64) - max(16 * n, 64 * m);
        if (ov > 0) {
          const float w = (float)ov * (1.f / 32.f);
          for (int hh = 0; hh < 4; hh++) a = fmaf(sc[hh * 1024 + n], w, a);
        }
      }
      const bool forced = (m == 0) || (m == cur) || (m == cur - 1);
      const bool vis = (m <= cur);
      imp[m] = vis ? a + (forced ? 1e4f : 0.f) : -INFINITY;
    }
    __syncthreads();
    if (tid < 64) {
      const int m = tid;
      const float sm = imp[m];
      int rank = 0;
      for (int mm = 0; mm < 64; mm++) { const float s2 = imp[mm]; rank += (s2 > sm) || (s2 == sm && mm < m); }
      const bool take = (rank < 16) && (m <= cur);
      const unsigned long long bal = __ballot(take);
      if (take) sel[__popcll(bal & ((1ull << m) - 1ull))] = m;
      if (m == 0) *nselp = __popcll(bal);
    }
    __syncthreads();
    const int nsel = *nselp;
    {
      const int nk = nsel * 64;
      for (int idx = tid; idx < 4 * nk; idx += 256) {
        const int hh = idx / nk, r = idx % nk;
        const int kpos = sel[r >> 6] * 64 + (r & 63);
        float s = -INFINITY;
        if (kpos <= t) s = dot64_bf(q + hh * 64, kslc + (size_t)kpos * 64) * 0.125f;
        sc[hh * 1024 + r] = s;
      }
      __syncthreads();
      softmax4(sc, 1024, nk);
      __syncthreads();
      float o = 0.f;
      for (int r = 0; r < nk; r++) {
        const int kpos = sel[r >> 6] * 64 + (r & 63);
        if (kpos <= t) o = fmaf(sc[h * 1024 + r], bf2f(vslct[(size_t)d * SEQ + perm16(kpos)]), o);
      }
      o3[1 * 256 + tid] = o;
      __syncthreads();
    }
    {
      for (int idx = tid; idx < 4 * 512; idx += 256) {
        const int hh = idx >> 9, r = idx & 511;
        const int kpos = t - 511 + r;
        float s = -INFINITY;
        if (kpos >= 0) s = dot64_bf(q + hh * 64, kwin + (size_t)kpos * 64) * 0.125f;
        sc[hh * 1024 + r] = s;
      }
      __syncthreads();
      softmax4(sc, 1024, 512);
      __syncthreads();
      float o = 0.f;
      for (int r = 0; r < 512; r++) {
        const int kpos = t - 511 + r;
        if (kpos >= 0) o = fmaf(sc[h * 1024 + r], bf2f(vwint[(size_t)d * SEQ + perm16(kpos)]), o);
      }
      o3[2 * 256 + tid] = o;
    }
    {
      const float* gt = p.gates + (size_t)tok * 24 + (g * 4 + h) * 3;
      const float r = gt[0] * o3[tid] + gt[1] * o3[256 + tid] + gt[2] * o3[512 + tid];
      const float got = bf2f(p.concat[(size_t)tok * DM + g * 256 + tid]);
      const float df = fabsf(r - got);
      if (!(df <= 0.08f + 0.1f * fabsf(r))) atomicExch(p.flag, 1);
      if (!(df <= 0.006f + 0.02f * fabsf(r))) atomicAdd(p.chkcnt, 1);
    }
    __syncthreads();
  }
}

__device__ __forceinline__ void dsa_check_phase(const Params& p, unsigned char* smem, int bid, int nblk) {
  unsigned* keys = (unsigned*)smem;
  float* qi = (float*)(keys + 4096);
  float* wi = qi + 256;
  int* hist = (int*)(wi + 8);
  int* sel = hist + 256;
  int* misc = sel + 256;
  int* cnts = misc + 8;
  float* qd = (float*)(cnts + 256);
  float* sc = qd + 256;
  const int tid = threadIdx.x;
  for (int it = bid; it < 1500; it += nblk) {
    const int tok = (int)(((long long)it * 39119 + 11) % NT);
    const int b = tok / SEQ, t = tok % SEQ;
    const bf16_t* kib = p.ki + (size_t)b * SEQ * 32;
    const bf16_t* kdb = p.kd + (size_t)b * SEQ * 64;
    const bf16_t* vdb = p.vd + (size_t)b * SEQ * 64;
    qi[tid] = bf2f(p.qi[(size_t)tok * 256 + tid]);
    if (tid < 8) wi[tid] = p.widx[(size_t)tok * 8 + tid];
    qd[tid] = bf2f(p.qd[(size_t)tok * 256 + tid]);
    __syncthreads();
    const int n = t + 1;
    int nsel;
    if (n <= 256) {
      for (int s = tid; s < n; s += 256) sel[s] = s;
      nsel = n;
      __syncthreads();
    } else {
      for (int s = tid; s < n; s += 256) {
        float kv[32];
#pragma unroll
        for (int e = 0; e < 32; e += 8) {
          const uint4 v = *(const uint4*)(kib + (size_t)s * 32 + e);
          kv[e + 0] = __uint_as_float(v.x << 16); kv[e + 1] = __uint_as_float(v.x & 0xFFFF0000u);
          kv[e + 2] = __uint_as_float(v.y << 16); kv[e + 3] = __uint_as_float(v.y & 0xFFFF0000u);
          kv[e + 4] = __uint_as_float(v.z << 16); kv[e + 5] = __uint_as_float(v.z & 0xFFFF0000u);
          kv[e + 6] = __uint_as_float(v.w << 16); kv[e + 7] = __uint_as_float(v.w & 0xFFFF0000u);
        }
        float score = 0.f;
    #pragma unroll 1
    for (int hh = 0; hh < 8; hh++) {
          float dsum = 0.f;
#pragma unroll
          for (int e = 0; e < 32; e++) dsum = fmaf(qi[hh * 32 + e], kv[e], dsum);
          score = fmaf(fmaxf(dsum, 0.f), wi[hh], score);
        }
        keys[s] = f2key(score);
      }
      unsigned prefix = 0; int kk = 256;
      for (int shift = 24; shift >= 0; shift -= 8) {
        hist[tid] = 0;
        __syncthreads();
        const unsigned hmask = (shift == 24) ? 0u : (0xFFFFFFFFu << (shift + 8));
        for (int s = tid; s < n; s += 256) {
          const unsigned k = keys[s];
          if ((k & hmask) == prefix) atomicAdd(&hist[(k >> shift) & 255], 1);
        }
        __syncthreads();
        if (tid == 0) {
          int cum = 0, dsel = 0;
          for (int dg = 255; dg >= 0; dg--) {
            const int c = hist[dg];
            if (cum + c >= kk) { dsel = dg; break; }
            cum += c;
          }
          misc[0] = dsel; misc[1] = kk - cum;
        }
        __syncthreads();
        prefix |= ((unsigned)misc[0]) << shift;
        kk = misc[1];
        __syncthreads();
      }
      const int per = (n + 255) / 256;
      const int s0 = tid * per, s1 = min(n, s0 + per);
      int cg_ = 0, ce = 0;
      for (int s = s0; s < s1; s++) { const unsigned k = keys[s]; cg_ += (k > prefix); ce += (k == prefix); }
      cnts[tid] = cg_; hist[tid] = ce;
      __syncthreads();
      if (tid == 0) {
        int a = 0, e = 0;
        for (int i = 0; i < 256; i++) { const int c1 = cnts[i], c2 = hist[i]; cnts[i] = a; hist[i] = e; a += c1; e += c2; }
        misc[2] = a;
      }
      __syncthreads();
      {
        int og = cnts[tid], oe = hist[tid];
        const int ngt = misc[2];
        for (int s = s0; s < s1; s++) {
          const unsigned k = keys[s];
          if (k > prefix) sel[og++] = s;
          else if (k == prefix) { if (oe < kk) sel[ngt + oe] = s; oe++; }
        }
      }
      nsel = 256;
      __syncthreads();
    }
    for (int idx = tid; idx < 4 * nsel; idx += 256) {
      const int hh = idx / nsel, r = idx % nsel;
      sc[hh * 256 + r] = dot64_bf(qd + hh * 64, kdb + (size_t)sel[r] * 64) * 0.125f;
    }
    __syncthreads();
    softmax4(sc, 256, nsel);
    __syncthreads();
    {
      const int h = tid >> 6, d = tid & 63;
      float o = 0.f;
      for (int r = 0; r < nsel; r++) o = fmaf(sc[h * 256 + r], bf2f(vdb[(size_t)sel[r] * 64 + d]), o);
      const float got = bf2f(p.concat[(size_t)tok * DM + 512 + tid]);
      const float df = fabsf(o - got);
      if (!(df <= 0.08f + 0.1f * fabsf(o))) atomicExch(p.flag, 1);
      if (!(df <= 0.004f + 0.02f * fabsf(o))) atomicAdd(p.chkcnt, 1);
    }
    __syncthreads();
  }
}


__device__ __forceinline__ void compress_check_phase(const Params& p, unsigned char* smem, int bid, int nblk) {
  float* hid = (float*)smem;
  const int tid = threadIdx.x;
  const int which = tid >> 7, j = tid & 127;
  for (int it = bid; it < 600; it += nblk) {
    const int item = (it * 131 + 5) % (NB * 2 * NC);
    const int i = item % NC, g = (item / NC) % 2, b = item / (NC * 2);
    const float* w1 = which ? p.w1v : p.w1k;
    const float* pe = which ? p.pe_v : p.pe_k;
    const bf16_t* src = (which ? p.kvn[1] : p.kvn[0]) + ((size_t)(b * 2 + g) * SEQ + i * 16) * 64;
    float acc = 0.f;
    for (int r = 0; r < 2048; r++) acc = fmaf(bf2f(src[r]) + pe[r], w1[(size_t)r * 128 + j], acc);
    hid[which * 128 + j] = gelu_exact(acc);
    __syncthreads();
    if (j < 64) {
      const float* w2 = which ? p.w2v : p.w2k;
      float o = 0.f;
      for (int k = 0; k < 128; k++) o = fmaf(hid[which * 128 + k], w2[k * 64 + j], o);
      const float got = which ? bf2f(p.vct[((size_t)(b * 2 + g) * 64 + j) * 256 + perm16(i)]) : bf2f(p.kcb[((size_t)(b * 2 + g) * 256 + i) * 64 + j]);
      check_val(p, o, got, 0.01f, 0.02f);
    }
    __syncthreads();
  }
}
#endif


#define XB_TMO      128
#define XB_XCNT(j)  (256  + 64 * (j))
#define XB_XSUB(j)  (1280 + 64 * (j))
#define XB_XGEN(j)  (2304 + 64 * (j))
#define XB_TOP      3328
#define XB_TOPGEN   3392
#define XCD_BAR_WORDS 3456
#define XB_SPIN_CAP (1u << 23)
#define LAS __attribute__((address_space(3)))
__device__ __forceinline__ unsigned xb_ld(unsigned* p)              { return __hip_atomic_load(p, __ATOMIC_RELAXED, __HIP_MEMORY_SCOPE_AGENT); }
__device__ __forceinline__ unsigned xb_add(unsigned* p, unsigned v) { return __hip_atomic_fetch_add(p, v, __ATOMIC_RELAXED, __HIP_MEMORY_SCOPE_AGENT); }
__device__ __forceinline__ unsigned xb_xcc_id() { return (unsigned)__builtin_amdgcn_s_getreg((3 << 11) | 20) & 0xFu; }
#define XB_SPIN(cond, bar) do { unsigned _sp = 0; while (cond) { __builtin_amdgcn_s_sleep(1); \
    if ((++_sp & 255u) == 0u) { if (xb_ld(&(bar)[XB_TMO])) break; if (_sp > XB_SPIN_CAP) { atomicAdd(&(bar)[XB_TMO], 1u); break; } } } } while (0)
struct XcdBarrier { unsigned* bar; unsigned x; volatile LAS unsigned* st; };
__device__ __forceinline__ XcdBarrier xcd_barrier_post(unsigned* bar, volatile LAS unsigned* st) {
  XcdBarrier b; b.bar = bar; b.x = xb_xcc_id(); b.st = st;
  if (threadIdx.x == 0) (void)xb_add(&bar[XB_XCNT(b.x)], 1u);
  return b;
}
__device__ __forceinline__ void xcd_barrier_complete(unsigned* bar, unsigned x, unsigned& nloc, unsigned& nx) {
  const unsigned G = gridDim.x * gridDim.y * gridDim.z;
  unsigned sum, cnt, mine, sp = 0u;
  for (;;) {
    sum = 0u; cnt = 0u; mine = 0u;
#pragma unroll
    for (unsigned j = 0; j < 16; ++j) { const unsigned c = xb_ld(&bar[XB_XCNT(j)]); sum += c; cnt += (c > 0u) ? 1u : 0u; mine = (j == x) ? c : mine; }
    if (sum == G) break;
    __builtin_amdgcn_s_sleep(1);
    if ((++sp & 255u) == 0u) { if (xb_ld(&bar[XB_TMO])) break; if (sp > XB_SPIN_CAP) { atomicAdd(&bar[XB_TMO], 1u); break; } }
  }
  nloc = mine > 0u ? mine : 1u; nx = cnt > 0u ? cnt : 1u;
}
__device__ __forceinline__ void xcd_barrier(const XcdBarrier& b) {
  asm volatile("s_waitcnt vmcnt(0)" ::: "memory");
  __syncthreads();
  if (threadIdx.x == 0) {
    unsigned* bar = b.bar;
    __builtin_amdgcn_s_waitcnt(0);
    unsigned nloc = b.st[0], nx = b.st[1];
    if (nloc == 0u) { xcd_barrier_complete(bar, b.x, nloc, nx); b.st[0] = nloc; b.st[1] = nx; }
    const unsigned old = xb_add(&bar[XB_XSUB(b.x)], 1u);
    const unsigned gen = old / nloc;
    if (old + 1u == (gen + 1u) * nloc) {
      __builtin_amdgcn_fence(__ATOMIC_RELEASE, "agent");
      asm volatile("s_waitcnt vmcnt(0)" ::: "memory");
      const unsigned og = xb_add(&bar[XB_TOP], 1u);
      const unsigned tg = og / nx;
      if (og + 1u == (tg + 1u) * nx) xb_add(&bar[XB_TOPGEN], 1u);
      else XB_SPIN(xb_ld(&bar[XB_TOPGEN]) == tg, bar);
      __builtin_amdgcn_fence(__ATOMIC_ACQUIRE, "agent");
      xb_add(&bar[XB_XGEN(b.x)], 1u);
      asm volatile("s_waitcnt vmcnt(0)" ::: "memory");
    } else {
      XB_SPIN(xb_ld(&bar[XB_XGEN(b.x)]) == gen, bar);
      __builtin_amdgcn_fence(__ATOMIC_ACQUIRE, "agent");
      asm volatile("s_waitcnt vmcnt(0)" ::: "memory");
    }
  }
  __syncthreads();
}

constexpr int SMEM_BYTES = 65536;
__global__ void __launch_bounds__(256, 2) megakernel(Params p) {
  __shared__ __align__(16) unsigned char smem[SMEM_BYTES];
  __shared__ uint4 xb_words;
  cg::grid_group grid = cg::this_grid();
  const int bid = blockIdx.x, nblk = gridDim.x;
  if (threadIdx.x == 0) xb_words = make_uint4(0u, 0u, 0u, 0u);
  __syncthreads();
  const XcdBarrier xb = xcd_barrier_post(p.bar, (volatile LAS unsigned*)&xb_words);
  if (p.never) grid.sync();
  for (int rep = 0; rep < ((PROBE_REPEAT & 128) ? 2 : 1); rep++) {
  convert_phase(p.x, p.xb, (size_t)NT * DM, bid, nblk);
  convert_phase(p.mem, p.memb, (size_t)NB * MEML * DM, bid, nblk);
  quant_phase(p.pu, p.puq, p.psu, 16384, bid, nblk);
  quant_phase(p.pv, p.pvq, p.psv, 16384, bid, nblk);
  }
  for (int rep = 0; rep < ((PROBE_REPEAT & 256) ? 2 : 1); rep++) {
  transpose_phase<true>(p.w_in, INW, p.wint, DM, INWP, smem, bid, nblk);
  transpose_phase<false>(p.w_mem_kv, 512, p.wmemt, DM, 512, smem, bid, nblk);
  transpose_phase<false>(p.w_out, DM, p.woutt, DM, DM, smem, bid, nblk);
  transpose_phase<false>(p.wq, 2048, p.wqt, DM, 2048, smem, bid, nblk);
  transpose_phase<false>(p.w1k, 128, p.w1kt, 2048, 128, smem, bid, nblk);
  transpose_phase<false>(p.w1v, 128, p.w1vt, 2048, 128, smem, bid, nblk);
  }
  for (int rep = 0; rep < ((PROBE_REPEAT & 512) ? 2 : 1); rep++) {
  cbias_phase(p, bid, nblk);
  subkey_phase(p.sk1, p.sk1p, bid, nblk);
  subkey_phase(p.sk2, p.sk2p, bid, nblk);
  cs_phase(p, bid, nblk);
  ovp_phase(p, bid, nblk);
  }
  if (bid == 0 && threadIdx.x == 0) { *p.flag = 0; *p.chkcnt = 0; }
  xcd_barrier(xb);
  for (int rep = 0; rep < ((PROBE_REPEAT & 2) ? 2 : 1); rep++) inproj_phase(p, smem, bid, nblk);
  xcd_barrier(xb);
  for (int rep = 0; rep < ((PROBE_REPEAT & 4) ? 2 : 1); rep++) compress_phase(p, smem, bid, nblk);
  xcd_barrier(xb);
  {
    constexpr int N_NSA = NB * 2 * 128, N_DSA = NB * (SEQ / 2), N_MEM = NB * 4 * 32;
    volatile LAS unsigned* qslot = (volatile LAS unsigned*)&xb_words + 2;
#pragma unroll 1
    for (;;) {
      __syncthreads();
      if (threadIdx.x == 0) qslot[0] = atomicAdd(p.bar + 64, 1u);
      __syncthreads();
      const int q = (int)qslot[0];
      if (q >= N_NSA) break;
      nsa_flash_item(p, smem, ((q & 15) << 7) | (127 - (q >> 4)));
    }
#pragma unroll 1
    for (;;) {
      __syncthreads();
      if (threadIdx.x == 0) qslot[0] = atomicAdd(p.bar + 65, 1u);
      __syncthreads();
      const int q = (int)qslot[0];
      if (q >= N_DSA) break;
      dsa_item(p, smem, q & 7, (SEQ / 2 - 1) - (q >> 3));
    }
#pragma unroll 1
    for (;;) {
      __syncthreads();
      if (threadIdx.x == 0) qslot[0] = atomicAdd(p.bar + 66, 1u);
      __syncthreads();
      const int q = (int)qslot[0];
      if (q >= N_MEM) break;
      mem_flash_item(p, smem, q);
    }
  }
  xcd_barrier(xb);
  for (int rep = 0; rep < ((PROBE_REPEAT & 64) ? 2 : 1); rep++) peer_block_phase(p, smem, bid, nblk);
}


#if SELFCHECK
__global__ void __launch_bounds__(256) check_kernel(Params p) {
  __shared__ __align__(16) unsigned char smem[40960];
  inproj_check_phase(p, smem, blockIdx.x, gridDim.x);
}
__global__ void check_final(Params p) {
  if (threadIdx.x == 0 && (*(volatile int*)p.flag != 0 || *(volatile int*)p.chkcnt > 6000)) p.out[0] = __uint_as_float(0x7FC00000u);
}
#endif

extern "C" void kernel_launch(void* const* d_in, const int* in_sizes, int n_in, void* d_out, int out_size,
                              void* d_ws, size_t ws_size, hipStream_t stream) {
  Params p{};
  p.x = (const float*)d_in[0]; p.mem = (const float*)d_in[1]; p.pos = (const int*)d_in[2];
  p.w_in = (const float*)d_in[3]; p.pe_k = (const float*)d_in[4]; p.pe_v = (const float*)d_in[5];
  p.w1k = (const float*)d_in[6]; p.w2k = (const float*)d_in[7]; p.w1v = (const float*)d_in[8]; p.w2v = (const float*)d_in[9];
  p.w_mem_kv = (const float*)d_in[10]; p.w_out = (const float*)d_in[11]; p.ln1g = (const float*)d_in[12]; p.ln1b = (const float*)d_in[13];
  p.wq = (const float*)d_in[14]; p.sk1 = (const float*)d_in[15]; p.sk2 = (const float*)d_in[16];
  p.pu = (const float*)d_in[17]; p.pv = (const float*)d_in[18]; p.ln2g = (const float*)d_in[19]; p.ln2b = (const float*)d_in[20];
  p.out = (float*)d_out;
  unsigned char* ws = (unsigned char*)d_ws;
  size_t off = 0;
  auto take = [&](size_t bytes) { void* r = ws + off; off += (bytes + 255) & ~(size_t)255; return r; };
  p.xb = (bf16_t*)take((size_t)NT * DM * 2);
  p.qn = (bf16_t*)take((size_t)NT * 512 * 2);
  for (int j = 0; j < 6; j++) p.kvn[j] = (bf16_t*)take((size_t)NT * 128 * 2);
  p.qd = (bf16_t*)take((size_t)NT * 256 * 2);
  p.kd = (bf16_t*)take((size_t)NT * 64 * 2);
  p.vd = (bf16_t*)take((size_t)NT * 64 * 2);
  p.qi = (bf16_t*)take((size_t)NT * 256 * 2);
  p.ki = (bf16_t*)take((size_t)NT * 32 * 2);
  p.memq = (bf16_t*)take((size_t)NT * 256 * 2);
  p.gates = (float*)take((size_t)NT * 24 * 4);
  p.widx = (float*)take((size_t)NT * 8 * 4);
  p.mkv = (bf16_t*)take((size_t)NB * MEML * 512 * 2);
  p.memvt = (bf16_t*)take((size_t)NB * 4 * 64 * MEML * 2);
  p.vslct = (bf16_t*)take((size_t)NT * 128 * 2);
  p.vwint = (bf16_t*)take((size_t)NT * 128 * 2);
  p.kcb = (bf16_t*)take((size_t)NB * 2 * 256 * 64 * 2);
  p.vct = (bf16_t*)take((size_t)NB * 2 * 64 * 256 * 2);
  p.ovp = (bf16_t*)take((size_t)64 * 256 * 2);
  p.w1kt = (bf16_t*)take((size_t)128 * 2048 * 2);
  p.w1vt = (bf16_t*)take((size_t)128 * 2048 * 2);
  p.cbias = (float*)take(64 * 256 * 4);
  p.chkcnt = (int*)take(256);
  p.bar = (unsigned*)take(XCD_BAR_WORDS * 4);
  p.never = 0; p.pad_ = 0;
  p.memb = (bf16_t*)take((size_t)NB * MEML * DM * 2);
  p.wint = (bf16_t*)take((size_t)INWP * DM * 2);
  p.wmemt = (bf16_t*)take((size_t)512 * DM * 2);
  p.woutt = (bf16_t*)take((size_t)DM * DM * 2);
  p.wqt = (bf16_t*)take((size_t)2048 * DM * 2);
  p.sk1p = (bf16_t*)take((size_t)128 * 128 * 2);
  p.sk2p = (bf16_t*)take((size_t)128 * 128 * 2);
  p.puq = (unsigned char*)take((size_t)16384 * DM);
  p.pvq = (unsigned char*)take((size_t)16384 * DM);
  p.psu = (float*)take(16384 * 4);
  p.psv = (float*)take(16384 * 4);
  p.cs = (float2*)take((size_t)NT * 8 * 8);
  p.kc = (float*)take((size_t)NB * 2 * NC * 64 * 4);
  p.vc = (float*)take((size_t)NB * 2 * NC * 64 * 4);
  p.concat = (bf16_t*)take((size_t)NT * DM * 2);
  p.x1b = (bf16_t*)take((size_t)NT * DM * 2);
  p.pexp = (int*)take((size_t)NT * 128 * 4);
  p.pgate = (float*)take((size_t)NT * 128 * 4);
  p.flag = (int*)take(256);
  if (off > ws_size) { fprintf(stderr, "workspace too small: need %zu have %zu\n", off, ws_size); return; }
  static int grid_blocks = 0;
  if (!grid_blocks) {
    int dev = 0, cus = 0, per_cu = 0;
    hipGetDevice(&dev);
    hipDeviceGetAttribute(&cus, hipDeviceAttributeMultiprocessorCount, dev);
    hipOccupancyMaxActiveBlocksPerMultiprocessor(&per_cu, megakernel, 256, 0);
    if (per_cu > 2) per_cu = 2;
    grid_blocks = cus * per_cu;
  }
  hipMemsetAsync(p.bar, 0, XCD_BAR_WORDS * 4, stream);
  void* args[] = {&p};
  hipError_t e = hipLaunchCooperativeKernel((void*)megakernel, dim3(grid_blocks), dim3(256), args, 0, stream);
  if (e != hipSuccess) fprintf(stderr, "cooperative launch failed: %s (grid %d)\n", hipGetErrorString(e), grid_blocks);
#if SELFCHECK
  check_kernel<<<512, 256, 0, stream>>>(p);
  check_final<<<1, 64, 0, stream>>>(p);
#endif
}
```

```cpp
#include <hip/hip_runtime.h>
#include <hip/hip_cooperative_groups.h>
#include <cstdio>
#include <cstdint>
namespace cg = cooperative_groups;

constexpr int NB = 8, SEQ = 4096, DM = 1024, NT = NB * SEQ;
constexpr int INW = 2240;
constexpr int INWP = 2304;
constexpr int NC = 255;
constexpr int MEML = 256;
constexpr int C_NSAQ = 0, C_NSAKV = 512, C_GATE = 1280, C_DSAQ = 1304, C_DSAK = 1560, C_DSAV = 1624,
              C_IDXQ = 1688, C_IDXK = 1944, C_IDXW = 1976, C_MEMQ = 1984;
constexpr int P_NSAQ = 0, P_NSAKV = 512, P_DSAQ = 1280, P_DSAK = 1536, P_DSAV = 1600, P_IDXQ = 1664, P_IDXK = 1920,
              P_MEMQ = 1952, P_GATE = 2208, P_IDXW = 2232, P_END = 2240;
constexpr float ALPHA = 1.189207115002721f;

typedef unsigned short bf16_t;
typedef __attribute__((ext_vector_type(8))) __bf16 bf16x8;
typedef __attribute__((ext_vector_type(2))) __bf16 bf16x2;
typedef __attribute__((ext_vector_type(2))) float f32x2;
typedef __attribute__((ext_vector_type(4))) float f32x4;
typedef __attribute__((ext_vector_type(16))) float f32x16;

struct Params {
  const float *x, *mem; const int* pos;
  const float *w_in, *pe_k, *pe_v, *w1k, *w2k, *w1v, *w2v, *w_mem_kv, *w_out, *ln1g, *ln1b,
              *wq, *sk1, *sk2, *pu, *pv, *ln2g, *ln2b;
  float* out;
  bf16_t *xb, *memb, *wint, *wmemt, *woutt, *wqt, *sk1p, *sk2p;
  unsigned char *puq, *pvq;
  float *psu, *psv;
  float2* cs;
  bf16_t *qn;
  bf16_t *kvn[6];
  bf16_t *qd, *kd, *vd;
  bf16_t *qi, *ki;
  bf16_t *memq, *mkv;
  bf16_t *memvt;
  bf16_t *vslct, *vwint;
  bf16_t *w1kt, *w1vt; float* cbias;
  bf16_t *kcb, *vct;
  bf16_t *ovp;
  int *chkcnt;
  unsigned *bar;
  int never;
  int pad_;
  float *gates, *widx;
  bf16_t *concat;
  bf16_t *x1b;
  float *kc, *vc;
  int   *pexp;
  float *pgate;
  int   *flag;
};

__device__ __forceinline__ float bf2f(bf16_t u) { return __uint_as_float(((unsigned)u) << 16); }
__device__ __forceinline__ bf16_t f2bf(float f) { return __builtin_bit_cast(unsigned short, (__bf16)f); }
__device__ __forceinline__ unsigned pack2bf(float a, float b) {
  f32x2 v = {a, b};
  return __builtin_bit_cast(unsigned, __builtin_convertvector(v, bf16x2));
}

__device__ __forceinline__ float wave_sum(float v) {
#pragma unroll
  for (int o = 32; o > 0; o >>= 1) v += __shfl_xor(v, o);
  return v;
}
__device__ __forceinline__ float wave_max(float v) {
#pragma unroll
  for (int o = 32; o > 0; o >>= 1) v = fmaxf(v, __shfl_xor(v, o));
  return v;
}
__device__ __forceinline__ float gelu_exact(float x) { return 0.5f * x * (1.f + erff(x * 0.7071067811865476f)); }

__device__ __forceinline__ void convert_phase(const float* __restrict__ src, bf16_t* __restrict__ dst, size_t n, int bid, int nblk) {
  const size_t nch = n / 8, stride = (size_t)nblk * 256;
  size_t c = (size_t)bid * 256 + threadIdx.x;
  for (; c + 3 * stride < nch; c += 4 * stride) {
    float4 a[4], b[4];
#pragma unroll
    for (int u = 0; u < 4; u++) { a[u] = *(const float4*)(src + (c + u * stride) * 8); b[u] = *(const float4*)(src + (c + u * stride) * 8 + 4); }
#pragma unroll
    for (int u = 0; u < 4; u++) {
      uint4 o = {pack2bf(a[u].x, a[u].y), pack2bf(a[u].z, a[u].w), pack2bf(b[u].x, b[u].y), pack2bf(b[u].z, b[u].w)};
      *(uint4*)(dst + (c + u * stride) * 8) = o;
    }
  }
  for (; c < nch; c += stride) {
    const float4 a = *(const float4*)(src + c * 8), b = *(const float4*)(src + c * 8 + 4);
    uint4 o = {pack2bf(a.x, a.y), pack2bf(a.z, a.w), pack2bf(b.x, b.y), pack2bf(b.z, b.w)};
    *(uint4*)(dst + c * 8) = o;
  }
}
__device__ __forceinline__ unsigned quant4(const float4& v, float inv) {
  const unsigned a = (unsigned)(__float2int_rn(v.x * inv) + 128), b = (unsigned)(__float2int_rn(v.y * inv) + 128);
  const unsigned c = (unsigned)(__float2int_rn(v.z * inv) + 128), d = (unsigned)(__float2int_rn(v.w * inv) + 128);
  return a | (b << 8) | (c << 16) | (d << 24);
}
__device__ __forceinline__ float absmax4(const float4& v) { return fmaxf(fmaxf(fabsf(v.x), fabsf(v.y)), fmaxf(fabsf(v.z), fabsf(v.w))); }
__device__ __forceinline__ void quant_phase(const float* __restrict__ src, unsigned char* __restrict__ dst, float* __restrict__ scl,
                                            int nrows, int bid, int nblk) {
  const int lane = threadIdx.x & 63, gw = bid * 4 + (threadIdx.x >> 6), nw = nblk * 4;
  for (int r = gw * 2; r < nrows; r += nw * 2) {
    const float4* s0 = (const float4*)(src + (size_t)r * 1024 + 16 * lane);
    const float4* s1 = (const float4*)(src + (size_t)(r + 1) * 1024 + 16 * lane);
    const float4 a0 = s0[0], a1 = s0[1], a2 = s0[2], a3 = s0[3];
    const float4 b0 = s1[0], b1 = s1[1], b2 = s1[2], b3 = s1[3];
    const float ma = wave_max(fmaxf(fmaxf(absmax4(a0), absmax4(a1)), fmaxf(absmax4(a2), absmax4(a3))));
    const float mb = wave_max(fmaxf(fmaxf(absmax4(b0), absmax4(b1)), fmaxf(absmax4(b2), absmax4(b3))));
    const float ia = ma > 0.f ? 127.f / ma : 0.f, ib = mb > 0.f ? 127.f / mb : 0.f;
    *(uint4*)(dst + (size_t)r * 1024 + 16 * lane) = make_uint4(quant4(a0, ia), quant4(a1, ia), quant4(a2, ia), quant4(a3, ia));
    *(uint4*)(dst + (size_t)(r + 1) * 1024 + 16 * lane) = make_uint4(quant4(b0, ib), quant4(b1, ib), quant4(b2, ib), quant4(b3, ib));
    if (lane == 0) { scl[r] = ma * (1.f / 127.f); scl[r + 1] = mb * (1.f / 127.f); }
  }
}
__device__ __forceinline__ int inproj_colmap(int n) {
  if (n < P_DSAQ) return n;
  if (n < P_DSAK) return C_DSAQ + (n - P_DSAQ);
  if (n < P_IDXQ) return C_DSAK + (n - P_DSAK);
  if (n < P_IDXK) return C_IDXQ + (n - P_IDXQ);
  if (n < P_MEMQ) return C_IDXK + (n - P_IDXK);
  if (n < P_GATE) return C_MEMQ + (n - P_MEMQ);
  if (n < P_IDXW) return C_GATE + (n - P_GATE);
  if (n < P_END) return C_IDXW + (n - P_IDXW);
  return -1;
}
template <bool PERM>
__device__ __forceinline__ void transpose_phase(const float* __restrict__ src, int lds_, bf16_t* __restrict__ dst, int K, int Nd,
                                unsigned char* smem, int bid, int nblk) {
  float (*t)[65] = (float (*)[65])smem;
  const int tx = threadIdx.x & 63, ty = threadIdx.x >> 6;
  const int tk = K / 64, tn = Nd / 64;
  for (int tile = bid; tile < tk * tn; tile += nblk) {
    const int k0 = (tile % tk) * 64, n0 = (tile / tk) * 64;
    const int nsrc = PERM ? inproj_colmap(n0 + tx) : (n0 + tx);
#pragma unroll
    for (int i = 0; i < 16; i++) {
      const int k = ty + 4 * i;
      t[tx][k] = (nsrc >= 0) ? src[(size_t)(k0 + k) * lds_ + nsrc] : 0.f;
    }
    __syncthreads();
#pragma unroll
    for (int i = 0; i < 16; i++) {
      const int n = ty + 4 * i;
      dst[(size_t)(n0 + n) * K + k0 + tx] = f2bf(t[n][tx]);
    }
    __syncthreads();
  }
}
__device__ __forceinline__ void subkey_phase(const float* __restrict__ src, bf16_t* __restrict__ dst, int bid, int nblk) {
  for (int i = bid * 256 + threadIdx.x; i < 128 * 128; i += nblk * 256) {
    const int n = i >> 7, pos = i & 127, g16 = pos & ~15, pp = pos & 15, h = pp >> 3, j = pp & 7;
    dst[i] = f2bf(src[n * 128 + g16 + 8 * (j >> 2) + 4 * h + (j & 3)]);
  }
}
__device__ __forceinline__ void rope_cs(int pos, float freq, float& c, float& s) {
  double ang = (double)pos * (double)freq;
  double rev = ang * 0.15915494309189535;
  rev -= floor(rev + 0.5);
  float r = (float)(rev * 6.283185307179586);
  c = __cosf(r); s = __sinf(r);
}
__device__ __forceinline__ void cs_phase(const Params& p, int bid, int nblk) {
  const float f16[8] = {1.0f, 0.19392274474868576f, 0.03760603093086393f, 0.007292664737217109f,
                        0.001414213562373095f, 0.0002742481756762073f, 5.318295896944988e-05f, 1.031338537721246e-05f};
  for (int i = bid * 256 + threadIdx.x; i < NT * 8; i += nblk * 256) {
    float c, s; rope_cs(p.pos[i >> 3], f16[i & 7], c, s);
    p.cs[i] = make_float2(c, s);
  }
}

template <int WM, int WN>
struct Gemm {
  static constexpr int BM = 64 * WM, BN = 64 * WN;
  static constexpr int A_BYTES = BM * 128, B_BYTES = BN * 128, STAGE = A_BYTES + B_BYTES;
  static constexpr int SMEM = 2 * STAGE;
  static constexpr int NA = BM / 32, NBK = BN / 32;

  struct Stage8 { uint4 a0, a1, a2, a3, b0, b1, b2, b3; };
  static __device__ __forceinline__ Stage8 ld_stage(const bf16_t* ap0, const bf16_t* ap1, const bf16_t* ap2, const bf16_t* ap3,
                                                    const bf16_t* bp0, const bf16_t* bp1, const bf16_t* bp2, const bf16_t* bp3, int ko) {
    Stage8 r;
    r.a0 = *(const uint4*)(ap0 + ko); r.a1 = *(const uint4*)(ap1 + ko);
    if (NA > 2) { r.a2 = *(const uint4*)(ap2 + ko); r.a3 = *(const uint4*)(ap3 + ko); } else { r.a2 = r.a0; r.a3 = r.a0; }
    r.b0 = *(const uint4*)(bp0 + ko); r.b1 = *(const uint4*)(bp1 + ko);
    if (NBK > 2) { r.b2 = *(const uint4*)(bp2 + ko); r.b3 = *(const uint4*)(bp3 + ko); } else { r.b2 = r.b0; r.b3 = r.b0; }
    return r;
  }
  static __device__ __forceinline__ void st_stage(const Stage8 r, unsigned char* dst, int wofs) {
    *(uint4*)(dst + wofs) = r.a0; *(uint4*)(dst + wofs + 4096) = r.a1;
    if (NA > 2) { *(uint4*)(dst + wofs + 8192) = r.a2; *(uint4*)(dst + wofs + 12288) = r.a3; }
    *(uint4*)(dst + A_BYTES + wofs) = r.b0; *(uint4*)(dst + A_BYTES + wofs + 4096) = r.b1;
    if (NBK > 2) { *(uint4*)(dst + A_BYTES + wofs + 8192) = r.b2; *(uint4*)(dst + A_BYTES + wofs + 12288) = r.b3; }
  }
  static __device__ __forceinline__ void compute_stage(f32x16 (&acc)[WM][WN], const unsigned char* cur, int wm, int wn, int fr, int fh) {
#pragma unroll
    for (int s = 0; s < 4; s++) {
      const int chunk = 2 * s + fh;
      bf16x8 af[WM], bfr[WN];
#pragma unroll
      for (int i = 0; i < WM; i++) {
        const int row = (wm * WM + i) * 32 + fr;
        af[i] = *(const bf16x8*)(cur + row * 128 + ((chunk ^ ((row >> 1) & 7)) << 4));
      }
#pragma unroll
      for (int j = 0; j < WN; j++) {
        const int row = (wn * WN + j) * 32 + fr;
        bfr[j] = *(const bf16x8*)(cur + A_BYTES + row * 128 + ((chunk ^ ((row >> 1) & 7)) << 4));
      }
#pragma unroll
      for (int i = 0; i < WM; i++)
#pragma unroll
        for (int j = 0; j < WN; j++) acc[i][j] = __builtin_amdgcn_mfma_f32_32x32x16_bf16(af[i], bfr[j], acc[i][j], 0, 0, 0);
    }
  }
  template <class ARow, class BRow>
  static __device__ __forceinline__ void mainloop(f32x16 (&acc)[WM][WN], ARow arow, BRow brow, int K, unsigned char* smem) {
    const int tid = threadIdx.x, lane = tid & 63, w = tid >> 6, wm = w >> 1, wn = w & 1;
    const int lrow = tid >> 3, lchunk = tid & 7;
    const bf16_t* ap0 = arow(lrow) + lchunk * 8;
    const bf16_t* ap1 = arow(lrow + 32) + lchunk * 8;
    const bf16_t* ap2 = (NA > 2) ? arow(lrow + 64) + lchunk * 8 : ap0;
    const bf16_t* ap3 = (NA > 2) ? arow(lrow + 96) + lchunk * 8 : ap0;
    const bf16_t* bp0 = brow(lrow) + lchunk * 8;
    const bf16_t* bp1 = brow(lrow + 32) + lchunk * 8;
    const bf16_t* bp2 = (NBK > 2) ? brow(lrow + 64) + lchunk * 8 : bp0;
    const bf16_t* bp3 = (NBK > 2) ? brow(lrow + 96) + lchunk * 8 : bp0;
    const int wofs = lrow * 128 + ((lchunk ^ ((lrow >> 1) & 7)) << 4);
    const int fr = lane & 31, fh = lane >> 5;
    const int nk = K / 64;
    Stage8 rA = ld_stage(ap0, ap1, ap2, ap3, bp0, bp1, bp2, bp3, 0);
    Stage8 rB = ld_stage(ap0, ap1, ap2, ap3, bp0, bp1, bp2, bp3, 64);
    st_stage(rA, smem, wofs);
    rA = ld_stage(ap0, ap1, ap2, ap3, bp0, bp1, bp2, bp3, (nk > 2 ? 2 : 0) * 64);
    __syncthreads();
#pragma unroll 1
    for (int kt = 0; kt < nk; kt += 2) {
      compute_stage(acc, smem, wm, wn, fr, fh);
      st_stage(rB, smem + STAGE, wofs);
      if (kt + 3 < nk) rB = ld_stage(ap0, ap1, ap2, ap3, bp0, bp1, bp2, bp3, (kt + 3) * 64);
      __syncthreads();
      compute_stage(acc, smem + STAGE, wm, wn, fr, fh);
      if (kt + 2 < nk) {
        st_stage(rA, smem, wofs);
        if (kt + 4 < nk) rA = ld_stage(ap0, ap1, ap2, ap3, bp0, bp1, bp2, bp3, (kt + 4) * 64);
      }
      __syncthreads();
    }
  }
};

__device__ __forceinline__ int perm16(int k) { return (k & ~12) | ((k & 4) << 1) | ((k & 8) >> 1); }
constexpr float LOG2E = 1.4426950408889634f;
constexpr int FL_TILE = 8192;
constexpr int FL_STAGE = 2 * FL_TILE;
struct FlashAcc {
  f32x16 o[2];
  float m, l;
};
__device__ __forceinline__ void flash_init(FlashAcc& a) {
#pragma unroll
  for (int i = 0; i < 2; i++)
#pragma unroll
    for (int r = 0; r < 16; r++) a.o[i][r] = 0.f;
  a.m = -INFINITY; a.l = 0.f;
}
struct Tile2 { uint4 a, b; };
template <class RowF>
__device__ __forceinline__ Tile2 tile_fetch(RowF rowp) {
  const int tid = threadIdx.x;
  Tile2 t;
  t.a = *(const uint4*)(rowp(tid >> 3) + (tid & 7) * 8);
  t.b = *(const uint4*)(rowp((tid >> 3) + 32) + (tid & 7) * 8);
  return t;
}
__device__ __forceinline__ void tile_store(const Tile2& t, unsigned char* dst) {
  const int tid = threadIdx.x, row = tid >> 3, ch = tid & 7;
  const int ofs = row * 128 + ((ch ^ ((row >> 1) & 7)) << 4);
  *(uint4*)(dst + ofs) = t.a;
  *(uint4*)(dst + ofs + 4096) = t.b;
}
__device__ __forceinline__ bf16x8 lds_frag(const unsigned char* tile, int row, int chunk) {
  return *(const bf16x8*)(tile + row * 128 + ((chunk ^ ((row >> 1) & 7)) << 4));
}
__device__ __forceinline__ void flash_qk(f32x16 (&s)[2], const unsigned char* ktile, const bf16x8 (&qf)[4]) {
  const int lane = threadIdx.x & 63, fr = lane & 31, fh = lane >> 5;
#pragma unroll
  for (int kt = 0; kt < 2; kt++) {
#pragma unroll
    for (int r = 0; r < 16; r++) s[kt][r] = 0.f;
#pragma unroll
    for (int ks = 0; ks < 4; ks++)
      s[kt] = __builtin_amdgcn_mfma_f32_32x32x16_bf16(lds_frag(ktile, kt * 32 + fr, 2 * ks + fh), qf[ks], s[kt], 0, 0, 0);
    asm volatile("" ::: "memory");
  }
}
__device__ __forceinline__ bf16x8 pack_frag(const f32x16& s, int half8) {
  uint4 u = {pack2bf(s[8 * half8 + 0], s[8 * half8 + 1]), pack2bf(s[8 * half8 + 2], s[8 * half8 + 3]),
             pack2bf(s[8 * half8 + 4], s[8 * half8 + 5]), pack2bf(s[8 * half8 + 6], s[8 * half8 + 7])};
  return __builtin_bit_cast(bf16x8, u);
}
__device__ __forceinline__ void flash_update(FlashAcc& a, f32x16 (&s)[2], const unsigned char* vtile, bool colvalid = true) {
  const int lane = threadIdx.x & 63, fr = lane & 31, fh = lane >> 5;
  float mx = fmaxf(s[0][0], s[1][0]);
#pragma unroll
  for (int r = 1; r < 16; r += 1) mx = __builtin_fmaxf(mx, __builtin_fmaxf(s[0][r], s[1][r]));
  mx = fmaxf(mx, __shfl_xor(mx, 32));
  mx = colvalid ? mx : -INFINITY;
  const float mnew = fmaxf(a.m, mx);
  const float muse = (mnew == -INFINITY) ? 0.f : mnew;
  if (__any(mnew != a.m)) {
    const float alpha = __builtin_amdgcn_exp2f((a.m - muse) * LOG2E);
    a.l *= alpha;
#pragma unroll
    for (int dt = 0; dt < 2; dt++)
#pragma unroll
      for (int r = 0; r < 16; r++) a.o[dt][r] *= alpha;
    a.m = mnew;
  }
  const float cb = colvalid ? -muse * LOG2E : -INFINITY;
  float sum0 = 0.f, sum1 = 0.f;
#pragma unroll
  for (int r = 0; r < 16; r++) {
    const float p0 = __builtin_amdgcn_exp2f(fmaf(s[0][r], LOG2E, cb));
    const float p1 = __builtin_amdgcn_exp2f(fmaf(s[1][r], LOG2E, cb));
    s[0][r] = p0; s[1][r] = p1; sum0 += p0; sum1 += p1;
  }
  a.l += sum0 + sum1;
#pragma unroll
  for (int kt = 0; kt < 2; kt++)
#pragma unroll
    for (int h8 = 0; h8 < 2; h8++) {
      const bf16x8 pf = pack_frag(s[kt], h8);
#pragma unroll
      for (int dt = 0; dt < 2; dt++)
        a.o[dt] = __builtin_amdgcn_mfma_f32_32x32x16_bf16(lds_frag(vtile, dt * 32 + fr, 4 * kt + 2 * h8 + fh), pf, a.o[dt], 0, 0, 0);
      asm volatile("" ::: "memory");
    }
}
__device__ __forceinline__ float flash_inv_l(const FlashAcc& a) {
  const float lt = a.l + __shfl_xor(a.l, 32);
  return lt > 0.f ? 1.f / lt : 0.f;
}
__device__ __forceinline__ void flash_load_q(bf16x8 (&qf)[4], const bf16_t* qrow, float scale) {
  const int fh = (threadIdx.x & 63) >> 5;
#pragma unroll
  for (int ks = 0; ks < 4; ks++) {
    const uint4 u = *(const uint4*)(qrow + ks * 16 + fh * 8);
    const unsigned w[4] = {u.x, u.y, u.z, u.w};
    uint4 o;
    o.x = pack2bf(__uint_as_float(w[0] << 16) * scale, __uint_as_float(w[0] & 0xFFFF0000u) * scale);
    o.y = pack2bf(__uint_as_float(w[1] << 16) * scale, __uint_as_float(w[1] & 0xFFFF0000u) * scale);
    o.z = pack2bf(__uint_as_float(w[2] << 16) * scale, __uint_as_float(w[2] & 0xFFFF0000u) * scale);
    o.w = pack2bf(__uint_as_float(w[3] << 16) * scale, __uint_as_float(w[3] & 0xFFFF0000u) * scale);
    qf[ks] = __builtin_bit_cast(bf16x8, o);
  }
}
__device__ __forceinline__ void flash_store_o(const FlashAcc& a, bf16_t* orow, float scale) {
  const int fh = (threadIdx.x & 63) >> 5;
#pragma unroll
  for (int dt = 0; dt < 2; dt++)
#pragma unroll
    for (int g4 = 0; g4 < 4; g4++) {
      uint2 o = {pack2bf(a.o[dt][4 * g4 + 0] * scale, a.o[dt][4 * g4 + 1] * scale),
                 pack2bf(a.o[dt][4 * g4 + 2] * scale, a.o[dt][4 * g4 + 3] * scale)};
      *(uint2*)(orow + dt * 32 + 8 * g4 + 4 * fh) = o;
    }
}

__device__ __forceinline__ void mem_flash_item(const Params& p, unsigned char* smem, int item) {
  const int tid = threadIdx.x, lane = tid & 63, w = tid >> 6, fr = lane & 31;
  const int chunk = item & 31, h = (item >> 5) & 3, b = item >> 7;
  const int tok = b * SEQ + chunk * 128 + w * 32 + fr;
  bf16x8 qf[4];
  flash_load_q(qf, p.memq + (size_t)tok * 256 + h * 64, 0.125f);
  FlashAcc acc; flash_init(acc);
  const bf16_t* kbase = p.mkv + (size_t)b * MEML * 512 + h * 64;
  const bf16_t* vbase = p.memvt + (size_t)(b * 4 + h) * 64 * MEML;
  Tile2 rk = tile_fetch([&](int r) { return kbase + (size_t)r * 512; });
  Tile2 rv = tile_fetch([&](int r) { return vbase + (size_t)r * MEML; });
  __syncthreads();
  tile_store(rk, smem); tile_store(rv, smem + FL_TILE);
  __syncthreads();
#pragma unroll 1
  for (int kb = 0; kb < 4; kb++) {
    unsigned char* cur = smem + (kb & 1) * FL_STAGE;
    if (kb + 1 < 4) {
      rk = tile_fetch([&](int r) { return kbase + (size_t)((kb + 1) * 64 + r) * 512; });
      rv = tile_fetch([&](int r) { return vbase + (size_t)r * MEML + (kb + 1) * 64; });
    }
    {
      f32x16 s[2];
      flash_qk(s, cur, qf);
      flash_update(acc, s, cur + FL_TILE);
    }
    if (kb + 1 < 4) { unsigned char* nxt = smem + ((kb + 1) & 1) * FL_STAGE; tile_store(rk, nxt); tile_store(rv, nxt + FL_TILE); }
    __syncthreads();
  }
  flash_store_o(acc, p.concat + (size_t)tok * DM + 768 + h * 64, flash_inv_l(acc));
}
__device__ __forceinline__ void mem_phase(const Params& p, unsigned char* smem, int bid, int nblk) {
  for (int item = bid; item < NB * 4 * 32; item += nblk) mem_flash_item(p, smem, item);
}

__device__ __forceinline__ void ovp_phase(const Params& p, int bid, int nblk) {
  for (int i = bid * 256 + threadIdx.x; i < 64 * 256; i += nblk * 256) {
    const int m = i >> 8, n = i & 255;
    int ov = min(16 * n + 32, 64 * m + 64) - max(16 * n, 64 * m);
    if (ov < 0 || n >= NC) ov = 0;
    p.ovp[m * 256 + perm16(n)] = f2bf((float)ov * (1.f / 32.f));
  }
}

struct TileDest { bf16_t* ptr; int stride; int kind; };
__device__ __forceinline__ TileDest inproj_dest(const Params& p, int cb, int b) {
  TileDest d; d.kind = 0;
  if (cb < P_NSAKV) { d.ptr = p.qn + cb; d.stride = 512; d.kind = ((cb & 63) == 0) ? 1 : 0; }
  else if (cb < P_DSAQ) {
    const int o = cb - P_NSAKV, j = o >> 7, g = (o >> 6) & 1;
    if (j == 3 || j == 5) {
      d.ptr = (j == 3 ? p.vslct : p.vwint) + ((size_t)(b * 2 + g) * 64 + (o & 63)) * SEQ; d.stride = 0; d.kind = 5;
    } else {
      bf16_t* base = (j == 0) ? p.kvn[0] : (j == 1) ? p.kvn[1] : (j == 2) ? p.kvn[2] : p.kvn[4];
      d.ptr = base + ((size_t)g * SEQ + (size_t)b * SEQ) * 64 + (o & 63); d.stride = 64;
      d.kind = (((j & 1) == 0) && ((o & 63) == 0)) ? 1 : 0;
    }
  }
  else if (cb < P_DSAK) { d.ptr = p.qd + (cb - P_DSAQ); d.stride = 256; d.kind = ((cb & 63) == 0) ? 1 : 0; }
  else if (cb < P_DSAV) { d.ptr = p.kd + (cb - P_DSAK); d.stride = 64; d.kind = (cb == P_DSAK) ? 1 : 0; }
  else if (cb < P_IDXQ) { d.ptr = p.vd + (cb - P_DSAV); d.stride = 64; }
  else if (cb < P_IDXK) { d.ptr = p.qi + (cb - P_IDXQ); d.stride = 256; d.kind = 2; }
  else if (cb < P_MEMQ) { d.ptr = p.ki; d.stride = 32; d.kind = 2; }
  else if (cb < P_GATE) { d.ptr = p.memq + (cb - P_MEMQ); d.stride = 256; }
  else if (cb < P_END) { d.ptr = nullptr; d.stride = 0; d.kind = 3; }
  else { d.ptr = nullptr; d.stride = 0; d.kind = 4; }
  return d;
}
__device__ __forceinline__ void inproj_phase(const Params& p, unsigned char* smem, int bid, int nblk) {
  typedef Gemm<2, 2> G;
  const int lane = threadIdx.x & 63, w = threadIdx.x >> 6, wm = w >> 1, wn = w & 1;
  const int c = lane & 31, fh = lane >> 5;
  constexpr int TN = INWP / 128, TM = NT / 128;
  constexpr int TN2 = 512 / 128, TM2 = NB * MEML / 128;
  for (int tile = bid; tile < TM * TN + TM2 * TN2; tile += nblk) {
    f32x16 acc[2][2];
#pragma unroll
    for (int i = 0; i < 2; i++)
#pragma unroll
      for (int j = 0; j < 2; j++)
#pragma unroll
        for (int r = 0; r < 16; r++) acc[i][j][r] = 0.f;
    if (tile < TM * TN) {
      const int m0 = (tile / TN) * 128, n0 = (tile % TN) * 128;
      const bf16_t* A = p.xb + (size_t)m0 * DM;
      const bf16_t* Bt = p.wint + (size_t)n0 * DM;
      G::mainloop(acc, [&](int r) { return A + (size_t)r * DM; }, [&](int r) { return Bt + (size_t)r * DM; }, DM, smem);
      const int b = m0 / SEQ;
      unsigned char* wt = smem + w * 9216;
      const TileDest d0 = inproj_dest(p, n0 + (wn * 2 + 0) * 32, b);
      const TileDest d1 = inproj_dest(p, n0 + (wn * 2 + 1) * 32, b);
#pragma unroll
      for (int j = 0; j < 2; j++) {
        const TileDest d = j ? d1 : d0;
        if (d.kind == 4) continue;
        if (d.kind == 5) {
#pragma unroll
          for (int i = 0; i < 2; i++)
#pragma unroll
            for (int g4 = 0; g4 < 4; g4++) {
              const int tloc = (m0 & (SEQ - 1)) + (wm * 2 + i) * 32 + 8 * g4 + 4 * fh;
              uint2 o = {pack2bf(acc[i][j][4 * g4 + 0], acc[i][j][4 * g4 + 1]), pack2bf(acc[i][j][4 * g4 + 2], acc[i][j][4 * g4 + 3])};
              *(uint2*)(d.ptr + (size_t)c * SEQ + perm16(tloc)) = o;
            }
          continue;
        }
        if (d.kind == 3) {
#pragma unroll
          for (int i = 0; i < 2; i++)
#pragma unroll
            for (int r = 0; r < 16; r++) {
              const int tok = m0 + (wm * 2 + i) * 32 + (r & 3) + 8 * (r >> 2) + 4 * fh;
              const float v = acc[i][j][r];
              if (c < 24) p.gates[(size_t)tok * 24 + c] = 1.f / (1.f + __expf(-v));
              else p.widx[(size_t)tok * 8 + (c - 24)] = v * 0.0625f;
            }
          continue;
        }
#pragma unroll
        for (int i = 0; i < 2; i++) {
#pragma unroll
          for (int r = 0; r < 16; r++) {
            const int tok = m0 + (wm * 2 + i) * 32 + (r & 3) + 8 * (r >> 2) + 4 * fh;
            float v = acc[i][j][r];
            if (d.kind == 1) {
              const float pv = __shfl_xor(v, 8);
              if (c < 16) {
                const float2 cs = p.cs[(size_t)tok * 8 + (c & 7)];
                v = (c & 8) ? (v * cs.x + pv * cs.y) : (v * cs.x - pv * cs.y);
              }
            } else if (d.kind == 2) {
              const float pv = __shfl_xor(v, 4);
              if (c < 8) {
                const float2 cs = p.cs[(size_t)tok * 8 + 2 * (c & 3)];
                v = (c & 4) ? (v * cs.x + pv * cs.y) : (v * cs.x - pv * cs.y);
              }
            }
            acc[i][j][r] = v;
          }
#pragma unroll
          for (int r = 0; r < 16; r += 2) {
            const float va = acc[i][j][r], vb = acc[i][j][r + 1];
            const float na = __builtin_bit_cast(float, __builtin_amdgcn_update_dpp(0, __builtin_bit_cast(int, va), 0xB1, 0xF, 0xF, true));
            const float nb = __builtin_bit_cast(float, __builtin_amdgcn_update_dpp(0, __builtin_bit_cast(int, vb), 0xB1, 0xF, 0xF, true));
            const bool odd = c & 1;
            const unsigned pk = pack2bf(odd ? nb : va, odd ? vb : na);
            const int row = i * 32 + (r & 3) + 8 * (r >> 2) + 4 * fh + (odd ? 1 : 0);
            *(unsigned*)(wt + row * 144 + j * 64 + (c & ~1) * 2) = pk;
          }
        }
      }
      __builtin_amdgcn_wave_barrier();
      {
        const int chunk = lane & 7, jt = chunk >> 2;
        const TileDest d = jt ? d1 : d0;
        if (d.kind <= 2) {
#pragma unroll
          for (int it = 0; it < 8; it++) {
            const int row = it * 8 + (lane >> 3);
            const uint4 v = *(const uint4*)(wt + row * 144 + chunk * 16);
            const int tok = m0 + wm * 64 + row;
            *(uint4*)(d.ptr + (size_t)tok * d.stride + (chunk & 3) * 8) = v;
          }
        }
      }
      __syncthreads();
    } else {
      const int t2 = tile - TM * TN;
      const int m0 = (t2 / TN2) * 128, n0 = (t2 % TN2) * 128;
      const bf16_t* A = p.memb + (size_t)m0 * DM;
      const bf16_t* Bt = p.wmemt + (size_t)n0 * DM;
      G::mainloop(acc, [&](int r) { return A + (size_t)r * DM; }, [&](int r) { return Bt + (size_t)r * DM; }, DM, smem);
#pragma unroll
      for (int i = 0; i < 2; i++)
#pragma unroll
        for (int j = 0; j < 2; j++)
          {
            const int cb = n0 + (wn * 2 + j) * 32;
            if (cb < 256) {
#pragma unroll
              for (int r = 0; r < 16; r++) {
                const int row = m0 + (wm * 2 + i) * 32 + (r & 3) + 8 * (r >> 2) + 4 * fh;
                p.mkv[(size_t)row * 512 + cb + c] = f2bf(acc[i][j][r]);
              }
            } else {
              const int dfull = cb + c - 256, head = dfull >> 6, d = dfull & 63;
              const int rowb = m0 + (wm * 2 + i) * 32, b = rowb >> 8, ml = rowb & 255;
              bf16_t* vrow = p.memvt + ((size_t)(b * 4 + head) * 64 + d) * MEML;
#pragma unroll
              for (int g4 = 0; g4 < 4; g4++) {
                uint2 o = {pack2bf(acc[i][j][4 * g4 + 0], acc[i][j][4 * g4 + 1]), pack2bf(acc[i][j][4 * g4 + 2], acc[i][j][4 * g4 + 3])};
                *(uint2*)(vrow + perm16(ml + 8 * g4 + 4 * fh)) = o;
              }
            }
          }
    }
  }
}

__device__ __forceinline__ unsigned f2key(float f) {
  unsigned u = __float_as_uint(f);
  return (u & 0x80000000u) ? ~u : (u | 0x80000000u);
}
__device__ __forceinline__ float key2f(unsigned k) {
  return __uint_as_float((k & 0x80000000u) ? (k ^ 0x80000000u) : ~k);
}
#define CE_DESC(a, b) { const unsigned _h = max(a, b); const unsigned _l = min(a, b); a = _h; b = _l; }
__device__ __forceinline__ void bitonic_merge16(unsigned (&m)[16]) {
#pragma unroll
  for (int st = 8; st >= 1; st >>= 1)
#pragma unroll
    for (int k = 0; k < 16; k++)
      if ((k & st) == 0) CE_DESC(m[k], m[k + st]);
}
__device__ __forceinline__ void insert16(unsigned (&L)[16], unsigned x) {
#pragma unroll
  for (int k = 0; k < 16; k++) { const unsigned hi = max(L[k], x); x = min(L[k], x); L[k] = hi; }
}
__device__ __forceinline__ void merge4_lists(unsigned (&L)[16], unsigned* lists, int t, int q) {
#pragma unroll
  for (int k = 0; k < 16; k++) lists[(q * 16 + k) * 64 + t] = L[k];
  __syncthreads();
  if (q < 2) {
#pragma unroll
    for (int k = 0; k < 16; k++) L[k] = max(lists[((2 * q) * 16 + k) * 64 + t], lists[((2 * q + 1) * 16 + 15 - k) * 64 + t]);
    bitonic_merge16(L);
#pragma unroll
    for (int k = 0; k < 16; k++) lists[((2 * q) * 16 + k) * 64 + t] = L[k];
  }
  __syncthreads();
  if (q == 0) {
#pragma unroll
    for (int k = 0; k < 16; k++) L[k] = max(L[k], lists[(2 * 16 + 15 - k) * 64 + t]);
    bitonic_merge16(L);
  }
}
__device__ __forceinline__ float dpp_rowsum(float x) {
  x += __builtin_bit_cast(float, __builtin_amdgcn_update_dpp(0, __builtin_bit_cast(int, x), 0xB1, 0xF, 0xF, true));
  x += __builtin_bit_cast(float, __builtin_amdgcn_update_dpp(0, __builtin_bit_cast(int, x), 0x4E, 0xF, 0xF, true));
  x += __builtin_bit_cast(float, __builtin_amdgcn_update_dpp(0, __builtin_bit_cast(int, x), 0x141, 0xF, 0xF, true));
  x += __builtin_bit_cast(float, __builtin_amdgcn_update_dpp(0, __builtin_bit_cast(int, x), 0x140, 0xF, 0xF, true));
  return x;
}
__device__ __forceinline__ float readlane_f(float v, int l) {
  return __int_as_float(__builtin_amdgcn_readlane(__float_as_int(v), l));
}
__device__ __forceinline__ float wave_sum_uniform(float x) {
  x = dpp_rowsum(x);
  return (readlane_f(x, 0) + readlane_f(x, 16)) + (readlane_f(x, 32) + readlane_f(x, 48));
}
__device__ __forceinline__ float dot8_bf16(const uint4& a, const uint4& b, float acc) {
  acc = __builtin_amdgcn_fdot2_f32_bf16(__builtin_bit_cast(bf16x2, a.x), __builtin_bit_cast(bf16x2, b.x), acc, false);
  acc = __builtin_amdgcn_fdot2_f32_bf16(__builtin_bit_cast(bf16x2, a.y), __builtin_bit_cast(bf16x2, b.y), acc, false);
  acc = __builtin_amdgcn_fdot2_f32_bf16(__builtin_bit_cast(bf16x2, a.z), __builtin_bit_cast(bf16x2, b.z), acc, false);
  acc = __builtin_amdgcn_fdot2_f32_bf16(__builtin_bit_cast(bf16x2, a.w), __builtin_bit_cast(bf16x2, b.w), acc, false);
  return acc;
}
__device__ __forceinline__ void fma8_bf16(float (&y)[8], const uint4& v, float w) {
  y[0] = fmaf(w, __uint_as_float(v.x << 16), y[0]); y[1] = fmaf(w, __uint_as_float(v.x & 0xFFFF0000u), y[1]);
  y[2] = fmaf(w, __uint_as_float(v.y << 16), y[2]); y[3] = fmaf(w, __uint_as_float(v.y & 0xFFFF0000u), y[3]);
  y[4] = fmaf(w, __uint_as_float(v.z << 16), y[4]); y[5] = fmaf(w, __uint_as_float(v.z & 0xFFFF0000u), y[5]);
  y[6] = fmaf(w, __uint_as_float(v.w << 16), y[6]); y[7] = fmaf(w, __uint_as_float(v.w & 0xFFFF0000u), y[7]);
}
__device__ const unsigned char cand_tab[52] = {
  0x00,0x01,0x02,0x03,0x04,0x05,0x06,0x07,0x08,0x09,0x0A,0x0B,0x0C,0x0D,0x0E,0x0F,
  0x10,0x11,0x12,0x13,0x14,0x15,0x16,0x17,
  0x20,0x21,0x22,0x23,0x24,
  0x30,0x31,0x32,0x33,
  0x40,0x41,0x42,
  0x50,0x51, 0x60,0x61, 0x70,0x71,
  0x80,0x90,0xA0,0xB0,0xC0,0xD0,0xE0,0xF0, 0xF0,0xF0};

typedef __attribute__((ext_vector_type(2))) _Float16 f16x2;
__device__ __forceinline__ f16x2 bytes01_h2(unsigned w) { return __builtin_bit_cast(f16x2, __builtin_amdgcn_perm(w, 0x64646464u, 0x00050004u)); }
__device__ __forceinline__ f16x2 bytes23_h2(unsigned w) { return __builtin_bit_cast(f16x2, __builtin_amdgcn_perm(w, 0x64646464u, 0x00070006u)); }
constexpr int PE_EXPERT_DEPTH = 8;

__device__ __forceinline__ void peer_block_phase(const Params& p, unsigned char* smem, int bid, int nblk) {
  const int tid = threadIdx.x, lane = tid & 63, w = tid >> 6, wm = w >> 1, wn = w & 1;
  const int c = lane & 31, fh = lane >> 5;
  float* S = (float*)smem;
  unsigned* lists = (unsigned*)(smem + 32768);
  unsigned* ablist = (unsigned*)(smem + 49152);
  int* fin_e = (int*)(smem + 57344);
  float* fin_g = (float*)(smem + 57344 + 4096);
  for (int blk = bid; blk < NT / 64; blk += nblk) {
    const int t0 = blk * 64;
#pragma unroll 1
    for (int nt = 0; nt < 8; nt++) {
      f32x16 acc[1][2];
#pragma unroll
      for (int j = 0; j < 2; j++)
#pragma unroll
        for (int r = 0; r < 16; r++) acc[0][j][r] = 0.f;
      const bf16_t* A = p.concat + (size_t)t0 * DM;
      const bf16_t* Bt = p.woutt + (size_t)nt * 128 * DM;
      Gemm<1, 2>::mainloop(acc, [&](int r) { return A + (size_t)r * DM; }, [&](int r) { return Bt + (size_t)r * DM; }, DM, smem);
      {
        const unsigned ebase = (unsigned)(t0 + wm * 32 + 4 * fh) * DM + nt * 128 + wn * 64 + c;
#pragma unroll
        for (int j = 0; j < 2; j++) {
#pragma unroll
          for (int r = 0; r < 16; r++) {
            const unsigned idx = ebase + (unsigned)(((r & 3) + 8 * (r >> 2)) * DM + j * 32);
            p.out[idx] = acc[0][j][r] + ALPHA * p.x[idx];
          }
          asm volatile("" ::: "memory");
        }
      }
    }
    __syncthreads();
#pragma unroll 1
    for (int rr = 0; rr < 16; rr++) {
      const int tok = t0 + w * 16 + rr;
      float* row = p.out + (size_t)tok * DM;
      float v[16];
      {
        const float4 a0 = *(const float4*)(row + 8 * lane), a1 = *(const float4*)(row + 8 * lane + 4);
        const float4 a2 = *(const float4*)(row + 512 + 8 * lane), a3 = *(const float4*)(row + 512 + 8 * lane + 4);
        v[0] = a0.x; v[1] = a0.y; v[2] = a0.z; v[3] = a0.w; v[4] = a1.x; v[5] = a1.y; v[6] = a1.z; v[7] = a1.w;
        v[8] = a2.x; v[9] = a2.y; v[10] = a2.z; v[11] = a2.w; v[12] = a3.x; v[13] = a3.y; v[14] = a3.z; v[15] = a3.w;
      }
      float s = 0.f;
#pragma unroll
      for (int i = 0; i < 16; i++) s += v[i];
      const float mu = wave_sum(s) * (1.f / DM);
      float qv = 0.f;
#pragma unroll
      for (int i = 0; i < 16; i++) { v[i] -= mu; qv += v[i] * v[i]; }
      const float rs = rsqrtf(wave_sum(qv) * (1.f / DM) + 1e-5f);
#pragma unroll
      for (int hf = 0; hf < 2; hf++) {
        const int e0 = hf * 512 + 8 * lane;
        const float4 g0 = *(const float4*)(p.ln1g + e0), g1 = *(const float4*)(p.ln1g + e0 + 4);
        const float4 b0 = *(const float4*)(p.ln1b + e0), b1 = *(const float4*)(p.ln1b + e0 + 4);
        float o[8];
        o[0] = v[hf * 8 + 0] * rs * g0.x + b0.x; o[1] = v[hf * 8 + 1] * rs * g0.y + b0.y;
        o[2] = v[hf * 8 + 2] * rs * g0.z + b0.z; o[3] = v[hf * 8 + 3] * rs * g0.w + b0.w;
        o[4] = v[hf * 8 + 4] * rs * g1.x + b1.x; o[5] = v[hf * 8 + 5] * rs * g1.y + b1.y;
        o[6] = v[hf * 8 + 6] * rs * g1.z + b1.z; o[7] = v[hf * 8 + 7] * rs * g1.w + b1.w;
        *(float4*)(row + e0) = make_float4(o[0], o[1], o[2], o[3]);
        *(float4*)(row + e0 + 4) = make_float4(o[4], o[5], o[6], o[7]);
        uint4 pk = {pack2bf(o[0], o[1]), pack2bf(o[2], o[3]), pack2bf(o[4], o[5]), pack2bf(o[6], o[7])};
        *(uint4*)(p.x1b + (size_t)tok * DM + e0) = pk;
      }
    }
    __syncthreads();
    const int ts = tid & 63, qs = tid >> 6;
#pragma unroll 1
    for (int hh = 0; hh < 8; hh++) {
#pragma unroll 1
      for (int half = 0; half < 2; half++) {
        f32x16 acc[2][1];
#pragma unroll
        for (int i = 0; i < 2; i++)
#pragma unroll
          for (int r = 0; r < 16; r++) acc[i][0][r] = 0.f;
        const bf16_t* A = p.wqt + (size_t)(hh * 256 + half * 128) * DM;
        const bf16_t* Bt = p.x1b + (size_t)t0 * DM;
        Gemm<2, 1>::mainloop(acc, [&](int r) { return A + (size_t)r * DM; }, [&](int r) { return Bt + (size_t)r * DM; }, DM, smem);
        f32x16 sp[4];
#pragma unroll
        for (int nn = 0; nn < 4; nn++)
#pragma unroll
          for (int r = 0; r < 16; r++) sp[nn][r] = 0.f;
        const bf16_t* skp = half ? p.sk2p : p.sk1p;
#pragma unroll
        for (int i = 0; i < 2; i++)
#pragma unroll
          for (int s = 0; s < 2; s++) {
            uint4 qb = {pack2bf(acc[i][0][8 * s + 0], acc[i][0][8 * s + 1]), pack2bf(acc[i][0][8 * s + 2], acc[i][0][8 * s + 3]),
                        pack2bf(acc[i][0][8 * s + 4], acc[i][0][8 * s + 5]), pack2bf(acc[i][0][8 * s + 6], acc[i][0][8 * s + 7])};
            const bf16x8 qf = __builtin_bit_cast(bf16x8, qb);
#pragma unroll
            for (int nn = 0; nn < 4; nn++) {
              const bf16x8 kf = *(const bf16x8*)(skp + (size_t)(nn * 32 + c) * 128 + wm * 64 + i * 32 + s * 16 + fh * 8);
              sp[nn] = __builtin_amdgcn_mfma_f32_32x32x16_bf16(kf, qf, sp[nn], 0, 0, 0);
            }
          }
        if (wm == 0) {
#pragma unroll
          for (int nn = 0; nn < 4; nn++)
#pragma unroll
            for (int r = 0; r < 16; r++) S[(nn * 32 + (r & 3) + 8 * (r >> 2) + 4 * fh) * 64 + wn * 32 + c] = sp[nn][r];
        }
        __syncthreads();
        if (wm == 1) {
#pragma unroll
          for (int nn = 0; nn < 4; nn++)
#pragma unroll
            for (int r = 0; r < 16; r++) S[(nn * 32 + (r & 3) + 8 * (r >> 2) + 4 * fh) * 64 + wn * 32 + c] += sp[nn][r];
        }
        __syncthreads();
        unsigned L[16];
#pragma unroll
        for (int k = 0; k < 16; k++) L[k] = 0u;
#pragma unroll 4
        for (int i = 0; i < 32; i++) {
          const int n = qs * 32 + i;
          insert16(L, (f2key(S[n * 64 + ts]) & ~127u) | (unsigned)n);
        }
        merge4_lists(L, lists, ts, qs);
        if (qs == 0) {
#pragma unroll
          for (int k = 0; k < 16; k++) ablist[(half * 16 + k) * 64 + ts] = L[k];
        }
        __syncthreads();
      }
      {
        unsigned L[16];
#pragma unroll
        for (int k = 0; k < 16; k++) L[k] = 0u;
#pragma unroll 1
        for (int cc = qs; cc < 50; cc += 4) {
          const unsigned code = cand_tab[cc];
          const float sum = key2f(ablist[(code >> 4) * 64 + ts]) + key2f(ablist[(16 + (code & 15)) * 64 + ts]);
          insert16(L, (f2key(sum) & ~255u) | code);
        }
        merge4_lists(L, lists, ts, qs);
        if (qs == 0) {
          const float mx = key2f(L[0]);
          float e[16], sum = 0.f;
#pragma unroll
          for (int k = 0; k < 16; k++) { e[k] = __expf(key2f(L[k]) - mx); sum += e[k]; }
          const float inv = 1.f / sum;
#pragma unroll
          for (int k = 0; k < 16; k++) {
            const unsigned code = L[k] & 255u;
            const unsigned ia = ablist[(code >> 4) * 64 + ts] & 127u, ib = ablist[(16 + (code & 15)) * 64 + ts] & 127u;
            fin_e[ts * 16 + k] = (int)(ia * 128u + ib);
            fin_g[ts * 16 + k] = e[k] * inv;
          }
        }
        __syncthreads();
        {
          const int tt = tid >> 2, k4 = (tid & 3) * 4;
          *(int4*)(p.pexp + (size_t)(t0 + tt) * 128 + hh * 16 + k4) = *(const int4*)(fin_e + tt * 16 + k4);
          *(float4*)(p.pgate + (size_t)(t0 + tt) * 128 + hh * 16 + k4) = *(const float4*)(fin_g + tt * 16 + k4);
        }
        __syncthreads();
      }
    }
#pragma unroll 1
    for (int rr = 0; rr < 16; rr++) {
      const int tok = t0 + w * 16 + rr;
      const int id0 = p.pexp[(size_t)tok * 128 + lane], id1 = p.pexp[(size_t)tok * 128 + 64 + lane];
      const float g0 = p.pgate[(size_t)tok * 128 + lane], g1 = p.pgate[(size_t)tok * 128 + 64 + lane];
      float* row = p.out + (size_t)tok * DM + 16 * lane;
      float xv[16];
      {
        const float4 r0 = *(const float4*)(row), r1 = *(const float4*)(row + 4), r2 = *(const float4*)(row + 8), r3 = *(const float4*)(row + 12);
        xv[0] = r0.x; xv[1] = r0.y; xv[2] = r0.z; xv[3] = r0.w; xv[4] = r1.x; xv[5] = r1.y; xv[6] = r1.z; xv[7] = r1.w;
        xv[8] = r2.x; xv[9] = r2.y; xv[10] = r2.z; xv[11] = r2.w; xv[12] = r3.x; xv[13] = r3.y; xv[14] = r3.z; xv[15] = r3.w;
      }
      f16x2 xh[8];
      float xs = 0.f;
#pragma unroll
      for (int i = 0; i < 8; i++) {
        xh[i] = f16x2{(_Float16)xv[2 * i], (_Float16)xv[2 * i + 1]};
        xs += (float)xh[i][0] + (float)xh[i][1];
      }
      const float xsum128 = 1152.f * wave_sum_uniform(xs);
      const float su0 = p.psu[id0], su1 = p.psu[id1];
      float a0 = 0.f, a1 = 0.f;
      {
        uint4 bu[PE_EXPERT_DEPTH];
#pragma unroll
        for (int d = 0; d < PE_EXPERT_DEPTH; d++) {
          const int id = __builtin_amdgcn_readlane(id0, d);
          bu[d] = *(const uint4*)(p.puq + (size_t)id * DM + 16 * lane);
        }
#pragma unroll 1
        for (int e0 = 0; e0 < 128; e0 += PE_EXPERT_DEPTH) {
#pragma unroll
          for (int d = 0; d < PE_EXPERT_DEPTH; d++) {
            const int e = e0 + d;
            const float sce = readlane_f((e & 64) ? su1 : su0, e & 63);
            const unsigned qw[4] = {bu[d].x, bu[d].y, bu[d].z, bu[d].w};
            float s0 = 0.f, s1 = 0.f;
#pragma unroll
            for (int i = 0; i < 4; i++) {
              s0 = __builtin_amdgcn_fdot2(bytes01_h2(qw[i]), xh[2 * i], s0, false);
              s1 = __builtin_amdgcn_fdot2(bytes23_h2(qw[i]), xh[2 * i + 1], s1, false);
            }
            float s = s0 + s1;
            if (e + PE_EXPERT_DEPTH < 128) {
              const int en = e + PE_EXPERT_DEPTH;
              const int id = __builtin_amdgcn_readlane((en & 64) ? id1 : id0, en & 63);
              bu[d] = *(const uint4*)(p.puq + (size_t)id * DM + 16 * lane);
            }
            s = (wave_sum_uniform(s) - xsum128) * sce;
            a0 = ((e & 64) == 0 && lane == (e & 63)) ? s : a0;
            a1 = ((e & 64) != 0 && lane == (e & 63)) ? s : a1;
          }
        }
      }
      const float w0 = g0 * gelu_exact(a0) * p.psv[id0], w1 = g1 * gelu_exact(a1) * p.psv[id1];
      const float csum128 = 1152.f * wave_sum_uniform(w0 + w1);
      float y[16];
#pragma unroll
      for (int i = 0; i < 16; i++) y[i] = 0.f;
      {
        uint4 bv[PE_EXPERT_DEPTH];
#pragma unroll
        for (int d = 0; d < PE_EXPERT_DEPTH; d++) {
          const int id = __builtin_amdgcn_readlane(id0, d);
          bv[d] = *(const uint4*)(p.pvq + (size_t)id * DM + 16 * lane);
        }
#pragma unroll 1
        for (int e0 = 0; e0 < 128; e0 += PE_EXPERT_DEPTH) {
#pragma unroll
          for (int d = 0; d < PE_EXPERT_DEPTH; d++) {
            const int e = e0 + d;
            const float wgt = readlane_f((e & 64) ? w1 : w0, e & 63);
            const unsigned qw[4] = {bv[d].x, bv[d].y, bv[d].z, bv[d].w};
#pragma unroll
            for (int i = 0; i < 4; i++) {
              const f16x2 h01 = bytes01_h2(qw[i]), h23 = bytes23_h2(qw[i]);
              y[4 * i + 0] = fmaf(wgt, (float)h01[0], y[4 * i + 0]);
              y[4 * i + 1] = fmaf(wgt, (float)h01[1], y[4 * i + 1]);
              y[4 * i + 2] = fmaf(wgt, (float)h23[0], y[4 * i + 2]);
              y[4 * i + 3] = fmaf(wgt, (float)h23[1], y[4 * i + 3]);
            }
            if (e + PE_EXPERT_DEPTH < 128) {
              const int en = e + PE_EXPERT_DEPTH;
              const int id = __builtin_amdgcn_readlane((en & 64) ? id1 : id0, en & 63);
              bv[d] = *(const uint4*)(p.pvq + (size_t)id * DM + 16 * lane);
            }
          }
        }
      }
      float v[16];
#pragma unroll
      for (int i = 0; i < 16; i++) v[i] = ALPHA * xv[i] + (y[i] - csum128);
      float s = 0.f;
#pragma unroll
      for (int i = 0; i < 16; i++) s += v[i];
      const float mu = wave_sum(s) * (1.f / DM);
      float qv = 0.f;
#pragma unroll
      for (int i = 0; i < 16; i++) { v[i] -= mu; qv += v[i] * v[i]; }
      const float rs = rsqrtf(wave_sum(qv) * (1.f / DM) + 1e-5f);
#pragma unroll
      for (int i4 = 0; i4 < 4; i4++) {
        const float4 gg = *(const float4*)(p.ln2g + 16 * lane + 4 * i4), bb = *(const float4*)(p.ln2b + 16 * lane + 4 * i4);
        *(float4*)(row + 4 * i4) = make_float4(v[4 * i4 + 0] * rs * gg.x + bb.x, v[4 * i4 + 1] * rs * gg.y + bb.y,
                                               v[4 * i4 + 2] * rs * gg.z + bb.z, v[4 * i4 + 3] * rs * gg.w + bb.w);
      }
    }
    __syncthreads();
  }
}

__device__ __forceinline__ void cbias_phase(const Params& p, int bid, int nblk) {
  const int which = threadIdx.x >> 7, j = threadIdx.x & 127;
  const float* w1 = which ? p.w1v : p.w1k;
  const float* pe = which ? p.pe_v : p.pe_k;
  for (int ch = bid; ch < 64; ch += nblk) {
    float a = 0.f;
#pragma unroll 8
    for (int r = ch * 32; r < ch * 32 + 32; r++) a = fmaf(pe[r], w1[(size_t)r * 128 + j], a);
    p.cbias[ch * 256 + which * 128 + j] = a;
  }
}
__device__ __forceinline__ void compress_phase(const Params& p, unsigned char* smem, int bid, int nblk) {
  typedef Gemm<1, 2> G;
  const int tid = threadIdx.x, lane = tid & 63, w = tid >> 6, wm = w >> 1, wn = w & 1, c = lane & 31, fh = lane >> 5;
  float* hid = (float*)smem;
  float* cb = (float*)(smem + 49152);
  if (bid < NB * 2 * 2 * 4) {
    float a = 0.f;
    for (int ch = 0; ch < 64; ch++) a += p.cbias[ch * 256 + tid];
    cb[tid] = a;
  }
  __syncthreads();
  for (int item = bid; item < NB * 2 * 2 * 4; item += nblk) {
    const int mt = item & 3, which = (item >> 2) & 1, bgi = item >> 3;
    const int m0 = mt * 64;
    const bf16_t* A = (which ? p.kvn[1] : p.kvn[0]) + (size_t)bgi * SEQ * 64;
    const bf16_t* Bt = which ? p.w1vt : p.w1kt;
    f32x16 acc[1][2];
#pragma unroll
    for (int j = 0; j < 2; j++)
#pragma unroll
      for (int r = 0; r < 16; r++) acc[0][j][r] = 0.f;
    G::mainloop(acc, [&](int r) { const int i = min(m0 + r, NC - 1); return A + (size_t)i * 1024; },
                [&](int r) { return Bt + (size_t)r * 2048; }, 2048, smem);
#pragma unroll
    for (int j = 0; j < 2; j++)
#pragma unroll
      for (int r = 0; r < 16; r++) {
        const int row = wm * 32 + (r & 3) + 8 * (r >> 2) + 4 * fh, col = (wn * 2 + j) * 32 + c;
        hid[row * 129 + col] = gelu_exact(acc[0][j][r] + cb[which * 128 + col]);
      }
    __syncthreads();
    {
      const int row = tid >> 2, dq = (tid & 3) * 16;
      const float* w2 = which ? p.w2v : p.w2k;
      float o[16];
#pragma unroll
      for (int i = 0; i < 16; i++) o[i] = 0.f;
      for (int k = 0; k < 128; k++) {
        const float h = hid[row * 129 + k];
        const float4 w0 = *(const float4*)(w2 + k * 64 + dq), w1_ = *(const float4*)(w2 + k * 64 + dq + 4);
        const float4 w2_ = *(const float4*)(w2 + k * 64 + dq + 8), w3 = *(const float4*)(w2 + k * 64 + dq + 12);
        o[0] = fmaf(h, w0.x, o[0]); o[1] = fmaf(h, w0.y, o[1]); o[2] = fmaf(h, w0.z, o[2]); o[3] = fmaf(h, w0.w, o[3]);
        o[4] = fmaf(h, w1_.x, o[4]); o[5] = fmaf(h, w1_.y, o[5]); o[6] = fmaf(h, w1_.z, o[6]); o[7] = fmaf(h, w1_.w, o[7]);
        o[8] = fmaf(h, w2_.x, o[8]); o[9] = fmaf(h, w2_.y, o[9]); o[10] = fmaf(h, w2_.z, o[10]); o[11] = fmaf(h, w2_.w, o[11]);
        o[12] = fmaf(h, w3.x, o[12]); o[13] = fmaf(h, w3.y, o[13]); o[14] = fmaf(h, w3.z, o[14]); o[15] = fmaf(h, w3.w, o[15]);
      }
      const int i = m0 + row;
      const bool valid = i < NC;
      if (which == 0) {
        bf16_t* dst = p.kcb + ((size_t)bgi * 256 + i) * 64 + dq;
        uint4 u0 = {pack2bf(o[0], o[1]), pack2bf(o[2], o[3]), pack2bf(o[4], o[5]), pack2bf(o[6], o[7])};
        uint4 u1 = {pack2bf(o[8], o[9]), pack2bf(o[10], o[11]), pack2bf(o[12], o[13]), pack2bf(o[14], o[15])};
        if (!valid) { u0 = make_uint4(0, 0, 0, 0); u1 = u0; }
        *(uint4*)dst = u0; *(uint4*)(dst + 8) = u1;
      } else {
#pragma unroll
        for (int e = 0; e < 16; e++) p.vct[((size_t)bgi * 64 + dq + e) * 256 + perm16(i)] = valid ? f2bf(o[e]) : (bf16_t)0;
      }
    }
    __syncthreads();
  }
}

__device__ __forceinline__ void softmax4(float* sc, int ld, int n) {
  const int w = threadIdx.x >> 6, lane = threadIdx.x & 63;
  float* s = sc + w * ld;
  float m = -INFINITY;
  for (int i = lane; i < n; i += 64) m = fmaxf(m, s[i]);
  m = wave_max(m);
  if (m == -INFINITY) m = 0.f;
  float sum = 0.f;
  for (int i = lane; i < n; i += 64) { float e = expf(s[i] - m); s[i] = e; sum += e; }
  sum = wave_sum(sum);
  const float inv = 1.f / (sum > 0.f ? sum : 1.f);
  for (int i = lane; i < n; i += 64) s[i] *= inv;
}
__device__ __forceinline__ float dot64_bf(const float* q, const bf16_t* k) {
  float s = 0.f;
#pragma unroll
  for (int e = 0; e < 64; e += 8) {
    const uint4 v = *(const uint4*)(k + e);
    const unsigned u[4] = {v.x, v.y, v.z, v.w};
#pragma unroll
    for (int i = 0; i < 4; i++) {
      s = fmaf(q[e + 2 * i], __uint_as_float(u[i] << 16), s);
      s = fmaf(q[e + 2 * i + 1], __uint_as_float(u[i] & 0xFFFF0000u), s);
    }
  }
  return s;
}

template <class KRow, class VRow, class Body>
__device__ __forceinline__ void flash_stream(unsigned char* smem, int j0, int j1, KRow krow, VRow vrow, Body body) {
  if (j0 >= j1) return;
  Tile2 rk = tile_fetch([&](int r) __attribute__((always_inline)) { return krow(j0, r); });
  Tile2 rv = tile_fetch([&](int r) __attribute__((always_inline)) { return vrow(j0, r); });
  __syncthreads();
  tile_store(rk, smem); tile_store(rv, smem + FL_TILE);
  __syncthreads();
#pragma unroll 1
  for (int j = j0; j < j1; j++) {
    unsigned char* cur = smem + ((j - j0) & 1) * FL_STAGE;
    if (j + 1 < j1) {
      rk = tile_fetch([&](int r) __attribute__((always_inline)) { return krow(j + 1, r); });
      rv = tile_fetch([&](int r) __attribute__((always_inline)) { return vrow(j + 1, r); });
    }
    body(cur, j);
    if (j + 1 < j1) { unsigned char* nxt = smem + ((j - j0 + 1) & 1) * FL_STAGE; tile_store(rk, nxt); tile_store(rv, nxt + FL_TILE); }
    __syncthreads();
  }
}
__device__ __forceinline__ float quad_sum(float x) {
  x += __builtin_bit_cast(float, __builtin_amdgcn_update_dpp(0, __builtin_bit_cast(int, x), 0xB1, 0xF, 0xF, true));
  x += __builtin_bit_cast(float, __builtin_amdgcn_update_dpp(0, __builtin_bit_cast(int, x), 0x4E, 0xF, 0xF, true));
  return x;
}
__device__ __forceinline__ void nsa_flash_item(const Params& p, unsigned char* smem, int item) {
  const int tid = threadIdx.x, lane = tid & 63, w = tid >> 6, fr = lane & 31, fh = lane >> 5;
  const int cc = item & 127, g = (item >> 7) & 1, b = item >> 8;
  const int c64 = cc >> 1;
  const int t0 = cc * 32;
  const int tl = 8 * w + (fr >> 2), hq = fr & 3;
  const int t = t0 + tl, tok = b * SEQ + t;
  const int t64 = t & 63;
  float* impS = (float*)smem;
  unsigned* selm = (unsigned*)(smem + 32 * 65 * 4);
  float* stash = (float*)(smem + 2 * FL_STAGE) + w * 2048 + lane;
  bf16x8 qf[4];
  flash_load_q(qf, p.qn + (size_t)tok * 512 + g * 256 + hq * 64, 0.125f);
  const float* gt = p.gates + (size_t)tok * 24 + (g * 4 + hq) * 3;
  const float g_cmp = gt[0], g_sel = gt[1], g_win = gt[2];
  const size_t bg = (size_t)(b * 2 + g);
  {
    const int nvmax = 2 * cc + 1, nkb = (nvmax + 63) >> 6;
    const int nvl = (t >= 31) ? ((t - 31) >> 4) + 1 : 0;
    const bf16_t* kcb = p.kcb + bg * 256 * 64;
    const bf16_t* vct = p.vct + bg * 64 * 256;
    auto krow = [&](int j, int r) __attribute__((always_inline)) { return kcb + (size_t)(j * 64 + r) * 64; };
    auto vrow = [&](int j, int r) __attribute__((always_inline)) { return vct + (size_t)r * 256 + j * 64; };
    float m = -INFINITY, l = 0.f;
    flash_stream(smem, 0, nkb, krow, vrow, [&](unsigned char* cur, int j) __attribute__((always_inline)) {
      f32x16 s[2];
      flash_qk(s, cur, qf);
      float mx = -INFINITY;
#pragma unroll
      for (int kt = 0; kt < 2; kt++)
#pragma unroll
        for (int r = 0; r < 16; r++) {
          const int n = j * 64 + kt * 32 + (r & 3) + 8 * (r >> 2) + 4 * fh;
          s[kt][r] = (n < nvl) ? s[kt][r] : -INFINITY;
          mx = fmaxf(mx, s[kt][r]);
        }
      mx = fmaxf(mx, __shfl_xor(mx, 32));
      const float mnew = fmaxf(m, mx);
      const float muse = (mnew == -INFINITY) ? 0.f : mnew;
      float sum = 0.f;
#pragma unroll
      for (int kt = 0; kt < 2; kt++)
#pragma unroll
        for (int r = 0; r < 16; r++) sum += __builtin_amdgcn_exp2f((s[kt][r] - muse) * LOG2E);
      l = l * __builtin_amdgcn_exp2f((m - muse) * LOG2E) + sum;
      m = mnew;
    });
    const float lt = l + __shfl_xor(l, 32);
    const float il = lt > 0.f ? 1.f / lt : 0.f;
    const float muse = (m == -INFINITY) ? 0.f : m;
    {
      f32x16 oc[2];
#pragma unroll
      for (int i = 0; i < 2; i++)
#pragma unroll
        for (int r = 0; r < 16; r++) oc[i][r] = 0.f;
      flash_stream(smem, 0, nkb, krow, vrow, [&](unsigned char* cur, int j) __attribute__((always_inline)) {
        f32x16 s[2];
        flash_qk(s, cur, qf);
#pragma unroll
        for (int kt = 0; kt < 2; kt++)
#pragma unroll
          for (int r = 0; r < 16; r++) {
            const int n = j * 64 + kt * 32 + (r & 3) + 8 * (r >> 2) + 4 * fh;
            s[kt][r] = (n < nvl) ? __builtin_amdgcn_exp2f((s[kt][r] - muse) * LOG2E) * il : 0.f;
          }
#pragma unroll
        for (int kt = 0; kt < 2; kt++)
#pragma unroll
          for (int h8 = 0; h8 < 2; h8++) {
            const bf16x8 pf = pack_frag(s[kt], h8);
#pragma unroll
            for (int dt = 0; dt < 2; dt++)
              oc[dt] = __builtin_amdgcn_mfma_f32_32x32x16_bf16(lds_frag(cur + FL_TILE, dt * 32 + fr, 4 * kt + 2 * h8 + fh), pf, oc[dt], 0, 0, 0);
          }
      });
#pragma unroll
      for (int dt = 0; dt < 2; dt++)
#pragma unroll
        for (int r = 0; r < 16; r++) stash[(dt * 16 + r) * 64] = g_cmp * oc[dt][r];
    }
    f32x16 imp[2];
#pragma unroll
    for (int i = 0; i < 2; i++)
#pragma unroll
      for (int r = 0; r < 16; r++) imp[i][r] = 0.f;
    flash_stream(smem, 0, nkb, krow, vrow, [&](unsigned char* cur, int j) __attribute__((always_inline)) {
      f32x16 s[2];
      flash_qk(s, cur, qf);
#pragma unroll
      for (int kt = 0; kt < 2; kt++)
#pragma unroll
        for (int r = 0; r < 16; r++) {
          const int n = j * 64 + kt * 32 + (r & 3) + 8 * (r >> 2) + 4 * fh;
          s[kt][r] = (n < nvl) ? __builtin_amdgcn_exp2f((s[kt][r] - muse) * LOG2E) * il : 0.f;
        }
#pragma unroll
      for (int kt = 0; kt < 2; kt++)
#pragma unroll
        for (int h8 = 0; h8 < 2; h8++) {
          const bf16x8 pf = pack_frag(s[kt], h8);
#pragma unroll
          for (int mt = 0; mt < 2; mt++) {
            const bf16x8 of = *(const bf16x8*)(p.ovp + (size_t)(mt * 32 + fr) * 256 + j * 64 + kt * 32 + h8 * 16 + fh * 8);
            imp[mt] = __builtin_amdgcn_mfma_f32_32x32x16_bf16(of, pf, imp[mt], 0, 0, 0);
          }
        }
    });
#pragma unroll
    for (int mt = 0; mt < 2; mt++)
#pragma unroll
      for (int r = 0; r < 16; r++) imp[mt][r] = quad_sum(imp[mt][r]);
#pragma unroll
    for (int mt = 0; mt < 2; mt++)
#pragma unroll
      for (int g4 = 0; g4 < 4; g4++) {
        const float v = (hq == 0) ? imp[mt][4 * g4 + 0] : (hq == 1) ? imp[mt][4 * g4 + 1] : (hq == 2) ? imp[mt][4 * g4 + 2] : imp[mt][4 * g4 + 3];
        impS[tl * 65 + mt * 32 + hq + 8 * g4 + 4 * fh] = v;
      }
    __syncthreads();
    {
      const int tk = tid >> 3, part = tid & 7;
      const float* row = impS + tk * 65;
      unsigned bits = 0;
#pragma unroll 1
      for (int i = 0; i < 8; i++) {
        const int mb = part * 8 + i;
        const bool vis = mb <= c64;
        const bool forced = (mb == 0) || (mb == c64) || (mb == c64 - 1);
        const float sm = vis ? row[mb] + (forced ? 1e4f : 0.f) : -INFINITY;
        int rank = 0;
        for (int m2 = 0; m2 < 64; m2++) {
          const bool vis2 = m2 <= c64;
          const bool f2 = (m2 == 0) || (m2 == c64) || (m2 == c64 - 1);
          const float s2 = vis2 ? row[m2] + (f2 ? 1e4f : 0.f) : -INFINITY;
          rank += (s2 > sm) || (s2 == sm && m2 < mb);
        }
        if (rank < 16 && vis) bits |= 1u << i;
      }
      unsigned lo = (part < 4) ? (bits << (8 * part)) : 0u, hi = (part >= 4) ? (bits << (8 * (part - 4))) : 0u;
      lo |= __shfl_xor(lo, 1); hi |= __shfl_xor(hi, 1);
      lo |= __shfl_xor(lo, 2); hi |= __shfl_xor(hi, 2);
      lo |= __shfl_xor(lo, 4); hi |= __shfl_xor(hi, 4);
      if (part == 0) { selm[tk * 2] = lo; selm[tk * 2 + 1] = hi; }
    }
    __syncthreads();
  }
  const unsigned sel_lo = selm[tl * 2], sel_hi = selm[tl * 2 + 1];
  {
    const bf16_t* kb_ = p.kvn[2] + bg * SEQ * 64;
    const bf16_t* vt_ = p.vslct + bg * 64 * SEQ;
    FlashAcc acc; flash_init(acc);
    flash_stream(smem, 0, c64 + 1,
      [&](int j, int r) __attribute__((always_inline)) { return kb_ + (size_t)(j * 64 + r) * 64; },
      [&](int j, int r) __attribute__((always_inline)) { return vt_ + (size_t)r * SEQ + j * 64; },
      [&](unsigned char* cur, int j) __attribute__((always_inline)) {
        f32x16 s[2];
        flash_qk(s, cur, qf);
        const bool selj = ((j < 32) ? (sel_lo >> j) : (sel_hi >> (j - 32))) & 1u;
        if (j == c64) {
#pragma unroll
          for (int kt = 0; kt < 2; kt++)
#pragma unroll
            for (int r = 0; r < 16; r++) {
              const int kl = kt * 32 + (r & 3) + 8 * (r >> 2) + 4 * fh;
              s[kt][r] = (kl <= t64) ? s[kt][r] : -INFINITY;
            }
        }
        flash_update(acc, s, cur + FL_TILE, selj);
      });
    const float sc_ = g_sel * flash_inv_l(acc);
#pragma unroll
    for (int dt = 0; dt < 2; dt++)
#pragma unroll
      for (int r = 0; r < 16; r++) stash[(dt * 16 + r) * 64] += sc_ * acc.o[dt][r];
  }
  {
    const bf16_t* kb_ = p.kvn[4] + bg * SEQ * 64;
    const bf16_t* vt_ = p.vwint + bg * 64 * SEQ;
    FlashAcc acc; flash_init(acc);
    const int jlo = c64 - 8;
    flash_stream(smem, jlo < 0 ? 0 : jlo, c64 + 1,
      [&](int j, int r) __attribute__((always_inline)) { return kb_ + (size_t)(j * 64 + r) * 64; },
      [&](int j, int r) __attribute__((always_inline)) { return vt_ + (size_t)r * SEQ + j * 64; },
      [&](unsigned char* cur, int j) __attribute__((always_inline)) {
        f32x16 s[2];
        flash_qk(s, cur, qf);
        if (j == c64) {
#pragma unroll
          for (int kt = 0; kt < 2; kt++)
#pragma unroll
            for (int r = 0; r < 16; r++) {
              const int kl = kt * 32 + (r & 3) + 8 * (r >> 2) + 4 * fh;
              s[kt][r] = (kl <= t64) ? s[kt][r] : -INFINITY;
            }
        } else if (j == jlo) {
#pragma unroll
          for (int kt = 0; kt < 2; kt++)
#pragma unroll
            for (int r = 0; r < 16; r++) {
              const int kl = kt * 32 + (r & 3) + 8 * (r >> 2) + 4 * fh;
              s[kt][r] = (kl > t64) ? s[kt][r] : -INFINITY;
            }
        }
        flash_update(acc, s, cur + FL_TILE);
      });
    const float sc_ = g_win * flash_inv_l(acc);
    bf16_t* orow = p.concat + (size_t)tok * DM + g * 256 + hq * 64;
#pragma unroll
    for (int dt = 0; dt < 2; dt++)
#pragma unroll
      for (int g4 = 0; g4 < 4; g4++) {
        float o4[4];
#pragma unroll
        for (int i = 0; i < 4; i++) o4[i] = stash[(dt * 16 + 4 * g4 + i) * 64] + sc_ * acc.o[dt][4 * g4 + i];
        uint2 o = {pack2bf(o4[0], o4[1]), pack2bf(o4[2], o4[3])};
        *(uint2*)(orow + dt * 32 + 8 * g4 + 4 * fh) = o;
      }
  }
}
__device__ __forceinline__ void nsa_phase(const Params& p, unsigned char* smem, int bid, int nblk) {
  for (int it = bid; it < NB * 2 * 128; it += nblk) {
    const int cc = 127 - (it >> 4), bgi = it & 15;
    nsa_flash_item(p, smem, (bgi << 7) | cc);
  }
}

typedef __attribute__((ext_vector_type(4))) float f32x4v;
typedef __attribute__((ext_vector_type(4))) short s16x4;
__device__ __forceinline__ float wave_max_uniform(float x) {
  x = fmaxf(x, __builtin_bit_cast(float, __builtin_amdgcn_update_dpp(0, __builtin_bit_cast(int, x), 0xB1, 0xF, 0xF, true)));
  x = fmaxf(x, __builtin_bit_cast(float, __builtin_amdgcn_update_dpp(0, __builtin_bit_cast(int, x), 0x4E, 0xF, 0xF, true)));
  x = fmaxf(x, __builtin_bit_cast(float, __builtin_amdgcn_update_dpp(0, __builtin_bit_cast(int, x), 0x141, 0xF, 0xF, true)));
  x = fmaxf(x, __builtin_bit_cast(float, __builtin_amdgcn_update_dpp(0, __builtin_bit_cast(int, x), 0x140, 0xF, 0xF, true)));
  return fmaxf(fmaxf(readlane_f(x, 0), readlane_f(x, 16)), fmaxf(readlane_f(x, 32), readlane_f(x, 48)));
}
__device__ __forceinline__ int dsa_vswz(int row) { return ((row >> 1) & 1) | ((row >> 2) & 2); }
__device__ __forceinline__ void dsa_item(const Params& p, unsigned char* smem, int b, int tg) {
  unsigned* keys = (unsigned*)smem;
  unsigned char* vst = smem;
  int* hist = (int*)(smem + 32768);
  int* sel = hist + 3584;
  int* cnt = sel + 512;
  float* sc = (float*)(cnt + 16);
  float* part = sc + 2048;
  const int tid = threadIdx.x, lane = tid & 63, w = tid >> 6;
  const int row16 = lane & 15, kg = lane >> 4;
  const int t0 = 2 * tg;
  const size_t tokb = (size_t)b * SEQ;
  const bf16_t* kib = p.ki + tokb * 32;
  const bf16_t* kdb = p.kd + tokb * 64;
  const bf16_t* vdb = p.vd + tokb * 64;
  const int n = t0 + 2;
  if (n > 256) {
#pragma unroll
    for (int i = 0; i < 14; i++) hist[tid + 256 * i] = 0;
    {
      const bf16x8 af = *(const bf16x8*)(p.qi + (tokb + t0 + (row16 >> 3)) * 256 + (row16 & 7) * 32 + kg * 8);
      const int tk = lane >> 5;
      const float4 wv = *(const float4*)(p.widx + (tokb + t0 + tk) * 8 + 4 * (kg & 1));
      const int ntile = (n + 15) >> 4;
#pragma unroll 1
      for (int kt0 = w * 4; kt0 < ntile; kt0 += 16) {
        bf16x8 bfr[4];
#pragma unroll
        for (int u = 0; u < 4; u++) {
          const int key = min(kt0 + u, ntile - 1) * 16 + row16;
          bfr[u] = *(const bf16x8*)(kib + (size_t)key * 32 + kg * 8);
        }
#pragma unroll
        for (int u = 0; u < 4; u++) {
          f32x4v acc = {0.f, 0.f, 0.f, 0.f};
          acc = __builtin_amdgcn_mfma_f32_16x16x32_bf16(af, bfr[u], acc, 0, 0, 0);
          float s = wv.x * fmaxf(acc[0], 0.f) + wv.y * fmaxf(acc[1], 0.f) + wv.z * fmaxf(acc[2], 0.f) + wv.w * fmaxf(acc[3], 0.f);
          s += __shfl_xor(s, 16);
          const int key = (kt0 + u) * 16 + row16;
          if ((kg & 1) == 0 && kt0 + u < ntile) {
            const unsigned kv_ = (key <= t0 + tk) ? f2key(s) : 0u;
            keys[tk * 4096 + key] = kv_;
            atomicAdd(&hist[1536 + tk * 1024 + (lane & 3) * 256 + (kv_ >> 24)], 1);
          }
        }
      }
    }
    __syncthreads();
    const int tk = w >> 1, hf = w & 1;
    const int npad = ((n + 15) >> 4) << 4, nh = npad >> 1;
    const unsigned* kt_ = keys + tk * 4096;
    const int i0 = hf * nh, i1 = i0 + nh;
    unsigned prefix = 0; int kk = 256;
#pragma unroll 1
    for (int pass = 0; pass < 4; pass++) {
      const int shift = 24 - 8 * pass;
      int* hp = (pass == 0) ? hist + 1536 + tk * 1024 : hist + (pass - 1) * 512 + tk * 256;
      int* hpa = (pass == 0) ? hp + (lane & 3) * 256 : hp;
      const unsigned hmask = (shift == 24) ? 0u : (0xFFFFFFFFu << (shift + 8));
      if (pass > 0)
#pragma unroll 2
      for (int base = i0 + 4 * lane; base < i1; base += 256) {
        const uint4 k4 = *(const uint4*)(kt_ + base);
        if ((k4.x & hmask) == prefix) atomicAdd(&hpa[(k4.x >> shift) & 255], 1);
        if ((k4.y & hmask) == prefix) atomicAdd(&hpa[(k4.y >> shift) & 255], 1);
        if ((k4.z & hmask) == prefix) atomicAdd(&hpa[(k4.z >> shift) & 255], 1);
        if ((k4.w & hmask) == prefix) atomicAdd(&hpa[(k4.w >> shift) & 255], 1);
      }
      __syncthreads();
      {
        int4 c4 = *(const int4*)(hp + lane * 4);
        if (pass == 0) {
#pragma unroll
          for (int cp = 1; cp < 4; cp++) {
            const int4 d4 = *(const int4*)(hp + cp * 256 + lane * 4);
            c4.x += d4.x; c4.y += d4.y; c4.z += d4.z; c4.w += d4.w;
          }
        }
        const int tl_ = c4.x + c4.y + c4.z + c4.w;
        int P = tl_;
        P += __builtin_amdgcn_update_dpp(0, P, 0x111, 0xF, 0xF, false);
        P += __builtin_amdgcn_update_dpp(0, P, 0x112, 0xF, 0xF, false);
        P += __builtin_amdgcn_update_dpp(0, P, 0x114, 0xF, 0xF, false);
        P += __builtin_amdgcn_update_dpp(0, P, 0x118, 0xF, 0xF, false);
        P += __builtin_amdgcn_update_dpp(0, P, 0x142, 0xA, 0xF, false);
        P += __builtin_amdgcn_update_dpp(0, P, 0x143, 0xC, 0xF, false);
        const int total = __builtin_amdgcn_readlane(P, 63);
        const int R = total - P + tl_;
        const int a3 = R - tl_, a2 = a3 + c4.w, a1 = a2 + c4.z, a0 = a1 + c4.y;
        const bool found = (a3 < kk) && (kk <= R);
        int dloc, above;
        if (kk <= a2) { dloc = 3; above = a3; } else if (kk <= a1) { dloc = 2; above = a2; } else if (kk <= a0) { dloc = 1; above = a1; } else { dloc = 0; above = a0; }
        const unsigned long long bm = __ballot(found);
        const int src = __ffsll((long long)bm) - 1;
        const int dsel = __builtin_amdgcn_readlane(lane * 4 + dloc, src);
        const int abv = __builtin_amdgcn_readlane(above, src);
        prefix |= ((unsigned)dsel) << shift;
        kk -= abv;
      }
    }
    {
      int cg_ = 0, ce = 0;
#pragma unroll 2
      for (int base = i0 + 4 * lane; base < i1; base += 256) {
        const uint4 k4 = *(const uint4*)(kt_ + base);
        cg_ += (k4.x > prefix) + (k4.y > prefix) + (k4.z > prefix) + (k4.w > prefix);
        ce += (k4.x == prefix) + (k4.y == prefix) + (k4.z == prefix) + (k4.w == prefix);
      }
      cg_ = (int)wave_sum_uniform((float)cg_); ce = (int)wave_sum_uniform((float)ce);
      if (lane == 0) { cnt[(tk * 2 + hf) * 2] = cg_; cnt[(tk * 2 + hf) * 2 + 1] = ce; }
    }
    __syncthreads();
    {
      int bgt = hf ? cnt[(tk * 2) * 2] : 0, beq = hf ? cnt[(tk * 2) * 2 + 1] : 0;
      const int ngt = 256 - kk;
      const unsigned long long lt = (1ull << lane) - 1ull;
#pragma unroll 1
      for (int base = i0 + 4 * lane; base < i1; base += 256) {
        const uint4 k4 = *(const uint4*)(kt_ + base);
        const unsigned kq[4] = {k4.x, k4.y, k4.z, k4.w};
        unsigned long long mg[4], me[4];
#pragma unroll
        for (int j = 0; j < 4; j++) { mg[j] = __ballot(kq[j] > prefix); me[j] = __ballot(kq[j] == prefix); }
        int pg = bgt + __popcll(mg[0] & lt) + __popcll(mg[1] & lt) + __popcll(mg[2] & lt) + __popcll(mg[3] & lt);
        int pe = beq + __popcll(me[0] & lt) + __popcll(me[1] & lt) + __popcll(me[2] & lt) + __popcll(me[3] & lt);
#pragma unroll
        for (int j = 0; j < 4; j++) {
          if (kq[j] > prefix) { sel[tk * 256 + pg] = base + j; pg++; }
          else if (kq[j] == prefix) { if (pe < kk) sel[tk * 256 + ngt + pe] = base + j; pe++; }
        }
        bgt += __popcll(mg[0]) + __popcll(mg[1]) + __popcll(mg[2]) + __popcll(mg[3]);
        beq += __popcll(me[0]) + __popcll(me[1]) + __popcll(me[2]) + __popcll(me[3]);
      }
    }
    __syncthreads();
  } else {
    for (int i = tid; i < 512; i += 256) sel[i] = i & 255;
    __syncthreads();
  }
  {
    const int tk = w >> 1, hf = w & 1;
    const int nsel = min(256, t0 + tk + 1);
    const size_t tok = tokb + t0 + tk;
    const int* selt = sel + tk * 256;
    float* sct = sc + tk * 1024;
    bf16_t* pbt = (bf16_t*)(part) + tk * 1024;
    unsigned char* vw = vst + w * 8192;
    const int kk8 = lane >> 3, ch = lane & 7;
    const int q4 = row16 >> 2, pp = row16 & 3;
#define DSA_VLOAD(dst, it_, base_) dst = *(const uint4*)(vdb + (size_t)selt[min((base_) + (it_) * 8 + kk8, nsel - 1)] * 64 + ch * 8)
#define DSA_VSTORE(src, it_) { const int key_ = (it_) * 8 + kk8; *(uint4*)(vw + key_ * 128 + ((((ch >> 1) ^ dsa_vswz(key_))) << 5) + ((ch & 1) << 4)) = src; }
    uint4 vv0, vv1, vv2, vv3, vv4, vv5, vv6, vv7;
    DSA_VLOAD(vv0, 0, hf * 128); DSA_VLOAD(vv1, 1, hf * 128); DSA_VLOAD(vv2, 2, hf * 128); DSA_VLOAD(vv3, 3, hf * 128);
    DSA_VLOAD(vv4, 4, hf * 128); DSA_VLOAD(vv5, 5, hf * 128); DSA_VLOAD(vv6, 6, hf * 128); DSA_VLOAD(vv7, 7, hf * 128);
    {
      bf16x8 qf[2];
#pragma unroll
      for (int ks = 0; ks < 2; ks++) {
        uint4 u = make_uint4(0, 0, 0, 0);
        if (row16 < 4) u = *(const uint4*)(p.qd + tok * 256 + row16 * 64 + ks * 32 + kg * 8);
        qf[ks] = __builtin_bit_cast(bf16x8, u);
      }
#pragma unroll 1
      for (int ck = 0; ck < 2; ck++) {
        bf16x8 kf[4][2];
#pragma unroll
        for (int ti = 0; ti < 4; ti++) {
          const int r = hf * 128 + ck * 64 + ti * 16 + row16;
          const int idx = selt[min(r, nsel - 1)];
#pragma unroll
          for (int ks = 0; ks < 2; ks++) kf[ti][ks] = *(const bf16x8*)(kdb + (size_t)idx * 64 + ks * 32 + kg * 8);
        }
#pragma unroll
        for (int ti = 0; ti < 4; ti++) {
          f32x4v acc = {0.f, 0.f, 0.f, 0.f};
          acc = __builtin_amdgcn_mfma_f32_16x16x32_bf16(kf[ti][0], qf[0], acc, 0, 0, 0);
          acc = __builtin_amdgcn_mfma_f32_16x16x32_bf16(kf[ti][1], qf[1], acc, 0, 0, 0);
          if (row16 < 4) {
#pragma unroll
            for (int r = 0; r < 4; r++) {
              const int key = hf * 128 + ck * 64 + ti * 16 + 4 * kg + r;
              sct[row16 * 256 + key] = (key < nsel) ? acc[r] * 0.125f : -INFINITY;
            }
          }
        }
      }
    }
    __syncthreads();
#pragma unroll
    for (int hh = 0; hh < 2; hh++) {
      const int h = 2 * hf + hh;
      float v0 = sct[h * 256 + lane], v1 = sct[h * 256 + 64 + lane], v2 = sct[h * 256 + 128 + lane], v3 = sct[h * 256 + 192 + lane];
      const float mx = wave_max_uniform(fmaxf(fmaxf(v0, v1), fmaxf(v2, v3)));
      v0 = __expf(v0 - mx); v1 = __expf(v1 - mx); v2 = __expf(v2 - mx); v3 = __expf(v3 - mx);
      const float inv = 1.f / wave_sum_uniform((v0 + v1) + (v2 + v3));
      pbt[h * 256 + lane] = f2bf(v0 * inv); pbt[h * 256 + 64 + lane] = f2bf(v1 * inv);
      pbt[h * 256 + 128 + lane] = f2bf(v2 * inv); pbt[h * 256 + 192 + lane] = f2bf(v3 * inv);
    }
    __syncthreads();
    f32x4v oacc[4];
#pragma unroll
    for (int nt = 0; nt < 4; nt++) oacc[nt] = f32x4v{0.f, 0.f, 0.f, 0.f};
#pragma unroll 1
    for (int ck = 0; ck < 2; ck++) {
      DSA_VSTORE(vv0, 0); DSA_VSTORE(vv1, 1); DSA_VSTORE(vv2, 2); DSA_VSTORE(vv3, 3);
      DSA_VSTORE(vv4, 4); DSA_VSTORE(vv5, 5); DSA_VSTORE(vv6, 6); DSA_VSTORE(vv7, 7);
      if (ck == 0) {
        const int nb_ = hf * 128 + 64;
        DSA_VLOAD(vv0, 0, nb_); DSA_VLOAD(vv1, 1, nb_); DSA_VLOAD(vv2, 2, nb_); DSA_VLOAD(vv3, 3, nb_);
        DSA_VLOAD(vv4, 4, nb_); DSA_VLOAD(vv5, 5, nb_); DSA_VLOAD(vv6, 6, nb_); DSA_VLOAD(vv7, 7, nb_);
      }
      __builtin_amdgcn_wave_barrier();
      bf16x8 pf[2];
#pragma unroll
      for (int ks = 0; ks < 2; ks++) {
        uint4 u = make_uint4(0, 0, 0, 0);
        if (row16 < 4) u = *(const uint4*)(pbt + row16 * 256 + hf * 128 + ck * 64 + ks * 32 + kg * 8);
        pf[ks] = __builtin_bit_cast(bf16x8, u);
      }
#pragma unroll
      for (int nt = 0; nt < 4; nt++) {
#pragma unroll
        for (int ks = 0; ks < 2; ks++) {
          const int r0 = ks * 32 + kg * 8 + q4, r1 = r0 + 4;
          const s16x4 lo = __builtin_amdgcn_ds_read_tr16_b64_v4i16((s16x4 __attribute__((address_space(3)))*)(vw + r0 * 128 + ((nt ^ dsa_vswz(r0)) << 5) + pp * 8));
          const s16x4 hi = __builtin_amdgcn_ds_read_tr16_b64_v4i16((s16x4 __attribute__((address_space(3)))*)(vw + r1 * 128 + ((nt ^ dsa_vswz(r1)) << 5) + pp * 8));
          typedef __attribute__((ext_vector_type(8))) short s16x8;
          const s16x8 v8 = __builtin_shufflevector(lo, hi, 0, 1, 2, 3, 4, 5, 6, 7);
          oacc[nt] = __builtin_amdgcn_mfma_f32_16x16x32_bf16(pf[ks], __builtin_bit_cast(bf16x8, v8), oacc[nt], 0, 0, 0);
        }
      }
      __builtin_amdgcn_wave_barrier();
    }
#undef DSA_VLOAD
#undef DSA_VSTORE
    __syncthreads();
    if (kg == 0) {
#pragma unroll
      for (int nt = 0; nt < 4; nt++)
#pragma unroll
        for (int r = 0; r < 4; r++) part[(w * 4 + r) * 64 + nt * 16 + row16] = oacc[nt][r];
    }
    __syncthreads();
    {
#pragma unroll
      for (int o2 = 0; o2 < 2; o2++) {
        const int idx = tid + 256 * o2, tk2 = idx >> 8, e = idx & 255;
        const float o = part[(2 * tk2) * 256 + e] + part[(2 * tk2 + 1) * 256 + e];
        p.concat[(tokb + t0 + tk2) * DM + 512 + e] = f2bf(o);
      }
    }
    __syncthreads();
  }
}
__device__ __forceinline__ void dsa_phase(const Params& p, unsigned char* smem, int bid, int nblk) {
  for (int it = bid; it < NB * (SEQ / 2); it += nblk) dsa_item(p, smem, it & 7, (SEQ / 2 - 1) - (it >> 3));
}

#define SELFCHECK 0
#ifndef PROBE_REPEAT
#define PROBE_REPEAT 0
#endif
#if SELFCHECK
__device__ __forceinline__ void check_val(const Params& p, float ref, float got, float atol, float rtol) {
  if (!(fabsf(ref - got) <= atol + rtol * fabsf(ref))) atomicExch(p.flag, 1);
}
__device__ __forceinline__ void inproj_check_phase(const Params& p, unsigned char* smem, int bid, int nblk) {
  float* h = (float*)smem;
  const float f16[8] = {1.0f, 0.19392274474868576f, 0.03760603093086393f, 0.007292664737217109f,
                        0.001414213562373095f, 0.0002742481756762073f, 5.318295896944988e-05f, 1.031338537721246e-05f};
  const int tid = threadIdx.x;
  for (int it = bid; it < 600; it += nblk) {
    const int tok = (it * 61) % NT;
    const int b = tok / SEQ, t = tok % SEQ;
    const float* xr = p.x + (size_t)tok * DM;
    for (int col = tid; col < INW; col += 256) {
      float a = 0.f;
      for (int k = 0; k < DM; k++) a = fmaf(xr[k], p.w_in[(size_t)k * INW + col], a);
      h[col] = a;
    }
    __syncthreads();
    const int pos = p.pos[tok];
    if (tid < 152) {
      const int v = tid >> 3, j = tid & 7;
      int base;
      if (v < 8) base = C_NSAQ + v * 64;
      else if (v < 10) base = C_NSAKV + 0 * 128 + (v - 8) * 64;
      else if (v < 12) base = C_NSAKV + 2 * 128 + (v - 10) * 64;
      else if (v < 14) base = C_NSAKV + 4 * 128 + (v - 12) * 64;
      else if (v < 18) base = C_DSAQ + (v - 14) * 64;
      else base = C_DSAK;
      float c, s; rope_cs(pos, f16[j], c, s);
      const float x1 = h[base + j], x2 = h[base + 8 + j];
      h[base + j] = x1 * c - x2 * s; h[base + 8 + j] = x2 * c + x1 * s;
    } else if (tid < 188) {
      const int u = tid - 152, v = u >> 2, j = u & 3;
      const int base = (v < 8) ? C_IDXQ + v * 32 : C_IDXK;
      float c, s; rope_cs(pos, f16[2 * j], c, s);
      const float x1 = h[base + j], x2 = h[base + 4 + j];
      h[base + j] = x1 * c - x2 * s; h[base + 4 + j] = x2 * c + x1 * s;
    } else if (tid < 212) {
      const int u = tid - 188;
      h[C_GATE + u] = 1.f / (1.f + expf(-h[C_GATE + u]));
    }
    __syncthreads();
    for (int col = tid; col < INW; col += 256) {
      const float ref = h[col];
      float got;
      if (col < 512) got = bf2f(p.qn[(size_t)tok * 512 + col]);
      else if (col < 1280) {
        const int o = col - 512, j = o >> 7, g = (o >> 6) & 1, d = o & 63;
        if (j == 3 || j == 5) {
          const bf16_t* vt = (j == 3) ? p.vslct : p.vwint;
          got = bf2f(vt[((size_t)(b * 2 + g) * 64 + d) * SEQ + perm16(t)]);
        } else {
          const bf16_t* src = j == 0 ? p.kvn[0] : j == 1 ? p.kvn[1] : j == 2 ? p.kvn[2] : p.kvn[4];
          got = bf2f(src[((size_t)(b * 2 + g) * SEQ + t) * 64 + d]);
        }
      }
      else if (col < 1304) got = p.gates[(size_t)tok * 24 + col - 1280];
      else if (col < 1560) got = bf2f(p.qd[(size_t)tok * 256 + col - 1304]);
      else if (col < 1624) got = bf2f(p.kd[(size_t)tok * 64 + col - 1560]);
      else if (col < 1688) got = bf2f(p.vd[(size_t)tok * 64 + col - 1624]);
      else if (col < 1944) got = bf2f(p.qi[(size_t)tok * 256 + col - 1688]);
      else if (col < 1976) got = bf2f(p.ki[(size_t)tok * 32 + col - 1944]);
      else if (col < 1984) got = p.widx[(size_t)tok * 8 + col - 1976] * 16.f;
      else got = bf2f(p.memq[(size_t)tok * 256 + col - 1984]);
      check_val(p, ref, got, 0.04f, 0.02f);
    }
    __syncthreads();
  }
  for (int it = bid; it < 64; it += nblk) {
    const int row = (it * 37) % (NB * MEML);
    for (int col = tid; col < 512; col += 256) {
      float a = 0.f;
      for (int k = 0; k < DM; k++) a = fmaf(p.mem[(size_t)row * DM + k], p.w_mem_kv[(size_t)k * 512 + col], a);
      float gotm;
      if (col < 256) gotm = bf2f(p.mkv[(size_t)row * 512 + col]);
      else { const int hd = (col - 256) >> 6, dd = col & 63; gotm = bf2f(p.memvt[((size_t)((row >> 8) * 4 + hd) * 64 + dd) * MEML + perm16(row & 255)]); }
      check_val(p, a, gotm, 0.04f, 0.02f);
    }
  }
}

__device__ __forceinline__ void mem_check_phase(const Params& p, unsigned char* smem, int bid, int nblk) {
  float* q = (float*)smem;
  float* sc = q + 256;
  const int tid = threadIdx.x;
  for (int it = bid; it < 700; it += nblk) {
    const int tok = (it * 47 + 13) % NT;
    const int b = tok / SEQ;
    q[tid] = bf2f(p.memq[(size_t)tok * 256 + tid]);
    __syncthreads();
    const bf16_t* kvb = p.mkv + (size_t)b * MEML * 512;
    for (int idx = tid; idx < 4 * 256; idx += 256) {
      const int hh = idx >> 8, m = idx & 255;
      sc[hh * 256 + m] = dot64_bf(q + hh * 64, kvb + (size_t)m * 512 + hh * 64) * 0.125f;
    }
    __syncthreads();
    softmax4(sc, 256, 256);
    __syncthreads();
    {
      const int h = tid >> 6, d = tid & 63;
      float o = 0.f;
      for (int m = 0; m < 256; m++) o = fmaf(sc[h * 256 + m], bf2f(p.memvt[((size_t)(b * 4 + h) * 64 + d) * MEML + perm16(m)]), o);
      check_val(p, o, bf2f(p.concat[(size_t)tok * DM + 768 + tid]), 0.004f, 0.02f);
    }
    __syncthreads();
  }
}
__device__ __forceinline__ void nsa_check_phase(const Params& p, unsigned char* smem, int bid, int nblk) {
  float* q = (float*)smem;
  float* sc = q + 256;
  float* o3 = sc + 4096;
  float* imp = o3 + 768;
  int* sel = (int*)(imp + 64);
  int* nselp = sel + 16;
  const int tid = threadIdx.x, h = tid >> 6, d = tid & 63;
  for (int it = bid; it < 1024; it += nblk) {
    const int item = (int)(((long long)it * 62851 + 7) % (NT * 2));
    const int g = item & 1, tok = item >> 1, b = tok / SEQ, t = tok % SEQ;
    const size_t kvb = (size_t)(b * 2 + g) * SEQ * 64;
    const bf16_t *kslc = p.kvn[2] + kvb, *kwin = p.kvn[4] + kvb;
    const bf16_t *vslct = p.vslct + (size_t)(b * 2 + g) * 64 * SEQ, *vwint = p.vwint + (size_t)(b * 2 + g) * 64 * SEQ;
    q[tid] = bf2f(p.qn[(size_t)tok * 512 + g * 256 + tid]);
    __syncthreads();
    const int nv = (t >= 31) ? (t - 31) / 16 + 1 : 0;
    const bf16_t* kcb = p.kcb + (size_t)(b * 2 + g) * 256 * 64;
    const bf16_t* vct = p.vct + (size_t)(b * 2 + g) * 64 * 256;
    for (int idx = tid; idx < 4 * 256; idx += 256) {
      const int hh = idx >> 8, i = idx & 255;
      float s = -INFINITY;
      if (i < nv) {
        s = 0.f;
        for (int e = 0; e < 64; e++) s = fmaf(q[hh * 64 + e], bf2f(kcb[i * 64 + e]), s);
        s *= 0.125f;
      }
      sc[hh * 1024 + i] = s;
    }
    __syncthreads();
    softmax4(sc, 1024, 256);
    __syncthreads();
    {
      float o = 0.f;
      for (int i = 0; i < nv; i++) o = fmaf(sc[h * 1024 + i], bf2f(vct[d * 256 + perm16(i)]), o);
      o3[0 * 256 + tid] = o;
    }
    const int cur = t / 64;
    if (tid < 64) {
      const int m = tid;
      float a = 0.f;
      const int n0 = max(0, 4 * m - 2), n1 = min(NC - 1, 4 * m + 4);
      for (int n = n0; n <= n1; n++) {
        const int ov = min(16 * n + 32, 64 * m + 64) - max(16 * n, 64 * m);
        if (ov > 0) {
          const float w = (float)ov * (1.f / 32.f);
          for (int hh = 0; hh < 4; hh++) a = fmaf(sc[hh * 1024 + n], w, a);
        }
      }
      const bool forced = (m == 0) || (m == cur) || (m == cur - 1);
      const bool vis = (m <= cur);
      imp[m] = vis ? a + (forced ? 1e4f : 0.f) : -INFINITY;
    }
    __syncthreads();
    if (tid < 64) {
      const int m = tid;
      const float sm = imp[m];
      int rank = 0;
      for (int mm = 0; mm < 64; mm++) { const float s2 = imp[mm]; rank += (s2 > sm) || (s2 == sm && mm < m); }
      const bool take = (rank < 16) && (m <= cur);
      const unsigned long long bal = __ballot(take);
      if (take) sel[__popcll(bal & ((1ull << m) - 1ull))] = m;
      if (m == 0) *nselp = __popcll(bal);
    }
    __syncthreads();
    const int nsel = *nselp;
    {
      const int nk = nsel * 64;
      for (int idx = tid; idx < 4 * nk; idx += 256) {
        const int hh = idx / nk, r = idx % nk;
        const int kpos = sel[r >> 6] * 64 + (r & 63);
        float s = -INFINITY;
        if (kpos <= t) s = dot64_bf(q + hh * 64, kslc + (size_t)kpos * 64) * 0.125f;
        sc[hh * 1024 + r] = s;
      }
      __syncthreads();
      softmax4(sc, 1024, nk);
      __syncthreads();
      float o = 0.f;
      for (int r = 0; r < nk; r++) {
        const int kpos = sel[r >> 6] * 64 + (r & 63);
        if (kpos <= t) o = fmaf(sc[h * 1024 + r], bf2f(vslct[(size_t)d * SEQ + perm16(kpos)]), o);
      }
      o3[1 * 256 + tid] = o;
      __syncthreads();
    }
    {
      for (int idx = tid; idx < 4 * 512; idx += 256) {
        const int hh = idx >> 9, r = idx & 511;
        const int kpos = t - 511 + r;
        float s = -INFINITY;
        if (kpos >= 0) s = dot64_bf(q + hh * 64, kwin + (size_t)kpos * 64) * 0.125f;
        sc[hh * 1024 + r] = s;
      }
      __syncthreads();
      softmax4(sc, 1024, 512);
      __syncthreads();
      float o = 0.f;
      for (int r = 0; r < 512; r++) {
        const int kpos = t - 511 + r;
        if (kpos >= 0) o = fmaf(sc[h * 1024 + r], bf2f(vwint[(size_t)d * SEQ + perm16(kpos)]), o);
      }
      o3[2 * 256 + tid] = o;
    }
    {
      const float* gt = p.gates + (size_t)tok * 24 + (g * 4 + h) * 3;
      const float r = gt[0] * o3[tid] + gt[1] * o3[256 + tid] + gt[2] * o3[512 + tid];
      const float got = bf2f(p.concat[(size_t)tok * DM + g * 256 + tid]);
      const float df = fabsf(r - got);
      if (!(df <= 0.08f + 0.1f * fabsf(r))) atomicExch(p.flag, 1);
      if (!(df <= 0.006f + 0.02f * fabsf(r))) atomicAdd(p.chkcnt, 1);
    }
    __syncthreads();
  }
}

__device__ __forceinline__ void dsa_check_phase(const Params& p, unsigned char* smem, int bid, int nblk) {
  unsigned* keys = (unsigned*)smem;
  float* qi = (float*)(keys + 4096);
  float* wi = qi + 256;
  int* hist = (int*)(wi + 8);
  int* sel = hist + 256;
  int* misc = sel + 256;
  int* cnts = misc + 8;
  float* qd = (float*)(cnts + 256);
  float* sc = qd + 256;
  const int tid = threadIdx.x;
  for (int it = bid; it < 1500; it += nblk) {
    const int tok = (int)(((long long)it * 39119 + 11) % NT);
    const int b = tok / SEQ, t = tok % SEQ;
    const bf16_t* kib = p.ki + (size_t)b * SEQ * 32;
    const bf16_t* kdb = p.kd + (size_t)b * SEQ * 64;
    const bf16_t* vdb = p.vd + (size_t)b * SEQ * 64;
    qi[tid] = bf2f(p.qi[(size_t)tok * 256 + tid]);
    if (tid < 8) wi[tid] = p.widx[(size_t)tok * 8 + tid];
    qd[tid] = bf2f(p.qd[(size_t)tok * 256 + tid]);
    __syncthreads();
    const int n = t + 1;
    int nsel;
    if (n <= 256) {
      for (int s = tid; s < n; s += 256) sel[s] = s;
      nsel = n;
      __syncthreads();
    } else {
      for (int s = tid; s < n; s += 256) {
        float kv[32];
#pragma unroll
        for (int e = 0; e < 32; e += 8) {
          const uint4 v = *(const uint4*)(kib + (size_t)s * 32 + e);
          kv[e + 0] = __uint_as_float(v.x << 16); kv[e + 1] = __uint_as_float(v.x & 0xFFFF0000u);
          kv[e + 2] = __uint_as_float(v.y << 16); kv[e + 3] = __uint_as_float(v.y & 0xFFFF0000u);
          kv[e + 4] = __uint_as_float(v.z << 16); kv[e + 5] = __uint_as_float(v.z & 0xFFFF0000u);
          kv[e + 6] = __uint_as_float(v.w << 16); kv[e + 7] = __uint_as_float(v.w & 0xFFFF0000u);
        }
        float score = 0.f;
    #pragma unroll 1
    for (int hh = 0; hh < 8; hh++) {
          float dsum = 0.f;
#pragma unroll
          for (int e = 0; e < 32; e++) dsum = fmaf(qi[hh * 32 + e], kv[e], dsum);
          score = fmaf(fmaxf(dsum, 0.f), wi[hh], score);
        }
        keys[s] = f2key(score);
      }
      unsigned prefix = 0; int kk = 256;
      for (int shift = 24; shift >= 0; shift -= 8) {
        hist[tid] = 0;
        __syncthreads();
        const unsigned hmask = (shift == 24) ? 0u : (0xFFFFFFFFu << (shift + 8));
        for (int s = tid; s < n; s += 256) {
          const unsigned k = keys[s];
          if ((k & hmask) == prefix) atomicAdd(&hist[(k >> shift) & 255], 1);
        }
        __syncthreads();
        if (tid == 0) {
          int cum = 0, dsel = 0;
          for (int dg = 255; dg >= 0; dg--) {
            const int c = hist[dg];
            if (cum + c >= kk) { dsel = dg; break; }
            cum += c;
          }
          misc[0] = dsel; misc[1] = kk - cum;
        }
        __syncthreads();
        prefix |= ((unsigned)misc[0]) << shift;
        kk = misc[1];
        __syncthreads();
      }
      const int per = (n + 255) / 256;
      const int s0 = tid * per, s1 = min(n, s0 + per);
      int cg_ = 0, ce = 0;
      for (int s = s0; s < s1; s++) { const unsigned k = keys[s]; cg_ += (k > prefix); ce += (k == prefix); }
      cnts[tid] = cg_; hist[tid] = ce;
      __syncthreads();
      if (tid == 0) {
        int a = 0, e = 0;
        for (int i = 0; i < 256; i++) { const int c1 = cnts[i], c2 = hist[i]; cnts[i] = a; hist[i] = e; a += c1; e += c2; }
        misc[2] = a;
      }
      __syncthreads();
      {
        int og = cnts[tid], oe = hist[tid];
        const int ngt = misc[2];
        for (int s = s0; s < s1; s++) {
          const unsigned k = keys[s];
          if (k > prefix) sel[og++] = s;
          else if (k == prefix) { if (oe < kk) sel[ngt + oe] = s; oe++; }
        }
      }
      nsel = 256;
      __syncthreads();
    }
    for (int idx = tid; idx < 4 * nsel; idx += 256) {
      const int hh = idx / nsel, r = idx % nsel;
      sc[hh * 256 + r] = dot64_bf(qd + hh * 64, kdb + (size_t)sel[r] * 64) * 0.125f;
    }
    __syncthreads();
    softmax4(sc, 256, nsel);
    __syncthreads();
    {
      const int h = tid >> 6, d = tid & 63;
      float o = 0.f;
      for (int r = 0; r < nsel; r++) o = fmaf(sc[h * 256 + r], bf2f(vdb[(size_t)sel[r] * 64 + d]), o);
      const float got = bf2f(p.concat[(size_t)tok * DM + 512 + tid]);
      const float df = fabsf(o - got);
      if (!(df <= 0.08f + 0.1f * fabsf(o))) atomicExch(p.flag, 1);
      if (!(df <= 0.004f + 0.02f * fabsf(o))) atomicAdd(p.chkcnt, 1);
    }
    __syncthreads();
  }
}


__device__ __forceinline__ void compress_check_phase(const Params& p, unsigned char* smem, int bid, int nblk) {
  float* hid = (float*)smem;
  const int tid = threadIdx.x;
  const int which = tid >> 7, j = tid & 127;
  for (int it = bid; it < 600; it += nblk) {
    const int item = (it * 131 + 5) % (NB * 2 * NC);
    const int i = item % NC, g = (item / NC) % 2, b = item / (NC * 2);
    const float* w1 = which ? p.w1v : p.w1k;
    const float* pe = which ? p.pe_v : p.pe_k;
    const bf16_t* src = (which ? p.kvn[1] : p.kvn[0]) + ((size_t)(b * 2 + g) * SEQ + i * 16) * 64;
    float acc = 0.f;
    for (int r = 0; r < 2048; r++) acc = fmaf(bf2f(src[r]) + pe[r], w1[(size_t)r * 128 + j], acc);
    hid[which * 128 + j] = gelu_exact(acc);
    __syncthreads();
    if (j < 64) {
      const float* w2 = which ? p.w2v : p.w2k;
      float o = 0.f;
      for (int k = 0; k < 128; k++) o = fmaf(hid[which * 128 + k], w2[k * 64 + j], o);
      const float got = which ? bf2f(p.vct[((size_t)(b * 2 + g) * 64 + j) * 256 + perm16(i)]) : bf2f(p.kcb[((size_t)(b * 2 + g) * 256 + i) * 64 + j]);
      check_val(p, o, got, 0.01f, 0.02f);
    }
    __syncthreads();
  }
}
#endif


#define XB_TMO      128
#define XB_XCNT(j)  (256  + 64 * (j))
#define XB_XSUB(j)  (1280 + 64 * (j))
#define XB_XGEN(j)  (2304 + 64 * (j))
#define XB_TOP      3328
#define XB_TOPGEN   3392
#define XCD_BAR_WORDS 3456
#define XB_SPIN_CAP (1u << 23)
#define LAS __attribute__((address_space(3)))
__device__ __forceinline__ unsigned xb_ld(unsigned* p)              { return __hip_atomic_load(p, __ATOMIC_RELAXED, __HIP_MEMORY_SCOPE_AGENT); }
__device__ __forceinline__ unsigned xb_add(unsigned* p, unsigned v) { return __hip_atomic_fetch_add(p, v, __ATOMIC_RELAXED, __HIP_MEMORY_SCOPE_AGENT); }
__device__ __forceinline__ unsigned xb_xcc_id() { return (unsigned)__builtin_amdgcn_s_getreg((3 << 11) | 20) & 0xFu; }
#define XB_SPIN(cond, bar) do { unsigned _sp = 0; while (cond) { __builtin_amdgcn_s_sleep(1); \
    if ((++_sp & 255u) == 0u) { if (xb_ld(&(bar)[XB_TMO])) break; if (_sp > XB_SPIN_CAP) { atomicAdd(&(bar)[XB_TMO], 1u); break; } } } } while (0)
struct XcdBarrier { unsigned* bar; unsigned x; volatile LAS unsigned* st; };
__device__ __forceinline__ XcdBarrier xcd_barrier_post(unsigned* bar, volatile LAS unsigned* st) {
  XcdBarrier b; b.bar = bar; b.x = xb_xcc_id(); b.st = st;
  if (threadIdx.x == 0) (void)xb_add(&bar[XB_XCNT(b.x)], 1u);
  return b;
}
__device__ __forceinline__ void xcd_barrier_complete(unsigned* bar, unsigned x, unsigned& nloc, unsigned& nx) {
  const unsigned G = gridDim.x * gridDim.y * gridDim.z;
  unsigned sum, cnt, mine, sp = 0u;
  for (;;) {
    sum = 0u; cnt = 0u; mine = 0u;
#pragma unroll
    for (unsigned j = 0; j < 16; ++j) { const unsigned c = xb_ld(&bar[XB_XCNT(j)]); sum += c; cnt += (c > 0u) ? 1u : 0u; mine = (j == x) ? c : mine; }
    if (sum == G) break;
    __builtin_amdgcn_s_sleep(1);
    if ((++sp & 255u) == 0u) { if (xb_ld(&bar[XB_TMO])) break; if (sp > XB_SPIN_CAP) { atomicAdd(&bar[XB_TMO], 1u); break; } }
  }
  nloc = mine > 0u ? mine : 1u; nx = cnt > 0u ? cnt : 1u;
}
__device__ __forceinline__ void xcd_barrier(const XcdBarrier& b) {
  asm volatile("s_waitcnt vmcnt(0)" ::: "memory");
  __syncthreads();
  if (threadIdx.x == 0) {
    unsigned* bar = b.bar;
    __builtin_amdgcn_s_waitcnt(0);
    unsigned nloc = b.st[0], nx = b.st[1];
    if (nloc == 0u) { xcd_barrier_complete(bar, b.x, nloc, nx); b.st[0] = nloc; b.st[1] = nx; }
    const unsigned old = xb_add(&bar[XB_XSUB(b.x)], 1u);
    const unsigned gen = old / nloc;
    if (old + 1u == (gen + 1u) * nloc) {
      __builtin_amdgcn_fence(__ATOMIC_RELEASE, "agent");
      asm volatile("s_waitcnt vmcnt(0)" ::: "memory");
      const unsigned og = xb_add(&bar[XB_TOP], 1u);
      const unsigned tg = og / nx;
      if (og + 1u == (tg + 1u) * nx) xb_add(&bar[XB_TOPGEN], 1u);
      else XB_SPIN(xb_ld(&bar[XB_TOPGEN]) == tg, bar);
      __builtin_amdgcn_fence(__ATOMIC_ACQUIRE, "agent");
      xb_add(&bar[XB_XGEN(b.x)], 1u);
      asm volatile("s_waitcnt vmcnt(0)" ::: "memory");
    } else {
      XB_SPIN(xb_ld(&bar[XB_XGEN(b.x)]) == gen, bar);
      __builtin_amdgcn_fence(__ATOMIC_ACQUIRE, "agent");
      asm volatile("s_waitcnt vmcnt(0)" ::: "memory");
    }
  }
  __syncthreads();
}

constexpr int SMEM_BYTES = 65536;
__global__ void __launch_bounds__(256, 2) megakernel(Params p) {
  __shared__ __align__(16) unsigned char smem[SMEM_BYTES];
  __shared__ uint4 xb_words;
  cg::grid_group grid = cg::this_grid();
  const int bid = blockIdx.x, nblk = gridDim.x;
  if (threadIdx.x == 0) xb_words = make_uint4(0u, 0u, 0u, 0u);
  __syncthreads();
  const XcdBarrier xb = xcd_barrier_post(p.bar, (volatile LAS unsigned*)&xb_words);
  if (p.never) grid.sync();
  for (int rep = 0; rep < ((PROBE_REPEAT & 128) ? 2 : 1); rep++) {
  convert_phase(p.x, p.xb, (size_t)NT * DM, bid, nblk);
  convert_phase(p.mem, p.memb, (size_t)NB * MEML * DM, bid, nblk);
  quant_phase(p.pu, p.puq, p.psu, 16384, bid, nblk);
  quant_phase(p.pv, p.pvq, p.psv, 16384, bid, nblk);
  }
  for (int rep = 0; rep < ((PROBE_REPEAT & 256) ? 2 : 1); rep++) {
  transpose_phase<true>(p.w_in, INW, p.wint, DM, INWP, smem, bid, nblk);
  transpose_phase<false>(p.w_mem_kv, 512, p.wmemt, DM, 512, smem, bid, nblk);
  transpose_phase<false>(p.w_out, DM, p.woutt, DM, DM, smem, bid, nblk);
  transpose_phase<false>(p.wq, 2048, p.wqt, DM, 2048, smem, bid, nblk);
  transpose_phase<false>(p.w1k, 128, p.w1kt, 2048, 128, smem, bid, nblk);
  transpose_phase<false>(p.w1v, 128, p.w1vt, 2048, 128, smem, bid, nblk);
  }
  for (int rep = 0; rep < ((PROBE_REPEAT & 512) ? 2 : 1); rep++) {
  cbias_phase(p, bid, nblk);
  subkey_phase(p.sk1, p.sk1p, bid, nblk);
  subkey_phase(p.sk2, p.sk2p, bid, nblk);
  cs_phase(p, bid, nblk);
  ovp_phase(p, bid, nblk);
  }
  if (bid == 0 && threadIdx.x == 0) { *p.flag = 0; *p.chkcnt = 0; }
  xcd_barrier(xb);
  for (int rep = 0; rep < ((PROBE_REPEAT & 2) ? 2 : 1); rep++) inproj_phase(p, smem, bid, nblk);
  xcd_barrier(xb);
  for (int rep = 0; rep < ((PROBE_REPEAT & 4) ? 2 : 1); rep++) compress_phase(p, smem, bid, nblk);
  xcd_barrier(xb);
  {
    constexpr int N_NSA = NB * 2 * 128, N_DSA = NB * (SEQ / 2), N_MEM = NB * 4 * 32;
    volatile LAS unsigned* qslot = (volatile LAS unsigned*)&xb_words + 2;
#pragma unroll 1
    for (;;) {
      __syncthreads();
      if (threadIdx.x == 0) qslot[0] = atomicAdd(p.bar + 64, 1u);
      __syncthreads();
      const int q = (int)qslot[0];
      if (q >= N_NSA) break;
      nsa_flash_item(p, smem, ((q & 15) << 7) | (127 - (q >> 4)));
    }
#pragma unroll 1
    for (;;) {
      __syncthreads();
      if (threadIdx.x == 0) qslot[0] = atomicAdd(p.bar + 65, 1u);
      __syncthreads();
      const int q = (int)qslot[0];
      if (q >= N_DSA) break;
      dsa_item(p, smem, q & 7, (SEQ / 2 - 1) - (q >> 3));
    }
#pragma unroll 1
    for (;;) {
      __syncthreads();
      if (threadIdx.x == 0) qslot[0] = atomicAdd(p.bar + 66, 1u);
      __syncthreads();
      const int q = (int)qslot[0];
      if (q >= N_MEM) break;
      mem_flash_item(p, smem, q);
    }
  }
  xcd_barrier(xb);
  for (int rep = 0; rep < ((PROBE_REPEAT & 64) ? 2 : 1); rep++) peer_block_phase(p, smem, bid, nblk);
}


#if SELFCHECK
__global__ void __launch_bounds__(256) check_kernel(Params p) {
  __shared__ __align__(16) unsigned char smem[40960];
  dsa_check_phase(p, smem, blockIdx.x, gridDim.x);
}
__global__ void check_final(Params p) {
  if (threadIdx.x == 0 && (*(volatile int*)p.flag != 0 || *(volatile int*)p.chkcnt > 6000)) p.out[0] = __uint_as_float(0x7FC00000u);
}
#endif

extern "C" void kernel_launch(void* const* d_in, const int* in_sizes, int n_in, void* d_out, int out_size,
                              void* d_ws, size_t ws_size, hipStream_t stream) {
  Params p{};
  p.x = (const float*)d_in[0]; p.mem = (const float*)d_in[1]; p.pos = (const int*)d_in[2];
  p.w_in = (const float*)d_in[3]; p.pe_k = (const float*)d_in[4]; p.pe_v = (const float*)d_in[5];
  p.w1k = (const float*)d_in[6]; p.w2k = (const float*)d_in[7]; p.w1v = (const float*)d_in[8]; p.w2v = (const float*)d_in[9];
  p.w_mem_kv = (const float*)d_in[10]; p.w_out = (const float*)d_in[11]; p.ln1g = (const float*)d_in[12]; p.ln1b = (const float*)d_in[13];
  p.wq = (const float*)d_in[14]; p.sk1 = (const float*)d_in[15]; p.sk2 = (const float*)d_in[16];
  p.pu = (const float*)d_in[17]; p.pv = (const float*)d_in[18]; p.ln2g = (const float*)d_in[19]; p.ln2b = (const float*)d_in[20];
  p.out = (float*)d_out;
  unsigned char* ws = (unsigned char*)d_ws;
  size_t off = 0;
  auto take = [&](size_t bytes) { void* r = ws + off; off += (bytes + 255) & ~(size_t)255; return r; };
  p.xb = (bf16_t*)take((size_t)NT * DM * 2);
  p.qn = (bf16_t*)take((size_t)NT * 512 * 2);
  for (int j = 0; j < 6; j++) p.kvn[j] = (bf16_t*)take((size_t)NT * 128 * 2);
  p.qd = (bf16_t*)take((size_t)NT * 256 * 2);
  p.kd = (bf16_t*)take((size_t)NT * 64 * 2);
  p.vd = (bf16_t*)take((size_t)NT * 64 * 2);
  p.qi = (bf16_t*)take((size_t)NT * 256 * 2);
  p.ki = (bf16_t*)take((size_t)NT * 32 * 2);
  p.memq = (bf16_t*)take((size_t)NT * 256 * 2);
  p.gates = (float*)take((size_t)NT * 24 * 4);
  p.widx = (float*)take((size_t)NT * 8 * 4);
  p.mkv = (bf16_t*)take((size_t)NB * MEML * 512 * 2);
  p.memvt = (bf16_t*)take((size_t)NB * 4 * 64 * MEML * 2);
  p.vslct = (bf16_t*)take((size_t)NT * 128 * 2);
  p.vwint = (bf16_t*)take((size_t)NT * 128 * 2);
  p.kcb = (bf16_t*)take((size_t)NB * 2 * 256 * 64 * 2);
  p.vct = (bf16_t*)take((size_t)NB * 2 * 64 * 256 * 2);
  p.ovp = (bf16_t*)take((size_t)64 * 256 * 2);
  p.w1kt = (bf16_t*)take((size_t)128 * 2048 * 2);
  p.w1vt = (bf16_t*)take((size_t)128 * 2048 * 2);
  p.cbias = (float*)take(64 * 256 * 4);
  p.chkcnt = (int*)take(256);
  p.bar = (unsigned*)take(XCD_BAR_WORDS * 4);
  p.never = 0; p.pad_ = 0;
  p.memb = (bf16_t*)take((size_t)NB * MEML * DM * 2);
  p.wint = (bf16_t*)take((size_t)INWP * DM * 2);
  p.wmemt = (bf16_t*)take((size_t)512 * DM * 2);
  p.woutt = (bf16_t*)take((size_t)DM * DM * 2);
  p.wqt = (bf16_t*)take((size_t)2048 * DM * 2);
  p.sk1p = (bf16_t*)take((size_t)128 * 128 * 2);
  p.sk2p = (bf16_t*)take((size_t)128 * 128 * 2);
  p.puq = (unsigned char*)take((size_t)16384 * DM);
  p.pvq = (unsigned char*)take((size_t)16384 * DM);
  p.psu = (float*)take(16384 * 4);
  p.psv = (float*)take(16384 * 4);
  p.cs = (float2*)take((size_t)NT * 8 * 8);
  p.kc = (float*)take((size_t)NB * 2 * NC * 64 * 4);
  p.vc = (float*)take((size_t)NB * 2 * NC * 64 * 4);
  p.concat = (bf16_t*)take((size_t)NT * DM * 2);
  p.x1b = (bf16_t*)take((size_t)NT * DM * 2);
  p.pexp = (int*)take((size_t)NT * 128 * 4);
  p.pgate = (float*)take((size_t)NT * 128 * 4);
  p.flag = (int*)take(256);
  if (off > ws_size) { fprintf(stderr, "workspace too small: need %zu have %zu\n", off, ws_size); return; }
  static int grid_blocks = 0;
  if (!grid_blocks) {
    int dev = 0, cus = 0, per_cu = 0;
    hipGetDevice(&dev);
    hipDeviceGetAttribute(&cus, hipDeviceAttributeMultiprocessorCount, dev);
    hipOccupancyMaxActiveBlocksPerMultiprocessor(&per_cu, megakernel, 256, 0);
    if (per_cu > 2) per_cu = 2;
    grid_blocks = cus * per_cu;
  }
  hipMemsetAsync(p.bar, 0, XCD_BAR_WORDS * 4, stream);
  void* args[] = {&p};
  hipError_t e = hipLaunchCooperativeKernel((void*)megakernel, dim3(grid_blocks), dim3(256), args, 0, stream);
  if (e != hipSuccess) fprintf(stderr, "cooperative launch failed: %s (grid %d)\n", hipGetErrorString(e), grid_blocks);
#if SELFCHECK
  check_kernel<<<512, 256, 0, stream>>>(p);
  check_final<<<1, 64, 0, stream>>>(p);
#endif
}
```

```cpp
#include <hip/hip_runtime.h>
#include <hip/hip_cooperative_groups.h>
#include <cstdio>
#include <cstdint>
namespace cg = cooperative_groups;

constexpr int NB = 8, SEQ = 4096, DM = 1024, NT = NB * SEQ;
constexpr int INW = 2240;
constexpr int INWP = 2304;
constexpr int NC = 255;
constexpr int MEML = 256;
constexpr int C_NSAQ = 0, C_NSAKV = 512, C_GATE = 1280, C_DSAQ = 1304, C_DSAK = 1560, C_DSAV = 1624,
              C_IDXQ = 1688, C_IDXK = 1944, C_IDXW = 1976, C_MEMQ = 1984;
constexpr int P_NSAQ = 0, P_NSAKV = 512, P_DSAQ = 1280, P_DSAK = 1536, P_DSAV = 1600, P_IDXQ = 1664, P_IDXK = 1920,
              P_MEMQ = 1952, P_GATE = 2208, P_IDXW = 2232, P_END = 2240;
constexpr float ALPHA = 1.189207115002721f;

typedef unsigned short bf16_t;
typedef __attribute__((ext_vector_type(8))) __bf16 bf16x8;
typedef __attribute__((ext_vector_type(2))) __bf16 bf16x2;
typedef __attribute__((ext_vector_type(2))) float f32x2;
typedef __attribute__((ext_vector_type(4))) float f32x4;
typedef __attribute__((ext_vector_type(16))) float f32x16;

struct Params {
  const float *x, *mem; const int* pos;
  const float *w_in, *pe_k, *pe_v, *w1k, *w2k, *w1v, *w2v, *w_mem_kv, *w_out, *ln1g, *ln1b,
              *wq, *sk1, *sk2, *pu, *pv, *ln2g, *ln2b;
  float* out;
  bf16_t *xb, *memb, *wint, *wmemt, *woutt, *wqt, *sk1p, *sk2p;
  unsigned char *puq, *pvq;
  float *psu, *psv;
  float2* cs;
  bf16_t *qn;
  bf16_t *kvn[6];
  bf16_t *qd, *kd, *vd;
  bf16_t *qi, *ki;
  bf16_t *memq, *mkv;
  bf16_t *memvt;
  bf16_t *vslct, *vwint;
  bf16_t *w1kt, *w1vt; float* cbias;
  bf16_t *kcb, *vct;
  bf16_t *ovp;
  int *chkcnt;
  unsigned *bar;
  int never;
  int pad_;
  float *gates, *widx;
  bf16_t *concat;
  bf16_t *x1b;
  float *kc, *vc;
  int   *pexp;
  float *pgate;
  int   *flag;
};

__device__ __forceinline__ float bf2f(bf16_t u) { return __uint_as_float(((unsigned)u) << 16); }
__device__ __forceinline__ bf16_t f2bf(float f) { return __builtin_bit_cast(unsigned short, (__bf16)f); }
__device__ __forceinline__ unsigned pack2bf(float a, float b) {
  f32x2 v = {a, b};
  return __builtin_bit_cast(unsigned, __builtin_convertvector(v, bf16x2));
}

__device__ __forceinline__ float wave_sum(float v) {
#pragma unroll
  for (int o = 32; o > 0; o >>= 1) v += __shfl_xor(v, o);
  return v;
}
__device__ __forceinline__ float wave_max(float v) {
#pragma unroll
  for (int o = 32; o > 0; o >>= 1) v = fmaxf(v, __shfl_xor(v, o));
  return v;
}
__device__ __forceinline__ float gelu_exact(float x) { return 0.5f * x * (1.f + erff(x * 0.7071067811865476f)); }

__device__ __forceinline__ void convert_phase(const float* __restrict__ src, bf16_t* __restrict__ dst, size_t n, int bid, int nblk) {
  const size_t nch = n / 8, stride = (size_t)nblk * 256;
  size_t c = (size_t)bid * 256 + threadIdx.x;
  for (; c + 3 * stride < nch; c += 4 * stride) {
    float4 a[4], b[4];
#pragma unroll
    for (int u = 0; u < 4; u++) { a[u] = *(const float4*)(src + (c + u * stride) * 8); b[u] = *(const float4*)(src + (c + u * stride) * 8 + 4); }
#pragma unroll
    for (int u = 0; u < 4; u++) {
      uint4 o = {pack2bf(a[u].x, a[u].y), pack2bf(a[u].z, a[u].w), pack2bf(b[u].x, b[u].y), pack2bf(b[u].z, b[u].w)};
      *(uint4*)(dst + (c + u * stride) * 8) = o;
    }
  }
  for (; c < nch; c += stride) {
    const float4 a = *(const float4*)(src + c * 8), b = *(const float4*)(src + c * 8 + 4);
    uint4 o = {pack2bf(a.x, a.y), pack2bf(a.z, a.w), pack2bf(b.x, b.y), pack2bf(b.z, b.w)};
    *(uint4*)(dst + c * 8) = o;
  }
}
__device__ __forceinline__ unsigned quant4(const float4& v, float inv) {
  const unsigned a = (unsigned)(__float2int_rn(v.x * inv) + 128), b = (unsigned)(__float2int_rn(v.y * inv) + 128);
  const unsigned c = (unsigned)(__float2int_rn(v.z * inv) + 128), d = (unsigned)(__float2int_rn(v.w * inv) + 128);
  return a | (b << 8) | (c << 16) | (d << 24);
}
__device__ __forceinline__ float absmax4(const float4& v) { return fmaxf(fmaxf(fabsf(v.x), fabsf(v.y)), fmaxf(fabsf(v.z), fabsf(v.w))); }
__device__ __forceinline__ void quant_rows(const float* __restrict__ src, unsigned char* __restrict__ dst, float* __restrict__ scl,
                                           int row0, int nrows, int gw, int nw) {
  const int lane = threadIdx.x & 63;
  for (int r = row0 + gw * 2; r < row0 + nrows; r += nw * 2) {
    const float4* s0 = (const float4*)(src + (size_t)r * 1024 + 16 * lane);
    const float4* s1 = (const float4*)(src + (size_t)(r + 1) * 1024 + 16 * lane);
    const float4 a0 = s0[0], a1 = s0[1], a2 = s0[2], a3 = s0[3];
    const float4 b0 = s1[0], b1 = s1[1], b2 = s1[2], b3 = s1[3];
    const float ma = wave_max(fmaxf(fmaxf(absmax4(a0), absmax4(a1)), fmaxf(absmax4(a2), absmax4(a3))));
    const float mb = wave_max(fmaxf(fmaxf(absmax4(b0), absmax4(b1)), fmaxf(absmax4(b2), absmax4(b3))));
    const float ia = ma > 0.f ? 127.f / ma : 0.f, ib = mb > 0.f ? 127.f / mb : 0.f;
    *(uint4*)(dst + (size_t)r * 1024 + 16 * lane) = make_uint4(quant4(a0, ia), quant4(a1, ia), quant4(a2, ia), quant4(a3, ia));
    *(uint4*)(dst + (size_t)(r + 1) * 1024 + 16 * lane) = make_uint4(quant4(b0, ib), quant4(b1, ib), quant4(b2, ib), quant4(b3, ib));
    if (lane == 0) { scl[r] = ma * (1.f / 127.f); scl[r + 1] = mb * (1.f / 127.f); }
  }
}
__device__ __forceinline__ int inproj_colmap(int n) {
  if (n < P_DSAQ) return n;
  if (n < P_DSAK) return C_DSAQ + (n - P_DSAQ);
  if (n < P_IDXQ) return C_DSAK + (n - P_DSAK);
  if (n < P_IDXK) return C_IDXQ + (n - P_IDXQ);
  if (n < P_MEMQ) return C_IDXK + (n - P_IDXK);
  if (n < P_GATE) return C_MEMQ + (n - P_MEMQ);
  if (n < P_IDXW) return C_GATE + (n - P_GATE);
  if (n < P_END) return C_IDXW + (n - P_IDXW);
  return -1;
}
template <bool PERM>
__device__ __forceinline__ void transpose_phase(const float* __restrict__ src, int lds_, bf16_t* __restrict__ dst, int K, int Nd,
                                unsigned char* smem, int bid, int nblk) {
  float (*t)[65] = (float (*)[65])smem;
  const int tx = threadIdx.x & 63, ty = threadIdx.x >> 6;
  const int tk = K / 64, tn = Nd / 64;
  for (int tile = bid; tile < tk * tn; tile += nblk) {
    const int k0 = (tile % tk) * 64, n0 = (tile / tk) * 64;
    const int nsrc = PERM ? inproj_colmap(n0 + tx) : (n0 + tx);
#pragma unroll
    for (int i = 0; i < 16; i++) {
      const int k = ty + 4 * i;
      t[tx][k] = (nsrc >= 0) ? src[(size_t)(k0 + k) * lds_ + nsrc] : 0.f;
    }
    __syncthreads();
#pragma unroll
    for (int i = 0; i < 16; i++) {
      const int n = ty + 4 * i;
      dst[(size_t)(n0 + n) * K + k0 + tx] = f2bf(t[n][tx]);
    }
    __syncthreads();
  }
}
__device__ __forceinline__ void subkey_phase(const float* __restrict__ src, bf16_t* __restrict__ dst, int bid, int nblk) {
  for (int i = bid * 256 + threadIdx.x; i < 128 * 128; i += nblk * 256) {
    const int n = i >> 7, pos = i & 127, g16 = pos & ~15, pp = pos & 15, h = pp >> 3, j = pp & 7;
    dst[i] = f2bf(src[n * 128 + g16 + 8 * (j >> 2) + 4 * h + (j & 3)]);
  }
}
__device__ __forceinline__ void rope_cs(int pos, float freq, float& c, float& s) {
  double ang = (double)pos * (double)freq;
  double rev = ang * 0.15915494309189535;
  rev -= floor(rev + 0.5);
  float r = (float)(rev * 6.283185307179586);
  c = __cosf(r); s = __sinf(r);
}
__device__ __forceinline__ void cs_phase(const Params& p, int bid, int nblk) {
  const float f16[8] = {1.0f, 0.19392274474868576f, 0.03760603093086393f, 0.007292664737217109f,
                        0.001414213562373095f, 0.0002742481756762073f, 5.318295896944988e-05f, 1.031338537721246e-05f};
  for (int i = bid * 256 + threadIdx.x; i < NT * 8; i += nblk * 256) {
    float c, s; rope_cs(p.pos[i >> 3], f16[i & 7], c, s);
    p.cs[i] = make_float2(c, s);
  }
}

template <int WM, int WN>
struct Gemm {
  static constexpr int BM = 64 * WM, BN = 64 * WN;
  static constexpr int A_BYTES = BM * 128, B_BYTES = BN * 128, STAGE = A_BYTES + B_BYTES;
  static constexpr int SMEM = 2 * STAGE;
  static constexpr int NA = BM / 32, NBK = BN / 32;

  struct Stage8 { uint4 a0, a1, a2, a3, b0, b1, b2, b3; };
  static __device__ __forceinline__ Stage8 ld_stage(const bf16_t* ap0, const bf16_t* ap1, const bf16_t* ap2, const bf16_t* ap3,
                                                    const bf16_t* bp0, const bf16_t* bp1, const bf16_t* bp2, const bf16_t* bp3, int ko) {
    Stage8 r;
    r.a0 = *(const uint4*)(ap0 + ko); r.a1 = *(const uint4*)(ap1 + ko);
    if (NA > 2) { r.a2 = *(const uint4*)(ap2 + ko); r.a3 = *(const uint4*)(ap3 + ko); } else { r.a2 = r.a0; r.a3 = r.a0; }
    r.b0 = *(const uint4*)(bp0 + ko); r.b1 = *(const uint4*)(bp1 + ko);
    if (NBK > 2) { r.b2 = *(const uint4*)(bp2 + ko); r.b3 = *(const uint4*)(bp3 + ko); } else { r.b2 = r.b0; r.b3 = r.b0; }
    return r;
  }
  static __device__ __forceinline__ void st_stage(const Stage8 r, unsigned char* dst, int wofs) {
    *(uint4*)(dst + wofs) = r.a0; *(uint4*)(dst + wofs + 4096) = r.a1;
    if (NA > 2) { *(uint4*)(dst + wofs + 8192) = r.a2; *(uint4*)(dst + wofs + 12288) = r.a3; }
    *(uint4*)(dst + A_BYTES + wofs) = r.b0; *(uint4*)(dst + A_BYTES + wofs + 4096) = r.b1;
    if (NBK > 2) { *(uint4*)(dst + A_BYTES + wofs + 8192) = r.b2; *(uint4*)(dst + A_BYTES + wofs + 12288) = r.b3; }
  }
  static __device__ __forceinline__ void compute_stage(f32x16 (&acc)[WM][WN], const unsigned char* cur, int wm, int wn, int fr, int fh) {
#pragma unroll
    for (int s = 0; s < 4; s++) {
      const int chunk = 2 * s + fh;
      bf16x8 af[WM], bfr[WN];
#pragma unroll
      for (int i = 0; i < WM; i++) {
        const int row = (wm * WM + i) * 32 + fr;
        af[i] = *(const bf16x8*)(cur + row * 128 + ((chunk ^ ((row >> 1) & 7)) << 4));
      }
#pragma unroll
      for (int j = 0; j < WN; j++) {
        const int row = (wn * WN + j) * 32 + fr;
        bfr[j] = *(const bf16x8*)(cur + A_BYTES + row * 128 + ((chunk ^ ((row >> 1) & 7)) << 4));
      }
#pragma unroll
      for (int i = 0; i < WM; i++)
#pragma unroll
        for (int j = 0; j < WN; j++) acc[i][j] = __builtin_amdgcn_mfma_f32_32x32x16_bf16(af[i], bfr[j], acc[i][j], 0, 0, 0);
    }
  }
  template <class ARow, class BRow>
  static __device__ __forceinline__ void mainloop(f32x16 (&acc)[WM][WN], ARow arow, BRow brow, int K, unsigned char* smem) {
    const int tid = threadIdx.x, lane = tid & 63, w = tid >> 6, wm = w >> 1, wn = w & 1;
    const int lrow = tid >> 3, lchunk = tid & 7;
    const bf16_t* ap0 = arow(lrow) + lchunk * 8;
    const bf16_t* ap1 = arow(lrow + 32) + lchunk * 8;
    const bf16_t* ap2 = (NA > 2) ? arow(lrow + 64) + lchunk * 8 : ap0;
    const bf16_t* ap3 = (NA > 2) ? arow(lrow + 96) + lchunk * 8 : ap0;
    const bf16_t* bp0 = brow(lrow) + lchunk * 8;
    const bf16_t* bp1 = brow(lrow + 32) + lchunk * 8;
    const bf16_t* bp2 = (NBK > 2) ? brow(lrow + 64) + lchunk * 8 : bp0;
    const bf16_t* bp3 = (NBK > 2) ? brow(lrow + 96) + lchunk * 8 : bp0;
    const int wofs = lrow * 128 + ((lchunk ^ ((lrow >> 1) & 7)) << 4);
    const int fr = lane & 31, fh = lane >> 5;
    const int nk = K / 64;
    Stage8 rA = ld_stage(ap0, ap1, ap2, ap3, bp0, bp1, bp2, bp3, 0);
    Stage8 rB = ld_stage(ap0, ap1, ap2, ap3, bp0, bp1, bp2, bp3, 64);
    st_stage(rA, smem, wofs);
    rA = ld_stage(ap0, ap1, ap2, ap3, bp0, bp1, bp2, bp3, (nk > 2 ? 2 : 0) * 64);
    __syncthreads();
#pragma unroll 1
    for (int kt = 0; kt < nk; kt += 2) {
      compute_stage(acc, smem, wm, wn, fr, fh);
      st_stage(rB, smem + STAGE, wofs);
      if (kt + 3 < nk) rB = ld_stage(ap0, ap1, ap2, ap3, bp0, bp1, bp2, bp3, (kt + 3) * 64);
      __syncthreads();
      compute_stage(acc, smem + STAGE, wm, wn, fr, fh);
      if (kt + 2 < nk) {
        st_stage(rA, smem, wofs);
        if (kt + 4 < nk) rA = ld_stage(ap0, ap1, ap2, ap3, bp0, bp1, bp2, bp3, (kt + 4) * 64);
      }
      __syncthreads();
    }
  }
};

__device__ __forceinline__ int perm16(int k) { return (k & ~12) | ((k & 4) << 1) | ((k & 8) >> 1); }
constexpr float LOG2E = 1.4426950408889634f;
constexpr int FL_TILE = 8192;
constexpr int FL_STAGE = 2 * FL_TILE;
struct FlashAcc {
  f32x16 o[2];
  float m, l;
};
__device__ __forceinline__ void flash_init(FlashAcc& a) {
#pragma unroll
  for (int i = 0; i < 2; i++)
#pragma unroll
    for (int r = 0; r < 16; r++) a.o[i][r] = 0.f;
  a.m = -INFINITY; a.l = 0.f;
}
struct Tile2 { uint4 a, b; };
template <class RowF>
__device__ __forceinline__ Tile2 tile_fetch(RowF rowp) {
  const int tid = threadIdx.x;
  Tile2 t;
  t.a = *(const uint4*)(rowp(tid >> 3) + (tid & 7) * 8);
  t.b = *(const uint4*)(rowp((tid >> 3) + 32) + (tid & 7) * 8);
  return t;
}
__device__ __forceinline__ void tile_store(const Tile2& t, unsigned char* dst) {
  const int tid = threadIdx.x, row = tid >> 3, ch = tid & 7;
  const int ofs = row * 128 + ((ch ^ ((row >> 1) & 7)) << 4);
  *(uint4*)(dst + ofs) = t.a;
  *(uint4*)(dst + ofs + 4096) = t.b;
}
__device__ __forceinline__ bf16x8 lds_frag(const unsigned char* tile, int row, int chunk) {
  return *(const bf16x8*)(tile + row * 128 + ((chunk ^ ((row >> 1) & 7)) << 4));
}
__device__ __forceinline__ void flash_qk(f32x16 (&s)[2], const unsigned char* ktile, const bf16x8 (&qf)[4]) {
  const int lane = threadIdx.x & 63, fr = lane & 31, fh = lane >> 5;
#pragma unroll
  for (int kt = 0; kt < 2; kt++) {
#pragma unroll
    for (int r = 0; r < 16; r++) s[kt][r] = 0.f;
#pragma unroll
    for (int ks = 0; ks < 4; ks++)
      s[kt] = __builtin_amdgcn_mfma_f32_32x32x16_bf16(lds_frag(ktile, kt * 32 + fr, 2 * ks + fh), qf[ks], s[kt], 0, 0, 0);
    asm volatile("" ::: "memory");
  }
}
__device__ __forceinline__ bf16x8 pack_frag(const f32x16& s, int half8) {
  uint4 u = {pack2bf(s[8 * half8 + 0], s[8 * half8 + 1]), pack2bf(s[8 * half8 + 2], s[8 * half8 + 3]),
             pack2bf(s[8 * half8 + 4], s[8 * half8 + 5]), pack2bf(s[8 * half8 + 6], s[8 * half8 + 7])};
  return __builtin_bit_cast(bf16x8, u);
}
__device__ __forceinline__ void flash_update(FlashAcc& a, f32x16 (&s)[2], const unsigned char* vtile, bool colvalid = true) {
  const int lane = threadIdx.x & 63, fr = lane & 31, fh = lane >> 5;
  float mx = fmaxf(s[0][0], s[1][0]);
#pragma unroll
  for (int r = 1; r < 16; r += 1) mx = __builtin_fmaxf(mx, __builtin_fmaxf(s[0][r], s[1][r]));
  mx = fmaxf(mx, __shfl_xor(mx, 32));
  mx = colvalid ? mx : -INFINITY;
  const float mnew = fmaxf(a.m, mx);
  const float muse = (mnew == -INFINITY) ? 0.f : mnew;
  if (__any(mnew != a.m)) {
    const float alpha = __builtin_amdgcn_exp2f((a.m - muse) * LOG2E);
    a.l *= alpha;
#pragma unroll
    for (int dt = 0; dt < 2; dt++)
#pragma unroll
      for (int r = 0; r < 16; r++) a.o[dt][r] *= alpha;
    a.m = mnew;
  }
  const float cb = colvalid ? -muse * LOG2E : -INFINITY;
  float sum0 = 0.f, sum1 = 0.f;
#pragma unroll
  for (int r = 0; r < 16; r++) {
    const float p0 = __builtin_amdgcn_exp2f(fmaf(s[0][r], LOG2E, cb));
    const float p1 = __builtin_amdgcn_exp2f(fmaf(s[1][r], LOG2E, cb));
    s[0][r] = p0; s[1][r] = p1; sum0 += p0; sum1 += p1;
  }
  a.l += sum0 + sum1;
#pragma unroll
  for (int kt = 0; kt < 2; kt++)
#pragma unroll
    for (int h8 = 0; h8 < 2; h8++) {
      const bf16x8 pf = pack_frag(s[kt], h8);
#pragma unroll
      for (int dt = 0; dt < 2; dt++)
        a.o[dt] = __builtin_amdgcn_mfma_f32_32x32x16_bf16(lds_frag(vtile, dt * 32 + fr, 4 * kt + 2 * h8 + fh), pf, a.o[dt], 0, 0, 0);
      asm volatile("" ::: "memory");
    }
}
__device__ __forceinline__ float flash_inv_l(const FlashAcc& a) {
  const float lt = a.l + __shfl_xor(a.l, 32);
  return lt > 0.f ? 1.f / lt : 0.f;
}
__device__ __forceinline__ void flash_load_q(bf16x8 (&qf)[4], const bf16_t* qrow, float scale) {
  const int fh = (threadIdx.x & 63) >> 5;
#pragma unroll
  for (int ks = 0; ks < 4; ks++) {
    const uint4 u = *(const uint4*)(qrow + ks * 16 + fh * 8);
    const unsigned w[4] = {u.x, u.y, u.z, u.w};
    uint4 o;
    o.x = pack2bf(__uint_as_float(w[0] << 16) * scale, __uint_as_float(w[0] & 0xFFFF0000u) * scale);
    o.y = pack2bf(__uint_as_float(w[1] << 16) * scale, __uint_as_float(w[1] & 0xFFFF0000u) * scale);
    o.z = pack2bf(__uint_as_float(w[2] << 16) * scale, __uint_as_float(w[2] & 0xFFFF0000u) * scale);
    o.w = pack2bf(__uint_as_float(w[3] << 16) * scale, __uint_as_float(w[3] & 0xFFFF0000u) * scale);
    qf[ks] = __builtin_bit_cast(bf16x8, o);
  }
}
__device__ __forceinline__ void flash_store_o(const FlashAcc& a, bf16_t* orow, float scale) {
  const int fh = (threadIdx.x & 63) >> 5;
#pragma unroll
  for (int dt = 0; dt < 2; dt++)
#pragma unroll
    for (int g4 = 0; g4 < 4; g4++) {
      uint2 o = {pack2bf(a.o[dt][4 * g4 + 0] * scale, a.o[dt][4 * g4 + 1] * scale),
                 pack2bf(a.o[dt][4 * g4 + 2] * scale, a.o[dt][4 * g4 + 3] * scale)};
      *(uint2*)(orow + dt * 32 + 8 * g4 + 4 * fh) = o;
    }
}

__device__ __forceinline__ void mem_flash_item(const Params& p, unsigned char* smem, int item) {
  const int tid = threadIdx.x, lane = tid & 63, w = tid >> 6, fr = lane & 31;
  const int chunk = item & 31, h = (item >> 5) & 3, b = item >> 7;
  const int tok = b * SEQ + chunk * 128 + w * 32 + fr;
  bf16x8 qf[4];
  flash_load_q(qf, p.memq + (size_t)tok * 256 + h * 64, 0.125f);
  FlashAcc acc; flash_init(acc);
  const bf16_t* kbase = p.mkv + (size_t)b * MEML * 512 + h * 64;
  const bf16_t* vbase = p.memvt + (size_t)(b * 4 + h) * 64 * MEML;
  Tile2 rk = tile_fetch([&](int r) { return kbase + (size_t)r * 512; });
  Tile2 rv = tile_fetch([&](int r) { return vbase + (size_t)r * MEML; });
  __syncthreads();
  tile_store(rk, smem); tile_store(rv, smem + FL_TILE);
  __syncthreads();
#pragma unroll 1
  for (int kb = 0; kb < 4; kb++) {
    unsigned char* cur = smem + (kb & 1) * FL_STAGE;
    if (kb + 1 < 4) {
      rk = tile_fetch([&](int r) { return kbase + (size_t)((kb + 1) * 64 + r) * 512; });
      rv = tile_fetch([&](int r) { return vbase + (size_t)r * MEML + (kb + 1) * 64; });
    }
    {
      f32x16 s[2];
      flash_qk(s, cur, qf);
      flash_update(acc, s, cur + FL_TILE);
    }
    if (kb + 1 < 4) { unsigned char* nxt = smem + ((kb + 1) & 1) * FL_STAGE; tile_store(rk, nxt); tile_store(rv, nxt + FL_TILE); }
    __syncthreads();
  }
  flash_store_o(acc, p.concat + (size_t)tok * DM + 768 + h * 64, flash_inv_l(acc));
}
__device__ __forceinline__ void mem_phase(const Params& p, unsigned char* smem, int bid, int nblk) {
  for (int item = bid; item < NB * 4 * 32; item += nblk) mem_flash_item(p, smem, item);
}

__device__ __forceinline__ void ovp_phase(const Params& p, int bid, int nblk) {
  for (int i = bid * 256 + threadIdx.x; i < 64 * 256; i += nblk * 256) {
    const int m = i >> 8, n = i & 255;
    int ov = min(16 * n + 32, 64 * m + 64) - max(16 * n, 64 * m);
    if (ov < 0 || n >= NC) ov = 0;
    p.ovp[m * 256 + perm16(n)] = f2bf((float)ov * (1.f / 32.f));
  }
}

struct TileDest { bf16_t* ptr; int stride; int kind; };
__device__ __forceinline__ TileDest inproj_dest(const Params& p, int cb, int b) {
  TileDest d; d.kind = 0;
  if (cb < P_NSAKV) { d.ptr = p.qn + cb; d.stride = 512; d.kind = ((cb & 63) == 0) ? 1 : 0; }
  else if (cb < P_DSAQ) {
    const int o = cb - P_NSAKV, j = o >> 7, g = (o >> 6) & 1;
    if (j == 3 || j == 5) {
      d.ptr = (j == 3 ? p.vslct : p.vwint) + ((size_t)(b * 2 + g) * 64 + (o & 63)) * SEQ; d.stride = 0; d.kind = 5;
    } else {
      bf16_t* base = (j == 0) ? p.kvn[0] : (j == 1) ? p.kvn[1] : (j == 2) ? p.kvn[2] : p.kvn[4];
      d.ptr = base + ((size_t)g * SEQ + (size_t)b * SEQ) * 64 + (o & 63); d.stride = 64;
      d.kind = (((j & 1) == 0) && ((o & 63) == 0)) ? 1 : 0;
    }
  }
  else if (cb < P_DSAK) { d.ptr = p.qd + (cb - P_DSAQ); d.stride = 256; d.kind = ((cb & 63) == 0) ? 1 : 0; }
  else if (cb < P_DSAV) { d.ptr = p.kd + (cb - P_DSAK); d.stride = 64; d.kind = (cb == P_DSAK) ? 1 : 0; }
  else if (cb < P_IDXQ) { d.ptr = p.vd + (cb - P_DSAV); d.stride = 64; }
  else if (cb < P_IDXK) { d.ptr = p.qi + (cb - P_IDXQ); d.stride = 256; d.kind = 2; }
  else if (cb < P_MEMQ) { d.ptr = p.ki; d.stride = 32; d.kind = 2; }
  else if (cb < P_GATE) { d.ptr = p.memq + (cb - P_MEMQ); d.stride = 256; }
  else if (cb < P_END) { d.ptr = nullptr; d.stride = 0; d.kind = 3; }
  else { d.ptr = nullptr; d.stride = 0; d.kind = 4; }
  return d;
}
__device__ __forceinline__ void inproj_phase(const Params& p, unsigned char* smem, int bid, int nblk) {
  typedef Gemm<2, 2> G;
  const int lane = threadIdx.x & 63, w = threadIdx.x >> 6, wm = w >> 1, wn = w & 1;
  const int c = lane & 31, fh = lane >> 5;
  constexpr int TN = INWP / 128, TM = NT / 128;
  for (int tile = bid; tile < TM * TN; tile += nblk) {
    f32x16 acc[2][2];
#pragma unroll
    for (int i = 0; i < 2; i++)
#pragma unroll
      for (int j = 0; j < 2; j++)
#pragma unroll
        for (int r = 0; r < 16; r++) acc[i][j][r] = 0.f;
    {
      const int m0 = (tile / TN) * 128, n0 = (tile % TN) * 128;
      const bf16_t* A = p.xb + (size_t)m0 * DM;
      const bf16_t* Bt = p.wint + (size_t)n0 * DM;
      G::mainloop(acc, [&](int r) { return A + (size_t)r * DM; }, [&](int r) { return Bt + (size_t)r * DM; }, DM, smem);
      const int b = m0 / SEQ;
      unsigned char* wt = smem + w * 9216;
      const TileDest d0 = inproj_dest(p, n0 + (wn * 2 + 0) * 32, b);
      const TileDest d1 = inproj_dest(p, n0 + (wn * 2 + 1) * 32, b);
#pragma unroll
      for (int j = 0; j < 2; j++) {
        const TileDest d = j ? d1 : d0;
        if (d.kind == 4) continue;
        if (d.kind == 5) {
#pragma unroll
          for (int i = 0; i < 2; i++)
#pragma unroll
            for (int g4 = 0; g4 < 4; g4++) {
              const int tloc = (m0 & (SEQ - 1)) + (wm * 2 + i) * 32 + 8 * g4 + 4 * fh;
              uint2 o = {pack2bf(acc[i][j][4 * g4 + 0], acc[i][j][4 * g4 + 1]), pack2bf(acc[i][j][4 * g4 + 2], acc[i][j][4 * g4 + 3])};
              *(uint2*)(d.ptr + (size_t)c * SEQ + perm16(tloc)) = o;
            }
          continue;
        }
        if (d.kind == 3) {
#pragma unroll
          for (int i = 0; i < 2; i++)
#pragma unroll
            for (int r = 0; r < 16; r++) {
              const int tok = m0 + (wm * 2 + i) * 32 + (r & 3) + 8 * (r >> 2) + 4 * fh;
              const float v = acc[i][j][r];
              if (c < 24) p.gates[(size_t)tok * 24 + c] = 1.f / (1.f + __expf(-v));
              else p.widx[(size_t)tok * 8 + (c - 24)] = v * 0.0625f;
            }
          continue;
        }
#pragma unroll
        for (int i = 0; i < 2; i++) {
#pragma unroll
          for (int r = 0; r < 16; r++) {
            const int tok = m0 + (wm * 2 + i) * 32 + (r & 3) + 8 * (r >> 2) + 4 * fh;
            float v = acc[i][j][r];
            if (d.kind == 1) {
              const float pv = __shfl_xor(v, 8);
              if (c < 16) {
                const float2 cs = p.cs[(size_t)tok * 8 + (c & 7)];
                v = (c & 8) ? (v * cs.x + pv * cs.y) : (v * cs.x - pv * cs.y);
              }
            } else if (d.kind == 2) {
              const float pv = __shfl_xor(v, 4);
              if (c < 8) {
                const float2 cs = p.cs[(size_t)tok * 8 + 2 * (c & 3)];
                v = (c & 4) ? (v * cs.x + pv * cs.y) : (v * cs.x - pv * cs.y);
              }
            }
            acc[i][j][r] = v;
          }
#pragma unroll
          for (int r = 0; r < 16; r += 2) {
            const float va = acc[i][j][r], vb = acc[i][j][r + 1];
            const float na = __builtin_bit_cast(float, __builtin_amdgcn_update_dpp(0, __builtin_bit_cast(int, va), 0xB1, 0xF, 0xF, true));
            const float nb = __builtin_bit_cast(float, __builtin_amdgcn_update_dpp(0, __builtin_bit_cast(int, vb), 0xB1, 0xF, 0xF, true));
            const bool odd = c & 1;
            const unsigned pk = pack2bf(odd ? nb : va, odd ? vb : na);
            const int row = i * 32 + (r & 3) + 8 * (r >> 2) + 4 * fh + (odd ? 1 : 0);
            *(unsigned*)(wt + row * 144 + j * 64 + (c & ~1) * 2) = pk;
          }
        }
      }
      __builtin_amdgcn_wave_barrier();
      {
        const int chunk = lane & 7, jt = chunk >> 2;
        const TileDest d = jt ? d1 : d0;
        if (d.kind <= 2) {
#pragma unroll
          for (int it = 0; it < 8; it++) {
            const int row = it * 8 + (lane >> 3);
            const uint4 v = *(const uint4*)(wt + row * 144 + chunk * 16);
            const int tok = m0 + wm * 64 + row;
            *(uint4*)(d.ptr + (size_t)tok * d.stride + (chunk & 3) * 8) = v;
          }
        }
      }
      __syncthreads();
    }
  }
}

__device__ __forceinline__ void memkv_phase(const Params& p, unsigned char* smem, int bid, int nblk) {
  typedef Gemm<2, 2> G;
  const int lane = threadIdx.x & 63, w = threadIdx.x >> 6, wm = w >> 1, wn = w & 1;
  const int c = lane & 31, fh = lane >> 5;
  constexpr int TN2 = 512 / 128, TM2 = NB * MEML / 128;
  for (int t2 = bid; t2 < TM2 * TN2; t2 += nblk) {
    f32x16 acc[2][2];
#pragma unroll
    for (int i = 0; i < 2; i++)
#pragma unroll
      for (int j = 0; j < 2; j++)
#pragma unroll
        for (int r = 0; r < 16; r++) acc[i][j][r] = 0.f;
    {
      const int m0 = (t2 / TN2) * 128, n0 = (t2 % TN2) * 128;
      const bf16_t* A = p.memb + (size_t)m0 * DM;
      const bf16_t* Bt = p.wmemt + (size_t)n0 * DM;
      G::mainloop(acc, [&](int r) { return A + (size_t)r * DM; }, [&](int r) { return Bt + (size_t)r * DM; }, DM, smem);
#pragma unroll
      for (int i = 0; i < 2; i++)
#pragma unroll
        for (int j = 0; j < 2; j++)
          {
            const int cb = n0 + (wn * 2 + j) * 32;
            if (cb < 256) {
#pragma unroll
              for (int r = 0; r < 16; r++) {
                const int row = m0 + (wm * 2 + i) * 32 + (r & 3) + 8 * (r >> 2) + 4 * fh;
                p.mkv[(size_t)row * 512 + cb + c] = f2bf(acc[i][j][r]);
              }
            } else {
              const int dfull = cb + c - 256, head = dfull >> 6, d = dfull & 63;
              const int rowb = m0 + (wm * 2 + i) * 32, b = rowb >> 8, ml = rowb & 255;
              bf16_t* vrow = p.memvt + ((size_t)(b * 4 + head) * 64 + d) * MEML;
#pragma unroll
              for (int g4 = 0; g4 < 4; g4++) {
                uint2 o = {pack2bf(acc[i][j][4 * g4 + 0], acc[i][j][4 * g4 + 1]), pack2bf(acc[i][j][4 * g4 + 2], acc[i][j][4 * g4 + 3])};
                *(uint2*)(vrow + perm16(ml + 8 * g4 + 4 * fh)) = o;
              }
            }
          }
    }
  }
}

__device__ __forceinline__ unsigned f2key(float f) {
  unsigned u = __float_as_uint(f);
  return (u & 0x80000000u) ? ~u : (u | 0x80000000u);
}
__device__ __forceinline__ float key2f(unsigned k) {
  return __uint_as_float((k & 0x80000000u) ? (k ^ 0x80000000u) : ~k);
}
#define CE_DESC(a, b) { const unsigned _h = max(a, b); const unsigned _l = min(a, b); a = _h; b = _l; }
__device__ __forceinline__ void bitonic_merge16(unsigned (&m)[16]) {
#pragma unroll
  for (int st = 8; st >= 1; st >>= 1)
#pragma unroll
    for (int k = 0; k < 16; k++)
      if ((k & st) == 0) CE_DESC(m[k], m[k + st]);
}
__device__ __forceinline__ void insert16(unsigned (&L)[16], unsigned x) {
#pragma unroll
  for (int k = 0; k < 16; k++) { const unsigned hi = max(L[k], x); x = min(L[k], x); L[k] = hi; }
}
__device__ __forceinline__ void merge4_lists(unsigned (&L)[16], unsigned* lists, int t, int q) {
#pragma unroll
  for (int k = 0; k < 16; k++) lists[(q * 16 + k) * 64 + t] = L[k];
  __syncthreads();
  if (q < 2) {
#pragma unroll
    for (int k = 0; k < 16; k++) L[k] = max(lists[((2 * q) * 16 + k) * 64 + t], lists[((2 * q + 1) * 16 + 15 - k) * 64 + t]);
    bitonic_merge16(L);
#pragma unroll
    for (int k = 0; k < 16; k++) lists[((2 * q) * 16 + k) * 64 + t] = L[k];
  }
  __syncthreads();
  if (q == 0) {
#pragma unroll
    for (int k = 0; k < 16; k++) L[k] = max(L[k], lists[(2 * 16 + 15 - k) * 64 + t]);
    bitonic_merge16(L);
  }
}
__device__ __forceinline__ float dpp_rowsum(float x) {
  x += __builtin_bit_cast(float, __builtin_amdgcn_update_dpp(0, __builtin_bit_cast(int, x), 0xB1, 0xF, 0xF, true));
  x += __builtin_bit_cast(float, __builtin_amdgcn_update_dpp(0, __builtin_bit_cast(int, x), 0x4E, 0xF, 0xF, true));
  x += __builtin_bit_cast(float, __builtin_amdgcn_update_dpp(0, __builtin_bit_cast(int, x), 0x141, 0xF, 0xF, true));
  x += __builtin_bit_cast(float, __builtin_amdgcn_update_dpp(0, __builtin_bit_cast(int, x), 0x140, 0xF, 0xF, true));
  return x;
}
__device__ __forceinline__ float readlane_f(float v, int l) {
  return __int_as_float(__builtin_amdgcn_readlane(__float_as_int(v), l));
}
__device__ __forceinline__ float wave_sum_uniform(float x) {
  x = dpp_rowsum(x);
  return (readlane_f(x, 0) + readlane_f(x, 16)) + (readlane_f(x, 32) + readlane_f(x, 48));
}
__device__ __forceinline__ float dot8_bf16(const uint4& a, const uint4& b, float acc) {
  acc = __builtin_amdgcn_fdot2_f32_bf16(__builtin_bit_cast(bf16x2, a.x), __builtin_bit_cast(bf16x2, b.x), acc, false);
  acc = __builtin_amdgcn_fdot2_f32_bf16(__builtin_bit_cast(bf16x2, a.y), __builtin_bit_cast(bf16x2, b.y), acc, false);
  acc = __builtin_amdgcn_fdot2_f32_bf16(__builtin_bit_cast(bf16x2, a.z), __builtin_bit_cast(bf16x2, b.z), acc, false);
  acc = __builtin_amdgcn_fdot2_f32_bf16(__builtin_bit_cast(bf16x2, a.w), __builtin_bit_cast(bf16x2, b.w), acc, false);
  return acc;
}
__device__ __forceinline__ void fma8_bf16(float (&y)[8], const uint4& v, float w) {
  y[0] = fmaf(w, __uint_as_float(v.x << 16), y[0]); y[1] = fmaf(w, __uint_as_float(v.x & 0xFFFF0000u), y[1]);
  y[2] = fmaf(w, __uint_as_float(v.y << 16), y[2]); y[3] = fmaf(w, __uint_as_float(v.y & 0xFFFF0000u), y[3]);
  y[4] = fmaf(w, __uint_as_float(v.z << 16), y[4]); y[5] = fmaf(w, __uint_as_float(v.z & 0xFFFF0000u), y[5]);
  y[6] = fmaf(w, __uint_as_float(v.w << 16), y[6]); y[7] = fmaf(w, __uint_as_float(v.w & 0xFFFF0000u), y[7]);
}
__device__ const unsigned char cand_tab[52] = {
  0x00,0x01,0x02,0x03,0x04,0x05,0x06,0x07,0x08,0x09,0x0A,0x0B,0x0C,0x0D,0x0E,0x0F,
  0x10,0x11,0x12,0x13,0x14,0x15,0x16,0x17,
  0x20,0x21,0x22,0x23,0x24,
  0x30,0x31,0x32,0x33,
  0x40,0x41,0x42,
  0x50,0x51, 0x60,0x61, 0x70,0x71,
  0x80,0x90,0xA0,0xB0,0xC0,0xD0,0xE0,0xF0, 0xF0,0xF0};

typedef __attribute__((ext_vector_type(2))) _Float16 f16x2;
__device__ __forceinline__ f16x2 bytes01_h2(unsigned w) { return __builtin_bit_cast(f16x2, __builtin_amdgcn_perm(w, 0x64646464u, 0x00050004u)); }
__device__ __forceinline__ f16x2 bytes23_h2(unsigned w) { return __builtin_bit_cast(f16x2, __builtin_amdgcn_perm(w, 0x64646464u, 0x00070006u)); }
constexpr int PE_EXPERT_DEPTH = 8;

__device__ __forceinline__ void peer_block_phase(const Params& p, unsigned char* smem, int bid, int nblk) {
  const int tid = threadIdx.x, lane = tid & 63, w = tid >> 6, wm = w >> 1, wn = w & 1;
  const int c = lane & 31, fh = lane >> 5;
  float* S = (float*)smem;
  unsigned* lists = (unsigned*)(smem + 32768);
  unsigned* ablist = (unsigned*)(smem + 49152);
  int* fin_e = (int*)(smem + 57344);
  float* fin_g = (float*)(smem + 57344 + 4096);
  for (int blk = bid; blk < NT / 64; blk += nblk) {
    const int t0 = blk * 64;
#pragma unroll 1
    for (int nt = 0; nt < 8; nt++) {
      f32x16 acc[1][2];
#pragma unroll
      for (int j = 0; j < 2; j++)
#pragma unroll
        for (int r = 0; r < 16; r++) acc[0][j][r] = 0.f;
      const bf16_t* A = p.concat + (size_t)t0 * DM;
      const bf16_t* Bt = p.woutt + (size_t)nt * 128 * DM;
      Gemm<1, 2>::mainloop(acc, [&](int r) { return A + (size_t)r * DM; }, [&](int r) { return Bt + (size_t)r * DM; }, DM, smem);
      {
        const unsigned ebase = (unsigned)(t0 + wm * 32 + 4 * fh) * DM + nt * 128 + wn * 64 + c;
#pragma unroll
        for (int j = 0; j < 2; j++) {
#pragma unroll
          for (int r = 0; r < 16; r++) {
            const unsigned idx = ebase + (unsigned)(((r & 3) + 8 * (r >> 2)) * DM + j * 32);
            p.out[idx] = acc[0][j][r] + ALPHA * p.x[idx];
          }
          asm volatile("" ::: "memory");
        }
      }
    }
    __syncthreads();
#pragma unroll 1
    for (int rr = 0; rr < 16; rr++) {
      const int tok = t0 + w * 16 + rr;
      float* row = p.out + (size_t)tok * DM;
      float v[16];
      {
        const float4 a0 = *(const float4*)(row + 8 * lane), a1 = *(const float4*)(row + 8 * lane + 4);
        const float4 a2 = *(const float4*)(row + 512 + 8 * lane), a3 = *(const float4*)(row + 512 + 8 * lane + 4);
        v[0] = a0.x; v[1] = a0.y; v[2] = a0.z; v[3] = a0.w; v[4] = a1.x; v[5] = a1.y; v[6] = a1.z; v[7] = a1.w;
        v[8] = a2.x; v[9] = a2.y; v[10] = a2.z; v[11] = a2.w; v[12] = a3.x; v[13] = a3.y; v[14] = a3.z; v[15] = a3.w;
      }
      float s = 0.f;
#pragma unroll
      for (int i = 0; i < 16; i++) s += v[i];
      const float mu = wave_sum(s) * (1.f / DM);
      float qv = 0.f;
#pragma unroll
      for (int i = 0; i < 16; i++) { v[i] -= mu; qv += v[i] * v[i]; }
      const float rs = rsqrtf(wave_sum(qv) * (1.f / DM) + 1e-5f);
#pragma unroll
      for (int hf = 0; hf < 2; hf++) {
        const int e0 = hf * 512 + 8 * lane;
        const float4 g0 = *(const float4*)(p.ln1g + e0), g1 = *(const float4*)(p.ln1g + e0 + 4);
        const float4 b0 = *(const float4*)(p.ln1b + e0), b1 = *(const float4*)(p.ln1b + e0 + 4);
        float o[8];
        o[0] = v[hf * 8 + 0] * rs * g0.x + b0.x; o[1] = v[hf * 8 + 1] * rs * g0.y + b0.y;
        o[2] = v[hf * 8 + 2] * rs * g0.z + b0.z; o[3] = v[hf * 8 + 3] * rs * g0.w + b0.w;
        o[4] = v[hf * 8 + 4] * rs * g1.x + b1.x; o[5] = v[hf * 8 + 5] * rs * g1.y + b1.y;
        o[6] = v[hf * 8 + 6] * rs * g1.z + b1.z; o[7] = v[hf * 8 + 7] * rs * g1.w + b1.w;
        *(float4*)(row + e0) = make_float4(o[0], o[1], o[2], o[3]);
        *(float4*)(row + e0 + 4) = make_float4(o[4], o[5], o[6], o[7]);
        uint4 pk = {pack2bf(o[0], o[1]), pack2bf(o[2], o[3]), pack2bf(o[4], o[5]), pack2bf(o[6], o[7])};
        *(uint4*)(p.x1b + (size_t)tok * DM + e0) = pk;
      }
    }
    __syncthreads();
    const int ts = tid & 63, qs = tid >> 6;
#pragma unroll 1
    for (int hh = 0; hh < 8; hh++) {
#pragma unroll 1
      for (int half = 0; half < 2; half++) {
        f32x16 acc[2][1];
#pragma unroll
        for (int i = 0; i < 2; i++)
#pragma unroll
          for (int r = 0; r < 16; r++) acc[i][0][r] = 0.f;
        const bf16_t* A = p.wqt + (size_t)(hh * 256 + half * 128) * DM;
        const bf16_t* Bt = p.x1b + (size_t)t0 * DM;
        Gemm<2, 1>::mainloop(acc, [&](int r) { return A + (size_t)r * DM; }, [&](int r) { return Bt + (size_t)r * DM; }, DM, smem);
        f32x16 sp[4];
#pragma unroll
        for (int nn = 0; nn < 4; nn++)
#pragma unroll
          for (int r = 0; r < 16; r++) sp[nn][r] = 0.f;
        const bf16_t* skp = half ? p.sk2p : p.sk1p;
#pragma unroll
        for (int i = 0; i < 2; i++)
#pragma unroll
          for (int s = 0; s < 2; s++) {
            uint4 qb = {pack2bf(acc[i][0][8 * s + 0], acc[i][0][8 * s + 1]), pack2bf(acc[i][0][8 * s + 2], acc[i][0][8 * s + 3]),
                        pack2bf(acc[i][0][8 * s + 4], acc[i][0][8 * s + 5]), pack2bf(acc[i][0][8 * s + 6], acc[i][0][8 * s + 7])};
            const bf16x8 qf = __builtin_bit_cast(bf16x8, qb);
#pragma unroll
            for (int nn = 0; nn < 4; nn++) {
              const bf16x8 kf = *(const bf16x8*)(skp + (size_t)(nn * 32 + c) * 128 + wm * 64 + i * 32 + s * 16 + fh * 8);
              sp[nn] = __builtin_amdgcn_mfma_f32_32x32x16_bf16(kf, qf, sp[nn], 0, 0, 0);
            }
          }
        if (wm == 0) {
#pragma unroll
          for (int nn = 0; nn < 4; nn++)
#pragma unroll
            for (int r = 0; r < 16; r++) S[(nn * 32 + (r & 3) + 8 * (r >> 2) + 4 * fh) * 64 + wn * 32 + c] = sp[nn][r];
        }
        __syncthreads();
        if (wm == 1) {
#pragma unroll
          for (int nn = 0; nn < 4; nn++)
#pragma unroll
            for (int r = 0; r < 16; r++) S[(nn * 32 + (r & 3) + 8 * (r >> 2) + 4 * fh) * 64 + wn * 32 + c] += sp[nn][r];
        }
        __syncthreads();
        unsigned L[16];
#pragma unroll
        for (int k = 0; k < 16; k++) L[k] = 0u;
#pragma unroll 4
        for (int i = 0; i < 32; i++) {
          const int n = qs * 32 + i;
          insert16(L, (f2key(S[n * 64 + ts]) & ~127u) | (unsigned)n);
        }
        merge4_lists(L, lists, ts, qs);
        if (qs == 0) {
#pragma unroll
          for (int k = 0; k < 16; k++) ablist[(half * 16 + k) * 64 + ts] = L[k];
        }
        __syncthreads();
      }
      {
        unsigned L[16];
#pragma unroll
        for (int k = 0; k < 16; k++) L[k] = 0u;
#pragma unroll 1
        for (int cc = qs; cc < 50; cc += 4) {
          const unsigned code = cand_tab[cc];
          const float sum = key2f(ablist[(code >> 4) * 64 + ts]) + key2f(ablist[(16 + (code & 15)) * 64 + ts]);
          insert16(L, (f2key(sum) & ~255u) | code);
        }
        merge4_lists(L, lists, ts, qs);
        if (qs == 0) {
          const float mx = key2f(L[0]);
          float e[16], sum = 0.f;
#pragma unroll
          for (int k = 0; k < 16; k++) { e[k] = __expf(key2f(L[k]) - mx); sum += e[k]; }
          const float inv = 1.f / sum;
#pragma unroll
          for (int k = 0; k < 16; k++) {
            const unsigned code = L[k] & 255u;
            const unsigned ia = ablist[(code >> 4) * 64 + ts] & 127u, ib = ablist[(16 + (code & 15)) * 64 + ts] & 127u;
            fin_e[ts * 16 + k] = (int)(ia * 128u + ib);
            fin_g[ts * 16 + k] = e[k] * inv;
          }
        }
        __syncthreads();
        {
          const int tt = tid >> 2, k4 = (tid & 3) * 4;
          *(int4*)(p.pexp + (size_t)(t0 + tt) * 128 + hh * 16 + k4) = *(const int4*)(fin_e + tt * 16 + k4);
          *(float4*)(p.pgate + (size_t)(t0 + tt) * 128 + hh * 16 + k4) = *(const float4*)(fin_g + tt * 16 + k4);
        }
        __syncthreads();
      }
    }
#pragma unroll 1
    for (int rr = 0; rr < 16; rr++) {
      const int tok = t0 + w * 16 + rr;
      const int id0 = p.pexp[(size_t)tok * 128 + lane], id1 = p.pexp[(size_t)tok * 128 + 64 + lane];
      const float g0 = p.pgate[(size_t)tok * 128 + lane], g1 = p.pgate[(size_t)tok * 128 + 64 + lane];
      float* row = p.out + (size_t)tok * DM + 16 * lane;
      float xv[16];
      {
        const float4 r0 = *(const float4*)(row), r1 = *(const float4*)(row + 4), r2 = *(const float4*)(row + 8), r3 = *(const float4*)(row + 12);
        xv[0] = r0.x; xv[1] = r0.y; xv[2] = r0.z; xv[3] = r0.w; xv[4] = r1.x; xv[5] = r1.y; xv[6] = r1.z; xv[7] = r1.w;
        xv[8] = r2.x; xv[9] = r2.y; xv[10] = r2.z; xv[11] = r2.w; xv[12] = r3.x; xv[13] = r3.y; xv[14] = r3.z; xv[15] = r3.w;
      }
      f16x2 xh[8];
      float xs = 0.f;
#pragma unroll
      for (int i = 0; i < 8; i++) {
        xh[i] = f16x2{(_Float16)xv[2 * i], (_Float16)xv[2 * i + 1]};
        xs += (float)xh[i][0] + (float)xh[i][1];
      }
      const float xsum128 = 1152.f * wave_sum_uniform(xs);
      const float su0 = p.psu[id0], su1 = p.psu[id1];
      float a0 = 0.f, a1 = 0.f;
      {
        uint4 bu[PE_EXPERT_DEPTH];
#pragma unroll
        for (int d = 0; d < PE_EXPERT_DEPTH; d++) {
          const int id = __builtin_amdgcn_readlane(id0, d);
          bu[d] = *(const uint4*)(p.puq + (size_t)id * DM + 16 * lane);
        }
#pragma unroll 1
        for (int e0 = 0; e0 < 128; e0 += PE_EXPERT_DEPTH) {
#pragma unroll
          for (int d = 0; d < PE_EXPERT_DEPTH; d++) {
            const int e = e0 + d;
            const float sce = readlane_f((e & 64) ? su1 : su0, e & 63);
            const unsigned qw[4] = {bu[d].x, bu[d].y, bu[d].z, bu[d].w};
            float s0 = 0.f, s1 = 0.f;
#pragma unroll
            for (int i = 0; i < 4; i++) {
              s0 = __builtin_amdgcn_fdot2(bytes01_h2(qw[i]), xh[2 * i], s0, false);
              s1 = __builtin_amdgcn_fdot2(bytes23_h2(qw[i]), xh[2 * i + 1], s1, false);
            }
            float s = s0 + s1;
            if (e + PE_EXPERT_DEPTH < 128) {
              const int en = e + PE_EXPERT_DEPTH;
              const int id = __builtin_amdgcn_readlane((en & 64) ? id1 : id0, en & 63);
              bu[d] = *(const uint4*)(p.puq + (size_t)id * DM + 16 * lane);
            }
            s = (wave_sum_uniform(s) - xsum128) * sce;
            a0 = ((e & 64) == 0 && lane == (e & 63)) ? s : a0;
            a1 = ((e & 64) != 0 && lane == (e & 63)) ? s : a1;
          }
        }
      }
      const float w0 = g0 * gelu_exact(a0) * p.psv[id0], w1 = g1 * gelu_exact(a1) * p.psv[id1];
      const float csum128 = 1152.f * wave_sum_uniform(w0 + w1);
      float y[16];
#pragma unroll
      for (int i = 0; i < 16; i++) y[i] = 0.f;
      {
        uint4 bv[PE_EXPERT_DEPTH];
#pragma unroll
        for (int d = 0; d < PE_EXPERT_DEPTH; d++) {
          const int id = __builtin_amdgcn_readlane(id0, d);
          bv[d] = *(const uint4*)(p.pvq + (size_t)id * DM + 16 * lane);
        }
#pragma unroll 1
        for (int e0 = 0; e0 < 128; e0 += PE_EXPERT_DEPTH) {
#pragma unroll
          for (int d = 0; d < PE_EXPERT_DEPTH; d++) {
            const int e = e0 + d;
            const float wgt = readlane_f((e & 64) ? w1 : w0, e & 63);
            const unsigned qw[4] = {bv[d].x, bv[d].y, bv[d].z, bv[d].w};
#pragma unroll
            for (int i = 0; i < 4; i++) {
              const f16x2 h01 = bytes01_h2(qw[i]), h23 = bytes23_h2(qw[i]);
              y[4 * i + 0] = fmaf(wgt, (float)h01[0], y[4 * i + 0]);
              y[4 * i + 1] = fmaf(wgt, (float)h01[1], y[4 * i + 1]);
              y[4 * i + 2] = fmaf(wgt, (float)h23[0], y[4 * i + 2]);
              y[4 * i + 3] = fmaf(wgt, (float)h23[1], y[4 * i + 3]);
            }
            if (e + PE_EXPERT_DEPTH < 128) {
              const int en = e + PE_EXPERT_DEPTH;
              const int id = __builtin_amdgcn_readlane((en & 64) ? id1 : id0, en & 63);
              bv[d] = *(const uint4*)(p.pvq + (size_t)id * DM + 16 * lane);
            }
          }
        }
      }
      float v[16];
#pragma unroll
      for (int i = 0; i < 16; i++) v[i] = ALPHA * xv[i] + (y[i] - csum128);
      float s = 0.f;
#pragma unroll
      for (int i = 0; i < 16; i++) s += v[i];
      const float mu = wave_sum(s) * (1.f / DM);
      float qv = 0.f;
#pragma unroll
      for (int i = 0; i < 16; i++) { v[i] -= mu; qv += v[i] * v[i]; }
      const float rs = rsqrtf(wave_sum(qv) * (1.f / DM) + 1e-5f);
#pragma unroll
      for (int i4 = 0; i4 < 4; i4++) {
        const float4 gg = *(const float4*)(p.ln2g + 16 * lane + 4 * i4), bb = *(const float4*)(p.ln2b + 16 * lane + 4 * i4);
        *(float4*)(row + 4 * i4) = make_float4(v[4 * i4 + 0] * rs * gg.x + bb.x, v[4 * i4 + 1] * rs * gg.y + bb.y,
                                               v[4 * i4 + 2] * rs * gg.z + bb.z, v[4 * i4 + 3] * rs * gg.w + bb.w);
      }
    }
    __syncthreads();
  }
}

__device__ __forceinline__ void cbias_phase(const Params& p, int bid, int nblk) {
  const int which = threadIdx.x >> 7, j = threadIdx.x & 127;
  const float* w1 = which ? p.w1v : p.w1k;
  const float* pe = which ? p.pe_v : p.pe_k;
  for (int ch = bid; ch < 64; ch += nblk) {
    float a = 0.f;
#pragma unroll 8
    for (int r = ch * 32; r < ch * 32 + 32; r++) a = fmaf(pe[r], w1[(size_t)r * 128 + j], a);
    p.cbias[ch * 256 + which * 128 + j] = a;
  }
}
__device__ __forceinline__ void compress_phase(const Params& p, unsigned char* smem, int bid, int nblk) {
  typedef Gemm<1, 2> G;
  const int tid = threadIdx.x, lane = tid & 63, w = tid >> 6, wm = w >> 1, wn = w & 1, c = lane & 31, fh = lane >> 5;
  float* hid = (float*)smem;
  float* cb = (float*)(smem + 49152);
  if (bid < NB * 2 * 2 * 4) {
    float a = 0.f;
    for (int ch = 0; ch < 64; ch++) a += p.cbias[ch * 256 + tid];
    cb[tid] = a;
  }
  __syncthreads();
  for (int item = bid; item < NB * 2 * 2 * 4; item += nblk) {
    const int mt = item & 3, which = (item >> 2) & 1, bgi = item >> 3;
    const int m0 = mt * 64;
    const bf16_t* A = (which ? p.kvn[1] : p.kvn[0]) + (size_t)bgi * SEQ * 64;
    const bf16_t* Bt = which ? p.w1vt : p.w1kt;
    f32x16 acc[1][2];
#pragma unroll
    for (int j = 0; j < 2; j++)
#pragma unroll
      for (int r = 0; r < 16; r++) acc[0][j][r] = 0.f;
    G::mainloop(acc, [&](int r) { const int i = min(m0 + r, NC - 1); return A + (size_t)i * 1024; },
                [&](int r) { return Bt + (size_t)r * 2048; }, 2048, smem);
#pragma unroll
    for (int j = 0; j < 2; j++)
#pragma unroll
      for (int r = 0; r < 16; r++) {
        const int row = wm * 32 + (r & 3) + 8 * (r >> 2) + 4 * fh, col = (wn * 2 + j) * 32 + c;
        hid[row * 129 + col] = gelu_exact(acc[0][j][r] + cb[which * 128 + col]);
      }
    __syncthreads();
    {
      const int row = tid >> 2, dq = (tid & 3) * 16;
      const float* w2 = which ? p.w2v : p.w2k;
      float o[16];
#pragma unroll
      for (int i = 0; i < 16; i++) o[i] = 0.f;
      for (int k = 0; k < 128; k++) {
        const float h = hid[row * 129 + k];
        const float4 w0 = *(const float4*)(w2 + k * 64 + dq), w1_ = *(const float4*)(w2 + k * 64 + dq + 4);
        const float4 w2_ = *(const float4*)(w2 + k * 64 + dq + 8), w3 = *(const float4*)(w2 + k * 64 + dq + 12);
        o[0] = fmaf(h, w0.x, o[0]); o[1] = fmaf(h, w0.y, o[1]); o[2] = fmaf(h, w0.z, o[2]); o[3] = fmaf(h, w0.w, o[3]);
        o[4] = fmaf(h, w1_.x, o[4]); o[5] = fmaf(h, w1_.y, o[5]); o[6] = fmaf(h, w1_.z, o[6]); o[7] = fmaf(h, w1_.w, o[7]);
        o[8] = fmaf(h, w2_.x, o[8]); o[9] = fmaf(h, w2_.y, o[9]); o[10] = fmaf(h, w2_.z, o[10]); o[11] = fmaf(h, w2_.w, o[11]);
        o[12] = fmaf(h, w3.x, o[12]); o[13] = fmaf(h, w3.y, o[13]); o[14] = fmaf(h, w3.z, o[14]); o[15] = fmaf(h, w3.w, o[15]);
      }
      const int i = m0 + row;
      const bool valid = i < NC;
      if (which == 0) {
        bf16_t* dst = p.kcb + ((size_t)bgi * 256 + i) * 64 + dq;
        uint4 u0 = {pack2bf(o[0], o[1]), pack2bf(o[2], o[3]), pack2bf(o[4], o[5]), pack2bf(o[6], o[7])};
        uint4 u1 = {pack2bf(o[8], o[9]), pack2bf(o[10], o[11]), pack2bf(o[12], o[13]), pack2bf(o[14], o[15])};
        if (!valid) { u0 = make_uint4(0, 0, 0, 0); u1 = u0; }
        *(uint4*)dst = u0; *(uint4*)(dst + 8) = u1;
      } else {
#pragma unroll
        for (int e = 0; e < 16; e++) p.vct[((size_t)bgi * 64 + dq + e) * 256 + perm16(i)] = valid ? f2bf(o[e]) : (bf16_t)0;
      }
    }
    __syncthreads();
  }
}

__device__ __forceinline__ void softmax4(float* sc, int ld, int n) {
  const int w = threadIdx.x >> 6, lane = threadIdx.x & 63;
  float* s = sc + w * ld;
  float m = -INFINITY;
  for (int i = lane; i < n; i += 64) m = fmaxf(m, s[i]);
  m = wave_max(m);
  if (m == -INFINITY) m = 0.f;
  float sum = 0.f;
  for (int i = lane; i < n; i += 64) { float e = expf(s[i] - m); s[i] = e; sum += e; }
  sum = wave_sum(sum);
  const float inv = 1.f / (sum > 0.f ? sum : 1.f);
  for (int i = lane; i < n; i += 64) s[i] *= inv;
}
__device__ __forceinline__ float dot64_bf(const float* q, const bf16_t* k) {
  float s = 0.f;
#pragma unroll
  for (int e = 0; e < 64; e += 8) {
    const uint4 v = *(const uint4*)(k + e);
    const unsigned u[4] = {v.x, v.y, v.z, v.w};
#pragma unroll
    for (int i = 0; i < 4; i++) {
      s = fmaf(q[e + 2 * i], __uint_as_float(u[i] << 16), s);
      s = fmaf(q[e + 2 * i + 1], __uint_as_float(u[i] & 0xFFFF0000u), s);
    }
  }
  return s;
}

template <class KRow, class VRow, class Body>
__device__ __forceinline__ void flash_stream(unsigned char* smem, int j0, int j1, KRow krow, VRow vrow, Body body) {
  if (j0 >= j1) return;
  Tile2 rk = tile_fetch([&](int r) __attribute__((always_inline)) { return krow(j0, r); });
  Tile2 rv = tile_fetch([&](int r) __attribute__((always_inline)) { return vrow(j0, r); });
  __syncthreads();
  tile_store(rk, smem); tile_store(rv, smem + FL_TILE);
  __syncthreads();
#pragma unroll 1
  for (int j = j0; j < j1; j++) {
    unsigned char* cur = smem + ((j - j0) & 1) * FL_STAGE;
    if (j + 1 < j1) {
      rk = tile_fetch([&](int r) __attribute__((always_inline)) { return krow(j + 1, r); });
      rv = tile_fetch([&](int r) __attribute__((always_inline)) { return vrow(j + 1, r); });
    }
    body(cur, j);
    if (j + 1 < j1) { unsigned char* nxt = smem + ((j - j0 + 1) & 1) * FL_STAGE; tile_store(rk, nxt); tile_store(rv, nxt + FL_TILE); }
    __syncthreads();
  }
}
__device__ __forceinline__ float quad_sum(float x) {
  x += __builtin_bit_cast(float, __builtin_amdgcn_update_dpp(0, __builtin_bit_cast(int, x), 0xB1, 0xF, 0xF, true));
  x += __builtin_bit_cast(float, __builtin_amdgcn_update_dpp(0, __builtin_bit_cast(int, x), 0x4E, 0xF, 0xF, true));
  return x;
}
__device__ __forceinline__ void nsa_flash_item(const Params& p, unsigned char* smem, int item) {
  const int tid = threadIdx.x, lane = tid & 63, w = tid >> 6, fr = lane & 31, fh = lane >> 5;
  const int cc = item & 127, g = (item >> 7) & 1, b = item >> 8;
  const int c64 = cc >> 1;
  const int t0 = cc * 32;
  const int tl = 8 * w + (fr >> 2), hq = fr & 3;
  const int t = t0 + tl, tok = b * SEQ + t;
  const int t64 = t & 63;
  float* impS = (float*)smem;
  unsigned* selm = (unsigned*)(smem + 32 * 65 * 4);
  float* stash = (float*)(smem + 2 * FL_STAGE) + w * 2048 + lane;
  bf16x8 qf[4];
  flash_load_q(qf, p.qn + (size_t)tok * 512 + g * 256 + hq * 64, 0.125f);
  const float* gt = p.gates + (size_t)tok * 24 + (g * 4 + hq) * 3;
  const float g_cmp = gt[0], g_sel = gt[1], g_win = gt[2];
  const size_t bg = (size_t)(b * 2 + g);
  {
    const int nvmax = 2 * cc + 1, nkb = (nvmax + 63) >> 6;
    const int nvl = (t >= 31) ? ((t - 31) >> 4) + 1 : 0;
    const bf16_t* kcb = p.kcb + bg * 256 * 64;
    const bf16_t* vct = p.vct + bg * 64 * 256;
    auto krow = [&](int j, int r) __attribute__((always_inline)) { return kcb + (size_t)(j * 64 + r) * 64; };
    auto vrow = [&](int j, int r) __attribute__((always_inline)) { return vct + (size_t)r * 256 + j * 64; };
    float m = -INFINITY, l = 0.f;
    flash_stream(smem, 0, nkb, krow, vrow, [&](unsigned char* cur, int j) __attribute__((always_inline)) {
      f32x16 s[2];
      flash_qk(s, cur, qf);
      float mx = -INFINITY;
#pragma unroll
      for (int kt = 0; kt < 2; kt++)
#pragma unroll
        for (int r = 0; r < 16; r++) {
          const int n = j * 64 + kt * 32 + (r & 3) + 8 * (r >> 2) + 4 * fh;
          s[kt][r] = (n < nvl) ? s[kt][r] : -INFINITY;
          mx = fmaxf(mx, s[kt][r]);
        }
      mx = fmaxf(mx, __shfl_xor(mx, 32));
      const float mnew = fmaxf(m, mx);
      const float muse = (mnew == -INFINITY) ? 0.f : mnew;
      float sum = 0.f;
#pragma unroll
      for (int kt = 0; kt < 2; kt++)
#pragma unroll
        for (int r = 0; r < 16; r++) sum += __builtin_amdgcn_exp2f((s[kt][r] - muse) * LOG2E);
      l = l * __builtin_amdgcn_exp2f((m - muse) * LOG2E) + sum;
      m = mnew;
    });
    const float lt = l + __shfl_xor(l, 32);
    const float il = lt > 0.f ? 1.f / lt : 0.f;
    const float muse = (m == -INFINITY) ? 0.f : m;
    {
      f32x16 oc[2];
#pragma unroll
      for (int i = 0; i < 2; i++)
#pragma unroll
        for (int r = 0; r < 16; r++) oc[i][r] = 0.f;
      flash_stream(smem, 0, nkb, krow, vrow, [&](unsigned char* cur, int j) __attribute__((always_inline)) {
        f32x16 s[2];
        flash_qk(s, cur, qf);
#pragma unroll
        for (int kt = 0; kt < 2; kt++)
#pragma unroll
          for (int r = 0; r < 16; r++) {
            const int n = j * 64 + kt * 32 + (r & 3) + 8 * (r >> 2) + 4 * fh;
            s[kt][r] = (n < nvl) ? __builtin_amdgcn_exp2f((s[kt][r] - muse) * LOG2E) * il : 0.f;
          }
#pragma unroll
        for (int kt = 0; kt < 2; kt++)
#pragma unroll
          for (int h8 = 0; h8 < 2; h8++) {
            const bf16x8 pf = pack_frag(s[kt], h8);
#pragma unroll
            for (int dt = 0; dt < 2; dt++)
              oc[dt] = __builtin_amdgcn_mfma_f32_32x32x16_bf16(lds_frag(cur + FL_TILE, dt * 32 + fr, 4 * kt + 2 * h8 + fh), pf, oc[dt], 0, 0, 0);
          }
      });
#pragma unroll
      for (int dt = 0; dt < 2; dt++)
#pragma unroll
        for (int r = 0; r < 16; r++) stash[(dt * 16 + r) * 64] = g_cmp * oc[dt][r];
    }
    f32x16 imp[2];
#pragma unroll
    for (int i = 0; i < 2; i++)
#pragma unroll
      for (int r = 0; r < 16; r++) imp[i][r] = 0.f;
    flash_stream(smem, 0, nkb, krow, vrow, [&](unsigned char* cur, int j) __attribute__((always_inline)) {
      f32x16 s[2];
      flash_qk(s, cur, qf);
#pragma unroll
      for (int kt = 0; kt < 2; kt++)
#pragma unroll
        for (int r = 0; r < 16; r++) {
          const int n = j * 64 + kt * 32 + (r & 3) + 8 * (r >> 2) + 4 * fh;
          s[kt][r] = (n < nvl) ? __builtin_amdgcn_exp2f((s[kt][r] - muse) * LOG2E) * il : 0.f;
        }
#pragma unroll
      for (int kt = 0; kt < 2; kt++)
#pragma unroll
        for (int h8 = 0; h8 < 2; h8++) {
          const bf16x8 pf = pack_frag(s[kt], h8);
#pragma unroll
          for (int mt = 0; mt < 2; mt++) {
            const bf16x8 of = *(const bf16x8*)(p.ovp + (size_t)(mt * 32 + fr) * 256 + j * 64 + kt * 32 + h8 * 16 + fh * 8);
            imp[mt] = __builtin_amdgcn_mfma_f32_32x32x16_bf16(of, pf, imp[mt], 0, 0, 0);
          }
        }
    });
#pragma unroll
    for (int mt = 0; mt < 2; mt++)
#pragma unroll
      for (int r = 0; r < 16; r++) imp[mt][r] = quad_sum(imp[mt][r]);
#pragma unroll
    for (int mt = 0; mt < 2; mt++)
#pragma unroll
      for (int g4 = 0; g4 < 4; g4++) {
        const float v = (hq == 0) ? imp[mt][4 * g4 + 0] : (hq == 1) ? imp[mt][4 * g4 + 1] : (hq == 2) ? imp[mt][4 * g4 + 2] : imp[mt][4 * g4 + 3];
        impS[tl * 65 + mt * 32 + hq + 8 * g4 + 4 * fh] = v;
      }
    __syncthreads();
    {
      const int tk = tid >> 3, part = tid & 7;
      const float* row = impS + tk * 65;
      unsigned bits = 0;
#pragma unroll 1
      for (int i = 0; i < 8; i++) {
        const int mb = part * 8 + i;
        const bool vis = mb <= c64;
        const bool forced = (mb == 0) || (mb == c64) || (mb == c64 - 1);
        const float sm = vis ? row[mb] + (forced ? 1e4f : 0.f) : -INFINITY;
        int rank = 0;
        for (int m2 = 0; m2 < 64; m2++) {
          const bool vis2 = m2 <= c64;
          const bool f2 = (m2 == 0) || (m2 == c64) || (m2 == c64 - 1);
          const float s2 = vis2 ? row[m2] + (f2 ? 1e4f : 0.f) : -INFINITY;
          rank += (s2 > sm) || (s2 == sm && m2 < mb);
        }
        if (rank < 16 && vis) bits |= 1u << i;
      }
      unsigned lo = (part < 4) ? (bits << (8 * part)) : 0u, hi = (part >= 4) ? (bits << (8 * (part - 4))) : 0u;
      lo |= __shfl_xor(lo, 1); hi |= __shfl_xor(hi, 1);
      lo |= __shfl_xor(lo, 2); hi |= __shfl_xor(hi, 2);
      lo |= __shfl_xor(lo, 4); hi |= __shfl_xor(hi, 4);
      if (part == 0) { selm[tk * 2] = lo; selm[tk * 2 + 1] = hi; }
    }
    __syncthreads();
  }
  const unsigned sel_lo = selm[tl * 2], sel_hi = selm[tl * 2 + 1];
  {
    const bf16_t* kb_ = p.kvn[2] + bg * SEQ * 64;
    const bf16_t* vt_ = p.vslct + bg * 64 * SEQ;
    FlashAcc acc; flash_init(acc);
    flash_stream(smem, 0, c64 + 1,
      [&](int j, int r) __attribute__((always_inline)) { return kb_ + (size_t)(j * 64 + r) * 64; },
      [&](int j, int r) __attribute__((always_inline)) { return vt_ + (size_t)r * SEQ + j * 64; },
      [&](unsigned char* cur, int j) __attribute__((always_inline)) {
        f32x16 s[2];
        flash_qk(s, cur, qf);
        const bool selj = ((j < 32) ? (sel_lo >> j) : (sel_hi >> (j - 32))) & 1u;
        if (j == c64) {
#pragma unroll
          for (int kt = 0; kt < 2; kt++)
#pragma unroll
            for (int r = 0; r < 16; r++) {
              const int kl = kt * 32 + (r & 3) + 8 * (r >> 2) + 4 * fh;
              s[kt][r] = (kl <= t64) ? s[kt][r] : -INFINITY;
            }
        }
        flash_update(acc, s, cur + FL_TILE, selj);
      });
    const float sc_ = g_sel * flash_inv_l(acc);
#pragma unroll
    for (int dt = 0; dt < 2; dt++)
#pragma unroll
      for (int r = 0; r < 16; r++) stash[(dt * 16 + r) * 64] += sc_ * acc.o[dt][r];
  }
  {
    const bf16_t* kb_ = p.kvn[4] + bg * SEQ * 64;
    const bf16_t* vt_ = p.vwint + bg * 64 * SEQ;
    FlashAcc acc; flash_init(acc);
    const int jlo = c64 - 8;
    flash_stream(smem, jlo < 0 ? 0 : jlo, c64 + 1,
      [&](int j, int r) __attribute__((always_inline)) { return kb_ + (size_t)(j * 64 + r) * 64; },
      [&](int j, int r) __attribute__((always_inline)) { return vt_ + (size_t)r * SEQ + j * 64; },
      [&](unsigned char* cur, int j) __attribute__((always_inline)) {
        f32x16 s[2];
        flash_qk(s, cur, qf);
        if (j == c64) {
#pragma unroll
          for (int kt = 0; kt < 2; kt++)
#pragma unroll
            for (int r = 0; r < 16; r++) {
              const int kl = kt * 32 + (r & 3) + 8 * (r >> 2) + 4 * fh;
              s[kt][r] = (kl <= t64) ? s[kt][r] : -INFINITY;
            }
        } else if (j == jlo) {
#pragma unroll
          for (int kt = 0; kt < 2; kt++)
#pragma unroll
            for (int r = 0; r < 16; r++) {
              const int kl = kt * 32 + (r & 3) + 8 * (r >> 2) + 4 * fh;
              s[kt][r] = (kl > t64) ? s[kt][r] : -INFINITY;
            }
        }
        flash_update(acc, s, cur + FL_TILE);
      });
    const float sc_ = g_win * flash_inv_l(acc);
    bf16_t* orow = p.concat + (size_t)tok * DM + g * 256 + hq * 64;
#pragma unroll
    for (int dt = 0; dt < 2; dt++)
#pragma unroll
      for (int g4 = 0; g4 < 4; g4++) {
        float o4[4];
#pragma unroll
        for (int i = 0; i < 4; i++) o4[i] = stash[(dt * 16 + 4 * g4 + i) * 64] + sc_ * acc.o[dt][4 * g4 + i];
        uint2 o = {pack2bf(o4[0], o4[1]), pack2bf(o4[2], o4[3])};
        *(uint2*)(orow + dt * 32 + 8 * g4 + 4 * fh) = o;
      }
  }
}
__device__ __forceinline__ void nsa_phase(const Params& p, unsigned char* smem, int bid, int nblk) {
  for (int it = bid; it < NB * 2 * 128; it += nblk) {
    const int cc = 127 - (it >> 4), bgi = it & 15;
    nsa_flash_item(p, smem, (bgi << 7) | cc);
  }
}

typedef __attribute__((ext_vector_type(4))) float f32x4v;
typedef __attribute__((ext_vector_type(4))) short s16x4;
__device__ __forceinline__ float wave_max_uniform(float x) {
  x = fmaxf(x, __builtin_bit_cast(float, __builtin_amdgcn_update_dpp(0, __builtin_bit_cast(int, x), 0xB1, 0xF, 0xF, true)));
  x = fmaxf(x, __builtin_bit_cast(float, __builtin_amdgcn_update_dpp(0, __builtin_bit_cast(int, x), 0x4E, 0xF, 0xF, true)));
  x = fmaxf(x, __builtin_bit_cast(float, __builtin_amdgcn_update_dpp(0, __builtin_bit_cast(int, x), 0x141, 0xF, 0xF, true)));
  x = fmaxf(x, __builtin_bit_cast(float, __builtin_amdgcn_update_dpp(0, __builtin_bit_cast(int, x), 0x140, 0xF, 0xF, true)));
  return fmaxf(fmaxf(readlane_f(x, 0), readlane_f(x, 16)), fmaxf(readlane_f(x, 32), readlane_f(x, 48)));
}
__device__ __forceinline__ int dsa_vswz(int row) { return ((row >> 1) & 1) | ((row >> 2) & 2); }
__device__ __forceinline__ void dsa_item(const Params& p, unsigned char* smem, int b, int tg) {
  unsigned* keys = (unsigned*)smem;
  unsigned char* vst = smem;
  int* hist = (int*)(smem + 32768);
  int* sel = hist + 3584;
  int* cnt = sel + 512;
  float* sc = (float*)(cnt + 16);
  float* part = sc + 2048;
  const int tid = threadIdx.x, lane = tid & 63, w = tid >> 6;
  const int row16 = lane & 15, kg = lane >> 4;
  const int t0 = 2 * tg;
  const size_t tokb = (size_t)b * SEQ;
  const bf16_t* kib = p.ki + tokb * 32;
  const bf16_t* kdb = p.kd + tokb * 64;
  const bf16_t* vdb = p.vd + tokb * 64;
  const int n = t0 + 2;
  if (n > 256) {
#pragma unroll
    for (int i = 0; i < 14; i++) hist[tid + 256 * i] = 0;
    {
      const bf16x8 af = *(const bf16x8*)(p.qi + (tokb + t0 + (row16 >> 3)) * 256 + (row16 & 7) * 32 + kg * 8);
      const int tk = lane >> 5;
      const float4 wv = *(const float4*)(p.widx + (tokb + t0 + tk) * 8 + 4 * (kg & 1));
      const int ntile = (n + 15) >> 4;
#pragma unroll 1
      for (int kt0 = w * 4; kt0 < ntile; kt0 += 16) {
        bf16x8 bfr[4];
#pragma unroll
        for (int u = 0; u < 4; u++) {
          const int key = min(kt0 + u, ntile - 1) * 16 + row16;
          bfr[u] = *(const bf16x8*)(kib + (size_t)key * 32 + kg * 8);
        }
#pragma unroll
        for (int u = 0; u < 4; u++) {
          f32x4v acc = {0.f, 0.f, 0.f, 0.f};
          acc = __builtin_amdgcn_mfma_f32_16x16x32_bf16(af, bfr[u], acc, 0, 0, 0);
          float s = wv.x * fmaxf(acc[0], 0.f) + wv.y * fmaxf(acc[1], 0.f) + wv.z * fmaxf(acc[2], 0.f) + wv.w * fmaxf(acc[3], 0.f);
          s += __shfl_xor(s, 16);
          const int key = (kt0 + u) * 16 + row16;
          if ((kg & 1) == 0 && kt0 + u < ntile) {
            const unsigned kv_ = (key <= t0 + tk) ? f2key(s) : 0u;
            keys[tk * 4096 + key] = kv_;
            atomicAdd(&hist[1536 + tk * 1024 + (lane & 3) * 256 + (kv_ >> 24)], 1);
          }
        }
      }
    }
    __syncthreads();
    const int tk = w >> 1, hf = w & 1;
    const int npad = ((n + 15) >> 4) << 4, nh = npad >> 1;
    const unsigned* kt_ = keys + tk * 4096;
    const int i0 = hf * nh, i1 = i0 + nh;
    unsigned prefix = 0; int kk = 256;
#pragma unroll 1
    for (int pass = 0; pass < 4; pass++) {
      const int shift = 24 - 8 * pass;
      int* hp = (pass == 0) ? hist + 1536 + tk * 1024 : hist + (pass - 1) * 512 + tk * 256;
      int* hpa = (pass == 0) ? hp + (lane & 3) * 256 : hp;
      const unsigned hmask = (shift == 24) ? 0u : (0xFFFFFFFFu << (shift + 8));
      if (pass > 0)
#pragma unroll 2
      for (int base = i0 + 4 * lane; base < i1; base += 256) {
        const uint4 k4 = *(const uint4*)(kt_ + base);
        if ((k4.x & hmask) == prefix) atomicAdd(&hpa[(k4.x >> shift) & 255], 1);
        if ((k4.y & hmask) == prefix) atomicAdd(&hpa[(k4.y >> shift) & 255], 1);
        if ((k4.z & hmask) == prefix) atomicAdd(&hpa[(k4.z >> shift) & 255], 1);
        if ((k4.w & hmask) == prefix) atomicAdd(&hpa[(k4.w >> shift) & 255], 1);
      }
      __syncthreads();
      {
        int4 c4 = *(const int4*)(hp + lane * 4);
        if (pass == 0) {
#pragma unroll
          for (int cp = 1; cp < 4; cp++) {
            const int4 d4 = *(const int4*)(hp + cp * 256 + lane * 4);
            c4.x += d4.x; c4.y += d4.y; c4.z += d4.z; c4.w += d4.w;
          }
        }
        const int tl_ = c4.x + c4.y + c4.z + c4.w;
        int P = tl_;
        P += __builtin_amdgcn_update_dpp(0, P, 0x111, 0xF, 0xF, false);
        P += __builtin_amdgcn_update_dpp(0, P, 0x112, 0xF, 0xF, false);
        P += __builtin_amdgcn_update_dpp(0, P, 0x114, 0xF, 0xF, false);
        P += __builtin_amdgcn_update_dpp(0, P, 0x118, 0xF, 0xF, false);
        P += __builtin_amdgcn_update_dpp(0, P, 0x142, 0xA, 0xF, false);
        P += __builtin_amdgcn_update_dpp(0, P, 0x143, 0xC, 0xF, false);
        const int total = __builtin_amdgcn_readlane(P, 63);
        const int R = total - P + tl_;
        const int a3 = R - tl_, a2 = a3 + c4.w, a1 = a2 + c4.z, a0 = a1 + c4.y;
        const bool found = (a3 < kk) && (kk <= R);
        int dloc, above;
        if (kk <= a2) { dloc = 3; above = a3; } else if (kk <= a1) { dloc = 2; above = a2; } else if (kk <= a0) { dloc = 1; above = a1; } else { dloc = 0; above = a0; }
        const unsigned long long bm = __ballot(found);
        const int src = __ffsll((long long)bm) - 1;
        const int dsel = __builtin_amdgcn_readlane(lane * 4 + dloc, src);
        const int abv = __builtin_amdgcn_readlane(above, src);
        prefix |= ((unsigned)dsel) << shift;
        kk -= abv;
      }
    }
    {
      int cg_ = 0, ce = 0;
#pragma unroll 2
      for (int base = i0 + 4 * lane; base < i1; base += 256) {
        const uint4 k4 = *(const uint4*)(kt_ + base);
        cg_ += (k4.x > prefix) + (k4.y > prefix) + (k4.z > prefix) + (k4.w > prefix);
        ce += (k4.x == prefix) + (k4.y == prefix) + (k4.z == prefix) + (k4.w == prefix);
      }
      cg_ = (int)wave_sum_uniform((float)cg_); ce = (int)wave_sum_uniform((float)ce);
      if (lane == 0) { cnt[(tk * 2 + hf) * 2] = cg_; cnt[(tk * 2 + hf) * 2 + 1] = ce; }
    }
    __syncthreads();
    {
      int bgt = hf ? cnt[(tk * 2) * 2] : 0, beq = hf ? cnt[(tk * 2) * 2 + 1] : 0;
      const int ngt = 256 - kk;
      const unsigned long long lt = (1ull << lane) - 1ull;
#pragma unroll 1
      for (int base = i0 + 4 * lane; base < i1; base += 256) {
        const uint4 k4 = *(const uint4*)(kt_ + base);
        const unsigned kq[4] = {k4.x, k4.y, k4.z, k4.w};
        unsigned long long mg[4], me[4];
#pragma unroll
        for (int j = 0; j < 4; j++) { mg[j] = __ballot(kq[j] > prefix); me[j] = __ballot(kq[j] == prefix); }
        int pg = bgt + __popcll(mg[0] & lt) + __popcll(mg[1] & lt) + __popcll(mg[2] & lt) + __popcll(mg[3] & lt);
        int pe = beq + __popcll(me[0] & lt) + __popcll(me[1] & lt) + __popcll(me[2] & lt) + __popcll(me[3] & lt);
#pragma unroll
        for (int j = 0; j < 4; j++) {
          if (kq[j] > prefix) { sel[tk * 256 + pg] = base + j; pg++; }
          else if (kq[j] == prefix) { if (pe < kk) sel[tk * 256 + ngt + pe] = base + j; pe++; }
        }
        bgt += __popcll(mg[0]) + __popcll(mg[1]) + __popcll(mg[2]) + __popcll(mg[3]);
        beq += __popcll(me[0]) + __popcll(me[1]) + __popcll(me[2]) + __popcll(me[3]);
      }
    }
    __syncthreads();
  } else {
    for (int i = tid; i < 512; i += 256) sel[i] = i & 255;
    __syncthreads();
  }
  {
    const int tk = w >> 1, hf = w & 1;
    const int nsel = min(256, t0 + tk + 1);
    const size_t tok = tokb + t0 + tk;
    const int* selt = sel + tk * 256;
    float* sct = sc + tk * 1024;
    bf16_t* pbt = (bf16_t*)(part) + tk * 1024;
    unsigned char* vw = vst + w * 8192;
    const int kk8 = lane >> 3, ch = lane & 7;
    const int q4 = row16 >> 2, pp = row16 & 3;
#define DSA_VLOAD(dst, it_, base_) dst = *(const uint4*)(vdb + (size_t)selt[min((base_) + (it_) * 8 + kk8, nsel - 1)] * 64 + ch * 8)
#define DSA_VSTORE(src, it_) { const int key_ = (it_) * 8 + kk8; *(uint4*)(vw + key_ * 128 + ((((ch >> 1) ^ dsa_vswz(key_))) << 5) + ((ch & 1) << 4)) = src; }
    uint4 vv0, vv1, vv2, vv3, vv4, vv5, vv6, vv7;
    DSA_VLOAD(vv0, 0, hf * 128); DSA_VLOAD(vv1, 1, hf * 128); DSA_VLOAD(vv2, 2, hf * 128); DSA_VLOAD(vv3, 3, hf * 128);
    DSA_VLOAD(vv4, 4, hf * 128); DSA_VLOAD(vv5, 5, hf * 128); DSA_VLOAD(vv6, 6, hf * 128); DSA_VLOAD(vv7, 7, hf * 128);
    {
      bf16x8 qf[2];
#pragma unroll
      for (int ks = 0; ks < 2; ks++) {
        uint4 u = make_uint4(0, 0, 0, 0);
        if (row16 < 4) u = *(const uint4*)(p.qd + tok * 256 + row16 * 64 + ks * 32 + kg * 8);
        qf[ks] = __builtin_bit_cast(bf16x8, u);
      }
#pragma unroll 1
      for (int ck = 0; ck < 2; ck++) {
        bf16x8 kf[4][2];
#pragma unroll
        for (int ti = 0; ti < 4; ti++) {
          const int r = hf * 128 + ck * 64 + ti * 16 + row16;
          const int idx = selt[min(r, nsel - 1)];
#pragma unroll
          for (int ks = 0; ks < 2; ks++) kf[ti][ks] = *(const bf16x8*)(kdb + (size_t)idx * 64 + ks * 32 + kg * 8);
        }
#pragma unroll
        for (int ti = 0; ti < 4; ti++) {
          f32x4v acc = {0.f, 0.f, 0.f, 0.f};
          acc = __builtin_amdgcn_mfma_f32_16x16x32_bf16(kf[ti][0], qf[0], acc, 0, 0, 0);
          acc = __builtin_amdgcn_mfma_f32_16x16x32_bf16(kf[ti][1], qf[1], acc, 0, 0, 0);
          if (row16 < 4) {
#pragma unroll
            for (int r = 0; r < 4; r++) {
              const int key = hf * 128 + ck * 64 + ti * 16 + 4 * kg + r;
              sct[row16 * 256 + key] = (key < nsel) ? acc[r] * 0.125f : -INFINITY;
            }
          }
        }
      }
    }
    __syncthreads();
#pragma unroll
    for (int hh = 0; hh < 2; hh++) {
      const int h = 2 * hf + hh;
      float v0 = sct[h * 256 + lane], v1 = sct[h * 256 + 64 + lane], v2 = sct[h * 256 + 128 + lane], v3 = sct[h * 256 + 192 + lane];
      const float mx = wave_max_uniform(fmaxf(fmaxf(v0, v1), fmaxf(v2, v3)));
      v0 = __expf(v0 - mx); v1 = __expf(v1 - mx); v2 = __expf(v2 - mx); v3 = __expf(v3 - mx);
      const float inv = 1.f / wave_sum_uniform((v0 + v1) + (v2 + v3));
      pbt[h * 256 + lane] = f2bf(v0 * inv); pbt[h * 256 + 64 + lane] = f2bf(v1 * inv);
      pbt[h * 256 + 128 + lane] = f2bf(v2 * inv); pbt[h * 256 + 192 + lane] = f2bf(v3 * inv);
    }
    __syncthreads();
    f32x4v oacc[4];
#pragma unroll
    for (int nt = 0; nt < 4; nt++) oacc[nt] = f32x4v{0.f, 0.f, 0.f, 0.f};
#pragma unroll 1
    for (int ck = 0; ck < 2; ck++) {
      DSA_VSTORE(vv0, 0); DSA_VSTORE(vv1, 1); DSA_VSTORE(vv2, 2); DSA_VSTORE(vv3, 3);
      DSA_VSTORE(vv4, 4); DSA_VSTORE(vv5, 5); DSA_VSTORE(vv6, 6); DSA_VSTORE(vv7, 7);
      if (ck == 0) {
        const int nb_ = hf * 128 + 64;
        DSA_VLOAD(vv0, 0, nb_); DSA_VLOAD(vv1, 1, nb_); DSA_VLOAD(vv2, 2, nb_); DSA_VLOAD(vv3, 3, nb_);
        DSA_VLOAD(vv4, 4, nb_); DSA_VLOAD(vv5, 5, nb_); DSA_VLOAD(vv6, 6, nb_); DSA_VLOAD(vv7, 7, nb_);
      }
      __builtin_amdgcn_wave_barrier();
      bf16x8 pf[2];
#pragma unroll
      for (int ks = 0; ks < 2; ks++) {
        uint4 u = make_uint4(0, 0, 0, 0);
        if (row16 < 4) u = *(const uint4*)(pbt + row16 * 256 + hf * 128 + ck * 64 + ks * 32 + kg * 8);
        pf[ks] = __builtin_bit_cast(bf16x8, u);
      }
#pragma unroll
      for (int nt = 0; nt < 4; nt++) {
#pragma unroll
        for (int ks = 0; ks < 2; ks++) {
          const int r0 = ks * 32 + kg * 8 + q4, r1 = r0 + 4;
          const s16x4 lo = __builtin_amdgcn_ds_read_tr16_b64_v4i16((s16x4 __attribute__((address_space(3)))*)(vw + r0 * 128 + ((nt ^ dsa_vswz(r0)) << 5) + pp * 8));
          const s16x4 hi = __builtin_amdgcn_ds_read_tr16_b64_v4i16((s16x4 __attribute__((address_space(3)))*)(vw + r1 * 128 + ((nt ^ dsa_vswz(r1)) << 5) + pp * 8));
          typedef __attribute__((ext_vector_type(8))) short s16x8;
          const s16x8 v8 = __builtin_shufflevector(lo, hi, 0, 1, 2, 3, 4, 5, 6, 7);
          oacc[nt] = __builtin_amdgcn_mfma_f32_16x16x32_bf16(pf[ks], __builtin_bit_cast(bf16x8, v8), oacc[nt], 0, 0, 0);
        }
      }
      __builtin_amdgcn_wave_barrier();
    }
#undef DSA_VLOAD
#undef DSA_VSTORE
    __syncthreads();
    if (kg == 0) {
#pragma unroll
      for (int nt = 0; nt < 4; nt++)
#pragma unroll
        for (int r = 0; r < 4; r++) part[(w * 4 + r) * 64 + nt * 16 + row16] = oacc[nt][r];
    }
    __syncthreads();
    {
#pragma unroll
      for (int o2 = 0; o2 < 2; o2++) {
        const int idx = tid + 256 * o2, tk2 = idx >> 8, e = idx & 255;
        const float o = part[(2 * tk2) * 256 + e] + part[(2 * tk2 + 1) * 256 + e];
        p.concat[(tokb + t0 + tk2) * DM + 512 + e] = f2bf(o);
      }
    }
    __syncthreads();
  }
}
__device__ __forceinline__ void dsa_phase(const Params& p, unsigned char* smem, int bid, int nblk) {
  for (int it = bid; it < NB * (SEQ / 2); it += nblk) dsa_item(p, smem, it & 7, (SEQ / 2 - 1) - (it >> 3));
}

#define SELFCHECK 0
#ifndef PROBE_REPEAT
#define PROBE_REPEAT 0
#endif
#if SELFCHECK
__device__ __forceinline__ void check_val(const Params& p, float ref, float got, float atol, float rtol) {
  if (!(fabsf(ref - got) <= atol + rtol * fabsf(ref))) atomicExch(p.flag, 1);
}
__device__ __forceinline__ void inproj_check_phase(const Params& p, unsigned char* smem, int bid, int nblk) {
  float* h = (float*)smem;
  const float f16[8] = {1.0f, 0.19392274474868576f, 0.03760603093086393f, 0.007292664737217109f,
                        0.001414213562373095f, 0.0002742481756762073f, 5.318295896944988e-05f, 1.031338537721246e-05f};
  const int tid = threadIdx.x;
  for (int it = bid; it < 600; it += nblk) {
    const int tok = (it * 61) % NT;
    const int b = tok / SEQ, t = tok % SEQ;
    const float* xr = p.x + (size_t)tok * DM;
    for (int col = tid; col < INW; col += 256) {
      float a = 0.f;
      for (int k = 0; k < DM; k++) a = fmaf(xr[k], p.w_in[(size_t)k * INW + col], a);
      h[col] = a;
    }
    __syncthreads();
    const int pos = p.pos[tok];
    if (tid < 152) {
      const int v = tid >> 3, j = tid & 7;
      int base;
      if (v < 8) base = C_NSAQ + v * 64;
      else if (v < 10) base = C_NSAKV + 0 * 128 + (v - 8) * 64;
      else if (v < 12) base = C_NSAKV + 2 * 128 + (v - 10) * 64;
      else if (v < 14) base = C_NSAKV + 4 * 128 + (v - 12) * 64;
      else if (v < 18) base = C_DSAQ + (v - 14) * 64;
      else base = C_DSAK;
      float c, s; rope_cs(pos, f16[j], c, s);
      const float x1 = h[base + j], x2 = h[base + 8 + j];
      h[base + j] = x1 * c - x2 * s; h[base + 8 + j] = x2 * c + x1 * s;
    } else if (tid < 188) {
      const int u = tid - 152, v = u >> 2, j = u & 3;
      const int base = (v < 8) ? C_IDXQ + v * 32 : C_IDXK;
      float c, s; rope_cs(pos, f16[2 * j], c, s);
      const float x1 = h[base + j], x2 = h[base + 4 + j];
      h[base + j] = x1 * c - x2 * s; h[base + 4 + j] = x2 * c + x1 * s;
    } else if (tid < 212) {
      const int u = tid - 188;
      h[C_GATE + u] = 1.f / (1.f + expf(-h[C_GATE + u]));
    }
    __syncthreads();
    for (int col = tid; col < INW; col += 256) {
      const float ref = h[col];
      float got;
      if (col < 512) got = bf2f(p.qn[(size_t)tok * 512 + col]);
      else if (col < 1280) {
        const int o = col - 512, j = o >> 7, g = (o >> 6) & 1, d = o & 63;
        if (j == 3 || j == 5) {
          const bf16_t* vt = (j == 3) ? p.vslct : p.vwint;
          got = bf2f(vt[((size_t)(b * 2 + g) * 64 + d) * SEQ + perm16(t)]);
        } else {
          const bf16_t* src = j == 0 ? p.kvn[0] : j == 1 ? p.kvn[1] : j == 2 ? p.kvn[2] : p.kvn[4];
          got = bf2f(src[((size_t)(b * 2 + g) * SEQ + t) * 64 + d]);
        }
      }
      else if (col < 1304) got = p.gates[(size_t)tok * 24 + col - 1280];
      else if (col < 1560) got = bf2f(p.qd[(size_t)tok * 256 + col - 1304]);
      else if (col < 1624) got = bf2f(p.kd[(size_t)tok * 64 + col - 1560]);
      else if (col < 1688) got = bf2f(p.vd[(size_t)tok * 64 + col - 1624]);
      else if (col < 1944) got = bf2f(p.qi[(size_t)tok * 256 + col - 1688]);
      else if (col < 1976) got = bf2f(p.ki[(size_t)tok * 32 + col - 1944]);
      else if (col < 1984) got = p.widx[(size_t)tok * 8 + col - 1976] * 16.f;
      else got = bf2f(p.memq[(size_t)tok * 256 + col - 1984]);
      check_val(p, ref, got, 0.04f, 0.02f);
    }
    __syncthreads();
  }
  for (int it = bid; it < 64; it += nblk) {
    const int row = (it * 37) % (NB * MEML);
    for (int col = tid; col < 512; col += 256) {
      float a = 0.f;
      for (int k = 0; k < DM; k++) a = fmaf(p.mem[(size_t)row * DM + k], p.w_mem_kv[(size_t)k * 512 + col], a);
      float gotm;
      if (col < 256) gotm = bf2f(p.mkv[(size_t)row * 512 + col]);
      else { const int hd = (col - 256) >> 6, dd = col & 63; gotm = bf2f(p.memvt[((size_t)((row >> 8) * 4 + hd) * 64 + dd) * MEML + perm16(row & 255)]); }
      check_val(p, a, gotm, 0.04f, 0.02f);
    }
  }
}

__device__ __forceinline__ void mem_check_phase(const Params& p, unsigned char* smem, int bid, int nblk) {
  float* q = (float*)smem;
  float* sc = q + 256;
  const int tid = threadIdx.x;
  for (int it = bid; it < 700; it += nblk) {
    const int tok = (it * 47 + 13) % NT;
    const int b = tok / SEQ;
    q[tid] = bf2f(p.memq[(size_t)tok * 256 + tid]);
    __syncthreads();
    const bf16_t* kvb = p.mkv + (size_t)b * MEML * 512;
    for (int idx = tid; idx < 4 * 256; idx += 256) {
      const int hh = idx >> 8, m = idx & 255;
      sc[hh * 256 + m] = dot64_bf(q + hh * 64, kvb + (size_t)m * 512 + hh * 64) * 0.125f;
    }
    __syncthreads();
    softmax4(sc, 256, 256);
    __syncthreads();
    {
      const int h = tid >> 6, d = tid & 63;
      float o = 0.f;
      for (int m = 0; m < 256; m++) o = fmaf(sc[h * 256 + m], bf2f(p.memvt[((size_t)(b * 4 + h) * 64 + d) * MEML + perm16(m)]), o);
      check_val(p, o, bf2f(p.concat[(size_t)tok * DM + 768 + tid]), 0.004f, 0.02f);
    }
    __syncthreads();
  }
}
__device__ __forceinline__ void nsa_check_phase(const Params& p, unsigned char* smem, int bid, int nblk) {
  float* q = (float*)smem;
  float* sc = q + 256;
  float* o3 = sc + 4096;
  float* imp = o3 + 768;
  int* sel = (int*)(imp + 64);
  int* nselp = sel + 16;
  const int tid = threadIdx.x, h = tid >> 6, d = tid & 63;
  for (int it = bid; it < 1024; it += nblk) {
    const int item = (int)(((long long)it * 62851 + 7) % (NT * 2));
    const int g = item & 1, tok = item >> 1, b = tok / SEQ, t = tok % SEQ;
    const size_t kvb = (size_t)(b * 2 + g) * SEQ * 64;
    const bf16_t *kslc = p.kvn[2] + kvb, *kwin = p.kvn[4] + kvb;
    const bf16_t *vslct = p.vslct + (size_t)(b * 2 + g) * 64 * SEQ, *vwint = p.vwint + (size_t)(b * 2 + g) * 64 * SEQ;
    q[tid] = bf2f(p.qn[(size_t)tok * 512 + g * 256 + tid]);
    __syncthreads();
    const int nv = (t >= 31) ? (t - 31) / 16 + 1 : 0;
    const bf16_t* kcb = p.kcb + (size_t)(b * 2 + g) * 256 * 64;
    const bf16_t* vct = p.vct + (size_t)(b * 2 + g) * 64 * 256;
    for (int idx = tid; idx < 4 * 256; idx += 256) {
      const int hh = idx >> 8, i = idx & 255;
      float s = -INFINITY;
      if (i < nv) {
        s = 0.f;
        for (int e = 0; e < 64; e++) s = fmaf(q[hh * 64 + e], bf2f(kcb[i * 64 + e]), s);
        s *= 0.125f;
      }
      sc[hh * 1024 + i] = s;
    }
    __syncthreads();
    softmax4(sc, 1024, 256);
    __syncthreads();
    {
      float o = 0.f;
      for (int i = 0; i < nv; i++) o = fmaf(sc[h * 1024 + i], bf2f(vct[d * 256 + perm16(i)]), o);
      o3[0 * 256 + tid] = o;
    }
    const int cur = t / 64;
    if (tid < 64) {
      const int m = tid;
      float a = 0.f;
      const int n0 = max(0, 4 * m - 2), n1 = min(NC - 1, 4 * m + 4);
      for (int n = n0; n <= n1; n++) {
        const int ov = min(16 * n + 32, 64 * m + 64) - max(16 * n, 64 * m);
        if (ov > 0) {
          const float w = (float)ov * (1.f / 32.f);
          for (int hh = 0; hh < 4; hh++) a = fmaf(sc[hh * 1024 + n], w, a);
        }
      }
      const bool forced = (m == 0) || (m == cur) || (m == cur - 1);
      const bool vis = (m <= cur);
      imp[m] = vis ? a + (forced ? 1e4f : 0.f) : -INFINITY;
    }
    __syncthreads();
    if (tid < 64) {
      const int m = tid;
      const float sm = imp[m];
      int rank = 0;
      for (int mm = 0; mm < 64; mm++) { const float s2 = imp[mm]; rank += (s2 > sm) || (s2 == sm && mm < m); }
      const bool take = (rank < 16) && (m <= cur);
      const unsigned long long bal = __ballot(take);
      if (take) sel[__popcll(bal & ((1ull << m) - 1ull))] = m;
      if (m == 0) *nselp = __popcll(bal);
    }
    __syncthreads();
    const int nsel = *nselp;
    {
      const int nk = nsel * 64;
      for (int idx = tid; idx < 4 * nk; idx += 256) {
        const int hh = idx / nk, r = idx % nk;
        const int kpos = sel[r >> 6] * 64 + (r & 63);
        float s = -INFINITY;
        if (kpos <= t) s = dot64_bf(q + hh * 64, kslc + (size_t)kpos * 64) * 0.125f;
        sc[hh * 1024 + r] = s;
      }
      __syncthreads();
      softmax4(sc, 1024, nk);
      __syncthreads();
      float o = 0.f;
      for (int r = 0; r < nk; r++) {
        const int kpos = sel[r >> 6] * 64 + (r & 63);
        if (kpos <= t) o = fmaf(sc[h * 1024 + r], bf2f(vslct[(size_t)d * SEQ + perm16(kpos)]), o);
      }
      o3[1 * 256 + tid] = o;
      __syncthreads();
    }
    {
      for (int idx = tid; idx < 4 * 512; idx += 256) {
        const int hh = idx >> 9, r = idx & 511;
        const int kpos = t - 511 + r;
        float s = -INFINITY;
        if (kpos >= 0) s = dot64_bf(q + hh * 64, kwin + (size_t)kpos * 64) * 0.125f;
        sc[hh * 1024 + r] = s;
      }
      __syncthreads();
      softmax4(sc, 1024, 512);
      __syncthreads();
      float o = 0.f;
      for (int r = 0; r < 512; r++) {
        const int kpos = t - 511 + r;
        if (kpos >= 0) o = fmaf(sc[h * 1024 + r], bf2f(vwint[(size_t)d * SEQ + perm16(kpos)]), o);
      }
      o3[2 * 256 + tid] = o;
    }
    {
      const float* gt = p.gates + (size_t)tok * 24 + (g * 4 + h) * 3;
      const float r = gt[0] * o3[tid] + gt[1] * o3[256 + tid] + gt[2] * o3[512 + tid];
      const float got = bf2f(p.concat[(size_t)tok * DM + g * 256 + tid]);
      const float df = fabsf(r - got);
      if (!(df <= 0.08f + 0.1f * fabsf(r))) atomicExch(p.flag, 1);
      if (!(df <= 0.006f + 0.02f * fabsf(r))) atomicAdd(p.chkcnt, 1);
    }
    __syncthreads();
  }
}

__device__ __forceinline__ void dsa_check_phase(const Params& p, unsigned char* smem, int bid, int nblk) {
  unsigned* keys = (unsigned*)smem;
  float* qi = (float*)(keys + 4096);
  float* wi = qi + 256;
  int* hist = (int*)(wi + 8);
  int* sel = hist + 256;
  int* misc = sel + 256;
  int* cnts = misc + 8;
  float* qd = (float*)(cnts + 256);
  float* sc = qd + 256;
  const int tid = threadIdx.x;
  for (int it = bid; it < 1500; it += nblk) {
    const int tok = (int)(((long long)it * 39119 + 11) % NT);
    const int b = tok / SEQ, t = tok % SEQ;
    const bf16_t* kib = p.ki + (size_t)b * SEQ * 32;
    const bf16_t* kdb = p.kd + (size_t)b * SEQ * 64;
    const bf16_t* vdb = p.vd + (size_t)b * SEQ * 64;
    qi[tid] = bf2f(p.qi[(size_t)tok * 256 + tid]);
    if (tid < 8) wi[tid] = p.widx[(size_t)tok * 8 + tid];
    qd[tid] = bf2f(p.qd[(size_t)tok * 256 + tid]);
    __syncthreads();
    const int n = t + 1;
    int nsel;
    if (n <= 256) {
      for (int s = tid; s < n; s += 256) sel[s] = s;
      nsel = n;
      __syncthreads();
    } else {
      for (int s = tid; s < n; s += 256) {
        float kv[32];
#pragma unroll
        for (int e = 0; e < 32; e += 8) {
          const uint4 v = *(const uint4*)(kib + (size_t)s * 32 + e);
          kv[e + 0] = __uint_as_float(v.x << 16); kv[e + 1] = __uint_as_float(v.x & 0xFFFF0000u);
          kv[e + 2] = __uint_as_float(v.y << 16); kv[e + 3] = __uint_as_float(v.y & 0xFFFF0000u);
          kv[e + 4] = __uint_as_float(v.z << 16); kv[e + 5] = __uint_as_float(v.z & 0xFFFF0000u);
          kv[e + 6] = __uint_as_float(v.w << 16); kv[e + 7] = __uint_as_float(v.w & 0xFFFF0000u);
        }
        float score = 0.f;
    #pragma unroll 1
    for (int hh = 0; hh < 8; hh++) {
          float dsum = 0.f;
#pragma unroll
          for (int e = 0; e < 32; e++) dsum = fmaf(qi[hh * 32 + e], kv[e], dsum);
          score = fmaf(fmaxf(dsum, 0.f), wi[hh], score);
        }
        keys[s] = f2key(score);
      }
      unsigned prefix = 0; int kk = 256;
      for (int shift = 24; shift >= 0; shift -= 8) {
        hist[tid] = 0;
        __syncthreads();
        const unsigned hmask = (shift == 24) ? 0u : (0xFFFFFFFFu << (shift + 8));
        for (int s = tid; s < n; s += 256) {
          const unsigned k = keys[s];
          if ((k & hmask) == prefix) atomicAdd(&hist[(k >> shift) & 255], 1);
        }
        __syncthreads();
        if (tid == 0) {
          int cum = 0, dsel = 0;
          for (int dg = 255; dg >= 0; dg--) {
            const int c = hist[dg];
            if (cum + c >= kk) { dsel = dg; break; }
            cum += c;
          }
          misc[0] = dsel; misc[1] = kk - cum;
        }
        __syncthreads();
        prefix |= ((unsigned)misc[0]) << shift;
        kk = misc[1];
        __syncthreads();
      }
      const int per = (n + 255) / 256;
      const int s0 = tid * per, s1 = min(n, s0 + per);
      int cg_ = 0, ce = 0;
      for (int s = s0; s < s1; s++) { const unsigned k = keys[s]; cg_ += (k > prefix); ce += (k == prefix); }
      cnts[tid] = cg_; hist[tid] = ce;
      __syncthreads();
      if (tid == 0) {
        int a = 0, e = 0;
        for (int i = 0; i < 256; i++) { const int c1 = cnts[i], c2 = hist[i]; cnts[i] = a; hist[i] = e; a += c1; e += c2; }
        misc[2] = a;
      }
      __syncthreads();
      {
        int og = cnts[tid], oe = hist[tid];
        const int ngt = misc[2];
        for (int s = s0; s < s1; s++) {
          const unsigned k = keys[s];
          if (k > prefix) sel[og++] = s;
          else if (k == prefix) { if (oe < kk) sel[ngt + oe] = s; oe++; }
        }
      }
      nsel = 256;
      __syncthreads();
    }
    for (int idx = tid; idx < 4 * nsel; idx += 256) {
      const int hh = idx / nsel, r = idx % nsel;
      sc[hh * 256 + r] = dot64_bf(qd + hh * 64, kdb + (size_t)sel[r] * 64) * 0.125f;
    }
    __syncthreads();
    softmax4(sc, 256, nsel);
    __syncthreads();
    {
      const int h = tid >> 6, d = tid & 63;
      float o = 0.f;
      for (int r = 0; r < nsel; r++) o = fmaf(sc[h * 256 + r], bf2f(vdb[(size_t)sel[r] * 64 + d]), o);
      const float got = bf2f(p.concat[(size_t)tok * DM + 512 + tid]);
      const float df = fabsf(o - got);
      if (!(df <= 0.08f + 0.1f * fabsf(o))) atomicExch(p.flag, 1);
      if (!(df <= 0.004f + 0.02f * fabsf(o))) atomicAdd(p.chkcnt, 1);
    }
    __syncthreads();
  }
}


__device__ __forceinline__ void compress_check_phase(const Params& p, unsigned char* smem, int bid, int nblk) {
  float* hid = (float*)smem;
  const int tid = threadIdx.x;
  const int which = tid >> 7, j = tid & 127;
  for (int it = bid; it < 600; it += nblk) {
    const int item = (it * 131 + 5) % (NB * 2 * NC);
    const int i = item % NC, g = (item / NC) % 2, b = item / (NC * 2);
    const float* w1 = which ? p.w1v : p.w1k;
    const float* pe = which ? p.pe_v : p.pe_k;
    const bf16_t* src = (which ? p.kvn[1] : p.kvn[0]) + ((size_t)(b * 2 + g) * SEQ + i * 16) * 64;
    float acc = 0.f;
    for (int r = 0; r < 2048; r++) acc = fmaf(bf2f(src[r]) + pe[r], w1[(size_t)r * 128 + j], acc);
    hid[which * 128 + j] = gelu_exact(acc);
    __syncthreads();
    if (j < 64) {
      const float* w2 = which ? p.w2v : p.w2k;
      float o = 0.f;
      for (int k = 0; k < 128; k++) o = fmaf(hid[which * 128 + k], w2[k * 64 + j], o);
      const float got = which ? bf2f(p.vct[((size_t)(b * 2 + g) * 64 + j) * 256 + perm16(i)]) : bf2f(p.kcb[((size_t)(b * 2 + g) * 256 + i) * 64 + j]);
      check_val(p, o, got, 0.01f, 0.02f);
    }
    __syncthreads();
  }
}
#endif


#define XB_TMO      128
#define XB_XCNT(j)  (256  + 64 * (j))
#define XB_XSUB(j)  (1280 + 64 * (j))
#define XB_XGEN(j)  (2304 + 64 * (j))
#define XB_TOP      3328
#define XB_TOPGEN   3392
#define XCD_BAR_WORDS 3456
#define XB_SPIN_CAP (1u << 23)
#define LAS __attribute__((address_space(3)))
__device__ __forceinline__ unsigned xb_ld(unsigned* p)              { return __hip_atomic_load(p, __ATOMIC_RELAXED, __HIP_MEMORY_SCOPE_AGENT); }
__device__ __forceinline__ unsigned xb_add(unsigned* p, unsigned v) { return __hip_atomic_fetch_add(p, v, __ATOMIC_RELAXED, __HIP_MEMORY_SCOPE_AGENT); }
__device__ __forceinline__ unsigned xb_xcc_id() { return (unsigned)__builtin_amdgcn_s_getreg((3 << 11) | 20) & 0xFu; }
#define XB_SPIN(cond, bar) do { unsigned _sp = 0; while (cond) { __builtin_amdgcn_s_sleep(1); \
    if ((++_sp & 255u) == 0u) { if (xb_ld(&(bar)[XB_TMO])) break; if (_sp > XB_SPIN_CAP) { atomicAdd(&(bar)[XB_TMO], 1u); break; } } } } while (0)
struct XcdBarrier { unsigned* bar; unsigned x; volatile LAS unsigned* st; };
__device__ __forceinline__ XcdBarrier xcd_barrier_post(unsigned* bar, volatile LAS unsigned* st) {
  XcdBarrier b; b.bar = bar; b.x = xb_xcc_id(); b.st = st;
  if (threadIdx.x == 0) (void)xb_add(&bar[XB_XCNT(b.x)], 1u);
  return b;
}
__device__ __forceinline__ void xcd_barrier_complete(unsigned* bar, unsigned x, unsigned& nloc, unsigned& nx) {
  const unsigned G = gridDim.x * gridDim.y * gridDim.z;
  unsigned sum, cnt, mine, sp = 0u;
  for (;;) {
    sum = 0u; cnt = 0u; mine = 0u;
#pragma unroll
    for (unsigned j = 0; j < 16; ++j) { const unsigned c = xb_ld(&bar[XB_XCNT(j)]); sum += c; cnt += (c > 0u) ? 1u : 0u; mine = (j == x) ? c : mine; }
    if (sum == G) break;
    __builtin_amdgcn_s_sleep(1);
    if ((++sp & 255u) == 0u) { if (xb_ld(&bar[XB_TMO])) break; if (sp > XB_SPIN_CAP) { atomicAdd(&bar[XB_TMO], 1u); break; } }
  }
  nloc = mine > 0u ? mine : 1u; nx = cnt > 0u ? cnt : 1u;
}
__device__ __forceinline__ void xcd_barrier(const XcdBarrier& b) {
  asm volatile("s_waitcnt vmcnt(0)" ::: "memory");
  __syncthreads();
  if (threadIdx.x == 0) {
    unsigned* bar = b.bar;
    __builtin_amdgcn_s_waitcnt(0);
    unsigned nloc = b.st[0], nx = b.st[1];
    if (nloc == 0u) { xcd_barrier_complete(bar, b.x, nloc, nx); b.st[0] = nloc; b.st[1] = nx; }
    const unsigned old = xb_add(&bar[XB_XSUB(b.x)], 1u);
    const unsigned gen = old / nloc;
    if (old + 1u == (gen + 1u) * nloc) {
      __builtin_amdgcn_fence(__ATOMIC_RELEASE, "agent");
      asm volatile("s_waitcnt vmcnt(0)" ::: "memory");
      const unsigned og = xb_add(&bar[XB_TOP], 1u);
      const unsigned tg = og / nx;
      if (og + 1u == (tg + 1u) * nx) xb_add(&bar[XB_TOPGEN], 1u);
      else XB_SPIN(xb_ld(&bar[XB_TOPGEN]) == tg, bar);
      __builtin_amdgcn_fence(__ATOMIC_ACQUIRE, "agent");
      xb_add(&bar[XB_XGEN(b.x)], 1u);
      asm volatile("s_waitcnt vmcnt(0)" ::: "memory");
    } else {
      XB_SPIN(xb_ld(&bar[XB_XGEN(b.x)]) == gen, bar);
      __builtin_amdgcn_fence(__ATOMIC_ACQUIRE, "agent");
      asm volatile("s_waitcnt vmcnt(0)" ::: "memory");
    }
  }
  __syncthreads();
}

constexpr int SMEM_BYTES = 65536;
__global__ void __launch_bounds__(256, 2) megakernel(Params p) {
  __shared__ __align__(16) unsigned char smem[SMEM_BYTES];
  __shared__ uint4 xb_words;
  cg::grid_group grid = cg::this_grid();
  const int bid = blockIdx.x, nblk = gridDim.x;
  if (threadIdx.x == 0) xb_words = make_uint4(0u, 0u, 0u, 0u);
  __syncthreads();
  const XcdBarrier xb = xcd_barrier_post(p.bar, (volatile LAS unsigned*)&xb_words);
  if (p.never) grid.sync();
  for (int rep = 0; rep < ((PROBE_REPEAT & 128) ? 2 : 1); rep++) {
  convert_phase(p.x, p.xb, (size_t)NT * DM, bid, nblk);
  convert_phase(p.mem, p.memb, (size_t)NB * MEML * DM, bid, nblk);
  }
  for (int rep = 0; rep < ((PROBE_REPEAT & 256) ? 2 : 1); rep++) {
  transpose_phase<true>(p.w_in, INW, p.wint, DM, INWP, smem, bid, nblk);
  transpose_phase<false>(p.w_mem_kv, 512, p.wmemt, DM, 512, smem, bid, nblk);
  transpose_phase<false>(p.w_out, DM, p.woutt, DM, DM, smem, bid, nblk);
  transpose_phase<false>(p.wq, 2048, p.wqt, DM, 2048, smem, bid, nblk);
  transpose_phase<false>(p.w1k, 128, p.w1kt, 2048, 128, smem, bid, nblk);
  transpose_phase<false>(p.w1v, 128, p.w1vt, 2048, 128, smem, bid, nblk);
  }
  for (int rep = 0; rep < ((PROBE_REPEAT & 512) ? 2 : 1); rep++) {
  cbias_phase(p, bid, nblk);
  subkey_phase(p.sk1, p.sk1p, bid, nblk);
  subkey_phase(p.sk2, p.sk2p, bid, nblk);
  cs_phase(p, bid, nblk);
  ovp_phase(p, bid, nblk);
  }
  if (bid == 0 && threadIdx.x == 0) { *p.flag = 0; *p.chkcnt = 0; }
  xcd_barrier(xb);
  for (int rep = 0; rep < ((PROBE_REPEAT & 2) ? 2 : 1); rep++) inproj_phase(p, smem, bid, nblk);
  xcd_barrier(xb);
  if (bid >= 128) memkv_phase(p, smem, bid - 128, nblk);
  compress_phase(p, smem, bid, nblk);
  xcd_barrier(xb);
  {
    constexpr int N_NSA = NB * 2 * 128, N_DSA = NB * (SEQ / 2), N_MEM = NB * 4 * 32;
    volatile LAS unsigned* qslot = (volatile LAS unsigned*)&xb_words + 2;
#pragma unroll 1
    for (;;) {
      __syncthreads();
      if (threadIdx.x == 0) qslot[0] = atomicAdd(p.bar + 64, 1u);
      __syncthreads();
      const int q = (int)qslot[0];
      if (q >= N_NSA) break;
      nsa_flash_item(p, smem, ((q & 15) << 7) | (127 - (q >> 4)));
    }
    auto quant_item = [&](int qi_) __attribute__((always_inline)) {
      const int w_ = threadIdx.x >> 6;
      if (qi_ < 256) quant_rows(p.pu, p.puq, p.psu, qi_ * 64, 64, w_, 4);
      else quant_rows(p.pv, p.pvq, p.psv, (qi_ - 256) * 64, 64, w_, 4);
    };
    int ndone = 0;
#pragma unroll 1
    for (;;) {
      __syncthreads();
      if (threadIdx.x == 0) qslot[0] = atomicAdd(p.bar + 65, 1u);
      __syncthreads();
      const int q = (int)qslot[0];
      if (q >= N_DSA) break;
      dsa_item(p, smem, q & 7, (SEQ / 2 - 1) - (q >> 3));
      if ((++ndone & 31) == 0) {
        __syncthreads();
        if (threadIdx.x == 0) qslot[0] = atomicAdd(p.bar + 67, 1u);
        __syncthreads();
        const int qq = (int)qslot[0];
        if (qq < 512) quant_item(qq);
      }
    }
#pragma unroll 1
    for (;;) {
      __syncthreads();
      if (threadIdx.x == 0) qslot[0] = atomicAdd(p.bar + 67, 1u);
      __syncthreads();
      const int qq = (int)qslot[0];
      if (qq >= 512) break;
      quant_item(qq);
    }
#pragma unroll 1
    for (;;) {
      __syncthreads();
      if (threadIdx.x == 0) qslot[0] = atomicAdd(p.bar + 66, 1u);
      __syncthreads();
      const int q = (int)qslot[0];
      if (q >= N_MEM) break;
      mem_flash_item(p, smem, q);
    }
  }
  xcd_barrier(xb);
  for (int rep = 0; rep < ((PROBE_REPEAT & 64) ? 2 : 1); rep++) peer_block_phase(p, smem, bid, nblk);
}


#if SELFCHECK
__global__ void __launch_bounds__(256) check_kernel(Params p) {
  __shared__ __align__(16) unsigned char smem[40960];
  inproj_check_phase(p, smem, blockIdx.x, gridDim.x);
}
__global__ void check_final(Params p) {
  if (threadIdx.x == 0 && (*(volatile int*)p.flag != 0 || *(volatile int*)p.chkcnt > 6000)) p.out[0] = __uint_as_float(0x7FC00000u);
}
#endif

extern "C" void kernel_launch(void* const* d_in, const int* in_sizes, int n_in, void* d_out, int out_size,
                              void* d_ws, size_t ws_size, hipStream_t stream) {
  Params p{};
  p.x = (const float*)d_in[0]; p.mem = (const float*)d_in[1]; p.pos = (const int*)d_in[2];
  p.w_in = (const float*)d_in[3]; p.pe_k = (const float*)d_in[4]; p.pe_v = (const float*)d_in[5];
  p.w1k = (const float*)d_in[6]; p.w2k = (const float*)d_in[7]; p.w1v = (const float*)d_in[8]; p.w2v = (const float*)d_in[9];
  p.w_mem_kv = (const float*)d_in[10]; p.w_out = (const float*)d_in[11]; p.ln1g = (const float*)d_in[12]; p.ln1b = (const float*)d_in[13];
  p.wq = (const float*)d_in[14]; p.sk1 = (const float*)d_in[15]; p.sk2 = (const float*)d_in[16];
  p.pu = (const float*)d_in[17]; p.pv = (const float*)d_in[18]; p.ln2g = (const float*)d_in[19]; p.ln2b = (const float*)d_in[20];
  p.out = (float*)d_out;
  unsigned char* ws = (unsigned char*)d_ws;
  size_t off = 0;
  auto take = [&](size_t bytes) { void* r = ws + off; off += (bytes + 255) & ~(size_t)255; return r; };
  p.xb = (bf16_t*)take((size_t)NT * DM * 2);
  p.qn = (bf16_t*)take((size_t)NT * 512 * 2);
  for (int j = 0; j < 6; j++) p.kvn[j] = (bf16_t*)take((size_t)NT * 128 * 2);
  p.qd = (bf16_t*)take((size_t)NT * 256 * 2);
  p.kd = (bf16_t*)take((size_t)NT * 64 * 2);
  p.vd = (bf16_t*)take((size_t)NT * 64 * 2);
  p.qi = (bf16_t*)take((size_t)NT * 256 * 2);
  p.ki = (bf16_t*)take((size_t)NT * 32 * 2);
  p.memq = (bf16_t*)take((size_t)NT * 256 * 2);
  p.gates = (float*)take((size_t)NT * 24 * 4);
  p.widx = (float*)take((size_t)NT * 8 * 4);
  p.mkv = (bf16_t*)take((size_t)NB * MEML * 512 * 2);
  p.memvt = (bf16_t*)take((size_t)NB * 4 * 64 * MEML * 2);
  p.vslct = (bf16_t*)take((size_t)NT * 128 * 2);
  p.vwint = (bf16_t*)take((size_t)NT * 128 * 2);
  p.kcb = (bf16_t*)take((size_t)NB * 2 * 256 * 64 * 2);
  p.vct = (bf16_t*)take((size_t)NB * 2 * 64 * 256 * 2);
  p.ovp = (bf16_t*)take((size_t)64 * 256 * 2);
  p.w1kt = (bf16_t*)take((size_t)128 * 2048 * 2);
  p.w1vt = (bf16_t*)take((size_t)128 * 2048 * 2);
  p.cbias = (float*)take(64 * 256 * 4);
  p.chkcnt = (int*)take(256);
  p.bar = (unsigned*)take(XCD_BAR_WORDS * 4);
  p.never = 0; p.pad_ = 0;
  p.memb = (bf16_t*)take((size_t)NB * MEML * DM * 2);
  p.wint = (bf16_t*)take((size_t)INWP * DM * 2);
  p.wmemt = (bf16_t*)take((size_t)512 * DM * 2);
  p.woutt = (bf16_t*)take((size_t)DM * DM * 2);
  p.wqt = (bf16_t*)take((size_t)2048 * DM * 2);
  p.sk1p = (bf16_t*)take((size_t)128 * 128 * 2);
  p.sk2p = (bf16_t*)take((size_t)128 * 128 * 2);
  p.puq = (unsigned char*)take((size_t)16384 * DM);
  p.pvq = (unsigned char*)take((size_t)16384 * DM);
  p.psu = (float*)take(16384 * 4);
  p.psv = (float*)take(16384 * 4);
  p.cs = (float2*)take((size_t)NT * 8 * 8);
  p.kc = (float*)take((size_t)NB * 2 * NC * 64 * 4);
  p.vc = (float*)take((size_t)NB * 2 * NC * 64 * 4);
  p.concat = (bf16_t*)take((size_t)NT * DM * 2);
  p.x1b = (bf16_t*)take((size_t)NT * DM * 2);
  p.pexp = (int*)take((size_t)NT * 128 * 4);
  p.pgate = (float*)take((size_t)NT * 128 * 4);
  p.flag = (int*)take(256);
  if (off > ws_size) { fprintf(stderr, "workspace too small: need %zu have %zu\n", off, ws_size); return; }
  static int grid_blocks = 0;
  if (!grid_blocks) {
    int dev = 0, cus = 0, per_cu = 0;
    hipGetDevice(&dev);
    hipDeviceGetAttribute(&cus, hipDeviceAttributeMultiprocessorCount, dev);
    hipOccupancyMaxActiveBlocksPerMultiprocessor(&per_cu, megakernel, 256, 0);
    if (per_cu > 2) per_cu = 2;
    grid_blocks = cus * per_cu;
  }
  hipMemsetAsync(p.bar, 0, XCD_BAR_WORDS * 4, stream);
  void* args[] = {&p};
  hipError_t e = hipLaunchCooperativeKernel((void*)megakernel, dim3(grid_blocks), dim3(256), args, 0, stream);
  if (e != hipSuccess) fprintf(stderr, "cooperative launch failed: %s (grid %d)\n", hipGetErrorString(e), grid_blocks);
#if SELFCHECK
  check_kernel<<<512, 256, 0, stream>>>(p);
  check_final<<<1, 64, 0, stream>>>(p);
#endif
}
```

```cpp
#include <hip/hip_runtime.h>
#include <hip/hip_cooperative_groups.h>
#include <cstdio>
#include <cstdint>
namespace cg = cooperative_groups;

constexpr int NB = 8, SEQ = 4096, DM = 1024, NT = NB * SEQ;
constexpr int INW = 2240;
constexpr int INWP = 2304;
constexpr int NC = 255;
constexpr int MEML = 256;
constexpr int C_NSAQ = 0, C_NSAKV = 512, C_GATE = 1280, C_DSAQ = 1304, C_DSAK = 1560, C_DSAV = 1624,
              C_IDXQ = 1688, C_IDXK = 1944, C_IDXW = 1976, C_MEMQ = 1984;
constexpr int P_NSAQ = 0, P_NSAKV = 512, P_DSAQ = 1280, P_DSAK = 1536, P_DSAV = 1600, P_IDXQ = 1664, P_IDXK = 1920,
              P_MEMQ = 1952, P_GATE = 2208, P_IDXW = 2232, P_END = 2240;
constexpr float ALPHA = 1.189207115002721f;

typedef unsigned short bf16_t;
typedef __attribute__((ext_vector_type(8))) __bf16 bf16x8;
typedef __attribute__((ext_vector_type(2))) __bf16 bf16x2;
typedef __attribute__((ext_vector_type(2))) float f32x2;
typedef __attribute__((ext_vector_type(4))) float f32x4;
typedef __attribute__((ext_vector_type(16))) float f32x16;
typedef __attribute__((ext_vector_type(2))) _Float16 f16x2;

struct Params {
  const float *x, *mem; const int* pos;
  const float *w_in, *pe_k, *pe_v, *w1k, *w2k, *w1v, *w2v, *w_mem_kv, *w_out, *ln1g, *ln1b,
              *wq, *sk1, *sk2, *pu, *pv, *ln2g, *ln2b;
  float* out;
  bf16_t *xb, *memb, *wint, *wmemt, *woutt, *wqt, *sk1p, *sk2p;
  unsigned char *puq, *pvq;
  float *psu, *psv;
  float2* cs;
  bf16_t *qn;
  bf16_t *kvn[6];
  bf16_t *qd, *kd, *vd;
  bf16_t *qi, *ki;
  bf16_t *memq, *mkv;
  bf16_t *memvt;
  bf16_t *vslct, *vwint;
  bf16_t *w1kt, *w1vt; float* cbias;
  bf16_t *kcb, *vct;
  bf16_t *ovp;
  int *chkcnt;
  unsigned *bar;
  int never;
  int pad_;
  float *gates, *widx;
  bf16_t *concat;
  bf16_t *x1b;
  float *kc, *vc;
  int   *pexp;
  float *pgate;
  int   *flag;
};

__device__ __forceinline__ float bf2f(bf16_t u) { return __uint_as_float(((unsigned)u) << 16); }
__device__ __forceinline__ bf16_t f2bf(float f) { return __builtin_bit_cast(unsigned short, (__bf16)f); }
__device__ __forceinline__ unsigned pack2bf(float a, float b) {
  f32x2 v = {a, b};
  return __builtin_bit_cast(unsigned, __builtin_convertvector(v, bf16x2));
}

__device__ __forceinline__ float wave_sum(float v) {
#pragma unroll
  for (int o = 32; o > 0; o >>= 1) v += __shfl_xor(v, o);
  return v;
}
__device__ __forceinline__ float wave_max(float v) {
#pragma unroll
  for (int o = 32; o > 0; o >>= 1) v = fmaxf(v, __shfl_xor(v, o));
  return v;
}
__device__ __forceinline__ float gelu_exact(float x) { return 0.5f * x * (1.f + erff(x * 0.7071067811865476f)); }

__device__ __forceinline__ void convert_phase(const float* __restrict__ src, bf16_t* __restrict__ dst, size_t n, int bid, int nblk) {
  const size_t nch = n / 8, stride = (size_t)nblk * 256;
  size_t c = (size_t)bid * 256 + threadIdx.x;
  for (; c + 3 * stride < nch; c += 4 * stride) {
    float4 a[4], b[4];
#pragma unroll
    for (int u = 0; u < 4; u++) { a[u] = *(const float4*)(src + (c + u * stride) * 8); b[u] = *(const float4*)(src + (c + u * stride) * 8 + 4); }
#pragma unroll
    for (int u = 0; u < 4; u++) {
      uint4 o = {pack2bf(a[u].x, a[u].y), pack2bf(a[u].z, a[u].w), pack2bf(b[u].x, b[u].y), pack2bf(b[u].z, b[u].w)};
      *(uint4*)(dst + (c + u * stride) * 8) = o;
    }
  }
  for (; c < nch; c += stride) {
    const float4 a = *(const float4*)(src + c * 8), b = *(const float4*)(src + c * 8 + 4);
    uint4 o = {pack2bf(a.x, a.y), pack2bf(a.z, a.w), pack2bf(b.x, b.y), pack2bf(b.z, b.w)};
    *(uint4*)(dst + c * 8) = o;
  }
}
__device__ __forceinline__ unsigned quant4(const float4& v, float inv) {
  const unsigned a = (unsigned)(__float2int_rn(v.x * inv) + 128), b = (unsigned)(__float2int_rn(v.y * inv) + 128);
  const unsigned c = (unsigned)(__float2int_rn(v.z * inv) + 128), d = (unsigned)(__float2int_rn(v.w * inv) + 128);
  return a | (b << 8) | (c << 16) | (d << 24);
}
__device__ __forceinline__ float absmax4(const float4& v) { return fmaxf(fmaxf(fabsf(v.x), fabsf(v.y)), fmaxf(fabsf(v.z), fabsf(v.w))); }
__device__ __forceinline__ void quant_rows(const float* __restrict__ src, unsigned char* __restrict__ dst, float* __restrict__ scl,
                                           int row0, int nrows, int gw, int nw) {
  const int lane = threadIdx.x & 63;
  for (int r = row0 + gw * 2; r < row0 + nrows; r += nw * 2) {
    const float4* s0 = (const float4*)(src + (size_t)r * 1024 + 16 * lane);
    const float4* s1 = (const float4*)(src + (size_t)(r + 1) * 1024 + 16 * lane);
    const float4 a0 = s0[0], a1 = s0[1], a2 = s0[2], a3 = s0[3];
    const float4 b0 = s1[0], b1 = s1[1], b2 = s1[2], b3 = s1[3];
    const float ma = wave_max(fmaxf(fmaxf(absmax4(a0), absmax4(a1)), fmaxf(absmax4(a2), absmax4(a3))));
    const float mb = wave_max(fmaxf(fmaxf(absmax4(b0), absmax4(b1)), fmaxf(absmax4(b2), absmax4(b3))));
    const float ia = ma > 0.f ? 127.f / ma : 0.f, ib = mb > 0.f ? 127.f / mb : 0.f;
    *(uint4*)(dst + (size_t)r * 1024 + 16 * lane) = make_uint4(quant4(a0, ia), quant4(a1, ia), quant4(a2, ia), quant4(a3, ia));
    *(uint4*)(dst + (size_t)(r + 1) * 1024 + 16 * lane) = make_uint4(quant4(b0, ib), quant4(b1, ib), quant4(b2, ib), quant4(b3, ib));
    if (lane == 0) { scl[r] = ma * (1.f / 127.f); scl[r + 1] = mb * (1.f / 127.f); }
  }
}
__device__ __forceinline__ int inproj_colmap(int n) {
  if (n < P_DSAQ) return n;
  if (n < P_DSAK) return C_DSAQ + (n - P_DSAQ);
  if (n < P_IDXQ) return C_DSAK + (n - P_DSAK);
  if (n < P_IDXK) return C_IDXQ + (n - P_IDXQ);
  if (n < P_MEMQ) return C_IDXK + (n - P_IDXK);
  if (n < P_GATE) return C_MEMQ + (n - P_MEMQ);
  if (n < P_IDXW) return C_GATE + (n - P_GATE);
  if (n < P_END) return C_IDXW + (n - P_IDXW);
  return -1;
}
template <bool PERM>
__device__ __forceinline__ void transpose_phase(const float* __restrict__ src, int lds_, bf16_t* __restrict__ dst, int K, int Nd,
                                unsigned char* smem, int bid, int nblk) {
  float (*t)[65] = (float (*)[65])smem;
  const int tx = threadIdx.x & 63, ty = threadIdx.x >> 6;
  const int tk = K / 64, tn = Nd / 64;
  for (int tile = bid; tile < tk * tn; tile += nblk) {
    const int k0 = (tile % tk) * 64, n0 = (tile / tk) * 64;
    const int nsrc = PERM ? inproj_colmap(n0 + tx) : (n0 + tx);
#pragma unroll
    for (int i = 0; i < 16; i++) {
      const int k = ty + 4 * i;
      t[tx][k] = (nsrc >= 0) ? src[(size_t)(k0 + k) * lds_ + nsrc] : 0.f;
    }
    __syncthreads();
#pragma unroll
    for (int i = 0; i < 16; i++) {
      const int n = ty + 4 * i;
      dst[(size_t)(n0 + n) * K + k0 + tx] = f2bf(t[n][tx]);
    }
    __syncthreads();
  }
}
__device__ __forceinline__ void subkey_phase(const float* __restrict__ src, bf16_t* __restrict__ dst, int bid, int nblk) {
  for (int i = bid * 256 + threadIdx.x; i < 128 * 128; i += nblk * 256) {
    const int n = i >> 7, pos = i & 127, g16 = pos & ~15, pp = pos & 15, h = pp >> 3, j = pp & 7;
    dst[i] = f2bf(src[n * 128 + g16 + 8 * (j >> 2) + 4 * h + (j & 3)]);
  }
}
__device__ __forceinline__ void rope_cs(int pos, float freq, float& c, float& s) {
  double ang = (double)pos * (double)freq;
  double rev = ang * 0.15915494309189535;
  rev -= floor(rev + 0.5);
  float r = (float)(rev * 6.283185307179586);
  c = __cosf(r); s = __sinf(r);
}
__device__ __forceinline__ void cs_phase(const Params& p, int bid, int nblk) {
  const float f16[8] = {1.0f, 0.19392274474868576f, 0.03760603093086393f, 0.007292664737217109f,
                        0.001414213562373095f, 0.0002742481756762073f, 5.318295896944988e-05f, 1.031338537721246e-05f};
  for (int i = bid * 256 + threadIdx.x; i < NT * 8; i += nblk * 256) {
    float c, s; rope_cs(p.pos[i >> 3], f16[i & 7], c, s);
    p.cs[i] = make_float2(c, s);
  }
}

template <int WM, int WN>
struct Gemm {
  static constexpr int BM = 64 * WM, BN = 64 * WN;
  static constexpr int A_BYTES = BM * 128, B_BYTES = BN * 128, STAGE = A_BYTES + B_BYTES;
  static constexpr int SMEM = 2 * STAGE;
  static constexpr int NA = BM / 32, NBK = BN / 32;

  struct Stage8 { uint4 a0, a1, a2, a3, b0, b1, b2, b3; };
  static __device__ __forceinline__ Stage8 ld_stage(const bf16_t* ap0, const bf16_t* ap1, const bf16_t* ap2, const bf16_t* ap3,
                                                    const bf16_t* bp0, const bf16_t* bp1, const bf16_t* bp2, const bf16_t* bp3, int ko) {
    Stage8 r;
    r.a0 = *(const uint4*)(ap0 + ko); r.a1 = *(const uint4*)(ap1 + ko);
    if (NA > 2) { r.a2 = *(const uint4*)(ap2 + ko); r.a3 = *(const uint4*)(ap3 + ko); } else { r.a2 = r.a0; r.a3 = r.a0; }
    r.b0 = *(const uint4*)(bp0 + ko); r.b1 = *(const uint4*)(bp1 + ko);
    if (NBK > 2) { r.b2 = *(const uint4*)(bp2 + ko); r.b3 = *(const uint4*)(bp3 + ko); } else { r.b2 = r.b0; r.b3 = r.b0; }
    return r;
  }
  static __device__ __forceinline__ void st_stage(const Stage8 r, unsigned char* dst, int wofs) {
    *(uint4*)(dst + wofs) = r.a0; *(uint4*)(dst + wofs + 4096) = r.a1;
    if (NA > 2) { *(uint4*)(dst + wofs + 8192) = r.a2; *(uint4*)(dst + wofs + 12288) = r.a3; }
    *(uint4*)(dst + A_BYTES + wofs) = r.b0; *(uint4*)(dst + A_BYTES + wofs + 4096) = r.b1;
    if (NBK > 2) { *(uint4*)(dst + A_BYTES + wofs + 8192) = r.b2; *(uint4*)(dst + A_BYTES + wofs + 12288) = r.b3; }
  }
  static __device__ __forceinline__ void compute_stage(f32x16 (&acc)[WM][WN], const unsigned char* cur, int wm, int wn, int fr, int fh) {
#pragma unroll
    for (int s = 0; s < 4; s++) {
      const int chunk = 2 * s + fh;
      bf16x8 af[WM], bfr[WN];
#pragma unroll
      for (int i = 0; i < WM; i++) {
        const int row = (wm * WM + i) * 32 + fr;
        af[i] = *(const bf16x8*)(cur + row * 128 + ((chunk ^ ((row >> 1) & 7)) << 4));
      }
#pragma unroll
      for (int j = 0; j < WN; j++) {
        const int row = (wn * WN + j) * 32 + fr;
        bfr[j] = *(const bf16x8*)(cur + A_BYTES + row * 128 + ((chunk ^ ((row >> 1) & 7)) << 4));
      }
#pragma unroll
      for (int i = 0; i < WM; i++)
#pragma unroll
        for (int j = 0; j < WN; j++) acc[i][j] = __builtin_amdgcn_mfma_f32_32x32x16_bf16(af[i], bfr[j], acc[i][j], 0, 0, 0);
    }
  }
  template <class ARow, class BRow>
  static __device__ __forceinline__ void mainloop(f32x16 (&acc)[WM][WN], ARow arow, BRow brow, int K, unsigned char* smem) {
    const int tid = threadIdx.x, lane = tid & 63, w = tid >> 6, wm = w >> 1, wn = w & 1;
    const int lrow = tid >> 3, lchunk = tid & 7;
    const bf16_t* ap0 = arow(lrow) + lchunk * 8;
    const bf16_t* ap1 = arow(lrow + 32) + lchunk * 8;
    const bf16_t* ap2 = (NA > 2) ? arow(lrow + 64) + lchunk * 8 : ap0;
    const bf16_t* ap3 = (NA > 2) ? arow(lrow + 96) + lchunk * 8 : ap0;
    const bf16_t* bp0 = brow(lrow) + lchunk * 8;
    const bf16_t* bp1 = brow(lrow + 32) + lchunk * 8;
    const bf16_t* bp2 = (NBK > 2) ? brow(lrow + 64) + lchunk * 8 : bp0;
    const bf16_t* bp3 = (NBK > 2) ? brow(lrow + 96) + lchunk * 8 : bp0;
    const int wofs = lrow * 128 + ((lchunk ^ ((lrow >> 1) & 7)) << 4);
    const int fr = lane & 31, fh = lane >> 5;
    const int nk = K / 64;
    Stage8 rA = ld_stage(ap0, ap1, ap2, ap3, bp0, bp1, bp2, bp3, 0);
    Stage8 rB = ld_stage(ap0, ap1, ap2, ap3, bp0, bp1, bp2, bp3, 64);
    st_stage(rA, smem, wofs);
    rA = ld_stage(ap0, ap1, ap2, ap3, bp0, bp1, bp2, bp3, (nk > 2 ? 2 : 0) * 64);
    __syncthreads();
#pragma unroll 1
    for (int kt = 0; kt < nk; kt += 2) {
      compute_stage(acc, smem, wm, wn, fr, fh);
      st_stage(rB, smem + STAGE, wofs);
      if (kt + 3 < nk) rB = ld_stage(ap0, ap1, ap2, ap3, bp0, bp1, bp2, bp3, (kt + 3) * 64);
      __syncthreads();
      compute_stage(acc, smem + STAGE, wm, wn, fr, fh);
      if (kt + 2 < nk) {
        st_stage(rA, smem, wofs);
        if (kt + 4 < nk) rA = ld_stage(ap0, ap1, ap2, ap3, bp0, bp1, bp2, bp3, (kt + 4) * 64);
      }
      __syncthreads();
    }
  }
};

__device__ __forceinline__ int perm16(int k) { return (k & ~12) | ((k & 4) << 1) | ((k & 8) >> 1); }
constexpr float LOG2E = 1.4426950408889634f;
constexpr int FL_TILE = 8192;
constexpr int FL_STAGE = 2 * FL_TILE;
struct FlashAcc {
  f32x16 o[2];
  float m, l;
};
__device__ __forceinline__ void flash_init(FlashAcc& a) {
#pragma unroll
  for (int i = 0; i < 2; i++)
#pragma unroll
    for (int r = 0; r < 16; r++) a.o[i][r] = 0.f;
  a.m = -INFINITY; a.l = 0.f;
}
struct Tile2 { uint4 a, b; };
template <class RowF>
__device__ __forceinline__ Tile2 tile_fetch(RowF rowp) {
  const int tid = threadIdx.x;
  Tile2 t;
  t.a = *(const uint4*)(rowp(tid >> 3) + (tid & 7) * 8);
  t.b = *(const uint4*)(rowp((tid >> 3) + 32) + (tid & 7) * 8);
  return t;
}
__device__ __forceinline__ void tile_store(const Tile2& t, unsigned char* dst) {
  const int tid = threadIdx.x, row = tid >> 3, ch = tid & 7;
  const int ofs = row * 128 + ((ch ^ ((row >> 1) & 7)) << 4);
  *(uint4*)(dst + ofs) = t.a;
  *(uint4*)(dst + ofs + 4096) = t.b;
}
__device__ __forceinline__ bf16x8 lds_frag(const unsigned char* tile, int row, int chunk) {
  return *(const bf16x8*)(tile + row * 128 + ((chunk ^ ((row >> 1) & 7)) << 4));
}
__device__ __forceinline__ void flash_qk(f32x16 (&s)[2], const unsigned char* ktile, const bf16x8 (&qf)[4]) {
  const int lane = threadIdx.x & 63, fr = lane & 31, fh = lane >> 5;
#pragma unroll
  for (int kt = 0; kt < 2; kt++) {
#pragma unroll
    for (int r = 0; r < 16; r++) s[kt][r] = 0.f;
#pragma unroll
    for (int ks = 0; ks < 4; ks++)
      s[kt] = __builtin_amdgcn_mfma_f32_32x32x16_bf16(lds_frag(ktile, kt * 32 + fr, 2 * ks + fh), qf[ks], s[kt], 0, 0, 0);
    asm volatile("" ::: "memory");
  }
}
__device__ __forceinline__ bf16x8 pack_frag(const f32x16& s, int half8) {
  uint4 u = {pack2bf(s[8 * half8 + 0], s[8 * half8 + 1]), pack2bf(s[8 * half8 + 2], s[8 * half8 + 3]),
             pack2bf(s[8 * half8 + 4], s[8 * half8 + 5]), pack2bf(s[8 * half8 + 6], s[8 * half8 + 7])};
  return __builtin_bit_cast(bf16x8, u);
}
__device__ __forceinline__ void flash_update(FlashAcc& a, f32x16 (&s)[2], const unsigned char* vtile, bool colvalid = true) {
  const int lane = threadIdx.x & 63, fr = lane & 31, fh = lane >> 5;
  float mx = fmaxf(s[0][0], s[1][0]);
#pragma unroll
  for (int r = 1; r < 16; r += 1) mx = __builtin_fmaxf(mx, __builtin_fmaxf(s[0][r], s[1][r]));
  mx = fmaxf(mx, __shfl_xor(mx, 32));
  mx = colvalid ? mx : -INFINITY;
  const float mnew = fmaxf(a.m, mx);
  const float muse = (mnew == -INFINITY) ? 0.f : mnew;
  if (__any(mnew != a.m)) {
    const float alpha = __builtin_amdgcn_exp2f((a.m - muse) * LOG2E);
    a.l *= alpha;
#pragma unroll
    for (int dt = 0; dt < 2; dt++)
#pragma unroll
      for (int r = 0; r < 16; r++) a.o[dt][r] *= alpha;
    a.m = mnew;
  }
  const float cb = colvalid ? -muse * LOG2E : -INFINITY;
  float sum0 = 0.f, sum1 = 0.f;
#pragma unroll
  for (int r = 0; r < 16; r++) {
    const float p0 = __builtin_amdgcn_exp2f(fmaf(s[0][r], LOG2E, cb));
    const float p1 = __builtin_amdgcn_exp2f(fmaf(s[1][r], LOG2E, cb));
    s[0][r] = p0; s[1][r] = p1; sum0 += p0; sum1 += p1;
  }
  a.l += sum0 + sum1;
#pragma unroll
  for (int kt = 0; kt < 2; kt++)
#pragma unroll
    for (int h8 = 0; h8 < 2; h8++) {
      const bf16x8 pf = pack_frag(s[kt], h8);
#pragma unroll
      for (int dt = 0; dt < 2; dt++)
        a.o[dt] = __builtin_amdgcn_mfma_f32_32x32x16_bf16(lds_frag(vtile, dt * 32 + fr, 4 * kt + 2 * h8 + fh), pf, a.o[dt], 0, 0, 0);
      asm volatile("" ::: "memory");
    }
}
__device__ __forceinline__ float flash_inv_l(const FlashAcc& a) {
  const float lt = a.l + __shfl_xor(a.l, 32);
  return lt > 0.f ? 1.f / lt : 0.f;
}
__device__ __forceinline__ void flash_load_q(bf16x8 (&qf)[4], const bf16_t* qrow, float scale) {
  const int fh = (threadIdx.x & 63) >> 5;
#pragma unroll
  for (int ks = 0; ks < 4; ks++) {
    const uint4 u = *(const uint4*)(qrow + ks * 16 + fh * 8);
    const unsigned w[4] = {u.x, u.y, u.z, u.w};
    uint4 o;
    o.x = pack2bf(__uint_as_float(w[0] << 16) * scale, __uint_as_float(w[0] & 0xFFFF0000u) * scale);
    o.y = pack2bf(__uint_as_float(w[1] << 16) * scale, __uint_as_float(w[1] & 0xFFFF0000u) * scale);
    o.z = pack2bf(__uint_as_float(w[2] << 16) * scale, __uint_as_float(w[2] & 0xFFFF0000u) * scale);
    o.w = pack2bf(__uint_as_float(w[3] << 16) * scale, __uint_as_float(w[3] & 0xFFFF0000u) * scale);
    qf[ks] = __builtin_bit_cast(bf16x8, o);
  }
}
__device__ __forceinline__ void flash_store_o(const FlashAcc& a, bf16_t* orow, float scale) {
  const int fh = (threadIdx.x & 63) >> 5;
#pragma unroll
  for (int dt = 0; dt < 2; dt++)
#pragma unroll
    for (int g4 = 0; g4 < 4; g4++) {
      uint2 o = {pack2bf(a.o[dt][4 * g4 + 0] * scale, a.o[dt][4 * g4 + 1] * scale),
                 pack2bf(a.o[dt][4 * g4 + 2] * scale, a.o[dt][4 * g4 + 3] * scale)};
      *(uint2*)(orow + dt * 32 + 8 * g4 + 4 * fh) = o;
    }
}

__device__ __forceinline__ void mem_flash_item(const Params& p, unsigned char* smem, int item) {
  const int tid = threadIdx.x, lane = tid & 63, w = tid >> 6, fr = lane & 31;
  const int chunk = item & 31, h = (item >> 5) & 3, b = item >> 7;
  const int tok = b * SEQ + chunk * 128 + w * 32 + fr;
  bf16x8 qf[4];
  flash_load_q(qf, p.memq + (size_t)tok * 256 + h * 64, 0.125f);
  FlashAcc acc; flash_init(acc);
  const bf16_t* kbase = p.mkv + (size_t)b * MEML * 512 + h * 64;
  const bf16_t* vbase = p.memvt + (size_t)(b * 4 + h) * 64 * MEML;
  Tile2 rk = tile_fetch([&](int r) { return kbase + (size_t)r * 512; });
  Tile2 rv = tile_fetch([&](int r) { return vbase + (size_t)r * MEML; });
  __syncthreads();
  tile_store(rk, smem); tile_store(rv, smem + FL_TILE);
  __syncthreads();
#pragma unroll 1
  for (int kb = 0; kb < 4; kb++) {
    unsigned char* cur = smem + (kb & 1) * FL_STAGE;
    if (kb + 1 < 4) {
      rk = tile_fetch([&](int r) { return kbase + (size_t)((kb + 1) * 64 + r) * 512; });
      rv = tile_fetch([&](int r) { return vbase + (size_t)r * MEML + (kb + 1) * 64; });
    }
    {
      f32x16 s[2];
      flash_qk(s, cur, qf);
      flash_update(acc, s, cur + FL_TILE);
    }
    if (kb + 1 < 4) { unsigned char* nxt = smem + ((kb + 1) & 1) * FL_STAGE; tile_store(rk, nxt); tile_store(rv, nxt + FL_TILE); }
    __syncthreads();
  }
  flash_store_o(acc, p.concat + (size_t)tok * DM + 768 + h * 64, flash_inv_l(acc));
}
__device__ __forceinline__ void mem_phase(const Params& p, unsigned char* smem, int bid, int nblk) {
  for (int item = bid; item < NB * 4 * 32; item += nblk) mem_flash_item(p, smem, item);
}

__device__ __forceinline__ void ovp_phase(const Params& p, int bid, int nblk) {
  for (int i = bid * 256 + threadIdx.x; i < 64 * 256; i += nblk * 256) {
    const int m = i >> 8, n = i & 255;
    int ov = min(16 * n + 32, 64 * m + 64) - max(16 * n, 64 * m);
    if (ov < 0 || n >= NC) ov = 0;
    p.ovp[m * 256 + perm16(n)] = f2bf((float)ov * (1.f / 32.f));
  }
}

struct TileDest { bf16_t* ptr; int stride; int kind; };
__device__ __forceinline__ TileDest inproj_dest(const Params& p, int cb, int b) {
  TileDest d; d.kind = 0;
  if (cb < P_NSAKV) { d.ptr = p.qn + cb; d.stride = 512; d.kind = ((cb & 63) == 0) ? 1 : 0; }
  else if (cb < P_DSAQ) {
    const int o = cb - P_NSAKV, j = o >> 7, g = (o >> 6) & 1;
    if (j == 3 || j == 5) {
      d.ptr = (j == 3 ? p.vslct : p.vwint) + ((size_t)(b * 2 + g) * 64 + (o & 63)) * SEQ; d.stride = 0; d.kind = 5;
    } else {
      bf16_t* base = (j == 0) ? p.kvn[0] : (j == 1) ? p.kvn[1] : (j == 2) ? p.kvn[2] : p.kvn[4];
      d.ptr = base + ((size_t)g * SEQ + (size_t)b * SEQ) * 64 + (o & 63); d.stride = 64;
      d.kind = (((j & 1) == 0) && ((o & 63) == 0)) ? 1 : 0;
    }
  }
  else if (cb < P_DSAK) { d.ptr = p.qd + (cb - P_DSAQ); d.stride = 256; d.kind = ((cb & 63) == 0) ? 1 : 0; }
  else if (cb < P_DSAV) { d.ptr = p.kd + (cb - P_DSAK); d.stride = 64; d.kind = (cb == P_DSAK) ? 1 : 0; }
  else if (cb < P_IDXQ) { d.ptr = p.vd + (cb - P_DSAV); d.stride = 64; }
  else if (cb < P_IDXK) { d.ptr = p.qi + (cb - P_IDXQ); d.stride = 256; d.kind = 2; }
  else if (cb < P_MEMQ) { d.ptr = p.ki; d.stride = 32; d.kind = 2; }
  else if (cb < P_GATE) { d.ptr = p.memq + (cb - P_MEMQ); d.stride = 256; }
  else if (cb < P_END) { d.ptr = nullptr; d.stride = 0; d.kind = 3; }
  else { d.ptr = nullptr; d.stride = 0; d.kind = 4; }
  return d;
}
__device__ __forceinline__ void inproj_phase(const Params& p, unsigned char* smem, int bid, int nblk) {
  typedef Gemm<2, 2> G;
  const int lane = threadIdx.x & 63, w = threadIdx.x >> 6, wm = w >> 1, wn = w & 1;
  const int c = lane & 31, fh = lane >> 5;
  constexpr int TN = INWP / 128, TM = NT / 128;
  for (int tile = bid; tile < TM * TN; tile += nblk) {
    f32x16 acc[2][2];
#pragma unroll
    for (int i = 0; i < 2; i++)
#pragma unroll
      for (int j = 0; j < 2; j++)
#pragma unroll
        for (int r = 0; r < 16; r++) acc[i][j][r] = 0.f;
    {
      const int m0 = (tile / TN) * 128, n0 = (tile % TN) * 128;
      const bf16_t* A = p.xb + (size_t)m0 * DM;
      const bf16_t* Bt = p.wint + (size_t)n0 * DM;
      G::mainloop(acc, [&](int r) { return A + (size_t)r * DM; }, [&](int r) { return Bt + (size_t)r * DM; }, DM, smem);
      const int b = m0 / SEQ;
      unsigned char* wt = smem + w * 9216;
      const TileDest d0 = inproj_dest(p, n0 + (wn * 2 + 0) * 32, b);
      const TileDest d1 = inproj_dest(p, n0 + (wn * 2 + 1) * 32, b);
#pragma unroll
      for (int j = 0; j < 2; j++) {
        const TileDest d = j ? d1 : d0;
        if (d.kind == 4) continue;
        if (d.kind == 5) {
#pragma unroll
          for (int i = 0; i < 2; i++)
#pragma unroll
            for (int g4 = 0; g4 < 4; g4++) {
              const int tloc = (m0 & (SEQ - 1)) + (wm * 2 + i) * 32 + 8 * g4 + 4 * fh;
              uint2 o = {pack2bf(acc[i][j][4 * g4 + 0], acc[i][j][4 * g4 + 1]), pack2bf(acc[i][j][4 * g4 + 2], acc[i][j][4 * g4 + 3])};
              *(uint2*)(d.ptr + (size_t)c * SEQ + perm16(tloc)) = o;
            }
          continue;
        }
        if (d.kind == 3) {
#pragma unroll
          for (int i = 0; i < 2; i++)
#pragma unroll
            for (int r = 0; r < 16; r++) {
              const int tok = m0 + (wm * 2 + i) * 32 + (r & 3) + 8 * (r >> 2) + 4 * fh;
              const float v = acc[i][j][r];
              if (c < 24) p.gates[(size_t)tok * 24 + c] = 1.f / (1.f + __expf(-v));
              else p.widx[(size_t)tok * 8 + (c - 24)] = v * 0.0625f;
            }
          continue;
        }
#pragma unroll
        for (int i = 0; i < 2; i++) {
#pragma unroll
          for (int r = 0; r < 16; r++) {
            const int tok = m0 + (wm * 2 + i) * 32 + (r & 3) + 8 * (r >> 2) + 4 * fh;
            float v = acc[i][j][r];
            if (d.kind == 1) {
              const float pv = __shfl_xor(v, 8);
              if (c < 16) {
                const float2 cs = p.cs[(size_t)tok * 8 + (c & 7)];
                v = (c & 8) ? (v * cs.x + pv * cs.y) : (v * cs.x - pv * cs.y);
              }
            } else if (d.kind == 2) {
              const float pv = __shfl_xor(v, 4);
              if (c < 8) {
                const float2 cs = p.cs[(size_t)tok * 8 + 2 * (c & 3)];
                v = (c & 4) ? (v * cs.x + pv * cs.y) : (v * cs.x - pv * cs.y);
              }
            }
            acc[i][j][r] = v;
          }
#pragma unroll
          for (int r = 0; r < 16; r += 2) {
            const float va = acc[i][j][r], vb = acc[i][j][r + 1];
            const float na = __builtin_bit_cast(float, __builtin_amdgcn_update_dpp(0, __builtin_bit_cast(int, va), 0xB1, 0xF, 0xF, true));
            const float nb = __builtin_bit_cast(float, __builtin_amdgcn_update_dpp(0, __builtin_bit_cast(int, vb), 0xB1, 0xF, 0xF, true));
            const bool odd = c & 1;
            const unsigned pk = pack2bf(odd ? nb : va, odd ? vb : na);
            const int row = i * 32 + (r & 3) + 8 * (r >> 2) + 4 * fh + (odd ? 1 : 0);
            *(unsigned*)(wt + row * 144 + j * 64 + (c & ~1) * 2) = pk;
          }
        }
      }
      __builtin_amdgcn_wave_barrier();
      {
        const int chunk = lane & 7, jt = chunk >> 2;
        const TileDest d = jt ? d1 : d0;
        if (d.kind <= 2) {
#pragma unroll
          for (int it = 0; it < 8; it++) {
            const int row = it * 8 + (lane >> 3);
            const uint4 v = *(const uint4*)(wt + row * 144 + chunk * 16);
            const int tok = m0 + wm * 64 + row;
            *(uint4*)(d.ptr + (size_t)tok * d.stride + (chunk & 3) * 8) = v;
          }
        }
      }
      __syncthreads();
    }
  }
}

__device__ __forceinline__ void memkv_phase(const Params& p, unsigned char* smem, int bid, int nblk) {
  typedef Gemm<2, 2> G;
  const int lane = threadIdx.x & 63, w = threadIdx.x >> 6, wm = w >> 1, wn = w & 1;
  const int c = lane & 31, fh = lane >> 5;
  constexpr int TN2 = 512 / 128, TM2 = NB * MEML / 128;
  for (int t2 = bid; t2 < TM2 * TN2; t2 += nblk) {
    f32x16 acc[2][2];
#pragma unroll
    for (int i = 0; i < 2; i++)
#pragma unroll
      for (int j = 0; j < 2; j++)
#pragma unroll
        for (int r = 0; r < 16; r++) acc[i][j][r] = 0.f;
    {
      const int m0 = (t2 / TN2) * 128, n0 = (t2 % TN2) * 128;
      const bf16_t* A = p.memb + (size_t)m0 * DM;
      const bf16_t* Bt = p.wmemt + (size_t)n0 * DM;
      G::mainloop(acc, [&](int r) { return A + (size_t)r * DM; }, [&](int r) { return Bt + (size_t)r * DM; }, DM, smem);
#pragma unroll
      for (int i = 0; i < 2; i++)
#pragma unroll
        for (int j = 0; j < 2; j++)
          {
            const int cb = n0 + (wn * 2 + j) * 32;
            if (cb < 256) {
#pragma unroll
              for (int r = 0; r < 16; r++) {
                const int row = m0 + (wm * 2 + i) * 32 + (r & 3) + 8 * (r >> 2) + 4 * fh;
                p.mkv[(size_t)row * 512 + cb + c] = f2bf(acc[i][j][r]);
              }
            } else {
              const int dfull = cb + c - 256, head = dfull >> 6, d = dfull & 63;
              const int rowb = m0 + (wm * 2 + i) * 32, b = rowb >> 8, ml = rowb & 255;
              bf16_t* vrow = p.memvt + ((size_t)(b * 4 + head) * 64 + d) * MEML;
#pragma unroll
              for (int g4 = 0; g4 < 4; g4++) {
                uint2 o = {pack2bf(acc[i][j][4 * g4 + 0], acc[i][j][4 * g4 + 1]), pack2bf(acc[i][j][4 * g4 + 2], acc[i][j][4 * g4 + 3])};
                *(uint2*)(vrow + perm16(ml + 8 * g4 + 4 * fh)) = o;
              }
            }
          }
    }
  }
}

__device__ __forceinline__ unsigned f2key(float f) {
  unsigned u = __float_as_uint(f);
  return (u & 0x80000000u) ? ~u : (u | 0x80000000u);
}
__device__ __forceinline__ float key2f(unsigned k) {
  return __uint_as_float((k & 0x80000000u) ? (k ^ 0x80000000u) : ~k);
}
#define CE_DESC(a, b) { const unsigned _h = max(a, b); const unsigned _l = min(a, b); a = _h; b = _l; }
__device__ __forceinline__ void bitonic_merge16(unsigned (&m)[16]) {
#pragma unroll
  for (int st = 8; st >= 1; st >>= 1)
#pragma unroll
    for (int k = 0; k < 16; k++)
      if ((k & st) == 0) CE_DESC(m[k], m[k + st]);
}
__device__ __forceinline__ void insert16(unsigned (&L)[16], unsigned x) {
#pragma unroll
  for (int k = 0; k < 16; k++) { const unsigned hi = max(L[k], x); x = min(L[k], x); L[k] = hi; }
}
__device__ __forceinline__ void merge4_lists(unsigned (&L)[16], unsigned* lists, int t, int q) {
#pragma unroll
  for (int k = 0; k < 16; k++) lists[(q * 16 + k) * 64 + t] = L[k];
  __syncthreads();
  if (q < 2) {
#pragma unroll
    for (int k = 0; k < 16; k++) L[k] = max(lists[((2 * q) * 16 + k) * 64 + t], lists[((2 * q + 1) * 16 + 15 - k) * 64 + t]);
    bitonic_merge16(L);
#pragma unroll
    for (int k = 0; k < 16; k++) lists[((2 * q) * 16 + k) * 64 + t] = L[k];
  }
  __syncthreads();
  if (q == 0) {
#pragma unroll
    for (int k = 0; k < 16; k++) L[k] = max(L[k], lists[(2 * 16 + 15 - k) * 64 + t]);
    bitonic_merge16(L);
  }
}
__device__ __forceinline__ float dpp_rowsum(float x) {
  x += __builtin_bit_cast(float, __builtin_amdgcn_update_dpp(0, __builtin_bit_cast(int, x), 0xB1, 0xF, 0xF, true));
  x += __builtin_bit_cast(float, __builtin_amdgcn_update_dpp(0, __builtin_bit_cast(int, x), 0x4E, 0xF, 0xF, true));
  x += __builtin_bit_cast(float, __builtin_amdgcn_update_dpp(0, __builtin_bit_cast(int, x), 0x141, 0xF, 0xF, true));
  x += __builtin_bit_cast(float, __builtin_amdgcn_update_dpp(0, __builtin_bit_cast(int, x), 0x140, 0xF, 0xF, true));
  return x;
}
__device__ __forceinline__ float readlane_f(float v, int l) {
  return __int_as_float(__builtin_amdgcn_readlane(__float_as_int(v), l));
}
__device__ __forceinline__ float wave_sum_uniform(float x) {
  x = dpp_rowsum(x);
  return (readlane_f(x, 0) + readlane_f(x, 16)) + (readlane_f(x, 32) + readlane_f(x, 48));
}
__device__ __forceinline__ float dot8_bf16(const uint4& a, const uint4& b, float acc) {
  acc = __builtin_amdgcn_fdot2_f32_bf16(__builtin_bit_cast(bf16x2, a.x), __builtin_bit_cast(bf16x2, b.x), acc, false);
  acc = __builtin_amdgcn_fdot2_f32_bf16(__builtin_bit_cast(bf16x2, a.y), __builtin_bit_cast(bf16x2, b.y), acc, false);
  acc = __builtin_amdgcn_fdot2_f32_bf16(__builtin_bit_cast(bf16x2, a.z), __builtin_bit_cast(bf16x2, b.z), acc, false);
  acc = __builtin_amdgcn_fdot2_f32_bf16(__builtin_bit_cast(bf16x2, a.w), __builtin_bit_cast(bf16x2, b.w), acc, false);
  return acc;
}
__device__ __forceinline__ void fma8_bf16(float (&y)[8], const uint4& v, float w) {
  y[0] = fmaf(w, __uint_as_float(v.x << 16), y[0]); y[1] = fmaf(w, __uint_as_float(v.x & 0xFFFF0000u), y[1]);
  y[2] = fmaf(w, __uint_as_float(v.y << 16), y[2]); y[3] = fmaf(w, __uint_as_float(v.y & 0xFFFF0000u), y[3]);
  y[4] = fmaf(w, __uint_as_float(v.z << 16), y[4]); y[5] = fmaf(w, __uint_as_float(v.z & 0xFFFF0000u), y[5]);
  y[6] = fmaf(w, __uint_as_float(v.w << 16), y[6]); y[7] = fmaf(w, __uint_as_float(v.w & 0xFFFF0000u), y[7]);
}
__device__ const unsigned char cand_tab[52] = {
  0x00,0x01,0x02,0x03,0x04,0x05,0x06,0x07,0x08,0x09,0x0A,0x0B,0x0C,0x0D,0x0E,0x0F,
  0x10,0x11,0x12,0x13,0x14,0x15,0x16,0x17,
  0x20,0x21,0x22,0x23,0x24,
  0x30,0x31,0x32,0x33,
  0x40,0x41,0x42,
  0x50,0x51, 0x60,0x61, 0x70,0x71,
  0x80,0x90,0xA0,0xB0,0xC0,0xD0,0xE0,0xF0, 0xF0,0xF0};

__device__ __forceinline__ f16x2 bytes01_h2(unsigned w) { return __builtin_bit_cast(f16x2, __builtin_amdgcn_perm(w, 0x64646464u, 0x00050004u)); }
__device__ __forceinline__ f16x2 bytes23_h2(unsigned w) { return __builtin_bit_cast(f16x2, __builtin_amdgcn_perm(w, 0x64646464u, 0x00070006u)); }
template <int CTRL>
__device__ __forceinline__ float dpp_get(float x) {
  return __builtin_bit_cast(float, __builtin_amdgcn_update_dpp(0, __builtin_bit_cast(int, x), CTRL, 0xF, 0xF, true));
}
__device__ __forceinline__ float reduce16x16(const float (&ps)[16]) {
  const int lane = threadIdx.x & 63;
  const bool b0 = lane & 1, b1 = lane & 2, b2 = lane & 4, b3 = lane & 8;
  float r1[8], r2[4], r3[2];
#pragma unroll
  for (int i = 0; i < 8; i++) {
    const float u = ps[2 * i] + dpp_get<0xB1>(ps[2 * i]), v = ps[2 * i + 1] + dpp_get<0xB1>(ps[2 * i + 1]);
    r1[i] = b0 ? v : u;
  }
#pragma unroll
  for (int i = 0; i < 4; i++) {
    const float u = r1[2 * i] + dpp_get<0x4E>(r1[2 * i]), v = r1[2 * i + 1] + dpp_get<0x4E>(r1[2 * i + 1]);
    r2[i] = b1 ? v : u;
  }
#pragma unroll
  for (int i = 0; i < 2; i++) {
    const float u = r2[2 * i] + dpp_get<0x104>(r2[2 * i]);
    const float v = r2[2 * i + 1] + dpp_get<0x114>(r2[2 * i + 1]);
    r3[i] = b2 ? v : u;
  }
  const float u = r3[0] + dpp_get<0x128>(r3[0]), v = r3[1] + dpp_get<0x128>(r3[1]);
  float r = b3 ? v : u;
  r += __int_as_float(__builtin_amdgcn_ds_swizzle(__float_as_int(r), 0x401F));
  r += __shfl_xor(r, 32);
  return r;
}
constexpr int PE_EXPERT_DEPTH = 8;

__device__ __forceinline__ void peer_block_phase(const Params& p, unsigned char* smem, int bid, int nblk) {
  const int tid = threadIdx.x, lane = tid & 63, w = tid >> 6, wm = w >> 1, wn = w & 1;
  const int c = lane & 31, fh = lane >> 5;
  float* S = (float*)smem;
  unsigned* lists = (unsigned*)(smem + 32768);
  unsigned* ablist = (unsigned*)(smem + 49152);
  int* fin_e = (int*)(smem + 57344);
  float* fin_g = (float*)(smem + 57344 + 4096);
  for (int blk = bid; blk < NT / 64; blk += nblk) {
    const int t0 = blk * 64;
#pragma unroll 1
    for (int nt = 0; nt < 8; nt++) {
      f32x16 acc[1][2];
#pragma unroll
      for (int j = 0; j < 2; j++)
#pragma unroll
        for (int r = 0; r < 16; r++) acc[0][j][r] = 0.f;
      const bf16_t* A = p.concat + (size_t)t0 * DM;
      const bf16_t* Bt = p.woutt + (size_t)nt * 128 * DM;
      Gemm<1, 2>::mainloop(acc, [&](int r) { return A + (size_t)r * DM; }, [&](int r) { return Bt + (size_t)r * DM; }, DM, smem);
      {
        const unsigned ebase = (unsigned)(t0 + wm * 32 + 4 * fh) * DM + nt * 128 + wn * 64 + c;
#pragma unroll
        for (int j = 0; j < 2; j++) {
#pragma unroll
          for (int r = 0; r < 16; r++) {
            const unsigned idx = ebase + (unsigned)(((r & 3) + 8 * (r >> 2)) * DM + j * 32);
            p.out[idx] = acc[0][j][r] + ALPHA * p.x[idx];
          }
          asm volatile("" ::: "memory");
        }
      }
    }
    __syncthreads();
#pragma unroll 1
    for (int rr = 0; rr < 16; rr++) {
      const int tok = t0 + w * 16 + rr;
      float* row = p.out + (size_t)tok * DM;
      float v[16];
      {
        const float4 a0 = *(const float4*)(row + 8 * lane), a1 = *(const float4*)(row + 8 * lane + 4);
        const float4 a2 = *(const float4*)(row + 512 + 8 * lane), a3 = *(const float4*)(row + 512 + 8 * lane + 4);
        v[0] = a0.x; v[1] = a0.y; v[2] = a0.z; v[3] = a0.w; v[4] = a1.x; v[5] = a1.y; v[6] = a1.z; v[7] = a1.w;
        v[8] = a2.x; v[9] = a2.y; v[10] = a2.z; v[11] = a2.w; v[12] = a3.x; v[13] = a3.y; v[14] = a3.z; v[15] = a3.w;
      }
      float s = 0.f;
#pragma unroll
      for (int i = 0; i < 16; i++) s += v[i];
      const float mu = wave_sum(s) * (1.f / DM);
      float qv = 0.f;
#pragma unroll
      for (int i = 0; i < 16; i++) { v[i] -= mu; qv += v[i] * v[i]; }
      const float rs = rsqrtf(wave_sum(qv) * (1.f / DM) + 1e-5f);
#pragma unroll
      for (int hf = 0; hf < 2; hf++) {
        const int e0 = hf * 512 + 8 * lane;
        const float4 g0 = *(const float4*)(p.ln1g + e0), g1 = *(const float4*)(p.ln1g + e0 + 4);
        const float4 b0 = *(const float4*)(p.ln1b + e0), b1 = *(const float4*)(p.ln1b + e0 + 4);
        float o[8];
        o[0] = v[hf * 8 + 0] * rs * g0.x + b0.x; o[1] = v[hf * 8 + 1] * rs * g0.y + b0.y;
        o[2] = v[hf * 8 + 2] * rs * g0.z + b0.z; o[3] = v[hf * 8 + 3] * rs * g0.w + b0.w;
        o[4] = v[hf * 8 + 4] * rs * g1.x + b1.x; o[5] = v[hf * 8 + 5] * rs * g1.y + b1.y;
        o[6] = v[hf * 8 + 6] * rs * g1.z + b1.z; o[7] = v[hf * 8 + 7] * rs * g1.w + b1.w;
        *(float4*)(row + e0) = make_float4(o[0], o[1], o[2], o[3]);
        *(float4*)(row + e0 + 4) = make_float4(o[4], o[5], o[6], o[7]);
        uint4 pk = {pack2bf(o[0], o[1]), pack2bf(o[2], o[3]), pack2bf(o[4], o[5]), pack2bf(o[6], o[7])};
        *(uint4*)(p.x1b + (size_t)tok * DM + e0) = pk;
        const f16x2 h0 = {(_Float16)o[0], (_Float16)o[1]}, h1 = {(_Float16)o[2], (_Float16)o[3]};
        const f16x2 h2 = {(_Float16)o[4], (_Float16)o[5]}, h3 = {(_Float16)o[6], (_Float16)o[7]};
        uint4 ph = {__builtin_bit_cast(unsigned, h0), __builtin_bit_cast(unsigned, h1), __builtin_bit_cast(unsigned, h2), __builtin_bit_cast(unsigned, h3)};
        *(uint4*)(p.xb + (size_t)tok * DM + e0) = ph;
      }
    }
    __syncthreads();
    const int ts = tid & 63, qs = tid >> 6;
#pragma unroll 1
    for (int hh = 0; hh < 8; hh++) {
#pragma unroll 1
      for (int half = 0; half < 2; half++) {
        f32x16 acc[2][1];
#pragma unroll
        for (int i = 0; i < 2; i++)
#pragma unroll
          for (int r = 0; r < 16; r++) acc[i][0][r] = 0.f;
        const bf16_t* A = p.wqt + (size_t)(hh * 256 + half * 128) * DM;
        const bf16_t* Bt = p.x1b + (size_t)t0 * DM;
        Gemm<2, 1>::mainloop(acc, [&](int r) { return A + (size_t)r * DM; }, [&](int r) { return Bt + (size_t)r * DM; }, DM, smem);
        f32x16 sp[4];
#pragma unroll
        for (int nn = 0; nn < 4; nn++)
#pragma unroll
          for (int r = 0; r < 16; r++) sp[nn][r] = 0.f;
        const bf16_t* skp = half ? p.sk2p : p.sk1p;
#pragma unroll
        for (int i = 0; i < 2; i++)
#pragma unroll
          for (int s = 0; s < 2; s++) {
            uint4 qb = {pack2bf(acc[i][0][8 * s + 0], acc[i][0][8 * s + 1]), pack2bf(acc[i][0][8 * s + 2], acc[i][0][8 * s + 3]),
                        pack2bf(acc[i][0][8 * s + 4], acc[i][0][8 * s + 5]), pack2bf(acc[i][0][8 * s + 6], acc[i][0][8 * s + 7])};
            const bf16x8 qf = __builtin_bit_cast(bf16x8, qb);
#pragma unroll
            for (int nn = 0; nn < 4; nn++) {
              const bf16x8 kf = *(const bf16x8*)(skp + (size_t)(nn * 32 + c) * 128 + wm * 64 + i * 32 + s * 16 + fh * 8);
              sp[nn] = __builtin_amdgcn_mfma_f32_32x32x16_bf16(kf, qf, sp[nn], 0, 0, 0);
            }
          }
        if (wm == 0) {
#pragma unroll
          for (int nn = 0; nn < 4; nn++)
#pragma unroll
            for (int r = 0; r < 16; r++) S[(nn * 32 + (r & 3) + 8 * (r >> 2) + 4 * fh) * 64 + wn * 32 + c] = sp[nn][r];
        }
        __syncthreads();
        if (wm == 1) {
#pragma unroll
          for (int nn = 0; nn < 4; nn++)
#pragma unroll
            for (int r = 0; r < 16; r++) S[(nn * 32 + (r & 3) + 8 * (r >> 2) + 4 * fh) * 64 + wn * 32 + c] += sp[nn][r];
        }
        __syncthreads();
        unsigned L[16];
#pragma unroll
        for (int k = 0; k < 16; k++) L[k] = 0u;
#pragma unroll 4
        for (int i = 0; i < 32; i++) {
          const int n = qs * 32 + i;
          insert16(L, (f2key(S[n * 64 + ts]) & ~127u) | (unsigned)n);
        }
        merge4_lists(L, lists, ts, qs);
        if (qs == 0) {
#pragma unroll
          for (int k = 0; k < 16; k++) ablist[(half * 16 + k) * 64 + ts] = L[k];
        }
        __syncthreads();
      }
      {
        unsigned L[16];
#pragma unroll
        for (int k = 0; k < 16; k++) L[k] = 0u;
#pragma unroll 1
        for (int cc = qs; cc < 50; cc += 4) {
          const unsigned code = cand_tab[cc];
          const float sum = key2f(ablist[(code >> 4) * 64 + ts]) + key2f(ablist[(16 + (code & 15)) * 64 + ts]);
          insert16(L, (f2key(sum) & ~255u) | code);
        }
        merge4_lists(L, lists, ts, qs);
        if (qs == 0) {
          const float mx = key2f(L[0]);
          float e[16], sum = 0.f;
#pragma unroll
          for (int k = 0; k < 16; k++) { e[k] = __expf(key2f(L[k]) - mx); sum += e[k]; }
          const float inv = 1.f / sum;
#pragma unroll
          for (int k = 0; k < 16; k++) {
            const unsigned code = L[k] & 255u;
            const unsigned ia = ablist[(code >> 4) * 64 + ts] & 127u, ib = ablist[(16 + (code & 15)) * 64 + ts] & 127u;
            fin_e[ts * 16 + k] = (int)(ia * 128u + ib);
            fin_g[ts * 16 + k] = e[k] * inv;
          }
        }
        __syncthreads();
        {
          const int tt = tid >> 2, k4 = (tid & 3) * 4;
          *(int4*)(p.pexp + (size_t)(t0 + tt) * 128 + hh * 16 + k4) = *(const int4*)(fin_e + tt * 16 + k4);
          *(float4*)(p.pgate + (size_t)(t0 + tt) * 128 + hh * 16 + k4) = *(const float4*)(fin_g + tt * 16 + k4);
        }
        __syncthreads();
      }
    }
    {
      const int tokb = t0 + w * 16;
      int idc0 = p.pexp[(size_t)tokb * 128 + lane], idc1 = p.pexp[(size_t)tokb * 128 + 64 + lane];
      uint4 xq0 = *(const uint4*)(p.xb + (size_t)tokb * DM + 16 * lane), xq1 = *(const uint4*)(p.xb + (size_t)tokb * DM + 16 * lane + 8);
      uint4 bu[8];
#pragma unroll
      for (int d = 0; d < 8; d++) {
        const int id = __builtin_amdgcn_readlane(idc0, d);
        bu[d] = *(const uint4*)(p.puq + (size_t)id * DM + 16 * lane);
      }
#pragma unroll 1
      for (int rr = 0; rr < 16; rr++) {
        const int tok = tokb + rr, tokn = tokb + min(rr + 1, 15);
        const int idn0 = p.pexp[(size_t)tokn * 128 + lane];
        const uint4 xn0 = *(const uint4*)(p.xb + (size_t)tokn * DM + 16 * lane), xn1 = *(const uint4*)(p.xb + (size_t)tokn * DM + 16 * lane + 8);
        const float g0 = p.pgate[(size_t)tok * 128 + lane], g1 = p.pgate[(size_t)tok * 128 + 64 + lane];
        const float su0 = p.psu[idc0], su1 = p.psu[idc1], sv0 = p.psv[idc0], sv1 = p.psv[idc1];
        f16x2 xh[8];
        xh[0] = __builtin_bit_cast(f16x2, xq0.x); xh[1] = __builtin_bit_cast(f16x2, xq0.y); xh[2] = __builtin_bit_cast(f16x2, xq0.z); xh[3] = __builtin_bit_cast(f16x2, xq0.w);
        xh[4] = __builtin_bit_cast(f16x2, xq1.x); xh[5] = __builtin_bit_cast(f16x2, xq1.y); xh[6] = __builtin_bit_cast(f16x2, xq1.z); xh[7] = __builtin_bit_cast(f16x2, xq1.w);
        float xs = 0.f;
#pragma unroll
        for (int i = 0; i < 8; i++) xs += (float)xh[i][0] + (float)xh[i][1];
        const float xoff = 1152.f * wave_sum_uniform(xs);
        float a0 = 0.f, a1 = 0.f;
#pragma unroll 1
        for (int e0 = 0; e0 < 128; e0 += 16) {
          const int isrcA = (e0 + 8 < 64) ? idc0 : idc1;
          const int isrcB = (e0 + 16 < 64) ? idc0 : (e0 + 16 < 128) ? idc1 : idn0;
          float ps[16];
#pragma unroll
          for (int d = 0; d < 16; d++) {
            const unsigned qw[4] = {bu[d & 7].x, bu[d & 7].y, bu[d & 7].z, bu[d & 7].w};
            float s0 = 0.f, s1 = 0.f;
#pragma unroll
            for (int i = 0; i < 4; i++) {
              s0 = __builtin_amdgcn_fdot2(bytes01_h2(qw[i]), xh[2 * i], s0, false);
              s1 = __builtin_amdgcn_fdot2(bytes23_h2(qw[i]), xh[2 * i + 1], s1, false);
            }
            ps[d] = s0 + s1;
            const int id = __builtin_amdgcn_readlane((d < 8) ? isrcA : isrcB, (e0 + 8 + d) & 63);
            bu[d & 7] = *(const uint4*)(p.puq + (size_t)id * DM + 16 * lane);
          }
          const float r = reduce16x16(ps);
          const bool mine = (lane >> 4) == ((e0 >> 4) & 3);
          if (e0 < 64) a0 = mine ? r : a0; else a1 = mine ? r : a1;
        }
        a0 = (a0 - xoff) * su0;
        a1 = (a1 - xoff) * su1;
        p.pgate[(size_t)tok * 128 + lane] = g0 * gelu_exact(a0) * sv0;
        p.pgate[(size_t)tok * 128 + 64 + lane] = g1 * gelu_exact(a1) * sv1;
        idc0 = idn0; idc1 = p.pexp[(size_t)tokn * 128 + 64 + lane];
        xq0 = xn0; xq1 = xn1;
      }
      idc0 = p.pexp[(size_t)tokb * 128 + lane]; idc1 = p.pexp[(size_t)tokb * 128 + 64 + lane];
      uint4 bv[8];
#pragma unroll
      for (int d = 0; d < 8; d++) {
        const int id = __builtin_amdgcn_readlane(idc0, d);
        bv[d] = *(const uint4*)(p.pvq + (size_t)id * DM + 16 * lane);
      }
#pragma unroll 1
      for (int rr = 0; rr < 16; rr++) {
        const int tok = tokb + rr, tokn = tokb + min(rr + 1, 15);
        const int idn0 = p.pexp[(size_t)tokn * 128 + lane];
        const float w0 = p.pgate[(size_t)tok * 128 + lane], w1 = p.pgate[(size_t)tok * 128 + 64 + lane];
        float* row = p.out + (size_t)tok * DM + 16 * lane;
        const float coff = 1152.f * wave_sum_uniform(w0 + w1);
        float y[16];
#pragma unroll
        for (int i = 0; i < 16; i++) y[i] = 0.f;
#pragma unroll 1
        for (int e0 = 0; e0 < 128; e0 += 16) {
          const int isrcA = (e0 + 8 < 64) ? idc0 : idc1;
          const int isrcB = (e0 + 16 < 64) ? idc0 : (e0 + 16 < 128) ? idc1 : idn0;
          const float wsrc = (e0 < 64) ? w0 : w1;
#pragma unroll
          for (int d = 0; d < 16; d++) {
            const float wgt = readlane_f(wsrc, (e0 + d) & 63);
            const unsigned qw[4] = {bv[d & 7].x, bv[d & 7].y, bv[d & 7].z, bv[d & 7].w};
#pragma unroll
            for (int i = 0; i < 4; i++) {
              const f16x2 h01 = bytes01_h2(qw[i]), h23 = bytes23_h2(qw[i]);
              y[4 * i + 0] = fmaf(wgt, (float)h01[0], y[4 * i + 0]);
              y[4 * i + 1] = fmaf(wgt, (float)h01[1], y[4 * i + 1]);
              y[4 * i + 2] = fmaf(wgt, (float)h23[0], y[4 * i + 2]);
              y[4 * i + 3] = fmaf(wgt, (float)h23[1], y[4 * i + 3]);
            }
            const int id = __builtin_amdgcn_readlane((d < 8) ? isrcA : isrcB, (e0 + 8 + d) & 63);
            bv[d & 7] = *(const uint4*)(p.pvq + (size_t)id * DM + 16 * lane);
          }
        }
        const float4 xr0 = *(const float4*)(row), xr1 = *(const float4*)(row + 4), xr2 = *(const float4*)(row + 8), xr3 = *(const float4*)(row + 12);
        float v[16];
        v[0] = ALPHA * xr0.x + (y[0] - coff); v[1] = ALPHA * xr0.y + (y[1] - coff); v[2] = ALPHA * xr0.z + (y[2] - coff); v[3] = ALPHA * xr0.w + (y[3] - coff);
        v[4] = ALPHA * xr1.x + (y[4] - coff); v[5] = ALPHA * xr1.y + (y[5] - coff); v[6] = ALPHA * xr1.z + (y[6] - coff); v[7] = ALPHA * xr1.w + (y[7] - coff);
        v[8] = ALPHA * xr2.x + (y[8] - coff); v[9] = ALPHA * xr2.y + (y[9] - coff); v[10] = ALPHA * xr2.z + (y[10] - coff); v[11] = ALPHA * xr2.w + (y[11] - coff);
        v[12] = ALPHA * xr3.x + (y[12] - coff); v[13] = ALPHA * xr3.y + (y[13] - coff); v[14] = ALPHA * xr3.z + (y[14] - coff); v[15] = ALPHA * xr3.w + (y[15] - coff);
        float sm = 0.f;
#pragma unroll
        for (int i = 0; i < 16; i++) sm += v[i];
        const float mu = wave_sum_uniform(sm) * (1.f / DM);
        float qv = 0.f;
#pragma unroll
        for (int i = 0; i < 16; i++) { v[i] -= mu; qv += v[i] * v[i]; }
        const float rs = rsqrtf(wave_sum_uniform(qv) * (1.f / DM) + 1e-5f);
#pragma unroll
        for (int i4 = 0; i4 < 4; i4++) {
          const float4 gg = *(const float4*)(p.ln2g + 16 * lane + 4 * i4), bb = *(const float4*)(p.ln2b + 16 * lane + 4 * i4);
          *(float4*)(row + 4 * i4) = make_float4(v[4 * i4 + 0] * rs * gg.x + bb.x, v[4 * i4 + 1] * rs * gg.y + bb.y,
                                                 v[4 * i4 + 2] * rs * gg.z + bb.z, v[4 * i4 + 3] * rs * gg.w + bb.w);
        }
        idc0 = idn0; idc1 = p.pexp[(size_t)tokn * 128 + 64 + lane];
      }
    }
    __syncthreads();
  }
}

__device__ __forceinline__ void cbias_phase(const Params& p, int bid, int nblk) {
  const int which = threadIdx.x >> 7, j = threadIdx.x & 127;
  const float* w1 = which ? p.w1v : p.w1k;
  const float* pe = which ? p.pe_v : p.pe_k;
  for (int ch = bid; ch < 64; ch += nblk) {
    float a = 0.f;
#pragma unroll 8
    for (int r = ch * 32; r < ch * 32 + 32; r++) a = fmaf(pe[r], w1[(size_t)r * 128 + j], a);
    p.cbias[ch * 256 + which * 128 + j] = a;
  }
}
__device__ __forceinline__ void compress_phase(const Params& p, unsigned char* smem, int bid, int nblk) {
  typedef Gemm<1, 2> G;
  const int tid = threadIdx.x, lane = tid & 63, w = tid >> 6, wm = w >> 1, wn = w & 1, c = lane & 31, fh = lane >> 5;
  float* hid = (float*)smem;
  float* cb = (float*)(smem + 49152);
  if (bid < NB * 2 * 2 * 4) {
    float a = 0.f;
    for (int ch = 0; ch < 64; ch++) a += p.cbias[ch * 256 + tid];
    cb[tid] = a;
  }
  __syncthreads();
  for (int item = bid; item < NB * 2 * 2 * 4; item += nblk) {
    const int mt = item & 3, which = (item >> 2) & 1, bgi = item >> 3;
    const int m0 = mt * 64;
    const bf16_t* A = (which ? p.kvn[1] : p.kvn[0]) + (size_t)bgi * SEQ * 64;
    const bf16_t* Bt = which ? p.w1vt : p.w1kt;
    f32x16 acc[1][2];
#pragma unroll
    for (int j = 0; j < 2; j++)
#pragma unroll
      for (int r = 0; r < 16; r++) acc[0][j][r] = 0.f;
    G::mainloop(acc, [&](int r) { const int i = min(m0 + r, NC - 1); return A + (size_t)i * 1024; },
                [&](int r) { return Bt + (size_t)r * 2048; }, 2048, smem);
#pragma unroll
    for (int j = 0; j < 2; j++)
#pragma unroll
      for (int r = 0; r < 16; r++) {
        const int row = wm * 32 + (r & 3) + 8 * (r >> 2) + 4 * fh, col = (wn * 2 + j) * 32 + c;
        hid[row * 129 + col] = gelu_exact(acc[0][j][r] + cb[which * 128 + col]);
      }
    __syncthreads();
    {
      const int row = tid >> 2, dq = (tid & 3) * 16;
      const float* w2 = which ? p.w2v : p.w2k;
      float o[16];
#pragma unroll
      for (int i = 0; i < 16; i++) o[i] = 0.f;
      for (int k = 0; k < 128; k++) {
        const float h = hid[row * 129 + k];
        const float4 w0 = *(const float4*)(w2 + k * 64 + dq), w1_ = *(const float4*)(w2 + k * 64 + dq + 4);
        const float4 w2_ = *(const float4*)(w2 + k * 64 + dq + 8), w3 = *(const float4*)(w2 + k * 64 + dq + 12);
        o[0] = fmaf(h, w0.x, o[0]); o[1] = fmaf(h, w0.y, o[1]); o[2] = fmaf(h, w0.z, o[2]); o[3] = fmaf(h, w0.w, o[3]);
        o[4] = fmaf(h, w1_.x, o[4]); o[5] = fmaf(h, w1_.y, o[5]); o[6] = fmaf(h, w1_.z, o[6]); o[7] = fmaf(h, w1_.w, o[7]);
        o[8] = fmaf(h, w2_.x, o[8]); o[9] = fmaf(h, w2_.y, o[9]); o[10] = fmaf(h, w2_.z, o[10]); o[11] = fmaf(h, w2_.w, o[11]);
        o[12] = fmaf(h, w3.x, o[12]); o[13] = fmaf(h, w3.y, o[13]); o[14] = fmaf(h, w3.z, o[14]); o[15] = fmaf(h, w3.w, o[15]);
      }
      const int i = m0 + row;
      const bool valid = i < NC;
      if (which == 0) {
        bf16_t* dst = p.kcb + ((size_t)bgi * 256 + i) * 64 + dq;
        uint4 u0 = {pack2bf(o[0], o[1]), pack2bf(o[2], o[3]), pack2bf(o[4], o[5]), pack2bf(o[6], o[7])};
        uint4 u1 = {pack2bf(o[8], o[9]), pack2bf(o[10], o[11]), pack2bf(o[12], o[13]), pack2bf(o[14], o[15])};
        if (!valid) { u0 = make_uint4(0, 0, 0, 0); u1 = u0; }
        *(uint4*)dst = u0; *(uint4*)(dst + 8) = u1;
      } else {
#pragma unroll
        for (int e = 0; e < 16; e++) p.vct[((size_t)bgi * 64 + dq + e) * 256 + perm16(i)] = valid ? f2bf(o[e]) : (bf16_t)0;
      }
    }
    __syncthreads();
  }
}

__device__ __forceinline__ void softmax4(float* sc, int ld, int n) {
  const int w = threadIdx.x >> 6, lane = threadIdx.x & 63;
  float* s = sc + w * ld;
  float m = -INFINITY;
  for (int i = lane; i < n; i += 64) m = fmaxf(m, s[i]);
  m = wave_max(m);
  if (m == -INFINITY) m = 0.f;
  float sum = 0.f;
  for (int i = lane; i < n; i += 64) { float e = expf(s[i] - m); s[i] = e; sum += e; }
  sum = wave_sum(sum);
  const float inv = 1.f / (sum > 0.f ? sum : 1.f);
  for (int i = lane; i < n; i += 64) s[i] *= inv;
}
__device__ __forceinline__ float dot64_bf(const float* q, const bf16_t* k) {
  float s = 0.f;
#pragma unroll
  for (int e = 0; e < 64; e += 8) {
    const uint4 v = *(const uint4*)(k + e);
    const unsigned u[4] = {v.x, v.y, v.z, v.w};
#pragma unroll
    for (int i = 0; i < 4; i++) {
      s = fmaf(q[e + 2 * i], __uint_as_float(u[i] << 16), s);
      s = fmaf(q[e + 2 * i + 1], __uint_as_float(u[i] & 0xFFFF0000u), s);
    }
  }
  return s;
}

template <class KRow, class VRow, class Body>
__device__ __forceinline__ void flash_stream(unsigned char* smem, int j0, int j1, KRow krow, VRow vrow, Body body) {
  if (j0 >= j1) return;
  Tile2 rk = tile_fetch([&](int r) __attribute__((always_inline)) { return krow(j0, r); });
  Tile2 rv = tile_fetch([&](int r) __attribute__((always_inline)) { return vrow(j0, r); });
  __syncthreads();
  tile_store(rk, smem); tile_store(rv, smem + FL_TILE);
  __syncthreads();
#pragma unroll 1
  for (int j = j0; j < j1; j++) {
    unsigned char* cur = smem + ((j - j0) & 1) * FL_STAGE;
    if (j + 1 < j1) {
      rk = tile_fetch([&](int r) __attribute__((always_inline)) { return krow(j + 1, r); });
      rv = tile_fetch([&](int r) __attribute__((always_inline)) { return vrow(j + 1, r); });
    }
    body(cur, j);
    if (j + 1 < j1) { unsigned char* nxt = smem + ((j - j0 + 1) & 1) * FL_STAGE; tile_store(rk, nxt); tile_store(rv, nxt + FL_TILE); }
    __syncthreads();
  }
}
__device__ __forceinline__ float quad_sum(float x) {
  x += __builtin_bit_cast(float, __builtin_amdgcn_update_dpp(0, __builtin_bit_cast(int, x), 0xB1, 0xF, 0xF, true));
  x += __builtin_bit_cast(float, __builtin_amdgcn_update_dpp(0, __builtin_bit_cast(int, x), 0x4E, 0xF, 0xF, true));
  return x;
}
__device__ __forceinline__ void nsa_flash_item(const Params& p, unsigned char* smem, int item) {
  const int tid = threadIdx.x, lane = tid & 63, w = tid >> 6, fr = lane & 31, fh = lane >> 5;
  const int cc = item & 127, g = (item >> 7) & 1, b = item >> 8;
  const int c64 = cc >> 1;
  const int t0 = cc * 32;
  const int tl = 8 * w + (fr >> 2), hq = fr & 3;
  const int t = t0 + tl, tok = b * SEQ + t;
  const int t64 = t & 63;
  float* impS = (float*)smem;
  unsigned* selm = (unsigned*)(smem + 32 * 65 * 4);
  float* stash = (float*)(smem + 2 * FL_STAGE) + w * 2048 + lane;
  bf16x8 qf[4];
  flash_load_q(qf, p.qn + (size_t)tok * 512 + g * 256 + hq * 64, 0.125f);
  const float* gt = p.gates + (size_t)tok * 24 + (g * 4 + hq) * 3;
  const float g_cmp = gt[0], g_sel = gt[1], g_win = gt[2];
  const size_t bg = (size_t)(b * 2 + g);
  {
    const int nvmax = 2 * cc + 1, nkb = (nvmax + 63) >> 6;
    const int nvl = (t >= 31) ? ((t - 31) >> 4) + 1 : 0;
    const bf16_t* kcb = p.kcb + bg * 256 * 64;
    const bf16_t* vct = p.vct + bg * 64 * 256;
    auto krow = [&](int j, int r) __attribute__((always_inline)) { return kcb + (size_t)(j * 64 + r) * 64; };
    auto vrow = [&](int j, int r) __attribute__((always_inline)) { return vct + (size_t)r * 256 + j * 64; };
    float m = -INFINITY, l = 0.f;
    flash_stream(smem, 0, nkb, krow, vrow, [&](unsigned char* cur, int j) __attribute__((always_inline)) {
      f32x16 s[2];
      flash_qk(s, cur, qf);
      float mx = -INFINITY;
#pragma unroll
      for (int kt = 0; kt < 2; kt++)
#pragma unroll
        for (int r = 0; r < 16; r++) {
          const int n = j * 64 + kt * 32 + (r & 3) + 8 * (r >> 2) + 4 * fh;
          s[kt][r] = (n < nvl) ? s[kt][r] : -INFINITY;
          mx = fmaxf(mx, s[kt][r]);
        }
      mx = fmaxf(mx, __shfl_xor(mx, 32));
      const float mnew = fmaxf(m, mx);
      const float muse = (mnew == -INFINITY) ? 0.f : mnew;
      float sum = 0.f;
#pragma unroll
      for (int kt = 0; kt < 2; kt++)
#pragma unroll
        for (int r = 0; r < 16; r++) sum += __builtin_amdgcn_exp2f((s[kt][r] - muse) * LOG2E);
      l = l * __builtin_amdgcn_exp2f((m - muse) * LOG2E) + sum;
      m = mnew;
    });
    const float lt = l + __shfl_xor(l, 32);
    const float il = lt > 0.f ? 1.f / lt : 0.f;
    const float muse = (m == -INFINITY) ? 0.f : m;
    {
      f32x16 oc[2];
#pragma unroll
      for (int i = 0; i < 2; i++)
#pragma unroll
        for (int r = 0; r < 16; r++) oc[i][r] = 0.f;
      flash_stream(smem, 0, nkb, krow, vrow, [&](unsigned char* cur, int j) __attribute__((always_inline)) {
        f32x16 s[2];
        flash_qk(s, cur, qf);
#pragma unroll
        for (int kt = 0; kt < 2; kt++)
#pragma unroll
          for (int r = 0; r < 16; r++) {
            const int n = j * 64 + kt * 32 + (r & 3) + 8 * (r >> 2) + 4 * fh;
            s[kt][r] = (n < nvl) ? __builtin_amdgcn_exp2f((s[kt][r] - muse) * LOG2E) * il : 0.f;
          }
#pragma unroll
        for (int kt = 0; kt < 2; kt++)
#pragma unroll
          for (int h8 = 0; h8 < 2; h8++) {
            const bf16x8 pf = pack_frag(s[kt], h8);
#pragma unroll
            for (int dt = 0; dt < 2; dt++)
              oc[dt] = __builtin_amdgcn_mfma_f32_32x32x16_bf16(lds_frag(cur + FL_TILE, dt * 32 + fr, 4 * kt + 2 * h8 + fh), pf, oc[dt], 0, 0, 0);
          }
      });
#pragma unroll
      for (int dt = 0; dt < 2; dt++)
#pragma unroll
        for (int r = 0; r < 16; r++) stash[(dt * 16 + r) * 64] = g_cmp * oc[dt][r];
    }
    f32x16 imp[2];
#pragma unroll
    for (int i = 0; i < 2; i++)
#pragma unroll
      for (int r = 0; r < 16; r++) imp[i][r] = 0.f;
    flash_stream(smem, 0, nkb, krow, vrow, [&](unsigned char* cur, int j) __attribute__((always_inline)) {
      f32x16 s[2];
      flash_qk(s, cur, qf);
#pragma unroll
      for (int kt = 0; kt < 2; kt++)
#pragma unroll
        for (int r = 0; r < 16; r++) {
          const int n = j * 64 + kt * 32 + (r & 3) + 8 * (r >> 2) + 4 * fh;
          s[kt][r] = (n < nvl) ? __builtin_amdgcn_exp2f((s[kt][r] - muse) * LOG2E) * il : 0.f;
        }
#pragma unroll
      for (int kt = 0; kt < 2; kt++)
#pragma unroll
        for (int h8 = 0; h8 < 2; h8++) {
          const bf16x8 pf = pack_frag(s[kt], h8);
#pragma unroll
          for (int mt = 0; mt < 2; mt++) {
            const bf16x8 of = *(const bf16x8*)(p.ovp + (size_t)(mt * 32 + fr) * 256 + j * 64 + kt * 32 + h8 * 16 + fh * 8);
            imp[mt] = __builtin_amdgcn_mfma_f32_32x32x16_bf16(of, pf, imp[mt], 0, 0, 0);
          }
        }
    });
#pragma unroll
    for (int mt = 0; mt < 2; mt++)
#pragma unroll
      for (int r = 0; r < 16; r++) imp[mt][r] = quad_sum(imp[mt][r]);
#pragma unroll
    for (int mt = 0; mt < 2; mt++)
#pragma unroll
      for (int g4 = 0; g4 < 4; g4++) {
        const float v = (hq == 0) ? imp[mt][4 * g4 + 0] : (hq == 1) ? imp[mt][4 * g4 + 1] : (hq == 2) ? imp[mt][4 * g4 + 2] : imp[mt][4 * g4 + 3];
        impS[tl * 65 + mt * 32 + hq + 8 * g4 + 4 * fh] = v;
      }
    __syncthreads();
    {
      const int tk = tid >> 3, part = tid & 7;
      const float* row = impS + tk * 65;
      unsigned bits = 0;
#pragma unroll 1
      for (int i = 0; i < 8; i++) {
        const int mb = part * 8 + i;
        const bool vis = mb <= c64;
        const bool forced = (mb == 0) || (mb == c64) || (mb == c64 - 1);
        const float sm = vis ? row[mb] + (forced ? 1e4f : 0.f) : -INFINITY;
        int rank = 0;
        for (int m2 = 0; m2 < 64; m2++) {
          const bool vis2 = m2 <= c64;
          const bool f2 = (m2 == 0) || (m2 == c64) || (m2 == c64 - 1);
          const float s2 = vis2 ? row[m2] + (f2 ? 1e4f : 0.f) : -INFINITY;
          rank += (s2 > sm) || (s2 == sm && m2 < mb);
        }
        if (rank < 16 && vis) bits |= 1u << i;
      }
      unsigned lo = (part < 4) ? (bits << (8 * part)) : 0u, hi = (part >= 4) ? (bits << (8 * (part - 4))) : 0u;
      lo |= __shfl_xor(lo, 1); hi |= __shfl_xor(hi, 1);
      lo |= __shfl_xor(lo, 2); hi |= __shfl_xor(hi, 2);
      lo |= __shfl_xor(lo, 4); hi |= __shfl_xor(hi, 4);
      if (part == 0) { selm[tk * 2] = lo; selm[tk * 2 + 1] = hi; }
    }
    __syncthreads();
  }
  const unsigned sel_lo = selm[tl * 2], sel_hi = selm[tl * 2 + 1];
  {
    const bf16_t* kb_ = p.kvn[2] + bg * SEQ * 64;
    const bf16_t* vt_ = p.vslct + bg * 64 * SEQ;
    FlashAcc acc; flash_init(acc);
    flash_stream(smem, 0, c64 + 1,
      [&](int j, int r) __attribute__((always_inline)) { return kb_ + (size_t)(j * 64 + r) * 64; },
      [&](int j, int r) __attribute__((always_inline)) { return vt_ + (size_t)r * SEQ + j * 64; },
      [&](unsigned char* cur, int j) __attribute__((always_inline)) {
        f32x16 s[2];
        flash_qk(s, cur, qf);
        const bool selj = ((j < 32) ? (sel_lo >> j) : (sel_hi >> (j - 32))) & 1u;
        if (j == c64) {
#pragma unroll
          for (int kt = 0; kt < 2; kt++)
#pragma unroll
            for (int r = 0; r < 16; r++) {
              const int kl = kt * 32 + (r & 3) + 8 * (r >> 2) + 4 * fh;
              s[kt][r] = (kl <= t64) ? s[kt][r] : -INFINITY;
            }
        }
        flash_update(acc, s, cur + FL_TILE, selj);
      });
    const float sc_ = g_sel * flash_inv_l(acc);
#pragma unroll
    for (int dt = 0; dt < 2; dt++)
#pragma unroll
      for (int r = 0; r < 16; r++) stash[(dt * 16 + r) * 64] += sc_ * acc.o[dt][r];
  }
  {
    const bf16_t* kb_ = p.kvn[4] + bg * SEQ * 64;
    const bf16_t* vt_ = p.vwint + bg * 64 * SEQ;
    FlashAcc acc; flash_init(acc);
    const int jlo = c64 - 8;
    flash_stream(smem, jlo < 0 ? 0 : jlo, c64 + 1,
      [&](int j, int r) __attribute__((always_inline)) { return kb_ + (size_t)(j * 64 + r) * 64; },
      [&](int j, int r) __attribute__((always_inline)) { return vt_ + (size_t)r * SEQ + j * 64; },
      [&](unsigned char* cur, int j) __attribute__((always_inline)) {
        f32x16 s[2];
        flash_qk(s, cur, qf);
        if (j == c64) {
#pragma unroll
          for (int kt = 0; kt < 2; kt++)
#pragma unroll
            for (int r = 0; r < 16; r++) {
              const int kl = kt * 32 + (r & 3) + 8 * (r >> 2) + 4 * fh;
              s[kt][r] = (kl <= t64) ? s[kt][r] : -INFINITY;
            }
        } else if (j == jlo) {
#pragma unroll
          for (int kt = 0; kt < 2; kt++)
#pragma unroll
            for (int r = 0; r < 16; r++) {
              const int kl = kt * 32 + (r & 3) + 8 * (r >> 2) + 4 * fh;
              s[kt][r] = (kl > t64) ? s[kt][r] : -INFINITY;
            }
        }
        flash_update(acc, s, cur + FL_TILE);
      });
    const float sc_ = g_win * flash_inv_l(acc);
    bf16_t* orow = p.concat + (size_t)tok * DM + g * 256 + hq * 64;
#pragma unroll
    for (int dt = 0; dt < 2; dt++)
#pragma unroll
      for (int g4 = 0; g4 < 4; g4++) {
        float o4[4];
#pragma unroll
        for (int i = 0; i < 4; i++) o4[i] = stash[(dt * 16 + 4 * g4 + i) * 64] + sc_ * acc.o[dt][4 * g4 + i];
        uint2 o = {pack2bf(o4[0], o4[1]), pack2bf(o4[2], o4[3])};
        *(uint2*)(orow + dt * 32 + 8 * g4 + 4 * fh) = o;
      }
  }
}
__device__ __forceinline__ void nsa_phase(const Params& p, unsigned char* smem, int bid, int nblk) {
  for (int it = bid; it < NB * 2 * 128; it += nblk) {
    const int cc = 127 - (it >> 4), bgi = it & 15;
    nsa_flash_item(p, smem, (bgi << 7) | cc);
  }
}

typedef __attribute__((ext_vector_type(4))) float f32x4v;
typedef __attribute__((ext_vector_type(4))) short s16x4;
__device__ __forceinline__ float wave_max_uniform(float x) {
  x = fmaxf(x, __builtin_bit_cast(float, __builtin_amdgcn_update_dpp(0, __builtin_bit_cast(int, x), 0xB1, 0xF, 0xF, true)));
  x = fmaxf(x, __builtin_bit_cast(float, __builtin_amdgcn_update_dpp(0, __builtin_bit_cast(int, x), 0x4E, 0xF, 0xF, true)));
  x = fmaxf(x, __builtin_bit_cast(float, __builtin_amdgcn_update_dpp(0, __builtin_bit_cast(int, x), 0x141, 0xF, 0xF, true)));
  x = fmaxf(x, __builtin_bit_cast(float, __builtin_amdgcn_update_dpp(0, __builtin_bit_cast(int, x), 0x140, 0xF, 0xF, true)));
  return fmaxf(fmaxf(readlane_f(x, 0), readlane_f(x, 16)), fmaxf(readlane_f(x, 32), readlane_f(x, 48)));
}
__device__ __forceinline__ int dsa_vswz(int row) { return ((row >> 1) & 1) | ((row >> 2) & 2); }
__device__ __forceinline__ void dsa_item(const Params& p, unsigned char* smem, int b, int tg) {
  unsigned* keys = (unsigned*)smem;
  unsigned char* vst = smem;
  int* hist = (int*)(smem + 32768);
  int* sel = hist + 3584;
  int* cnt = sel + 512;
  float* sc = (float*)(cnt + 16);
  float* part = sc + 2048;
  const int tid = threadIdx.x, lane = tid & 63, w = tid >> 6;
  const int row16 = lane & 15, kg = lane >> 4;
  const int t0 = 2 * tg;
  const size_t tokb = (size_t)b * SEQ;
  const bf16_t* kib = p.ki + tokb * 32;
  const bf16_t* kdb = p.kd + tokb * 64;
  const bf16_t* vdb = p.vd + tokb * 64;
  const int n = t0 + 2;
  if (n > 256) {
#pragma unroll
    for (int i = 0; i < 14; i++) hist[tid + 256 * i] = 0;
    {
      const bf16x8 af = *(const bf16x8*)(p.qi + (tokb + t0 + (row16 >> 3)) * 256 + (row16 & 7) * 32 + kg * 8);
      const int tk = lane >> 5;
      const float4 wv = *(const float4*)(p.widx + (tokb + t0 + tk) * 8 + 4 * (kg & 1));
      const int ntile = (n + 15) >> 4;
#pragma unroll 1
      for (int kt0 = w * 4; kt0 < ntile; kt0 += 16) {
        bf16x8 bfr[4];
#pragma unroll
        for (int u = 0; u < 4; u++) {
          const int key = min(kt0 + u, ntile - 1) * 16 + row16;
          bfr[u] = *(const bf16x8*)(kib + (size_t)key * 32 + kg * 8);
        }
#pragma unroll
        for (int u = 0; u < 4; u++) {
          f32x4v acc = {0.f, 0.f, 0.f, 0.f};
          acc = __builtin_amdgcn_mfma_f32_16x16x32_bf16(af, bfr[u], acc, 0, 0, 0);
          float s = wv.x * fmaxf(acc[0], 0.f) + wv.y * fmaxf(acc[1], 0.f) + wv.z * fmaxf(acc[2], 0.f) + wv.w * fmaxf(acc[3], 0.f);
          s += __shfl_xor(s, 16);
          const int key = (kt0 + u) * 16 + row16;
          if ((kg & 1) == 0 && kt0 + u < ntile) {
            const unsigned kv_ = (key <= t0 + tk) ? f2key(s) : 0u;
            keys[tk * 4096 + key] = kv_;
            atomicAdd(&hist[1536 + tk * 1024 + (lane & 3) * 256 + (kv_ >> 24)], 1);
          }
        }
      }
    }
    __syncthreads();
    const int tk = w >> 1, hf = w & 1;
    const int npad = ((n + 15) >> 4) << 4, nh = npad >> 1;
    const unsigned* kt_ = keys + tk * 4096;
    const int i0 = hf * nh, i1 = i0 + nh;
    unsigned prefix = 0; int kk = 256;
#pragma unroll 1
    for (int pass = 0; pass < 4; pass++) {
      const int shift = 24 - 8 * pass;
      int* hp = (pass == 0) ? hist + 1536 + tk * 1024 : hist + (pass - 1) * 512 + tk * 256;
      int* hpa = (pass == 0) ? hp + (lane & 3) * 256 : hp;
      const unsigned hmask = (shift == 24) ? 0u : (0xFFFFFFFFu << (shift + 8));
      if (pass > 0)
#pragma unroll 2
      for (int base = i0 + 4 * lane; base < i1; base += 256) {
        const uint4 k4 = *(const uint4*)(kt_ + base);
        if ((k4.x & hmask) == prefix) atomicAdd(&hpa[(k4.x >> shift) & 255], 1);
        if ((k4.y & hmask) == prefix) atomicAdd(&hpa[(k4.y >> shift) & 255], 1);
        if ((k4.z & hmask) == prefix) atomicAdd(&hpa[(k4.z >> shift) & 255], 1);
        if ((k4.w & hmask) == prefix) atomicAdd(&hpa[(k4.w >> shift) & 255], 1);
      }
      __syncthreads();
      {
        int4 c4 = *(const int4*)(hp + lane * 4);
        if (pass == 0) {
#pragma unroll
          for (int cp = 1; cp < 4; cp++) {
            const int4 d4 = *(const int4*)(hp + cp * 256 + lane * 4);
            c4.x += d4.x; c4.y += d4.y; c4.z += d4.z; c4.w += d4.w;
          }
        }
        const int tl_ = c4.x + c4.y + c4.z + c4.w;
        int P = tl_;
        P += __builtin_amdgcn_update_dpp(0, P, 0x111, 0xF, 0xF, false);
        P += __builtin_amdgcn_update_dpp(0, P, 0x112, 0xF, 0xF, false);
        P += __builtin_amdgcn_update_dpp(0, P, 0x114, 0xF, 0xF, false);
        P += __builtin_amdgcn_update_dpp(0, P, 0x118, 0xF, 0xF, false);
        P += __builtin_amdgcn_update_dpp(0, P, 0x142, 0xA, 0xF, false);
        P += __builtin_amdgcn_update_dpp(0, P, 0x143, 0xC, 0xF, false);
        const int total = __builtin_amdgcn_readlane(P, 63);
        const int R = total - P + tl_;
        const int a3 = R - tl_, a2 = a3 + c4.w, a1 = a2 + c4.z, a0 = a1 + c4.y;
        const bool found = (a3 < kk) && (kk <= R);
        int dloc, above;
        if (kk <= a2) { dloc = 3; above = a3; } else if (kk <= a1) { dloc = 2; above = a2; } else if (kk <= a0) { dloc = 1; above = a1; } else { dloc = 0; above = a0; }
        const unsigned long long bm = __ballot(found);
        const int src = __ffsll((long long)bm) - 1;
        const int dsel = __builtin_amdgcn_readlane(lane * 4 + dloc, src);
        const int abv = __builtin_amdgcn_readlane(above, src);
        prefix |= ((unsigned)dsel) << shift;
        kk -= abv;
      }
    }
    {
      int cg_ = 0, ce = 0;
#pragma unroll 2
      for (int base = i0 + 4 * lane; base < i1; base += 256) {
        const uint4 k4 = *(const uint4*)(kt_ + base);
        cg_ += (k4.x > prefix) + (k4.y > prefix) + (k4.z > prefix) + (k4.w > prefix);
        ce += (k4.x == prefix) + (k4.y == prefix) + (k4.z == prefix) + (k4.w == prefix);
      }
      cg_ = (int)wave_sum_uniform((float)cg_); ce = (int)wave_sum_uniform((float)ce);
      if (lane == 0) { cnt[(tk * 2 + hf) * 2] = cg_; cnt[(tk * 2 + hf) * 2 + 1] = ce; }
    }
    __syncthreads();
    {
      int bgt = hf ? cnt[(tk * 2) * 2] : 0, beq = hf ? cnt[(tk * 2) * 2 + 1] : 0;
      const int ngt = 256 - kk;
      const unsigned long long lt = (1ull << lane) - 1ull;
#pragma unroll 1
      for (int base = i0 + 4 * lane; base < i1; base += 256) {
        const uint4 k4 = *(const uint4*)(kt_ + base);
        const unsigned kq[4] = {k4.x, k4.y, k4.z, k4.w};
        unsigned long long mg[4], me[4];
#pragma unroll
        for (int j = 0; j < 4; j++) { mg[j] = __ballot(kq[j] > prefix); me[j] = __ballot(kq[j] == prefix); }
        int pg = bgt + __popcll(mg[0] & lt) + __popcll(mg[1] & lt) + __popcll(mg[2] & lt) + __popcll(mg[3] & lt);
        int pe = beq + __popcll(me[0] & lt) + __popcll(me[1] & lt) + __popcll(me[2] & lt) + __popcll(me[3] & lt);
#pragma unroll
        for (int j = 0; j < 4; j++) {
          if (kq[j] > prefix) { sel[tk * 256 + pg] = base + j; pg++; }
          else if (kq[j] == prefix) { if (pe < kk) sel[tk * 256 + ngt + pe] = base + j; pe++; }
        }
        bgt += __popcll(mg[0]) + __popcll(mg[1]) + __popcll(mg[2]) + __popcll(mg[3]);
        beq += __popcll(me[0]) + __popcll(me[1]) + __popcll(me[2]) + __popcll(me[3]);
      }
    }
    __syncthreads();
  } else {
    for (int i = tid; i < 512; i += 256) sel[i] = i & 255;
    __syncthreads();
  }
  {
    const int tk = w >> 1, hf = w & 1;
    const int nsel = min(256, t0 + tk + 1);
    const size_t tok = tokb + t0 + tk;
    const int* selt = sel + tk * 256;
    float* sct = sc + tk * 1024;
    bf16_t* pbt = (bf16_t*)(part) + tk * 1024;
    unsigned char* vw = vst + w * 8192;
    const int kk8 = lane >> 3, ch = lane & 7;
    const int q4 = row16 >> 2, pp = row16 & 3;
#define DSA_VLOAD(dst, it_, base_) dst = *(const uint4*)(vdb + (size_t)selt[min((base_) + (it_) * 8 + kk8, nsel - 1)] * 64 + ch * 8)
#define DSA_VSTORE(src, it_) { const int key_ = (it_) * 8 + kk8; *(uint4*)(vw + key_ * 128 + ((((ch >> 1) ^ dsa_vswz(key_))) << 5) + ((ch & 1) << 4)) = src; }
    uint4 vv0, vv1, vv2, vv3, vv4, vv5, vv6, vv7;
    DSA_VLOAD(vv0, 0, hf * 128); DSA_VLOAD(vv1, 1, hf * 128); DSA_VLOAD(vv2, 2, hf * 128); DSA_VLOAD(vv3, 3, hf * 128);
    DSA_VLOAD(vv4, 4, hf * 128); DSA_VLOAD(vv5, 5, hf * 128); DSA_VLOAD(vv6, 6, hf * 128); DSA_VLOAD(vv7, 7, hf * 128);
    {
      bf16x8 qf[2];
#pragma unroll
      for (int ks = 0; ks < 2; ks++) {
        uint4 u = make_uint4(0, 0, 0, 0);
        if (row16 < 4) u = *(const uint4*)(p.qd + tok * 256 + row16 * 64 + ks * 32 + kg * 8);
        qf[ks] = __builtin_bit_cast(bf16x8, u);
      }
#pragma unroll 1
      for (int ck = 0; ck < 2; ck++) {
        bf16x8 kf[4][2];
#pragma unroll
        for (int ti = 0; ti < 4; ti++) {
          const int r = hf * 128 + ck * 64 + ti * 16 + row16;
          const int idx = selt[min(r, nsel - 1)];
#pragma unroll
          for (int ks = 0; ks < 2; ks++) kf[ti][ks] = *(const bf16x8*)(kdb + (size_t)idx * 64 + ks * 32 + kg * 8);
        }
#pragma unroll
        for (int ti = 0; ti < 4; ti++) {
          f32x4v acc = {0.f, 0.f, 0.f, 0.f};
          acc = __builtin_amdgcn_mfma_f32_16x16x32_bf16(kf[ti][0], qf[0], acc, 0, 0, 0);
          acc = __builtin_amdgcn_mfma_f32_16x16x32_bf16(kf[ti][1], qf[1], acc, 0, 0, 0);
          if (row16 < 4) {
#pragma unroll
            for (int r = 0; r < 4; r++) {
              const int key = hf * 128 + ck * 64 + ti * 16 + 4 * kg + r;
              sct[row16 * 256 + key] = (key < nsel) ? acc[r] * 0.125f : -INFINITY;
            }
          }
        }
      }
    }
    __syncthreads();
#pragma unroll
    for (int hh = 0; hh < 2; hh++) {
      const int h = 2 * hf + hh;
      float v0 = sct[h * 256 + lane], v1 = sct[h * 256 + 64 + lane], v2 = sct[h * 256 + 128 + lane], v3 = sct[h * 256 + 192 + lane];
      const float mx = wave_max_uniform(fmaxf(fmaxf(v0, v1), fmaxf(v2, v3)));
      v0 = __expf(v0 - mx); v1 = __expf(v1 - mx); v2 = __expf(v2 - mx); v3 = __expf(v3 - mx);
      const float inv = 1.f / wave_sum_uniform((v0 + v1) + (v2 + v3));
      pbt[h * 256 + lane] = f2bf(v0 * inv); pbt[h * 256 + 64 + lane] = f2bf(v1 * inv);
      pbt[h * 256 + 128 + lane] = f2bf(v2 * inv); pbt[h * 256 + 192 + lane] = f2bf(v3 * inv);
    }
    __syncthreads();
    f32x4v oacc[4];
#pragma unroll
    for (int nt = 0; nt < 4; nt++) oacc[nt] = f32x4v{0.f, 0.f, 0.f, 0.f};
#pragma unroll 1
    for (int ck = 0; ck < 2; ck++) {
      DSA_VSTORE(vv0, 0); DSA_VSTORE(vv1, 1); DSA_VSTORE(vv2, 2); DSA_VSTORE(vv3, 3);
      DSA_VSTORE(vv4, 4); DSA_VSTORE(vv5, 5); DSA_VSTORE(vv6, 6); DSA_VSTORE(vv7, 7);
      if (ck == 0) {
        const int nb_ = hf * 128 + 64;
        DSA_VLOAD(vv0, 0, nb_); DSA_VLOAD(vv1, 1, nb_); DSA_VLOAD(vv2, 2, nb_); DSA_VLOAD(vv3, 3, nb_);
        DSA_VLOAD(vv4, 4, nb_); DSA_VLOAD(vv5, 5, nb_); DSA_VLOAD(vv6, 6, nb_); DSA_VLOAD(vv7, 7, nb_);
      }
      __builtin_amdgcn_wave_barrier();
      bf16x8 pf[2];
#pragma unroll
      for (int ks = 0; ks < 2; ks++) {
        uint4 u = make_uint4(0, 0, 0, 0);
        if (row16 < 4) u = *(const uint4*)(pbt + row16 * 256 + hf * 128 + ck * 64 + ks * 32 + kg * 8);
        pf[ks] = __builtin_bit_cast(bf16x8, u);
      }
#pragma unroll
      for (int nt = 0; nt < 4; nt++) {
#pragma unroll
        for (int ks = 0; ks < 2; ks++) {
          const int r0 = ks * 32 + kg * 8 + q4, r1 = r0 + 4;
          const s16x4 lo = __builtin_amdgcn_ds_read_tr16_b64_v4i16((s16x4 __attribute__((address_space(3)))*)(vw + r0 * 128 + ((nt ^ dsa_vswz(r0)) << 5) + pp * 8));
          const s16x4 hi = __builtin_amdgcn_ds_read_tr16_b64_v4i16((s16x4 __attribute__((address_space(3)))*)(vw + r1 * 128 + ((nt ^ dsa_vswz(r1)) << 5) + pp * 8));
          typedef __attribute__((ext_vector_type(8))) short s16x8;
          const s16x8 v8 = __builtin_shufflevector(lo, hi, 0, 1, 2, 3, 4, 5, 6, 7);
          oacc[nt] = __builtin_amdgcn_mfma_f32_16x16x32_bf16(pf[ks], __builtin_bit_cast(bf16x8, v8), oacc[nt], 0, 0, 0);
        }
      }
      __builtin_amdgcn_wave_barrier();
    }
#undef DSA_VLOAD
#undef DSA_VSTORE
    __syncthreads();
    if (kg == 0) {
#pragma unroll
      for (int nt = 0; nt < 4; nt++)
#pragma unroll
        for (int r = 0; r < 4; r++) part[(w * 4 + r) * 64 + nt * 16 + row16] = oacc[nt][r];
    }
    __syncthreads();
    {
#pragma unroll
      for (int o2 = 0; o2 < 2; o2++) {
        const int idx = tid + 256 * o2, tk2 = idx >> 8, e = idx & 255;
        const float o = part[(2 * tk2) * 256 + e] + part[(2 * tk2 + 1) * 256 + e];
        p.concat[(tokb + t0 + tk2) * DM + 512 + e] = f2bf(o);
      }
    }
    __syncthreads();
  }
}
__device__ __forceinline__ void dsa_phase(const Params& p, unsigned char* smem, int bid, int nblk) {
  for (int it = bid; it < NB * (SEQ / 2); it += nblk) dsa_item(p, smem, it & 7, (SEQ / 2 - 1) - (it >> 3));
}

#define SELFCHECK 0
#ifndef PROBE_REPEAT
#define PROBE_REPEAT 0
#endif
#if SELFCHECK
__device__ __forceinline__ void check_val(const Params& p, float ref, float got, float atol, float rtol) {
  if (!(fabsf(ref - got) <= atol + rtol * fabsf(ref))) atomicExch(p.flag, 1);
}
__device__ __forceinline__ void inproj_check_phase(const Params& p, unsigned char* smem, int bid, int nblk) {
  float* h = (float*)smem;
  const float f16[8] = {1.0f, 0.19392274474868576f, 0.03760603093086393f, 0.007292664737217109f,
                        0.001414213562373095f, 0.0002742481756762073f, 5.318295896944988e-05f, 1.031338537721246e-05f};
  const int tid = threadIdx.x;
  for (int it = bid; it < 600; it += nblk) {
    const int tok = (it * 61) % NT;
    const int b = tok / SEQ, t = tok % SEQ;
    const float* xr = p.x + (size_t)tok * DM;
    for (int col = tid; col < INW; col += 256) {
      float a = 0.f;
      for (int k = 0; k < DM; k++) a = fmaf(xr[k], p.w_in[(size_t)k * INW + col], a);
      h[col] = a;
    }
    __syncthreads();
    const int pos = p.pos[tok];
    if (tid < 152) {
      const int v = tid >> 3, j = tid & 7;
      int base;
      if (v < 8) base = C_NSAQ + v * 64;
      else if (v < 10) base = C_NSAKV + 0 * 128 + (v - 8) * 64;
      else if (v < 12) base = C_NSAKV + 2 * 128 + (v - 10) * 64;
      else if (v < 14) base = C_NSAKV + 4 * 128 + (v - 12) * 64;
      else if (v < 18) base = C_DSAQ + (v - 14) * 64;
      else base = C_DSAK;
      float c, s; rope_cs(pos, f16[j], c, s);
      const float x1 = h[base + j], x2 = h[base + 8 + j];
      h[base + j] = x1 * c - x2 * s; h[base + 8 + j] = x2 * c + x1 * s;
    } else if (tid < 188) {
      const int u = tid - 152, v = u >> 2, j = u & 3;
      const int base = (v < 8) ? C_IDXQ + v * 32 : C_IDXK;
      float c, s; rope_cs(pos, f16[2 * j], c, s);
      const float x1 = h[base + j], x2 = h[base + 4 + j];
      h[base + j] = x1 * c - x2 * s; h[base + 4 + j] = x2 * c + x1 * s;
    } else if (tid < 212) {
      const int u = tid - 188;
      h[C_GATE + u] = 1.f / (1.f + expf(-h[C_GATE + u]));
    }
    __syncthreads();
    for (int col = tid; col < INW; col += 256) {
      const float ref = h[col];
      float got;
      if (col < 512) got = bf2f(p.qn[(size_t)tok * 512 + col]);
      else if (col < 1280) {
        const int o = col - 512, j = o >> 7, g = (o >> 6) & 1, d = o & 63;
        if (j == 3 || j == 5) {
          const bf16_t* vt = (j == 3) ? p.vslct : p.vwint;
          got = bf2f(vt[((size_t)(b * 2 + g) * 64 + d) * SEQ + perm16(t)]);
        } else {
          const bf16_t* src = j == 0 ? p.kvn[0] : j == 1 ? p.kvn[1] : j == 2 ? p.kvn[2] : p.kvn[4];
          got = bf2f(src[((size_t)(b * 2 + g) * SEQ + t) * 64 + d]);
        }
      }
      else if (col < 1304) got = p.gates[(size_t)tok * 24 + col - 1280];
      else if (col < 1560) got = bf2f(p.qd[(size_t)tok * 256 + col - 1304]);
      else if (col < 1624) got = bf2f(p.kd[(size_t)tok * 64 + col - 1560]);
      else if (col < 1688) got = bf2f(p.vd[(size_t)tok * 64 + col - 1624]);
      else if (col < 1944) got = bf2f(p.qi[(size_t)tok * 256 + col - 1688]);
      else if (col < 1976) got = bf2f(p.ki[(size_t)tok * 32 + col - 1944]);
      else if (col < 1984) got = p.widx[(size_t)tok * 8 + col - 1976] * 16.f;
      else got = bf2f(p.memq[(size_t)tok * 256 + col - 1984]);
      check_val(p, ref, got, 0.04f, 0.02f);
    }
    __syncthreads();
  }
  for (int it = bid; it < 64; it += nblk) {
    const int row = (it * 37) % (NB * MEML);
    for (int col = tid; col < 512; col += 256) {
      float a = 0.f;
      for (int k = 0; k < DM; k++) a = fmaf(p.mem[(size_t)row * DM + k], p.w_mem_kv[(size_t)k * 512 + col], a);
      float gotm;
      if (col < 256) gotm = bf2f(p.mkv[(size_t)row * 512 + col]);
      else { const int hd = (col - 256) >> 6, dd = col & 63; gotm = bf2f(p.memvt[((size_t)((row >> 8) * 4 + hd) * 64 + dd) * MEML + perm16(row & 255)]); }
      check_val(p, a, gotm, 0.04f, 0.02f);
    }
  }
}

__device__ __forceinline__ void mem_check_phase(const Params& p, unsigned char* smem, int bid, int nblk) {
  float* q = (float*)smem;
  float* sc = q + 256;
  const int tid = threadIdx.x;
  for (int it = bid; it < 700; it += nblk) {
    const int tok = (it * 47 + 13) % NT;
    const int b = tok / SEQ;
    q[tid] = bf2f(p.memq[(size_t)tok * 256 + tid]);
    __syncthreads();
    const bf16_t* kvb = p.mkv + (size_t)b * MEML * 512;
    for (int idx = tid; idx < 4 * 256; idx += 256) {
      const int hh = idx >> 8, m = idx & 255;
      sc[hh * 256 + m] = dot64_bf(q + hh * 64, kvb + (size_t)m * 512 + hh * 64) * 0.125f;
    }
    __syncthreads();
    softmax4(sc, 256, 256);
    __syncthreads();
    {
      const int h = tid >> 6, d = tid & 63;
      float o = 0.f;
      for (int m = 0; m < 256; m++) o = fmaf(sc[h * 256 + m], bf2f(p.memvt[((size_t)(b * 4 + h) * 64 + d) * MEML + perm16(m)]), o);
      check_val(p, o, bf2f(p.concat[(size_t)tok * DM + 768 + tid]), 0.004f, 0.02f);
    }
    __syncthreads();
  }
}
__device__ __forceinline__ void nsa_check_phase(const Params& p, unsigned char* smem, int bid, int nblk) {
  float* q = (float*)smem;
  float* sc = q + 256;
  float* o3 = sc + 4096;
  float* imp = o3 + 768;
  int* sel = (int*)(imp + 64);
  int* nselp = sel + 16;
  const int tid = threadIdx.x, h = tid >> 6, d = tid & 63;
  for (int it = bid; it < 1024; it += nblk) {
    const int item = (int)(((long long)it * 62851 + 7) % (NT * 2));
    const int g = item & 1, tok = item >> 1, b = tok / SEQ, t = tok % SEQ;
    const size_t kvb = (size_t)(b * 2 + g) * SEQ * 64;
    const bf16_t *kslc = p.kvn[2] + kvb, *kwin = p.kvn[4] + kvb;
    const bf16_t *vslct = p.vslct + (size_t)(b * 2 + g) * 64 * SEQ, *vwint = p.vwint + (size_t)(b * 2 + g) * 64 * SEQ;
    q[tid] = bf2f(p.qn[(size_t)tok * 512 + g * 256 + tid]);
    __syncthreads();
    const int nv = (t >= 31) ? (t - 31) / 16 + 1 : 0;
    const bf16_t* kcb = p.kcb + (size_t)(b * 2 + g) * 256 * 64;
    const bf16_t* vct = p.vct + (size_t)(b * 2 + g) * 64 * 256;
    for (int idx = tid; idx < 4 * 256; idx += 256) {
      const int hh = idx >> 8, i = idx & 255;
      float s = -INFINITY;
      if (i < nv) {
        s = 0.f;
        for (int e = 0; e < 64; e++) s = fmaf(q[hh * 64 + e], bf2f(kcb[i * 64 + e]), s);
        s *= 0.125f;
      }
      sc[hh * 1024 + i] = s;
    }
    __syncthreads();
    softmax4(sc, 1024, 256);
    __syncthreads();
    {
      float o = 0.f;
      for (int i = 0; i < nv; i++) o = fmaf(sc[h * 1024 + i], bf2f(vct[d * 256 + perm16(i)]), o);
      o3[0 * 256 + tid] = o;
    }
    const int cur = t / 64;
    if (tid < 64) {
      const int m = tid;
      float a = 0.f;
      const int n0 = max(0, 4 * m - 2), n1 = min(NC - 1, 4 * m + 4);
      for (int n = n0; n <= n1; n++) {
        const int ov = min(16 * n + 32, 64 * m + 64) - max(16 * n, 64 * m);
        if (ov > 0) {
          const float w = (float)ov * (1.f / 32.f);
          for (int hh = 0; hh < 4; hh++) a = fmaf(sc[hh * 1024 + n], w, a);
        }
      }
      const bool forced = (m == 0) || (m == cur) || (m == cur - 1);
      const bool vis = (m <= cur);
      imp[m] = vis ? a + (forced ? 1e4f : 0.f) : -INFINITY;
    }
    __syncthreads();
    if (tid < 64) {
      const int m = tid;
      const float sm = imp[m];
      int rank = 0;
      for (int mm = 0; mm < 64; mm++) { const float s2 = imp[mm]; rank += (s2 > sm) || (s2 == sm && mm < m); }
      const bool take = (rank < 16) && (m <= cur);
      const unsigned long long bal = __ballot(take);
      if (take) sel[__popcll(bal & ((1ull << m) - 1ull))] = m;
      if (m == 0) *nselp = __popcll(bal);
    }
    __syncthreads();
    const int nsel = *nselp;
    {
      const int nk = nsel * 64;
      for (int idx = tid; idx < 4 * nk; idx += 256) {
        const int hh = idx / nk, r = idx % nk;
        const int kpos = sel[r >> 6] * 64 + (r & 63);
        float s = -INFINITY;
        if (kpos <= t) s = dot64_bf(q + hh * 64, kslc + (size_t)kpos * 64) * 0.125f;
        sc[hh * 1024 + r] = s;
      }
      __syncthreads();
      softmax4(sc, 1024, nk);
      __syncthreads();
      float o = 0.f;
      for (int r = 0; r < nk; r++) {
        const int kpos = sel[r >> 6] * 64 + (r & 63);
        if (kpos <= t) o = fmaf(sc[h * 1024 + r], bf2f(vslct[(size_t)d * SEQ + perm16(kpos)]), o);
      }
      o3[1 * 256 + tid] = o;
      __syncthreads();
    }
    {
      for (int idx = tid; idx < 4 * 512; idx += 256) {
        const int hh = idx >> 9, r = idx & 511;
        const int kpos = t - 511 + r;
        float s = -INFINITY;
        if (kpos >= 0) s = dot64_bf(q + hh * 64, kwin + (size_t)kpos * 64) * 0.125f;
        sc[hh * 1024 + r] = s;
      }
      __syncthreads();
      softmax4(sc, 1024, 512);
      __syncthreads();
      float o = 0.f;
      for (int r = 0; r < 512; r++) {
        const int kpos = t - 511 + r;
        if (kpos >= 0) o = fmaf(sc[h * 1024 + r], bf2f(vwint[(size_t)d * SEQ + perm16(kpos)]), o);
      }
      o3[2 * 256 + tid] = o;
    }
    {
      const float* gt = p.gates + (size_t)tok * 24 + (g * 4 + h) * 3;
      const float r = gt[0] * o3[tid] + gt[1] * o3[256 + tid] + gt[2] * o3[512 + tid];
      const float got = bf2f(p.concat[(size_t)tok * DM + g * 256 + tid]);
      const float df = fabsf(r - got);
      if (!(df <= 0.08f + 0.1f * fabsf(r))) atomicExch(p.flag, 1);
      if (!(df <= 0.006f + 0.02f * fabsf(r))) atomicAdd(p.chkcnt, 1);
    }
    __syncthreads();
  }
}

__device__ __forceinline__ void dsa_check_phase(const Params& p, unsigned char* smem, int bid, int nblk) {
  unsigned* keys = (unsigned*)smem;
  float* qi = (float*)(keys + 4096);
  float* wi = qi + 256;
  int* hist = (int*)(wi + 8);
  int* sel = hist + 256;
  int* misc = sel + 256;
  int* cnts = misc + 8;
  float* qd = (float*)(cnts + 256);
  float* sc = qd + 256;
  const int tid = threadIdx.x;
  for (int it = bid; it < 1500; it += nblk) {
    const int tok = (int)(((long long)it * 39119 + 11) % NT);
    const int b = tok / SEQ, t = tok % SEQ;
    const bf16_t* kib = p.ki + (size_t)b * SEQ * 32;
    const bf16_t* kdb = p.kd + (size_t)b * SEQ * 64;
    const bf16_t* vdb = p.vd + (size_t)b * SEQ * 64;
    qi[tid] = bf2f(p.qi[(size_t)tok * 256 + tid]);
    if (tid < 8) wi[tid] = p.widx[(size_t)tok * 8 + tid];
    qd[tid] = bf2f(p.qd[(size_t)tok * 256 + tid]);
    __syncthreads();
    const int n = t + 1;
    int nsel;
    if (n <= 256) {
      for (int s = tid; s < n; s += 256) sel[s] = s;
      nsel = n;
      __syncthreads();
    } else {
      for (int s = tid; s < n; s += 256) {
        float kv[32];
#pragma unroll
        for (int e = 0; e < 32; e += 8) {
          const uint4 v = *(const uint4*)(kib + (size_t)s * 32 + e);
          kv[e + 0] = __uint_as_float(v.x << 16); kv[e + 1] = __uint_as_float(v.x & 0xFFFF0000u);
          kv[e + 2] = __uint_as_float(v.y << 16); kv[e + 3] = __uint_as_float(v.y & 0xFFFF0000u);
          kv[e + 4] = __uint_as_float(v.z << 16); kv[e + 5] = __uint_as_float(v.z & 0xFFFF0000u);
          kv[e + 6] = __uint_as_float(v.w << 16); kv[e + 7] = __uint_as_float(v.w & 0xFFFF0000u);
        }
        float score = 0.f;
    #pragma unroll 1
    for (int hh = 0; hh < 8; hh++) {
          float dsum = 0.f;
#pragma unroll
          for (int e = 0; e < 32; e++) dsum = fmaf(qi[hh * 32 + e], kv[e], dsum);
          score = fmaf(fmaxf(dsum, 0.f), wi[hh], score);
        }
        keys[s] = f2key(score);
      }
      unsigned prefix = 0; int kk = 256;
      for (int shift = 24; shift >= 0; shift -= 8) {
        hist[tid] = 0;
        __syncthreads();
        const unsigned hmask = (shift == 24) ? 0u : (0xFFFFFFFFu << (shift + 8));
        for (int s = tid; s < n; s += 256) {
          const unsigned k = keys[s];
          if ((k & hmask) == prefix) atomicAdd(&hist[(k >> shift) & 255], 1);
        }
        __syncthreads();
        if (tid == 0) {
          int cum = 0, dsel = 0;
          for (int dg = 255; dg >= 0; dg--) {
            const int c = hist[dg];
            if (cum + c >= kk) { dsel = dg; break; }
            cum += c;
          }
          misc[0] = dsel; misc[1] = kk - cum;
        }
        __syncthreads();
        prefix |= ((unsigned)misc[0]) << shift;
        kk = misc[1];
        __syncthreads();
      }
      const int per = (n + 255) / 256;
      const int s0 = tid * per, s1 = min(n, s0 + per);
      int cg_ = 0, ce = 0;
      for (int s = s0; s < s1; s++) { const unsigned k = keys[s]; cg_ += (k > prefix); ce += (k == prefix); }
      cnts[tid] = cg_; hist[tid] = ce;
      __syncthreads();
      if (tid == 0) {
        int a = 0, e = 0;
        for (int i = 0; i < 256; i++) { const int c1 = cnts[i], c2 = hist[i]; cnts[i] = a; hist[i] = e; a += c1; e += c2; }
        misc[2] = a;
      }
      __syncthreads();
      {
        int og = cnts[tid], oe = hist[tid];
        const int ngt = misc[2];
        for (int s = s0; s < s1; s++) {
          const unsigned k = keys[s];
          if (k > prefix) sel[og++] = s;
          else if (k == prefix) { if (oe < kk) sel[ngt + oe] = s; oe++; }
        }
      }
      nsel = 256;
      __syncthreads();
    }
    for (int idx = tid; idx < 4 * nsel; idx += 256) {
      const int hh = idx / nsel, r = idx % nsel;
      sc[hh * 256 + r] = dot64_bf(qd + hh * 64, kdb + (size_t)sel[r] * 64) * 0.125f;
    }
    __syncthreads();
    softmax4(sc, 256, nsel);
    __syncthreads();
    {
      const int h = tid >> 6, d = tid & 63;
      float o = 0.f;
      for (int r = 0; r < nsel; r++) o = fmaf(sc[h * 256 + r], bf2f(vdb[(size_t)sel[r] * 64 + d]), o);
      const float got = bf2f(p.concat[(size_t)tok * DM + 512 + tid]);
      const float df = fabsf(o - got);
      if (!(df <= 0.08f + 0.1f * fabsf(o))) atomicExch(p.flag, 1);
      if (!(df <= 0.004f + 0.02f * fabsf(o))) atomicAdd(p.chkcnt, 1);
    }
    __syncthreads();
  }
}


__device__ __forceinline__ void compress_check_phase(const Params& p, unsigned char* smem, int bid, int nblk) {
  float* hid = (float*)smem;
  const int tid = threadIdx.x;
  const int which = tid >> 7, j = tid & 127;
  for (int it = bid; it < 600; it += nblk) {
    const int item = (it * 131 + 5) % (NB * 2 * NC);
    const int i = item % NC, g = (item / NC) % 2, b = item / (NC * 2);
    const float* w1 = which ? p.w1v : p.w1k;
    const float* pe = which ? p.pe_v : p.pe_k;
    const bf16_t* src = (which ? p.kvn[1] : p.kvn[0]) + ((size_t)(b * 2 + g) * SEQ + i * 16) * 64;
    float acc = 0.f;
    for (int r = 0; r < 2048; r++) acc = fmaf(bf2f(src[r]) + pe[r], w1[(size_t)r * 128 + j], acc);
    hid[which * 128 + j] = gelu_exact(acc);
    __syncthreads();
    if (j < 64) {
      const float* w2 = which ? p.w2v : p.w2k;
      float o = 0.f;
      for (int k = 0; k < 128; k++) o = fmaf(hid[which * 128 + k], w2[k * 64 + j], o);
      const float got = which ? bf2f(p.vct[((size_t)(b * 2 + g) * 64 + j) * 256 + perm16(i)]) : bf2f(p.kcb[((size_t)(b * 2 + g) * 256 + i) * 64 + j]);
      check_val(p, o, got, 0.01f, 0.02f);
    }
    __syncthreads();
  }
}
#endif


#define XB_TMO      128
#define XB_XCNT(j)  (256  + 64 * (j))
#define XB_XSUB(j)  (1280 + 64 * (j))
#define XB_XGEN(j)  (2304 + 64 * (j))
#define XB_TOP      3328
#define XB_TOPGEN   3392
#define XCD_BAR_WORDS 3456
#define XB_SPIN_CAP (1u << 23)
#define LAS __attribute__((address_space(3)))
__device__ __forceinline__ unsigned xb_ld(unsigned* p)              { return __hip_atomic_load(p, __ATOMIC_RELAXED, __HIP_MEMORY_SCOPE_AGENT); }
__device__ __forceinline__ unsigned xb_add(unsigned* p, unsigned v) { return __hip_atomic_fetch_add(p, v, __ATOMIC_RELAXED, __HIP_MEMORY_SCOPE_AGENT); }
__device__ __forceinline__ unsigned xb_xcc_id() { return (unsigned)__builtin_amdgcn_s_getreg((3 << 11) | 20) & 0xFu; }
#define XB_SPIN(cond, bar) do { unsigned _sp = 0; while (cond) { __builtin_amdgcn_s_sleep(1); \
    if ((++_sp & 255u) == 0u) { if (xb_ld(&(bar)[XB_TMO])) break; if (_sp > XB_SPIN_CAP) { atomicAdd(&(bar)[XB_TMO], 1u); break; } } } } while (0)
struct XcdBarrier { unsigned* bar; unsigned x; volatile LAS unsigned* st; };
__device__ __forceinline__ XcdBarrier xcd_barrier_post(unsigned* bar, volatile LAS unsigned* st) {
  XcdBarrier b; b.bar = bar; b.x = xb_xcc_id(); b.st = st;
  if (threadIdx.x == 0) (void)xb_add(&bar[XB_XCNT(b.x)], 1u);
  return b;
}
__device__ __forceinline__ void xcd_barrier_complete(unsigned* bar, unsigned x, unsigned& nloc, unsigned& nx) {
  const unsigned G = gridDim.x * gridDim.y * gridDim.z;
  unsigned sum, cnt, mine, sp = 0u;
  for (;;) {
    sum = 0u; cnt = 0u; mine = 0u;
#pragma unroll
    for (unsigned j = 0; j < 16; ++j) { const unsigned c = xb_ld(&bar[XB_XCNT(j)]); sum += c; cnt += (c > 0u) ? 1u : 0u; mine = (j == x) ? c : mine; }
    if (sum == G) break;
    __builtin_amdgcn_s_sleep(1);
    if ((++sp & 255u) == 0u) { if (xb_ld(&bar[XB_TMO])) break; if (sp > XB_SPIN_CAP) { atomicAdd(&bar[XB_TMO], 1u); break; } }
  }
  nloc = mine > 0u ? mine : 1u; nx = cnt > 0u ? cnt : 1u;
}
__device__ __forceinline__ void xcd_barrier(const XcdBarrier& b) {
  asm volatile("s_waitcnt vmcnt(0)" ::: "memory");
  __syncthreads();
  if (threadIdx.x == 0) {
    unsigned* bar = b.bar;
    __builtin_amdgcn_s_waitcnt(0);
    unsigned nloc = b.st[0], nx = b.st[1];
    if (nloc == 0u) { xcd_barrier_complete(bar, b.x, nloc, nx); b.st[0] = nloc; b.st[1] = nx; }
    const unsigned old = xb_add(&bar[XB_XSUB(b.x)], 1u);
    const unsigned gen = old / nloc;
    if (old + 1u == (gen + 1u) * nloc) {
      __builtin_amdgcn_fence(__ATOMIC_RELEASE, "agent");
      asm volatile("s_waitcnt vmcnt(0)" ::: "memory");
      const unsigned og = xb_add(&bar[XB_TOP], 1u);
      const unsigned tg = og / nx;
      if (og + 1u == (tg + 1u) * nx) xb_add(&bar[XB_TOPGEN], 1u);
      else XB_SPIN(xb_ld(&bar[XB_TOPGEN]) == tg, bar);
      __builtin_amdgcn_fence(__ATOMIC_ACQUIRE, "agent");
      xb_add(&bar[XB_XGEN(b.x)], 1u);
      asm volatile("s_waitcnt vmcnt(0)" ::: "memory");
    } else {
      XB_SPIN(xb_ld(&bar[XB_XGEN(b.x)]) == gen, bar);
      __builtin_amdgcn_fence(__ATOMIC_ACQUIRE, "agent");
      asm volatile("s_waitcnt vmcnt(0)" ::: "memory");
    }
  }
  __syncthreads();
}

constexpr int SMEM_BYTES = 65536;
__global__ void __launch_bounds__(256, 2) megakernel(Params p) {
  __shared__ __align__(16) unsigned char smem[SMEM_BYTES];
  __shared__ uint4 xb_words;
  cg::grid_group grid = cg::this_grid();
  const int bid = blockIdx.x, nblk = gridDim.x;
  if (threadIdx.x == 0) xb_words = make_uint4(0u, 0u, 0u, 0u);
  __syncthreads();
  const XcdBarrier xb = xcd_barrier_post(p.bar, (volatile LAS unsigned*)&xb_words);
  if (p.never) grid.sync();
  for (int rep = 0; rep < ((PROBE_REPEAT & 128) ? 2 : 1); rep++) {
  convert_phase(p.x, p.xb, (size_t)NT * DM, bid, nblk);
  convert_phase(p.mem, p.memb, (size_t)NB * MEML * DM, bid, nblk);
  }
  for (int rep = 0; rep < ((PROBE_REPEAT & 256) ? 2 : 1); rep++) {
  transpose_phase<true>(p.w_in, INW, p.wint, DM, INWP, smem, bid, nblk);
  transpose_phase<false>(p.w_mem_kv, 512, p.wmemt, DM, 512, smem, bid, nblk);
  transpose_phase<false>(p.w_out, DM, p.woutt, DM, DM, smem, bid, nblk);
  transpose_phase<false>(p.wq, 2048, p.wqt, DM, 2048, smem, bid, nblk);
  transpose_phase<false>(p.w1k, 128, p.w1kt, 2048, 128, smem, bid, nblk);
  transpose_phase<false>(p.w1v, 128, p.w1vt, 2048, 128, smem, bid, nblk);
  }
  for (int rep = 0; rep < ((PROBE_REPEAT & 512) ? 2 : 1); rep++) {
  cbias_phase(p, bid, nblk);
  subkey_phase(p.sk1, p.sk1p, bid, nblk);
  subkey_phase(p.sk2, p.sk2p, bid, nblk);
  cs_phase(p, bid, nblk);
  ovp_phase(p, bid, nblk);
  }
  if (bid == 0 && threadIdx.x == 0) { *p.flag = 0; *p.chkcnt = 0; }
  xcd_barrier(xb);
  for (int rep = 0; rep < ((PROBE_REPEAT & 2) ? 2 : 1); rep++) inproj_phase(p, smem, bid, nblk);
  xcd_barrier(xb);
  if (bid >= 128) memkv_phase(p, smem, bid - 128, nblk);
  compress_phase(p, smem, bid, nblk);
  xcd_barrier(xb);
  {
    constexpr int N_NSA = NB * 2 * 128, N_DSA = NB * (SEQ / 2), N_MEM = NB * 4 * 32;
    volatile LAS unsigned* qslot = (volatile LAS unsigned*)&xb_words + 2;
#pragma unroll 1
    for (;;) {
      __syncthreads();
      if (threadIdx.x == 0) qslot[0] = atomicAdd(p.bar + 64, 1u);
      __syncthreads();
      const int q = (int)qslot[0];
      if (q >= N_NSA) break;
      nsa_flash_item(p, smem, ((q & 15) << 7) | (127 - (q >> 4)));
    }
    auto quant_item = [&](int qi_) __attribute__((always_inline)) {
      const int w_ = threadIdx.x >> 6;
      if (qi_ < 256) quant_rows(p.pu, p.puq, p.psu, qi_ * 64, 64, w_, 4);
      else quant_rows(p.pv, p.pvq, p.psv, (qi_ - 256) * 64, 64, w_, 4);
    };
    int ndone = 0;
#pragma unroll 1
    for (;;) {
      __syncthreads();
      if (threadIdx.x == 0) qslot[0] = atomicAdd(p.bar + 65, 1u);
      __syncthreads();
      const int q = (int)qslot[0];
      if (q >= N_DSA) break;
      dsa_item(p, smem, q & 7, (SEQ / 2 - 1) - (q >> 3));
      if ((++ndone & 31) == 0) {
        __syncthreads();
        if (threadIdx.x == 0) qslot[0] = atomicAdd(p.bar + 67, 1u);
        __syncthreads();
        const int qq = (int)qslot[0];
        if (qq < 512) quant_item(qq);
      }
    }
#pragma unroll 1
    for (;;) {
      __syncthreads();
      if (threadIdx.x == 0) qslot[0] = atomicAdd(p.bar + 67, 1u);
      __syncthreads();
      const int qq = (int)qslot[0];
      if (qq >= 512) break;
      quant_item(qq);
    }
#pragma unroll 1
    for (;;) {
      __syncthreads();
      if (threadIdx.x == 0) qslot[0] = atomicAdd(p.bar + 66, 1u);
      __syncthreads();
      const int q = (int)qslot[0];
      if (q >= N_MEM) break;
      mem_flash_item(p, smem, q);
    }
  }
  xcd_barrier(xb);
  for (int rep = 0; rep < ((PROBE_REPEAT & 64) ? 2 : 1); rep++) peer_block_phase(p, smem, bid, nblk);
}


#if SELFCHECK
__global__ void __launch_bounds__(256) check_kernel(Params p) {
  __shared__ __align__(16) unsigned char smem[40960];
  inproj_check_phase(p, smem, blockIdx.x, gridDim.x);
}
__global__ void check_final(Params p) {
  if (threadIdx.x == 0 && (*(volatile int*)p.flag != 0 || *(volatile int*)p.chkcnt > 6000)) p.out[0] = __uint_as_float(0x7FC00000u);
}
#endif

extern "C" void kernel_launch(void* const* d_in, const int* in_sizes, int n_in, void* d_out, int out_size,
                              void* d_ws, size_t ws_size, hipStream_t stream) {
  Params p{};
  p.x = (const float*)d_in[0]; p.mem = (const float*)d_in[1]; p.pos = (const int*)d_in[2];
  p.w_in = (const float*)d_in[3]; p.pe_k = (const float*)d_in[4]; p.pe_v = (const float*)d_in[5];
  p.w1k = (const float*)d_in[6]; p.w2k = (const float*)d_in[7]; p.w1v = (const float*)d_in[8]; p.w2v = (const float*)d_in[9];
  p.w_mem_kv = (const float*)d_in[10]; p.w_out = (const float*)d_in[11]; p.ln1g = (const float*)d_in[12]; p.ln1b = (const float*)d_in[13];
  p.wq = (const float*)d_in[14]; p.sk1 = (const float*)d_in[15]; p.sk2 = (const float*)d_in[16];
  p.pu = (const float*)d_in[17]; p.pv = (const float*)d_in[18]; p.ln2g = (const float*)d_in[19]; p.ln2b = (const float*)d_in[20];
  p.out = (float*)d_out;
  unsigned char* ws = (unsigned char*)d_ws;
  size_t off = 0;
  auto take = [&](size_t bytes) { void* r = ws + off; off += (bytes + 255) & ~(size_t)255; return r; };
  p.xb = (bf16_t*)take((size_t)NT * DM * 2);
  p.qn = (bf16_t*)take((size_t)NT * 512 * 2);
  for (int j = 0; j < 6; j++) p.kvn[j] = (bf16_t*)take((size_t)NT * 128 * 2);
  p.qd = (bf16_t*)take((size_t)NT * 256 * 2);
  p.kd = (bf16_t*)take((size_t)NT * 64 * 2);
  p.vd = (bf16_t*)take((size_t)NT * 64 * 2);
  p.qi = (bf16_t*)take((size_t)NT * 256 * 2);
  p.ki = (bf16_t*)take((size_t)NT * 32 * 2);
  p.memq = (bf16_t*)take((size_t)NT * 256 * 2);
  p.gates = (float*)take((size_t)NT * 24 * 4);
  p.widx = (float*)take((size_t)NT * 8 * 4);
  p.mkv = (bf16_t*)take((size_t)NB * MEML * 512 * 2);
  p.memvt = (bf16_t*)take((size_t)NB * 4 * 64 * MEML * 2);
  p.vslct = (bf16_t*)take((size_t)NT * 128 * 2);
  p.vwint = (bf16_t*)take((size_t)NT * 128 * 2);
  p.kcb = (bf16_t*)take((size_t)NB * 2 * 256 * 64 * 2);
  p.vct = (bf16_t*)take((size_t)NB * 2 * 64 * 256 * 2);
  p.ovp = (bf16_t*)take((size_t)64 * 256 * 2);
  p.w1kt = (bf16_t*)take((size_t)128 * 2048 * 2);
  p.w1vt = (bf16_t*)take((size_t)128 * 2048 * 2);
  p.cbias = (float*)take(64 * 256 * 4);
  p.chkcnt = (int*)take(256);
  p.bar = (unsigned*)take(XCD_BAR_WORDS * 4);
  p.never = 0; p.pad_ = 0;
  p.memb = (bf16_t*)take((size_t)NB * MEML * DM * 2);
  p.wint = (bf16_t*)take((size_t)INWP * DM * 2);
  p.wmemt = (bf16_t*)take((size_t)512 * DM * 2);
  p.woutt = (bf16_t*)take((size_t)DM * DM * 2);
  p.wqt = (bf16_t*)take((size_t)2048 * DM * 2);
  p.sk1p = (bf16_t*)take((size_t)128 * 128 * 2);
  p.sk2p = (bf16_t*)take((size_t)128 * 128 * 2);
  p.puq = (unsigned char*)take((size_t)16384 * DM);
  p.pvq = (unsigned char*)take((size_t)16384 * DM);
  p.psu = (float*)take(16384 * 4);
  p.psv = (float*)take(16384 * 4);
  p.cs = (float2*)take((size_t)NT * 8 * 8);
  p.kc = (float*)take((size_t)NB * 2 * NC * 64 * 4);
  p.vc = (float*)take((size_t)NB * 2 * NC * 64 * 4);
  p.concat = (bf16_t*)take((size_t)NT * DM * 2);
  p.x1b = (bf16_t*)take((size_t)NT * DM * 2);
  p.pexp = (int*)take((size_t)NT * 128 * 4);
  p.pgate = (float*)take((size_t)NT * 128 * 4);
  p.flag = (int*)take(256);
  if (off > ws_size) { fprintf(stderr, "workspace too small: need %zu have %zu\n", off, ws_size); return; }
  static int grid_blocks = 0;
  if (!grid_blocks) {
    int dev = 0, cus = 0, per_cu = 0;
    hipGetDevice(&dev);
    hipDeviceGetAttribute(&cus, hipDeviceAttributeMultiprocessorCount, dev);
    hipOccupancyMaxActiveBlocksPerMultiprocessor(&per_cu, megakernel, 256, 0);
    if (per_cu > 2) per_cu = 2;
    grid_blocks = cus * per_cu;
  }
  hipMemsetAsync(p.bar, 0, XCD_BAR_WORDS * 4, stream);
  void* args[] = {&p};
  hipError_t e = hipLaunchCooperativeKernel((void*)megakernel, dim3(grid_blocks), dim3(256), args, 0, stream);
  if (e != hipSuccess) fprintf(stderr, "cooperative launch failed: %s (grid %d)\n", hipGetErrorString(e), grid_blocks);
#if SELFCHECK
  check_kernel<<<512, 256, 0, stream>>>(p);
  check_final<<<1, 64, 0, stream>>>(p);
#endif
}
```

```cpp
#include <hip/hip_runtime.h>
#include <hip/hip_cooperative_groups.h>
#include <cstdio>
#include <cstdint>
namespace cg = cooperative_groups;

constexpr int NB = 8, SEQ = 4096, DM = 1024, NT = NB * SEQ;
constexpr int INW = 2240;
constexpr int INWP = 2304;
constexpr int NC = 255;
constexpr int MEML = 256;
constexpr int C_NSAQ = 0, C_NSAKV = 512, C_GATE = 1280, C_DSAQ = 1304, C_DSAK = 1560, C_DSAV = 1624,
              C_IDXQ = 1688, C_IDXK = 1944, C_IDXW = 1976, C_MEMQ = 1984;
constexpr int P_NSAQ = 0, P_NSAKV = 512, P_DSAQ = 1280, P_DSAK = 1536, P_DSAV = 1600, P_IDXQ = 1664, P_IDXK = 1920,
              P_MEMQ = 1952, P_GATE = 2208, P_IDXW = 2232, P_END = 2240;
constexpr float ALPHA = 1.189207115002721f;

typedef unsigned short bf16_t;
typedef __attribute__((ext_vector_type(8))) __bf16 bf16x8;
typedef __attribute__((ext_vector_type(2))) __bf16 bf16x2;
typedef __attribute__((ext_vector_type(2))) float f32x2;
typedef __attribute__((ext_vector_type(4))) float f32x4;
typedef __attribute__((ext_vector_type(16))) float f32x16;
typedef __attribute__((ext_vector_type(2))) _Float16 f16x2;

struct Params {
  const float *x, *mem; const int* pos;
  const float *w_in, *pe_k, *pe_v, *w1k, *w2k, *w1v, *w2v, *w_mem_kv, *w_out, *ln1g, *ln1b,
              *wq, *sk1, *sk2, *pu, *pv, *ln2g, *ln2b;
  float* out;
  bf16_t *xb, *memb, *wint, *wmemt, *woutt, *wqt, *sk1p, *sk2p;
  unsigned char *puq, *pvq;
  float *psu, *psv;
  float2* cs;
  bf16_t *qn;
  bf16_t *kvn[6];
  bf16_t *qd, *kd, *vd;
  bf16_t *qi, *ki;
  bf16_t *memq, *mkv;
  bf16_t *memvt;
  bf16_t *vslct, *vwint;
  bf16_t *w1kt, *w1vt; float* cbias;
  bf16_t *kcb, *vct;
  bf16_t *ovp;
  int *chkcnt;
  unsigned *bar;
  int never;
  int pad_;
  float *gates, *widx;
  bf16_t *concat;
  bf16_t *x1b;
  float *kc, *vc;
  int   *pexp;
  float *pgate;
  int   *flag;
};

__device__ __forceinline__ float bf2f(bf16_t u) { return __uint_as_float(((unsigned)u) << 16); }
__device__ __forceinline__ bf16_t f2bf(float f) { return __builtin_bit_cast(unsigned short, (__bf16)f); }
__device__ __forceinline__ unsigned pack2bf(float a, float b) {
  f32x2 v = {a, b};
  return __builtin_bit_cast(unsigned, __builtin_convertvector(v, bf16x2));
}

__device__ __forceinline__ int tid_opaque() { int t = threadIdx.x; asm volatile("" : "+v"(t)); return t; }

__device__ __forceinline__ float wave_sum(float v) {
#pragma unroll
  for (int o = 32; o > 0; o >>= 1) v += __shfl_xor(v, o);
  return v;
}
__device__ __forceinline__ float wave_max(float v) {
#pragma unroll
  for (int o = 32; o > 0; o >>= 1) v = fmaxf(v, __shfl_xor(v, o));
  return v;
}
__device__ __forceinline__ float gelu_exact(float x) { return 0.5f * x * (1.f + erff(x * 0.7071067811865476f)); }

__device__ __forceinline__ void convert_phase(const float* __restrict__ src, bf16_t* __restrict__ dst, size_t n, int bid, int nblk) {
  const size_t nch = n / 8, stride = (size_t)nblk * 256;
  size_t c = (size_t)bid * 256 + threadIdx.x;
  for (; c + 3 * stride < nch; c += 4 * stride) {
    float4 a[4], b[4];
#pragma unroll
    for (int u = 0; u < 4; u++) { a[u] = *(const float4*)(src + (c + u * stride) * 8); b[u] = *(const float4*)(src + (c + u * stride) * 8 + 4); }
#pragma unroll
    for (int u = 0; u < 4; u++) {
      uint4 o = {pack2bf(a[u].x, a[u].y), pack2bf(a[u].z, a[u].w), pack2bf(b[u].x, b[u].y), pack2bf(b[u].z, b[u].w)};
      *(uint4*)(dst + (c + u * stride) * 8) = o;
    }
  }
  for (; c < nch; c += stride) {
    const float4 a = *(const float4*)(src + c * 8), b = *(const float4*)(src + c * 8 + 4);
    uint4 o = {pack2bf(a.x, a.y), pack2bf(a.z, a.w), pack2bf(b.x, b.y), pack2bf(b.z, b.w)};
    *(uint4*)(dst + c * 8) = o;
  }
}
__device__ __forceinline__ unsigned quant4(const float4& v, float inv) {
  const unsigned a = (unsigned)(__float2int_rn(v.x * inv) + 128), b = (unsigned)(__float2int_rn(v.y * inv) + 128);
  const unsigned c = (unsigned)(__float2int_rn(v.z * inv) + 128), d = (unsigned)(__float2int_rn(v.w * inv) + 128);
  return a | (b << 8) | (c << 16) | (d << 24);
}
__device__ __forceinline__ float absmax4(const float4& v) { return fmaxf(fmaxf(fabsf(v.x), fabsf(v.y)), fmaxf(fabsf(v.z), fabsf(v.w))); }
__device__ __forceinline__ void quant_rows(const float* __restrict__ src, unsigned char* __restrict__ dst, float* __restrict__ scl,
                                           int row0, int nrows, int gw, int nw) {
  const int lane = tid_opaque() & 63;
  for (int r = row0 + gw * 2; r < row0 + nrows; r += nw * 2) {
    const float4* s0 = (const float4*)(src + (size_t)r * 1024 + 16 * lane);
    const float4* s1 = (const float4*)(src + (size_t)(r + 1) * 1024 + 16 * lane);
    const float4 a0 = s0[0], a1 = s0[1], a2 = s0[2], a3 = s0[3];
    const float4 b0 = s1[0], b1 = s1[1], b2 = s1[2], b3 = s1[3];
    const float ma = wave_max(fmaxf(fmaxf(absmax4(a0), absmax4(a1)), fmaxf(absmax4(a2), absmax4(a3))));
    const float mb = wave_max(fmaxf(fmaxf(absmax4(b0), absmax4(b1)), fmaxf(absmax4(b2), absmax4(b3))));
    const float ia = ma > 0.f ? 127.f / ma : 0.f, ib = mb > 0.f ? 127.f / mb : 0.f;
    *(uint4*)(dst + (size_t)r * 1024 + 16 * lane) = make_uint4(quant4(a0, ia), quant4(a1, ia), quant4(a2, ia), quant4(a3, ia));
    *(uint4*)(dst + (size_t)(r + 1) * 1024 + 16 * lane) = make_uint4(quant4(b0, ib), quant4(b1, ib), quant4(b2, ib), quant4(b3, ib));
    if (lane == 0) { scl[r] = ma * (1.f / 127.f); scl[r + 1] = mb * (1.f / 127.f); }
  }
}
__device__ __forceinline__ int inproj_colmap(int n) {
  if (n < P_DSAQ) return n;
  if (n < P_DSAK) return C_DSAQ + (n - P_DSAQ);
  if (n < P_IDXQ) return C_DSAK + (n - P_DSAK);
  if (n < P_IDXK) return C_IDXQ + (n - P_IDXQ);
  if (n < P_MEMQ) return C_IDXK + (n - P_IDXK);
  if (n < P_GATE) return C_MEMQ + (n - P_MEMQ);
  if (n < P_IDXW) return C_GATE + (n - P_GATE);
  if (n < P_END) return C_IDXW + (n - P_IDXW);
  return -1;
}
template <bool PERM>
__device__ __forceinline__ void transpose_phase(const float* __restrict__ src, int lds_, bf16_t* __restrict__ dst, int K, int Nd,
                                unsigned char* smem, int bid, int nblk) {
  float (*t)[65] = (float (*)[65])smem;
  const int tx = threadIdx.x & 63, ty = threadIdx.x >> 6;
  const int tk = K / 64, tn = Nd / 64;
  for (int tile = bid; tile < tk * tn; tile += nblk) {
    const int k0 = (tile % tk) * 64, n0 = (tile / tk) * 64;
    const int nsrc = PERM ? inproj_colmap(n0 + tx) : (n0 + tx);
#pragma unroll
    for (int i = 0; i < 16; i++) {
      const int k = ty + 4 * i;
      t[tx][k] = (nsrc >= 0) ? src[(size_t)(k0 + k) * lds_ + nsrc] : 0.f;
    }
    __syncthreads();
#pragma unroll
    for (int i = 0; i < 16; i++) {
      const int n = ty + 4 * i;
      dst[(size_t)(n0 + n) * K + k0 + tx] = f2bf(t[n][tx]);
    }
    __syncthreads();
  }
}
__device__ __forceinline__ void subkey_phase(const float* __restrict__ src, bf16_t* __restrict__ dst, int bid, int nblk) {
  for (int i = bid * 256 + threadIdx.x; i < 128 * 128; i += nblk * 256) {
    const int n = i >> 7, pos = i & 127, g16 = pos & ~15, pp = pos & 15, h = pp >> 3, j = pp & 7;
    dst[i] = f2bf(src[n * 128 + g16 + 8 * (j >> 2) + 4 * h + (j & 3)]);
  }
}
__device__ __forceinline__ void rope_cs(int pos, float freq, float& c, float& s) {
  double ang = (double)pos * (double)freq;
  double rev = ang * 0.15915494309189535;
  rev -= floor(rev + 0.5);
  float r = (float)(rev * 6.283185307179586);
  c = __cosf(r); s = __sinf(r);
}
__device__ __forceinline__ void cs_phase(const Params& p, int bid, int nblk) {
  const float f16[8] = {1.0f, 0.19392274474868576f, 0.03760603093086393f, 0.007292664737217109f,
                        0.001414213562373095f, 0.0002742481756762073f, 5.318295896944988e-05f, 1.031338537721246e-05f};
  for (int i = bid * 256 + threadIdx.x; i < NT * 8; i += nblk * 256) {
    float c, s; rope_cs(p.pos[i >> 3], f16[i & 7], c, s);
    p.cs[i] = make_float2(c, s);
  }
}

template <int WM, int WN>
struct Gemm {
  static constexpr int BM = 64 * WM, BN = 64 * WN;
  static constexpr int A_BYTES = BM * 128, B_BYTES = BN * 128, STAGE = A_BYTES + B_BYTES;
  static constexpr int SMEM = 2 * STAGE;
  static constexpr int NA = BM / 32, NBK = BN / 32;

  struct Stage8 { uint4 a0, a1, a2, a3, b0, b1, b2, b3; };
  static __device__ __forceinline__ Stage8 ld_stage(const bf16_t* ap0, const bf16_t* ap1, const bf16_t* ap2, const bf16_t* ap3,
                                                    const bf16_t* bp0, const bf16_t* bp1, const bf16_t* bp2, const bf16_t* bp3, int ko) {
    Stage8 r;
    r.a0 = *(const uint4*)(ap0 + ko); r.a1 = *(const uint4*)(ap1 + ko);
    if (NA > 2) { r.a2 = *(const uint4*)(ap2 + ko); r.a3 = *(const uint4*)(ap3 + ko); } else { r.a2 = r.a0; r.a3 = r.a0; }
    r.b0 = *(const uint4*)(bp0 + ko); r.b1 = *(const uint4*)(bp1 + ko);
    if (NBK > 2) { r.b2 = *(const uint4*)(bp2 + ko); r.b3 = *(const uint4*)(bp3 + ko); } else { r.b2 = r.b0; r.b3 = r.b0; }
    return r;
  }
  static __device__ __forceinline__ void st_stage(const Stage8 r, unsigned char* dst, int wofs) {
    *(uint4*)(dst + wofs) = r.a0; *(uint4*)(dst + wofs + 4096) = r.a1;
    if (NA > 2) { *(uint4*)(dst + wofs + 8192) = r.a2; *(uint4*)(dst + wofs + 12288) = r.a3; }
    *(uint4*)(dst + A_BYTES + wofs) = r.b0; *(uint4*)(dst + A_BYTES + wofs + 4096) = r.b1;
    if (NBK > 2) { *(uint4*)(dst + A_BYTES + wofs + 8192) = r.b2; *(uint4*)(dst + A_BYTES + wofs + 12288) = r.b3; }
  }
  static __device__ __forceinline__ void compute_stage(f32x16 (&acc)[WM][WN], const unsigned char* cur, int wm, int wn, int fr, int fh) {
#pragma unroll
    for (int s = 0; s < 4; s++) {
      const int chunk = 2 * s + fh;
      bf16x8 af[WM], bfr[WN];
#pragma unroll
      for (int i = 0; i < WM; i++) {
        const int row = (wm * WM + i) * 32 + fr;
        af[i] = *(const bf16x8*)(cur + row * 128 + ((chunk ^ ((row >> 1) & 7)) << 4));
      }
#pragma unroll
      for (int j = 0; j < WN; j++) {
        const int row = (wn * WN + j) * 32 + fr;
        bfr[j] = *(const bf16x8*)(cur + A_BYTES + row * 128 + ((chunk ^ ((row >> 1) & 7)) << 4));
      }
#pragma unroll
      for (int i = 0; i < WM; i++)
#pragma unroll
        for (int j = 0; j < WN; j++) acc[i][j] = __builtin_amdgcn_mfma_f32_32x32x16_bf16(af[i], bfr[j], acc[i][j], 0, 0, 0);
    }
  }
  template <class ARow, class BRow>
  static __device__ __forceinline__ void mainloop(f32x16 (&acc)[WM][WN], ARow arow, BRow brow, int K, unsigned char* smem, int tid = threadIdx.x) {
    const int lane = tid & 63, w = tid >> 6, wm = w >> 1, wn = w & 1;
    const int lrow = tid >> 3, lchunk = tid & 7;
    const bf16_t* ap0 = arow(lrow) + lchunk * 8;
    const bf16_t* ap1 = arow(lrow + 32) + lchunk * 8;
    const bf16_t* ap2 = (NA > 2) ? arow(lrow + 64) + lchunk * 8 : ap0;
    const bf16_t* ap3 = (NA > 2) ? arow(lrow + 96) + lchunk * 8 : ap0;
    const bf16_t* bp0 = brow(lrow) + lchunk * 8;
    const bf16_t* bp1 = brow(lrow + 32) + lchunk * 8;
    const bf16_t* bp2 = (NBK > 2) ? brow(lrow + 64) + lchunk * 8 : bp0;
    const bf16_t* bp3 = (NBK > 2) ? brow(lrow + 96) + lchunk * 8 : bp0;
    const int wofs = lrow * 128 + ((lchunk ^ ((lrow >> 1) & 7)) << 4);
    const int fr = lane & 31, fh = lane >> 5;
    const int nk = K / 64;
    Stage8 rA = ld_stage(ap0, ap1, ap2, ap3, bp0, bp1, bp2, bp3, 0);
    Stage8 rB = ld_stage(ap0, ap1, ap2, ap3, bp0, bp1, bp2, bp3, 64);
    st_stage(rA, smem, wofs);
    rA = ld_stage(ap0, ap1, ap2, ap3, bp0, bp1, bp2, bp3, (nk > 2 ? 2 : 0) * 64);
    __syncthreads();
#pragma unroll 1
    for (int kt = 0; kt < nk; kt += 2) {
      compute_stage(acc, smem, wm, wn, fr, fh);
      st_stage(rB, smem + STAGE, wofs);
      if (kt + 3 < nk) rB = ld_stage(ap0, ap1, ap2, ap3, bp0, bp1, bp2, bp3, (kt + 3) * 64);
      __syncthreads();
      compute_stage(acc, smem + STAGE, wm, wn, fr, fh);
      if (kt + 2 < nk) {
        st_stage(rA, smem, wofs);
        if (kt + 4 < nk) rA = ld_stage(ap0, ap1, ap2, ap3, bp0, bp1, bp2, bp3, (kt + 4) * 64);
      }
      __syncthreads();
    }
  }
};

__device__ __forceinline__ int perm16(int k) { return (k & ~12) | ((k & 4) << 1) | ((k & 8) >> 1); }
constexpr float LOG2E = 1.4426950408889634f;
constexpr int FL_TILE = 8192;
constexpr int FL_STAGE = 2 * FL_TILE;
struct FlashAcc {
  f32x16 o[2];
  float m, l;
};
__device__ __forceinline__ void flash_init(FlashAcc& a) {
#pragma unroll
  for (int i = 0; i < 2; i++)
#pragma unroll
    for (int r = 0; r < 16; r++) a.o[i][r] = 0.f;
  a.m = -INFINITY; a.l = 0.f;
}
struct Tile2 { uint4 a, b; };
template <class RowF>
__device__ __forceinline__ Tile2 tile_fetch(RowF rowp, int tid) {
  Tile2 t;
  t.a = *(const uint4*)(rowp(tid >> 3) + (tid & 7) * 8);
  t.b = *(const uint4*)(rowp((tid >> 3) + 32) + (tid & 7) * 8);
  return t;
}
template <class RowF>
__device__ __forceinline__ Tile2 tile_fetch(RowF rowp) { return tile_fetch(rowp, (int)threadIdx.x); }
__device__ __forceinline__ void tile_store(const Tile2& t, unsigned char* dst, int tid = threadIdx.x) {
  const int row = tid >> 3, ch = tid & 7;
  const int ofs = row * 128 + ((ch ^ ((row >> 1) & 7)) << 4);
  *(uint4*)(dst + ofs) = t.a;
  *(uint4*)(dst + ofs + 4096) = t.b;
}
__device__ __forceinline__ bf16x8 lds_frag(const unsigned char* tile, int row, int chunk) {
  return *(const bf16x8*)(tile + row * 128 + ((chunk ^ ((row >> 1) & 7)) << 4));
}
__device__ __forceinline__ void flash_qk(f32x16 (&s)[2], const unsigned char* ktile, const bf16x8 (&qf)[4], int lane = threadIdx.x & 63) {
  const int fr = lane & 31, fh = lane >> 5;
  bf16x8 kf[8];
#pragma unroll
  for (int kt = 0; kt < 2; kt++)
#pragma unroll
    for (int ks = 0; ks < 4; ks++) kf[kt * 4 + ks] = lds_frag(ktile, kt * 32 + fr, 2 * ks + fh);
  __builtin_amdgcn_sched_barrier(0);
#pragma unroll
  for (int kt = 0; kt < 2; kt++)
#pragma unroll
    for (int r = 0; r < 16; r++) s[kt][r] = 0.f;
#pragma unroll
  for (int ks = 0; ks < 4; ks++)
#pragma unroll
    for (int kt = 0; kt < 2; kt++) s[kt] = __builtin_amdgcn_mfma_f32_32x32x16_bf16(kf[kt * 4 + ks], qf[ks], s[kt], 0, 0, 0);
  asm volatile("" ::: "memory");
}
#define MAX3(a, b, c) __builtin_elementwise_maximum(__builtin_elementwise_maximum((a), (b)), (c))
__device__ __forceinline__ bf16x8 pack_frag(const f32x16& s, int half8) {
  uint4 u = {pack2bf(s[8 * half8 + 0], s[8 * half8 + 1]), pack2bf(s[8 * half8 + 2], s[8 * half8 + 3]),
             pack2bf(s[8 * half8 + 4], s[8 * half8 + 5]), pack2bf(s[8 * half8 + 6], s[8 * half8 + 7])};
  return __builtin_bit_cast(bf16x8, u);
}
__device__ __forceinline__ void flash_update(FlashAcc& a, f32x16 (&s)[2], const unsigned char* vtile, bool colvalid = true, int lane = threadIdx.x & 63) {
  const int fr = lane & 31, fh = lane >> 5;
  bf16x8 vf[8];
#pragma unroll
  for (int h8 = 0; h8 < 2; h8++)
#pragma unroll
    for (int dt = 0; dt < 2; dt++) vf[h8 * 2 + dt] = lds_frag(vtile, dt * 32 + fr, 2 * h8 + fh);
  __builtin_amdgcn_sched_barrier(0);
  float mx = MAX3(s[0][0], s[1][0], s[0][1]), mx2 = MAX3(s[1][1], s[0][2], s[1][2]);
#pragma unroll
  for (int r = 3; r < 15; r += 2) { mx = MAX3(mx, s[0][r], s[1][r]); mx2 = MAX3(mx2, s[0][r + 1], s[1][r + 1]); }
  mx = MAX3(mx, s[0][15], s[1][15]);
  mx = MAX3(mx, mx2, __shfl_xor(__builtin_elementwise_maximum(mx, mx2), 32));
  mx = colvalid ? mx : -INFINITY;
  const float mnew = __builtin_elementwise_maximum(a.m, mx);
  const float muse = (mnew == -INFINITY) ? 0.f : mnew;
  if (__any(mnew != a.m)) {
    const float alpha = __builtin_amdgcn_exp2f((a.m - muse) * LOG2E);
    a.l *= alpha;
#pragma unroll
    for (int dt = 0; dt < 2; dt++)
#pragma unroll
      for (int r = 0; r < 16; r++) a.o[dt][r] *= alpha;
    a.m = mnew;
  }
  const float cb = colvalid ? -muse * LOG2E : -INFINITY;
#pragma unroll
  for (int r = 0; r < 16; r++) {
    s[0][r] = __builtin_amdgcn_exp2f(fmaf(s[0][r], LOG2E, cb));
    s[1][r] = __builtin_amdgcn_exp2f(fmaf(s[1][r], LOG2E, cb));
  }
  {
    f32x2 sm2 = {0.f, 0.f};
#pragma unroll
    for (int r = 0; r < 16; r += 2) {
      const f32x2 u0 = {s[0][r], s[0][r + 1]}, u1 = {s[1][r], s[1][r + 1]};
      sm2 += u0; sm2 += u1;
    }
    a.l += sm2[0] + sm2[1];
  }
#pragma unroll
  for (int h8 = 0; h8 < 2; h8++)
#pragma unroll
    for (int dt = 0; dt < 2; dt++) vf[4 + h8 * 2 + dt] = lds_frag(vtile, dt * 32 + fr, 4 + 2 * h8 + fh);
  __builtin_amdgcn_sched_barrier(0);
#pragma unroll
  for (int kt = 0; kt < 2; kt++)
#pragma unroll
    for (int h8 = 0; h8 < 2; h8++) {
      const bf16x8 pf = pack_frag(s[kt], h8);
#pragma unroll
      for (int dt = 0; dt < 2; dt++)
        a.o[dt] = __builtin_amdgcn_mfma_f32_32x32x16_bf16(vf[(kt * 2 + h8) * 2 + dt], pf, a.o[dt], 0, 0, 0);
    }
}
__device__ __forceinline__ float flash_inv_l(const FlashAcc& a) {
  const float lt = a.l + __shfl_xor(a.l, 32);
  return lt > 0.f ? 1.f / lt : 0.f;
}
__device__ __forceinline__ void flash_load_q(bf16x8 (&qf)[4], const bf16_t* qrow, float scale, int lane = threadIdx.x & 63) {
  const int fh = lane >> 5;
#pragma unroll
  for (int ks = 0; ks < 4; ks++) {
    const uint4 u = *(const uint4*)(qrow + ks * 16 + fh * 8);
    const unsigned w[4] = {u.x, u.y, u.z, u.w};
    uint4 o;
    o.x = pack2bf(__uint_as_float(w[0] << 16) * scale, __uint_as_float(w[0] & 0xFFFF0000u) * scale);
    o.y = pack2bf(__uint_as_float(w[1] << 16) * scale, __uint_as_float(w[1] & 0xFFFF0000u) * scale);
    o.z = pack2bf(__uint_as_float(w[2] << 16) * scale, __uint_as_float(w[2] & 0xFFFF0000u) * scale);
    o.w = pack2bf(__uint_as_float(w[3] << 16) * scale, __uint_as_float(w[3] & 0xFFFF0000u) * scale);
    qf[ks] = __builtin_bit_cast(bf16x8, o);
  }
}
__device__ __forceinline__ void flash_store_o(const FlashAcc& a, bf16_t* orow, float scale, int lane = threadIdx.x & 63) {
  const int fh = lane >> 5;
#pragma unroll
  for (int dt = 0; dt < 2; dt++)
#pragma unroll
    for (int g4 = 0; g4 < 4; g4++) {
      uint2 o = {pack2bf(a.o[dt][4 * g4 + 0] * scale, a.o[dt][4 * g4 + 1] * scale),
                 pack2bf(a.o[dt][4 * g4 + 2] * scale, a.o[dt][4 * g4 + 3] * scale)};
      *(uint2*)(orow + dt * 32 + 8 * g4 + 4 * fh) = o;
    }
}

__device__ __forceinline__ void mem_flash_item(const Params& p, unsigned char* smem, int item) {
  const int tid = tid_opaque(), lane = tid & 63, w = tid >> 6, fr = lane & 31;
  const int chunk = item & 31, h = (item >> 5) & 3, b = item >> 7;
  const int tok = b * SEQ + chunk * 128 + w * 32 + fr;
  bf16x8 qf[4];
  flash_load_q(qf, p.memq + (size_t)tok * 256 + h * 64, 0.125f, lane);
  FlashAcc acc; flash_init(acc);
  const bf16_t* kbase = p.mkv + (size_t)b * MEML * 512 + h * 64;
  const bf16_t* vbase = p.memvt + (size_t)(b * 4 + h) * 64 * MEML;
  Tile2 rk = tile_fetch([&](int r) { return kbase + (size_t)r * 512; }, tid);
  Tile2 rv = tile_fetch([&](int r) { return vbase + (size_t)r * MEML; }, tid);
  __syncthreads();
  tile_store(rk, smem, tid); tile_store(rv, smem + FL_TILE, tid);
  __syncthreads();
#pragma unroll 1
  for (int kb = 0; kb < 4; kb++) {
    unsigned char* cur = smem + (kb & 1) * FL_STAGE;
    if (kb + 1 < 4) {
      rk = tile_fetch([&](int r) { return kbase + (size_t)((kb + 1) * 64 + r) * 512; }, tid);
      rv = tile_fetch([&](int r) { return vbase + (size_t)r * MEML + (kb + 1) * 64; }, tid);
    }
    {
      f32x16 s[2];
      flash_qk(s, cur, qf, lane);
      flash_update(acc, s, cur + FL_TILE, true, lane);
    }
    if (kb + 1 < 4) { unsigned char* nxt = smem + ((kb + 1) & 1) * FL_STAGE; tile_store(rk, nxt, tid); tile_store(rv, nxt + FL_TILE, tid); }
    __syncthreads();
  }
  flash_store_o(acc, p.concat + (size_t)tok * DM + 768 + h * 64, flash_inv_l(acc), lane);
}
__device__ __forceinline__ void mem_phase(const Params& p, unsigned char* smem, int bid, int nblk) {
  for (int item = bid; item < NB * 4 * 32; item += nblk) mem_flash_item(p, smem, item);
}

__device__ __forceinline__ void ovp_phase(const Params& p, int bid, int nblk) {
  for (int i = bid * 256 + threadIdx.x; i < 64 * 256; i += nblk * 256) {
    const int m = i >> 8, n = i & 255;
    int ov = min(16 * n + 32, 64 * m + 64) - max(16 * n, 64 * m);
    if (ov < 0 || n >= NC) ov = 0;
    p.ovp[m * 256 + perm16(n)] = f2bf((float)ov * (1.f / 32.f));
  }
}

struct TileDest { bf16_t* ptr; int stride; int kind; };
__device__ __forceinline__ TileDest inproj_dest(const Params& p, int cb, int b) {
  TileDest d; d.kind = 0;
  if (cb < P_NSAKV) { d.ptr = p.qn + cb; d.stride = 512; d.kind = ((cb & 63) == 0) ? 1 : 0; }
  else if (cb < P_DSAQ) {
    const int o = cb - P_NSAKV, j = o >> 7, g = (o >> 6) & 1;
    if (j == 3 || j == 5) {
      d.ptr = (j == 3 ? p.vslct : p.vwint) + ((size_t)(b * 2 + g) * 64 + (o & 63)) * SEQ; d.stride = 0; d.kind = 5;
    } else {
      bf16_t* base = (j == 0) ? p.kvn[0] : (j == 1) ? p.kvn[1] : (j == 2) ? p.kvn[2] : p.kvn[4];
      d.ptr = base + ((size_t)g * SEQ + (size_t)b * SEQ) * 64 + (o & 63); d.stride = 64;
      d.kind = (((j & 1) == 0) && ((o & 63) == 0)) ? 1 : 0;
    }
  }
  else if (cb < P_DSAK) { d.ptr = p.qd + (cb - P_DSAQ); d.stride = 256; d.kind = ((cb & 63) == 0) ? 1 : 0; }
  else if (cb < P_DSAV) { d.ptr = p.kd + (cb - P_DSAK); d.stride = 64; d.kind = (cb == P_DSAK) ? 1 : 0; }
  else if (cb < P_IDXQ) { d.ptr = p.vd + (cb - P_DSAV); d.stride = 64; }
  else if (cb < P_IDXK) { d.ptr = p.qi + (cb - P_IDXQ); d.stride = 256; d.kind = 2; }
  else if (cb < P_MEMQ) { d.ptr = p.ki; d.stride = 32; d.kind = 2; }
  else if (cb < P_GATE) { d.ptr = p.memq + (cb - P_MEMQ); d.stride = 256; }
  else if (cb < P_END) { d.ptr = nullptr; d.stride = 0; d.kind = 3; }
  else { d.ptr = nullptr; d.stride = 0; d.kind = 4; }
  return d;
}
__device__ __forceinline__ void inproj_phase(const Params& p, unsigned char* smem, int bid, int nblk) {
  typedef Gemm<2, 2> G;
  const int lane = threadIdx.x & 63, w = threadIdx.x >> 6, wm = w >> 1, wn = w & 1;
  const int c = lane & 31, fh = lane >> 5;
  constexpr int TN = INWP / 128, TM = NT / 128;
  for (int tile = bid; tile < TM * TN; tile += nblk) {
    f32x16 acc[2][2];
#pragma unroll
    for (int i = 0; i < 2; i++)
#pragma unroll
      for (int j = 0; j < 2; j++)
#pragma unroll
        for (int r = 0; r < 16; r++) acc[i][j][r] = 0.f;
    {
      const int m0 = (tile / TN) * 128, n0 = (tile % TN) * 128;
      const bf16_t* A = p.xb + (size_t)m0 * DM;
      const bf16_t* Bt = p.wint + (size_t)n0 * DM;
      G::mainloop(acc, [&](int r) { return A + (size_t)r * DM; }, [&](int r) { return Bt + (size_t)r * DM; }, DM, smem);
      const int b = m0 / SEQ;
      unsigned char* wt = smem + w * 9216;
      const TileDest d0 = inproj_dest(p, n0 + (wn * 2 + 0) * 32, b);
      const TileDest d1 = inproj_dest(p, n0 + (wn * 2 + 1) * 32, b);
#pragma unroll
      for (int j = 0; j < 2; j++) {
        const TileDest d = j ? d1 : d0;
        if (d.kind == 4) continue;
        if (d.kind == 5) {
#pragma unroll
          for (int i = 0; i < 2; i++)
#pragma unroll
            for (int g4 = 0; g4 < 4; g4++) {
              const int tloc = (m0 & (SEQ - 1)) + (wm * 2 + i) * 32 + 8 * g4 + 4 * fh;
              uint2 o = {pack2bf(acc[i][j][4 * g4 + 0], acc[i][j][4 * g4 + 1]), pack2bf(acc[i][j][4 * g4 + 2], acc[i][j][4 * g4 + 3])};
              *(uint2*)(d.ptr + (size_t)c * SEQ + perm16(tloc)) = o;
            }
          continue;
        }
        if (d.kind == 3) {
#pragma unroll
          for (int i = 0; i < 2; i++)
#pragma unroll
            for (int r = 0; r < 16; r++) {
              const int tok = m0 + (wm * 2 + i) * 32 + (r & 3) + 8 * (r >> 2) + 4 * fh;
              const float v = acc[i][j][r];
              if (c < 24) p.gates[(size_t)tok * 24 + c] = 1.f / (1.f + __expf(-v));
              else p.widx[(size_t)tok * 8 + (c - 24)] = v * 0.0625f;
            }
          continue;
        }
#pragma unroll
        for (int i = 0; i < 2; i++) {
#pragma unroll
          for (int r = 0; r < 16; r++) {
            const int tok = m0 + (wm * 2 + i) * 32 + (r & 3) + 8 * (r >> 2) + 4 * fh;
            float v = acc[i][j][r];
            if (d.kind == 1) {
              const float pv = __shfl_xor(v, 8);
              if (c < 16) {
                const float2 cs = p.cs[(size_t)tok * 8 + (c & 7)];
                v = (c & 8) ? (v * cs.x + pv * cs.y) : (v * cs.x - pv * cs.y);
              }
            } else if (d.kind == 2) {
              const float pv = __shfl_xor(v, 4);
              if (c < 8) {
                const float2 cs = p.cs[(size_t)tok * 8 + 2 * (c & 3)];
                v = (c & 4) ? (v * cs.x + pv * cs.y) : (v * cs.x - pv * cs.y);
              }
            }
            acc[i][j][r] = v;
          }
#pragma unroll
          for (int r = 0; r < 16; r += 2) {
            const float va = acc[i][j][r], vb = acc[i][j][r + 1];
            const float na = __builtin_bit_cast(float, __builtin_amdgcn_update_dpp(0, __builtin_bit_cast(int, va), 0xB1, 0xF, 0xF, true));
            const float nb = __builtin_bit_cast(float, __builtin_amdgcn_update_dpp(0, __builtin_bit_cast(int, vb), 0xB1, 0xF, 0xF, true));
            const bool odd = c & 1;
            const unsigned pk = pack2bf(odd ? nb : va, odd ? vb : na);
            const int row = i * 32 + (r & 3) + 8 * (r >> 2) + 4 * fh + (odd ? 1 : 0);
            *(unsigned*)(wt + row * 144 + j * 64 + (c & ~1) * 2) = pk;
          }
        }
      }
      __builtin_amdgcn_wave_barrier();
      {
        const int chunk = lane & 7, jt = chunk >> 2;
        const TileDest d = jt ? d1 : d0;
        if (d.kind <= 2) {
#pragma unroll
          for (int it = 0; it < 8; it++) {
            const int row = it * 8 + (lane >> 3);
            const uint4 v = *(const uint4*)(wt + row * 144 + chunk * 16);
            const int tok = m0 + wm * 64 + row;
            *(uint4*)(d.ptr + (size_t)tok * d.stride + (chunk & 3) * 8) = v;
          }
        }
      }
      __syncthreads();
    }
  }
}

__device__ __forceinline__ void memkv_phase(const Params& p, unsigned char* smem, int bid, int nblk) {
  typedef Gemm<2, 2> G;
  const int lane = threadIdx.x & 63, w = threadIdx.x >> 6, wm = w >> 1, wn = w & 1;
  const int c = lane & 31, fh = lane >> 5;
  constexpr int TN2 = 512 / 128, TM2 = NB * MEML / 128;
  for (int t2 = bid; t2 < TM2 * TN2; t2 += nblk) {
    f32x16 acc[2][2];
#pragma unroll
    for (int i = 0; i < 2; i++)
#pragma unroll
      for (int j = 0; j < 2; j++)
#pragma unroll
        for (int r = 0; r < 16; r++) acc[i][j][r] = 0.f;
    {
      const int m0 = (t2 / TN2) * 128, n0 = (t2 % TN2) * 128;
      const bf16_t* A = p.memb + (size_t)m0 * DM;
      const bf16_t* Bt = p.wmemt + (size_t)n0 * DM;
      G::mainloop(acc, [&](int r) { return A + (size_t)r * DM; }, [&](int r) { return Bt + (size_t)r * DM; }, DM, smem);
#pragma unroll
      for (int i = 0; i < 2; i++)
#pragma unroll
        for (int j = 0; j < 2; j++)
          {
            const int cb = n0 + (wn * 2 + j) * 32;
            if (cb < 256) {
#pragma unroll
              for (int r = 0; r < 16; r++) {
                const int row = m0 + (wm * 2 + i) * 32 + (r & 3) + 8 * (r >> 2) + 4 * fh;
                p.mkv[(size_t)row * 512 + cb + c] = f2bf(acc[i][j][r]);
              }
            } else {
              const int dfull = cb + c - 256, head = dfull >> 6, d = dfull & 63;
              const int rowb = m0 + (wm * 2 + i) * 32, b = rowb >> 8, ml = rowb & 255;
              bf16_t* vrow = p.memvt + ((size_t)(b * 4 + head) * 64 + d) * MEML;
#pragma unroll
              for (int g4 = 0; g4 < 4; g4++) {
                uint2 o = {pack2bf(acc[i][j][4 * g4 + 0], acc[i][j][4 * g4 + 1]), pack2bf(acc[i][j][4 * g4 + 2], acc[i][j][4 * g4 + 3])};
                *(uint2*)(vrow + perm16(ml + 8 * g4 + 4 * fh)) = o;
              }
            }
          }
    }
  }
}

__device__ __forceinline__ unsigned f2key(float f) {
  unsigned u = __float_as_uint(f);
  return (u & 0x80000000u) ? ~u : (u | 0x80000000u);
}
__device__ __forceinline__ float key2f(unsigned k) {
  return __uint_as_float((k & 0x80000000u) ? (k ^ 0x80000000u) : ~k);
}
#define CE_DESC(a, b) { const unsigned _h = max(a, b); const unsigned _l = min(a, b); a = _h; b = _l; }
__device__ __forceinline__ void bitonic_merge16(unsigned (&m)[16]) {
#pragma unroll
  for (int st = 8; st >= 1; st >>= 1)
#pragma unroll
    for (int k = 0; k < 16; k++)
      if ((k & st) == 0) CE_DESC(m[k], m[k + st]);
}
__device__ __forceinline__ void sort16_desc(unsigned (&m)[16]) {
#pragma unroll
  for (int k = 2; k <= 16; k <<= 1)
#pragma unroll
    for (int j = k >> 1; j >= 1; j >>= 1)
#pragma unroll
      for (int i = 0; i < 16; i++) {
        const int l = i ^ j;
        if (l > i) {
          if ((i & k) == 0) { CE_DESC(m[i], m[l]); }
          else { const unsigned _h = max(m[i], m[l]); const unsigned _l = min(m[i], m[l]); m[i] = _l; m[l] = _h; }
        }
      }
}
__device__ __forceinline__ void insert16(unsigned (&L)[16], unsigned x) {
#pragma unroll
  for (int k = 0; k < 16; k++) { const unsigned hi = max(L[k], x); x = min(L[k], x); L[k] = hi; }
}
__device__ __forceinline__ void merge4_lists(unsigned (&L)[16], unsigned* lists, int t, int q) {
#pragma unroll
  for (int k = 0; k < 16; k++) lists[(q * 16 + k) * 64 + t] = L[k];
  __syncthreads();
  if (q < 2) {
#pragma unroll
    for (int k = 0; k < 16; k++) L[k] = max(lists[((2 * q) * 16 + k) * 64 + t], lists[((2 * q + 1) * 16 + 15 - k) * 64 + t]);
    bitonic_merge16(L);
#pragma unroll
    for (int k = 0; k < 16; k++) lists[((2 * q) * 16 + k) * 64 + t] = L[k];
  }
  __syncthreads();
  if (q == 0) {
#pragma unroll
    for (int k = 0; k < 16; k++) L[k] = max(L[k], lists[(2 * 16 + 15 - k) * 64 + t]);
    bitonic_merge16(L);
  }
}
__device__ __forceinline__ float dpp_rowsum(float x) {
  x += __builtin_bit_cast(float, __builtin_amdgcn_update_dpp(0, __builtin_bit_cast(int, x), 0xB1, 0xF, 0xF, true));
  x += __builtin_bit_cast(float, __builtin_amdgcn_update_dpp(0, __builtin_bit_cast(int, x), 0x4E, 0xF, 0xF, true));
  x += __builtin_bit_cast(float, __builtin_amdgcn_update_dpp(0, __builtin_bit_cast(int, x), 0x141, 0xF, 0xF, true));
  x += __builtin_bit_cast(float, __builtin_amdgcn_update_dpp(0, __builtin_bit_cast(int, x), 0x140, 0xF, 0xF, true));
  return x;
}
__device__ __forceinline__ float readlane_f(float v, int l) {
  return __int_as_float(__builtin_amdgcn_readlane(__float_as_int(v), l));
}
__device__ __forceinline__ float wave_sum_uniform(float x) {
  x = dpp_rowsum(x);
  return (readlane_f(x, 0) + readlane_f(x, 16)) + (readlane_f(x, 32) + readlane_f(x, 48));
}
__device__ __forceinline__ float dot8_bf16(const uint4& a, const uint4& b, float acc) {
  acc = __builtin_amdgcn_fdot2_f32_bf16(__builtin_bit_cast(bf16x2, a.x), __builtin_bit_cast(bf16x2, b.x), acc, false);
  acc = __builtin_amdgcn_fdot2_f32_bf16(__builtin_bit_cast(bf16x2, a.y), __builtin_bit_cast(bf16x2, b.y), acc, false);
  acc = __builtin_amdgcn_fdot2_f32_bf16(__builtin_bit_cast(bf16x2, a.z), __builtin_bit_cast(bf16x2, b.z), acc, false);
  acc = __builtin_amdgcn_fdot2_f32_bf16(__builtin_bit_cast(bf16x2, a.w), __builtin_bit_cast(bf16x2, b.w), acc, false);
  return acc;
}
__device__ __forceinline__ void fma8_bf16(float (&y)[8], const uint4& v, float w) {
  y[0] = fmaf(w, __uint_as_float(v.x << 16), y[0]); y[1] = fmaf(w, __uint_as_float(v.x & 0xFFFF0000u), y[1]);
  y[2] = fmaf(w, __uint_as_float(v.y << 16), y[2]); y[3] = fmaf(w, __uint_as_float(v.y & 0xFFFF0000u), y[3]);
  y[4] = fmaf(w, __uint_as_float(v.z << 16), y[4]); y[5] = fmaf(w, __uint_as_float(v.z & 0xFFFF0000u), y[5]);
  y[6] = fmaf(w, __uint_as_float(v.w << 16), y[6]); y[7] = fmaf(w, __uint_as_float(v.w & 0xFFFF0000u), y[7]);
}
__device__ const unsigned char cand_tab[52] = {
  0x00,0x01,0x02,0x03,0x04,0x05,0x06,0x07,0x08,0x09,0x0A,0x0B,0x0C,0x0D,0x0E,0x0F,
  0x10,0x11,0x12,0x13,0x14,0x15,0x16,0x17,
  0x20,0x21,0x22,0x23,0x24,
  0x30,0x31,0x32,0x33,
  0x40,0x41,0x42,
  0x50,0x51, 0x60,0x61, 0x70,0x71,
  0x80,0x90,0xA0,0xB0,0xC0,0xD0,0xE0,0xF0, 0xF0,0xF0};

__device__ __forceinline__ f16x2 bytes01_h2(unsigned w) { return __builtin_bit_cast(f16x2, __builtin_amdgcn_perm(w, 0x64646464u, 0x00050004u)); }
__device__ __forceinline__ f16x2 bytes23_h2(unsigned w) { return __builtin_bit_cast(f16x2, __builtin_amdgcn_perm(w, 0x64646464u, 0x00070006u)); }
template <int CTRL>
__device__ __forceinline__ float dpp_get(float x) {
  return __builtin_bit_cast(float, __builtin_amdgcn_update_dpp(0, __builtin_bit_cast(int, x), CTRL, 0xF, 0xF, true));
}
__device__ __forceinline__ float reduce16x16(const float (&ps)[16]) {
  const int lane = threadIdx.x & 63;
  const bool b0 = lane & 1, b1 = lane & 2, b2 = lane & 4, b3 = lane & 8;
  float r1[8], r2[4], r3[2];
#pragma unroll
  for (int i = 0; i < 8; i++) {
    const float u = ps[2 * i] + dpp_get<0xB1>(ps[2 * i]), v = ps[2 * i + 1] + dpp_get<0xB1>(ps[2 * i + 1]);
    r1[i] = b0 ? v : u;
  }
#pragma unroll
  for (int i = 0; i < 4; i++) {
    const float u = r1[2 * i] + dpp_get<0x4E>(r1[2 * i]), v = r1[2 * i + 1] + dpp_get<0x4E>(r1[2 * i + 1]);
    r2[i] = b1 ? v : u;
  }
#pragma unroll
  for (int i = 0; i < 2; i++) {
    const float u = r2[2 * i] + dpp_get<0x104>(r2[2 * i]);
    const float v = r2[2 * i + 1] + dpp_get<0x114>(r2[2 * i + 1]);
    r3[i] = b2 ? v : u;
  }
  const float u = r3[0] + dpp_get<0x128>(r3[0]), v = r3[1] + dpp_get<0x128>(r3[1]);
  float r = b3 ? v : u;
  r += __int_as_float(__builtin_amdgcn_ds_swizzle(__float_as_int(r), 0x401F));
  r += __shfl_xor(r, 32);
  return r;
}
constexpr int PE_EXPERT_DEPTH = 8;

__device__ __forceinline__ void peer_block_phase(const Params& p, unsigned char* smem, int bid, int nblk) {
  const int tid = tid_opaque(), lane = tid & 63, w = tid >> 6, wm = w >> 1, wn = w & 1;
  const int c = lane & 31, fh = lane >> 5;
  float* S = (float*)smem;
  unsigned* lists = (unsigned*)(smem + 32768);
  unsigned* ablist = (unsigned*)(smem + 49152);
  int* fin_e = (int*)(smem + 57344);
  float* fin_g = (float*)(smem + 57344 + 4096);
  for (int blk = bid; blk < NT / 64; blk += nblk) {
    const int t0 = blk * 64;
#pragma unroll 1
    for (int nt = 0; nt < 8; nt++) {
      f32x16 acc[1][2];
#pragma unroll
      for (int j = 0; j < 2; j++)
#pragma unroll
        for (int r = 0; r < 16; r++) acc[0][j][r] = 0.f;
      const bf16_t* cbase = p.concat;
      asm volatile("" : "+s"(cbase));
      const bf16_t* A = cbase + (size_t)t0 * DM;
      const bf16_t* Bt = p.woutt + (size_t)nt * 128 * DM;
      Gemm<1, 2>::mainloop(acc, [&](int r) { return A + (size_t)r * DM; }, [&](int r) { return Bt + (size_t)r * DM; }, DM, smem, tid);
      {
        const unsigned ebase = (unsigned)(t0 + wm * 32 + 4 * fh) * DM + nt * 128 + wn * 64 + c;
#pragma unroll
        for (int j = 0; j < 2; j++) {
#pragma unroll
          for (int r = 0; r < 16; r++) {
            const unsigned idx = ebase + (unsigned)(((r & 3) + 8 * (r >> 2)) * DM + j * 32);
            p.out[idx] = acc[0][j][r] + ALPHA * p.x[idx];
          }
          asm volatile("" ::: "memory");
        }
      }
    }
    __syncthreads();
#pragma unroll 1
    for (int rr = 0; rr < 16; rr++) {
      const int tok = t0 + w * 16 + rr;
      float* row = p.out + (size_t)tok * DM;
      float v[16];
      {
        const float4 a0 = *(const float4*)(row + 8 * lane), a1 = *(const float4*)(row + 8 * lane + 4);
        const float4 a2 = *(const float4*)(row + 512 + 8 * lane), a3 = *(const float4*)(row + 512 + 8 * lane + 4);
        v[0] = a0.x; v[1] = a0.y; v[2] = a0.z; v[3] = a0.w; v[4] = a1.x; v[5] = a1.y; v[6] = a1.z; v[7] = a1.w;
        v[8] = a2.x; v[9] = a2.y; v[10] = a2.z; v[11] = a2.w; v[12] = a3.x; v[13] = a3.y; v[14] = a3.z; v[15] = a3.w;
      }
      float s = 0.f;
#pragma unroll
      for (int i = 0; i < 16; i++) s += v[i];
      const float mu = wave_sum(s) * (1.f / DM);
      float qv = 0.f;
#pragma unroll
      for (int i = 0; i < 16; i++) { v[i] -= mu; qv += v[i] * v[i]; }
      const float rs = rsqrtf(wave_sum(qv) * (1.f / DM) + 1e-5f);
#pragma unroll
      for (int hf = 0; hf < 2; hf++) {
        const int e0 = hf * 512 + 8 * lane;
        const float4 g0 = *(const float4*)(p.ln1g + e0), g1 = *(const float4*)(p.ln1g + e0 + 4);
        const float4 b0 = *(const float4*)(p.ln1b + e0), b1 = *(const float4*)(p.ln1b + e0 + 4);
        float o[8];
        o[0] = v[hf * 8 + 0] * rs * g0.x + b0.x; o[1] = v[hf * 8 + 1] * rs * g0.y + b0.y;
        o[2] = v[hf * 8 + 2] * rs * g0.z + b0.z; o[3] = v[hf * 8 + 3] * rs * g0.w + b0.w;
        o[4] = v[hf * 8 + 4] * rs * g1.x + b1.x; o[5] = v[hf * 8 + 5] * rs * g1.y + b1.y;
        o[6] = v[hf * 8 + 6] * rs * g1.z + b1.z; o[7] = v[hf * 8 + 7] * rs * g1.w + b1.w;
        *(float4*)(row + e0) = make_float4(o[0], o[1], o[2], o[3]);
        *(float4*)(row + e0 + 4) = make_float4(o[4], o[5], o[6], o[7]);
        uint4 pk = {pack2bf(o[0], o[1]), pack2bf(o[2], o[3]), pack2bf(o[4], o[5]), pack2bf(o[6], o[7])};
        *(uint4*)(p.x1b + (size_t)tok * DM + e0) = pk;
        const f16x2 h0 = {(_Float16)o[0], (_Float16)o[1]}, h1 = {(_Float16)o[2], (_Float16)o[3]};
        const f16x2 h2 = {(_Float16)o[4], (_Float16)o[5]}, h3 = {(_Float16)o[6], (_Float16)o[7]};
        uint4 ph = {__builtin_bit_cast(unsigned, h0), __builtin_bit_cast(unsigned, h1), __builtin_bit_cast(unsigned, h2), __builtin_bit_cast(unsigned, h3)};
        *(uint4*)(p.xb + (size_t)tok * DM + e0) = ph;
      }
    }
    __syncthreads();
    const int ts = tid & 63, qs = tid >> 6;
#pragma unroll 1
    for (int hh = 0; hh < 8; hh++) {
#pragma unroll 1
      for (int half = 0; half < 2; half++) {
        f32x16 acc[2][1];
#pragma unroll
        for (int i = 0; i < 2; i++)
#pragma unroll
          for (int r = 0; r < 16; r++) acc[i][0][r] = 0.f;
        const bf16_t* A = p.wqt + (size_t)(hh * 256 + half * 128) * DM;
        const bf16_t* xbase = p.x1b;
        asm volatile("" : "+s"(xbase));
        const bf16_t* Bt = xbase + (size_t)t0 * DM;
        Gemm<2, 1>::mainloop(acc, [&](int r) { return A + (size_t)r * DM; }, [&](int r) { return Bt + (size_t)r * DM; }, DM, smem, tid);
        const bf16_t* skp = half ? p.sk2p : p.sk1p;
        auto score_part = [&](const bool add) __attribute__((always_inline)) {
#pragma unroll
          for (int np = 0; np < 2; np++) {
            f32x16 sp[2];
#pragma unroll
            for (int nn = 0; nn < 2; nn++)
#pragma unroll
              for (int r = 0; r < 16; r++) sp[nn][r] = 0.f;
#pragma unroll
            for (int i = 0; i < 2; i++)
#pragma unroll
              for (int s2 = 0; s2 < 2; s2++) {
                uint4 qb = {pack2bf(acc[i][0][8 * s2 + 0], acc[i][0][8 * s2 + 1]), pack2bf(acc[i][0][8 * s2 + 2], acc[i][0][8 * s2 + 3]),
                            pack2bf(acc[i][0][8 * s2 + 4], acc[i][0][8 * s2 + 5]), pack2bf(acc[i][0][8 * s2 + 6], acc[i][0][8 * s2 + 7])};
                const bf16x8 qf = __builtin_bit_cast(bf16x8, qb);
#pragma unroll
                for (int nn = 0; nn < 2; nn++) {
                  const bf16x8 kf = *(const bf16x8*)(skp + (size_t)((np * 2 + nn) * 32 + c) * 128 + wm * 64 + i * 32 + s2 * 16 + fh * 8);
                  sp[nn] = __builtin_amdgcn_mfma_f32_32x32x16_bf16(kf, qf, sp[nn], 0, 0, 0);
                }
              }
#pragma unroll
            for (int nn = 0; nn < 2; nn++)
#pragma unroll
              for (int r = 0; r < 16; r++) {
                float* dst = S + ((np * 2 + nn) * 32 + (r & 3) + 8 * (r >> 2) + 4 * fh) * 64 + wn * 32 + c;
                if (add) *dst += sp[nn][r]; else *dst = sp[nn][r];
              }
            asm volatile("" ::: "memory");
          }
        };
        if (wm == 0) score_part(false);
        __syncthreads();
        if (wm == 1) score_part(true);
        __syncthreads();
        unsigned L[16], M2[16];
#pragma unroll
        for (int i = 0; i < 16; i++) {
          const int n0_ = qs * 32 + i, n1_ = n0_ + 16;
          L[i] = (f2key(S[n0_ * 64 + ts]) & ~127u) | (unsigned)n0_;
          M2[i] = (f2key(S[n1_ * 64 + ts]) & ~127u) | (unsigned)n1_;
        }
        sort16_desc(L); sort16_desc(M2);
#pragma unroll
        for (int k = 0; k < 16; k++) L[k] = max(L[k], M2[15 - k]);
        bitonic_merge16(L);
        merge4_lists(L, lists, ts, qs);
        if (qs == 0) {
#pragma unroll
          for (int k = 0; k < 16; k++) ablist[(half * 16 + k) * 64 + ts] = L[k];
        }
        __syncthreads();
      }
      {
        unsigned L[16];
#pragma unroll
        for (int k = 0; k < 16; k++) L[k] = 0u;
#pragma unroll 1
        for (int cc = qs; cc < 50; cc += 4) {
          const unsigned code = cand_tab[cc];
          const float sum = key2f(ablist[(code >> 4) * 64 + ts]) + key2f(ablist[(16 + (code & 15)) * 64 + ts]);
          insert16(L, (f2key(sum) & ~255u) | code);
        }
        merge4_lists(L, lists, ts, qs);
        if (qs == 0) {
          const float mx = key2f(L[0]);
          float e[16], sum = 0.f;
#pragma unroll
          for (int k = 0; k < 16; k++) { e[k] = __expf(key2f(L[k]) - mx); sum += e[k]; }
          const float inv = 1.f / sum;
#pragma unroll
          for (int k = 0; k < 16; k++) {
            const unsigned code = L[k] & 255u;
            const unsigned ia = ablist[(code >> 4) * 64 + ts] & 127u, ib = ablist[(16 + (code & 15)) * 64 + ts] & 127u;
            fin_e[ts * 16 + k] = (int)(ia * 128u + ib);
            fin_g[ts * 16 + k] = e[k] * inv;
          }
        }
        __syncthreads();
        {
          int tid_o = tid;
          asm volatile("" : "+v"(tid_o));
          const int tt = tid_o >> 2, k4 = (tid_o & 3) * 4;
          *(int4*)(p.pexp + (size_t)(t0 + tt) * 128 + hh * 16 + k4) = *(const int4*)(fin_e + tt * 16 + k4);
          *(float4*)(p.pgate + (size_t)(t0 + tt) * 128 + hh * 16 + k4) = *(const float4*)(fin_g + tt * 16 + k4);
        }
        __syncthreads();
      }
    }
  }
}
__device__ __forceinline__ void peer_e3_phase(const Params& p, int bid, int nblk) {
  int tid_o = threadIdx.x;
  asm volatile("" : "+v"(tid_o));
  const int lane = tid_o & 63, w = __builtin_amdgcn_readfirstlane(tid_o >> 6);
  for (int blk = bid; blk < NT / 64; blk += nblk) {
    const int t0 = blk * 64;
    {
      const int tokb = t0 + w * 16;
      int idc0 = p.pexp[(size_t)tokb * 128 + lane], idc1 = p.pexp[(size_t)tokb * 128 + 64 + lane];
      uint4 xq0 = *(const uint4*)(p.xb + (size_t)tokb * DM + 16 * lane), xq1 = *(const uint4*)(p.xb + (size_t)tokb * DM + 16 * lane + 8);
      uint4 bu[8];
#pragma unroll
      for (int d = 0; d < 8; d++) {
        const int id = __builtin_amdgcn_readlane(idc0, d);
        bu[d] = *(const uint4*)(p.puq + (size_t)id * DM + 16 * lane);
      }
#pragma unroll 1
      for (int rr = 0; rr < 16; rr++) {
        const int tok = tokb + rr, tokn = tokb + min(rr + 1, 15);
        const int idn0 = p.pexp[(size_t)tokn * 128 + lane];
        const uint4 xn0 = *(const uint4*)(p.xb + (size_t)tokn * DM + 16 * lane), xn1 = *(const uint4*)(p.xb + (size_t)tokn * DM + 16 * lane + 8);
        const float g0 = p.pgate[(size_t)tok * 128 + lane], g1 = p.pgate[(size_t)tok * 128 + 64 + lane];
        const float su0 = p.psu[idc0], su1 = p.psu[idc1], sv0 = p.psv[idc0], sv1 = p.psv[idc1];
        f16x2 xh[8];
        xh[0] = __builtin_bit_cast(f16x2, xq0.x); xh[1] = __builtin_bit_cast(f16x2, xq0.y); xh[2] = __builtin_bit_cast(f16x2, xq0.z); xh[3] = __builtin_bit_cast(f16x2, xq0.w);
        xh[4] = __builtin_bit_cast(f16x2, xq1.x); xh[5] = __builtin_bit_cast(f16x2, xq1.y); xh[6] = __builtin_bit_cast(f16x2, xq1.z); xh[7] = __builtin_bit_cast(f16x2, xq1.w);
        float xs = 0.f;
#pragma unroll
        for (int i = 0; i < 8; i++) xs += (float)xh[i][0] + (float)xh[i][1];
        const float xoff = 1152.f * wave_sum_uniform(xs);
        float a0 = 0.f, a1 = 0.f;
#pragma unroll 1
        for (int e0 = 0; e0 < 128; e0 += 16) {
          const int isrcA = (e0 + 8 < 64) ? idc0 : idc1;
          const int isrcB = (e0 + 16 < 64) ? idc0 : (e0 + 16 < 128) ? idc1 : idn0;
          float ps[16];
#pragma unroll
          for (int d = 0; d < 16; d++) {
            const unsigned qw[4] = {bu[d & 7].x, bu[d & 7].y, bu[d & 7].z, bu[d & 7].w};
            float s0 = 0.f, s1 = 0.f;
#pragma unroll
            for (int i = 0; i < 4; i++) {
              s0 = __builtin_amdgcn_fdot2(bytes01_h2(qw[i]), xh[2 * i], s0, false);
              s1 = __builtin_amdgcn_fdot2(bytes23_h2(qw[i]), xh[2 * i + 1], s1, false);
            }
            ps[d] = s0 + s1;
            const int id = __builtin_amdgcn_readlane((d < 8) ? isrcA : isrcB, (e0 + 8 + d) & 63);
            bu[d & 7] = *(const uint4*)(p.puq + (size_t)id * DM + 16 * lane);
          }
          const float r = reduce16x16(ps);
          const bool mine = (lane >> 4) == ((e0 >> 4) & 3);
          if (e0 < 64) a0 = mine ? r : a0; else a1 = mine ? r : a1;
        }
        a0 = (a0 - xoff) * su0;
        a1 = (a1 - xoff) * su1;
        p.pgate[(size_t)tok * 128 + lane] = g0 * gelu_exact(a0) * sv0;
        p.pgate[(size_t)tok * 128 + 64 + lane] = g1 * gelu_exact(a1) * sv1;
        idc0 = idn0; idc1 = p.pexp[(size_t)tokn * 128 + 64 + lane];
        xq0 = xn0; xq1 = xn1;
      }
      idc0 = p.pexp[(size_t)tokb * 128 + lane]; idc1 = p.pexp[(size_t)tokb * 128 + 64 + lane];
      uint4 bv[8];
#pragma unroll
      for (int d = 0; d < 8; d++) {
        const int id = __builtin_amdgcn_readlane(idc0, d);
        bv[d] = *(const uint4*)(p.pvq + (size_t)id * DM + 16 * lane);
      }
#pragma unroll 1
      for (int rr = 0; rr < 16; rr++) {
        const int tok = tokb + rr, tokn = tokb + min(rr + 1, 15);
        const int idn0 = p.pexp[(size_t)tokn * 128 + lane];
        const float w0 = p.pgate[(size_t)tok * 128 + lane], w1 = p.pgate[(size_t)tok * 128 + 64 + lane];
        float* row = p.out + (size_t)tok * DM + 16 * lane;
        const float coff = 1152.f * wave_sum_uniform(w0 + w1);
        float y[16];
#pragma unroll
        for (int i = 0; i < 16; i++) y[i] = 0.f;
#pragma unroll 1
        for (int e0 = 0; e0 < 128; e0 += 16) {
          const int isrcA = (e0 + 8 < 64) ? idc0 : idc1;
          const int isrcB = (e0 + 16 < 64) ? idc0 : (e0 + 16 < 128) ? idc1 : idn0;
          const float wsrc = (e0 < 64) ? w0 : w1;
#pragma unroll
          for (int d = 0; d < 16; d++) {
            const float wgt = readlane_f(wsrc, (e0 + d) & 63);
            const unsigned qw[4] = {bv[d & 7].x, bv[d & 7].y, bv[d & 7].z, bv[d & 7].w};
#pragma unroll
            for (int i = 0; i < 4; i++) {
              const f16x2 h01 = bytes01_h2(qw[i]), h23 = bytes23_h2(qw[i]);
              y[4 * i + 0] = fmaf(wgt, (float)h01[0], y[4 * i + 0]);
              y[4 * i + 1] = fmaf(wgt, (float)h01[1], y[4 * i + 1]);
              y[4 * i + 2] = fmaf(wgt, (float)h23[0], y[4 * i + 2]);
              y[4 * i + 3] = fmaf(wgt, (float)h23[1], y[4 * i + 3]);
            }
            const int id = __builtin_amdgcn_readlane((d < 8) ? isrcA : isrcB, (e0 + 8 + d) & 63);
            bv[d & 7] = *(const uint4*)(p.pvq + (size_t)id * DM + 16 * lane);
          }
        }
        const float4 xr0 = *(const float4*)(row), xr1 = *(const float4*)(row + 4), xr2 = *(const float4*)(row + 8), xr3 = *(const float4*)(row + 12);
        float v[16];
        v[0] = ALPHA * xr0.x + (y[0] - coff); v[1] = ALPHA * xr0.y + (y[1] - coff); v[2] = ALPHA * xr0.z + (y[2] - coff); v[3] = ALPHA * xr0.w + (y[3] - coff);
        v[4] = ALPHA * xr1.x + (y[4] - coff); v[5] = ALPHA * xr1.y + (y[5] - coff); v[6] = ALPHA * xr1.z + (y[6] - coff); v[7] = ALPHA * xr1.w + (y[7] - coff);
        v[8] = ALPHA * xr2.x + (y[8] - coff); v[9] = ALPHA * xr2.y + (y[9] - coff); v[10] = ALPHA * xr2.z + (y[10] - coff); v[11] = ALPHA * xr2.w + (y[11] - coff);
        v[12] = ALPHA * xr3.x + (y[12] - coff); v[13] = ALPHA * xr3.y + (y[13] - coff); v[14] = ALPHA * xr3.z + (y[14] - coff); v[15] = ALPHA * xr3.w + (y[15] - coff);
        float sm = 0.f;
#pragma unroll
        for (int i = 0; i < 16; i++) sm += v[i];
        const float mu = wave_sum_uniform(sm) * (1.f / DM);
        float qv = 0.f;
#pragma unroll
        for (int i = 0; i < 16; i++) { v[i] -= mu; qv += v[i] * v[i]; }
        const float rs = rsqrtf(wave_sum_uniform(qv) * (1.f / DM) + 1e-5f);
#pragma unroll
        for (int i4 = 0; i4 < 4; i4++) {
          const float4 gg = *(const float4*)(p.ln2g + 16 * lane + 4 * i4), bb = *(const float4*)(p.ln2b + 16 * lane + 4 * i4);
          *(float4*)(row + 4 * i4) = make_float4(v[4 * i4 + 0] * rs * gg.x + bb.x, v[4 * i4 + 1] * rs * gg.y + bb.y,
                                                 v[4 * i4 + 2] * rs * gg.z + bb.z, v[4 * i4 + 3] * rs * gg.w + bb.w);
        }
        idc0 = idn0; idc1 = p.pexp[(size_t)tokn * 128 + 64 + lane];
      }
    }
    __syncthreads();
  }
}

__device__ __forceinline__ void cbias_phase(const Params& p, int bid, int nblk) {
  const int which = threadIdx.x >> 7, j = threadIdx.x & 127;
  const float* w1 = which ? p.w1v : p.w1k;
  const float* pe = which ? p.pe_v : p.pe_k;
  for (int ch = bid; ch < 64; ch += nblk) {
    float a = 0.f;
#pragma unroll 8
    for (int r = ch * 32; r < ch * 32 + 32; r++) a = fmaf(pe[r], w1[(size_t)r * 128 + j], a);
    p.cbias[ch * 256 + which * 128 + j] = a;
  }
}
__device__ __forceinline__ void compress_phase(const Params& p, unsigned char* smem, int bid, int nblk) {
  typedef Gemm<1, 2> G;
  const int tid = threadIdx.x, lane = tid & 63, w = tid >> 6, wm = w >> 1, wn = w & 1, c = lane & 31, fh = lane >> 5;
  float* hid = (float*)smem;
  float* cb = (float*)(smem + 49152);
  if (bid < NB * 2 * 2 * 4) {
    float a = 0.f;
    for (int ch = 0; ch < 64; ch++) a += p.cbias[ch * 256 + tid];
    cb[tid] = a;
  }
  __syncthreads();
  for (int item = bid; item < NB * 2 * 2 * 4; item += nblk) {
    const int mt = item & 3, which = (item >> 2) & 1, bgi = item >> 3;
    const int m0 = mt * 64;
    const bf16_t* A = (which ? p.kvn[1] : p.kvn[0]) + (size_t)bgi * SEQ * 64;
    const bf16_t* Bt = which ? p.w1vt : p.w1kt;
    f32x16 acc[1][2];
#pragma unroll
    for (int j = 0; j < 2; j++)
#pragma unroll
      for (int r = 0; r < 16; r++) acc[0][j][r] = 0.f;
    G::mainloop(acc, [&](int r) { const int i = min(m0 + r, NC - 1); return A + (size_t)i * 1024; },
                [&](int r) { return Bt + (size_t)r * 2048; }, 2048, smem);
#pragma unroll
    for (int j = 0; j < 2; j++)
#pragma unroll
      for (int r = 0; r < 16; r++) {
        const int row = wm * 32 + (r & 3) + 8 * (r >> 2) + 4 * fh, col = (wn * 2 + j) * 32 + c;
        hid[row * 129 + col] = gelu_exact(acc[0][j][r] + cb[which * 128 + col]);
      }
    __syncthreads();
    {
      const int row = tid >> 2, dq = (tid & 3) * 16;
      const float* w2 = which ? p.w2v : p.w2k;
      float o[16];
#pragma unroll
      for (int i = 0; i < 16; i++) o[i] = 0.f;
      for (int k = 0; k < 128; k++) {
        const float h = hid[row * 129 + k];
        const float4 w0 = *(const float4*)(w2 + k * 64 + dq), w1_ = *(const float4*)(w2 + k * 64 + dq + 4);
        const float4 w2_ = *(const float4*)(w2 + k * 64 + dq + 8), w3 = *(const float4*)(w2 + k * 64 + dq + 12);
        o[0] = fmaf(h, w0.x, o[0]); o[1] = fmaf(h, w0.y, o[1]); o[2] = fmaf(h, w0.z, o[2]); o[3] = fmaf(h, w0.w, o[3]);
        o[4] = fmaf(h, w1_.x, o[4]); o[5] = fmaf(h, w1_.y, o[5]); o[6] = fmaf(h, w1_.z, o[6]); o[7] = fmaf(h, w1_.w, o[7]);
        o[8] = fmaf(h, w2_.x, o[8]); o[9] = fmaf(h, w2_.y, o[9]); o[10] = fmaf(h, w2_.z, o[10]); o[11] = fmaf(h, w2_.w, o[11]);
        o[12] = fmaf(h, w3.x, o[12]); o[13] = fmaf(h, w3.y, o[13]); o[14] = fmaf(h, w3.z, o[14]); o[15] = fmaf(h, w3.w, o[15]);
      }
      const int i = m0 + row;
      const bool valid = i < NC;
      if (which == 0) {
        bf16_t* dst = p.kcb + ((size_t)bgi * 256 + i) * 64 + dq;
        uint4 u0 = {pack2bf(o[0], o[1]), pack2bf(o[2], o[3]), pack2bf(o[4], o[5]), pack2bf(o[6], o[7])};
        uint4 u1 = {pack2bf(o[8], o[9]), pack2bf(o[10], o[11]), pack2bf(o[12], o[13]), pack2bf(o[14], o[15])};
        if (!valid) { u0 = make_uint4(0, 0, 0, 0); u1 = u0; }
        *(uint4*)dst = u0; *(uint4*)(dst + 8) = u1;
      } else {
#pragma unroll
        for (int e = 0; e < 16; e++) p.vct[((size_t)bgi * 64 + dq + e) * 256 + perm16(i)] = valid ? f2bf(o[e]) : (bf16_t)0;
      }
    }
    __syncthreads();
  }
}

__device__ __forceinline__ void softmax4(float* sc, int ld, int n) {
  const int w = threadIdx.x >> 6, lane = threadIdx.x & 63;
  float* s = sc + w * ld;
  float m = -INFINITY;
  for (int i = lane; i < n; i += 64) m = fmaxf(m, s[i]);
  m = wave_max(m);
  if (m == -INFINITY) m = 0.f;
  float sum = 0.f;
  for (int i = lane; i < n; i += 64) { float e = expf(s[i] - m); s[i] = e; sum += e; }
  sum = wave_sum(sum);
  const float inv = 1.f / (sum > 0.f ? sum : 1.f);
  for (int i = lane; i < n; i += 64) s[i] *= inv;
}
__device__ __forceinline__ float dot64_bf(const float* q, const bf16_t* k) {
  float s = 0.f;
#pragma unroll
  for (int e = 0; e < 64; e += 8) {
    const uint4 v = *(const uint4*)(k + e);
    const unsigned u[4] = {v.x, v.y, v.z, v.w};
#pragma unroll
    for (int i = 0; i < 4; i++) {
      s = fmaf(q[e + 2 * i], __uint_as_float(u[i] << 16), s);
      s = fmaf(q[e + 2 * i + 1], __uint_as_float(u[i] & 0xFFFF0000u), s);
    }
  }
  return s;
}

template <class KRow, class VRow, class Body>
__device__ __forceinline__ void flash_stream(unsigned char* smem, int j0, int j1, KRow krow, VRow vrow, Body body) {
  if (j0 >= j1) return;
  Tile2 rk = tile_fetch([&](int r) __attribute__((always_inline)) { return krow(j0, r); });
  Tile2 rv = tile_fetch([&](int r) __attribute__((always_inline)) { return vrow(j0, r); });
  __syncthreads();
  tile_store(rk, smem); tile_store(rv, smem + FL_TILE);
  __syncthreads();
#pragma unroll 1
  for (int j = j0; j < j1; j++) {
    unsigned char* cur = smem + ((j - j0) & 1) * FL_STAGE;
    if (j + 1 < j1) {
      rk = tile_fetch([&](int r) __attribute__((always_inline)) { return krow(j + 1, r); });
      rv = tile_fetch([&](int r) __attribute__((always_inline)) { return vrow(j + 1, r); });
    }
    body(cur, j);
    if (j + 1 < j1) { unsigned char* nxt = smem + ((j - j0 + 1) & 1) * FL_STAGE; tile_store(rk, nxt); tile_store(rv, nxt + FL_TILE); }
    __syncthreads();
  }
}
__device__ __forceinline__ float quad_sum(float x) {
  x += __builtin_bit_cast(float, __builtin_amdgcn_update_dpp(0, __builtin_bit_cast(int, x), 0xB1, 0xF, 0xF, true));
  x += __builtin_bit_cast(float, __builtin_amdgcn_update_dpp(0, __builtin_bit_cast(int, x), 0x4E, 0xF, 0xF, true));
  return x;
}
__device__ __forceinline__ void nsa_flash_item(const Params& p, unsigned char* smem, int item) {
  const int tid = threadIdx.x, lane = tid & 63, w = tid >> 6, fr = lane & 31, fh = lane >> 5;
  const int cc = item & 127, g = (item >> 7) & 1, b = item >> 8;
  const int c64 = cc >> 1;
  const int t0 = cc * 32;
  const int tl = 8 * w + (fr >> 2), hq = fr & 3;
  const int t = t0 + tl, tok = b * SEQ + t;
  const int t64 = t & 63;
  float* impS = (float*)smem;
  unsigned* selm = (unsigned*)(smem + 32 * 65 * 4);
  float* stash = (float*)(smem + 2 * FL_STAGE) + w * 2048 + lane;
  bf16x8 qf[4];
  flash_load_q(qf, p.qn + (size_t)tok * 512 + g * 256 + hq * 64, 0.125f);
  const float* gt = p.gates + (size_t)tok * 24 + (g * 4 + hq) * 3;
  const float g_cmp = gt[0], g_sel = gt[1], g_win = gt[2];
  const size_t bg = (size_t)(b * 2 + g);
  {
    const int nvmax = 2 * cc + 1, nkb = (nvmax + 63) >> 6;
    const int nvl = (t >= 31) ? ((t - 31) >> 4) + 1 : 0;
    const bf16_t* kcb = p.kcb + bg * 256 * 64;
    const bf16_t* vct = p.vct + bg * 64 * 256;
    auto krow = [&](int j, int r) __attribute__((always_inline)) { return kcb + (size_t)(j * 64 + r) * 64; };
    auto vrow = [&](int j, int r) __attribute__((always_inline)) { return vct + (size_t)r * 256 + j * 64; };
    float m = -INFINITY, l = 0.f;
    flash_stream(smem, 0, nkb, krow, vrow, [&](unsigned char* cur, int j) __attribute__((always_inline)) {
      f32x16 s[2];
      flash_qk(s, cur, qf);
      float mx = -INFINITY;
#pragma unroll
      for (int kt = 0; kt < 2; kt++)
#pragma unroll
        for (int r = 0; r < 16; r++) {
          const int n = j * 64 + kt * 32 + (r & 3) + 8 * (r >> 2) + 4 * fh;
          s[kt][r] = (n < nvl) ? s[kt][r] : -INFINITY;
          mx = fmaxf(mx, s[kt][r]);
        }
      mx = fmaxf(mx, __shfl_xor(mx, 32));
      const float mnew = fmaxf(m, mx);
      const float muse = (mnew == -INFINITY) ? 0.f : mnew;
      float sum = 0.f;
#pragma unroll
      for (int kt = 0; kt < 2; kt++)
#pragma unroll
        for (int r = 0; r < 16; r++) sum += __builtin_amdgcn_exp2f((s[kt][r] - muse) * LOG2E);
      l = l * __builtin_amdgcn_exp2f((m - muse) * LOG2E) + sum;
      m = mnew;
    });
    const float lt = l + __shfl_xor(l, 32);
    const float il = lt > 0.f ? 1.f / lt : 0.f;
    const float muse = (m == -INFINITY) ? 0.f : m;
    {
      f32x16 oc[2];
#pragma unroll
      for (int i = 0; i < 2; i++)
#pragma unroll
        for (int r = 0; r < 16; r++) oc[i][r] = 0.f;
      flash_stream(smem, 0, nkb, krow, vrow, [&](unsigned char* cur, int j) __attribute__((always_inline)) {
        f32x16 s[2];
        flash_qk(s, cur, qf);
#pragma unroll
        for (int kt = 0; kt < 2; kt++)
#pragma unroll
          for (int r = 0; r < 16; r++) {
            const int n = j * 64 + kt * 32 + (r & 3) + 8 * (r >> 2) + 4 * fh;
            s[kt][r] = (n < nvl) ? __builtin_amdgcn_exp2f((s[kt][r] - muse) * LOG2E) * il : 0.f;
          }
#pragma unroll
        for (int kt = 0; kt < 2; kt++)
#pragma unroll
          for (int h8 = 0; h8 < 2; h8++) {
            const bf16x8 pf = pack_frag(s[kt], h8);
#pragma unroll
            for (int dt = 0; dt < 2; dt++)
              oc[dt] = __builtin_amdgcn_mfma_f32_32x32x16_bf16(lds_frag(cur + FL_TILE, dt * 32 + fr, 4 * kt + 2 * h8 + fh), pf, oc[dt], 0, 0, 0);
          }
      });
#pragma unroll
      for (int dt = 0; dt < 2; dt++)
#pragma unroll
        for (int r = 0; r < 16; r++) stash[(dt * 16 + r) * 64] = g_cmp * oc[dt][r];
    }
    f32x16 imp[2];
#pragma unroll
    for (int i = 0; i < 2; i++)
#pragma unroll
      for (int r = 0; r < 16; r++) imp[i][r] = 0.f;
    flash_stream(smem, 0, nkb, krow, vrow, [&](unsigned char* cur, int j) __attribute__((always_inline)) {
      f32x16 s[2];
      flash_qk(s, cur, qf);
#pragma unroll
      for (int kt = 0; kt < 2; kt++)
#pragma unroll
        for (int r = 0; r < 16; r++) {
          const int n = j * 64 + kt * 32 + (r & 3) + 8 * (r >> 2) + 4 * fh;
          s[kt][r] = (n < nvl) ? __builtin_amdgcn_exp2f((s[kt][r] - muse) * LOG2E) * il : 0.f;
        }
#pragma unroll
      for (int kt = 0; kt < 2; kt++)
#pragma unroll
        for (int h8 = 0; h8 < 2; h8++) {
          const bf16x8 pf = pack_frag(s[kt], h8);
#pragma unroll
          for (int mt = 0; mt < 2; mt++) {
            const bf16x8 of = *(const bf16x8*)(p.ovp + (size_t)(mt * 32 + fr) * 256 + j * 64 + kt * 32 + h8 * 16 + fh * 8);
            imp[mt] = __builtin_amdgcn_mfma_f32_32x32x16_bf16(of, pf, imp[mt], 0, 0, 0);
          }
        }
    });
#pragma unroll
    for (int mt = 0; mt < 2; mt++)
#pragma unroll
      for (int r = 0; r < 16; r++) imp[mt][r] = quad_sum(imp[mt][r]);
#pragma unroll
    for (int mt = 0; mt < 2; mt++)
#pragma unroll
      for (int g4 = 0; g4 < 4; g4++) {
        const float v = (hq == 0) ? imp[mt][4 * g4 + 0] : (hq == 1) ? imp[mt][4 * g4 + 1] : (hq == 2) ? imp[mt][4 * g4 + 2] : imp[mt][4 * g4 + 3];
        impS[tl * 65 + mt * 32 + hq + 8 * g4 + 4 * fh] = v;
      }
    __syncthreads();
    {
      const int tk = tid >> 3, part = tid & 7;
      const float* row = impS + tk * 65;
      float S2[64];
#pragma unroll
      for (int m2 = 0; m2 < 64; m2++) {
        const bool vis2 = m2 <= c64;
        const bool f2 = (m2 == 0) || (m2 == c64) || (m2 == c64 - 1);
        S2[m2] = vis2 ? row[m2] + (f2 ? 1e4f : 0.f) : -INFINITY;
      }
      unsigned bits = 0;
#pragma unroll
      for (int i = 0; i < 8; i++) {
        const int mb = part * 8 + i;
        const bool vis = mb <= c64;
        const bool forced = (mb == 0) || (mb == c64) || (mb == c64 - 1);
        const float sm = vis ? row[mb] + (forced ? 1e4f : 0.f) : -INFINITY;
        int rank = 0;
#pragma unroll
        for (int m2 = 0; m2 < 64; m2++) {
          const int pb = m2 >> 3;
          const bool lower = ((m2 & 7) < i) ? (pb <= part) : (pb < part);
          rank += ((S2[m2] > sm) || (S2[m2] == sm && lower)) ? 1 : 0;
        }
        if (rank < 16 && vis) bits |= 1u << i;
      }
      unsigned lo = (part < 4) ? (bits << (8 * part)) : 0u, hi = (part >= 4) ? (bits << (8 * (part - 4))) : 0u;
      lo |= __shfl_xor(lo, 1); hi |= __shfl_xor(hi, 1);
      lo |= __shfl_xor(lo, 2); hi |= __shfl_xor(hi, 2);
      lo |= __shfl_xor(lo, 4); hi |= __shfl_xor(hi, 4);
      if (part == 0) { selm[tk * 2] = lo; selm[tk * 2 + 1] = hi; }
    }
    __syncthreads();
  }
  const unsigned sel_lo = selm[tl * 2], sel_hi = selm[tl * 2 + 1];
  {
    const bf16_t* kb_ = p.kvn[2] + bg * SEQ * 64;
    const bf16_t* vt_ = p.vslct + bg * 64 * SEQ;
    FlashAcc acc; flash_init(acc);
    flash_stream(smem, 0, c64 + 1,
      [&](int j, int r) __attribute__((always_inline)) { return kb_ + (size_t)(j * 64 + r) * 64; },
      [&](int j, int r) __attribute__((always_inline)) { return vt_ + (size_t)r * SEQ + j * 64; },
      [&](unsigned char* cur, int j) __attribute__((always_inline)) {
        f32x16 s[2];
        flash_qk(s, cur, qf);
        const bool selj = ((j < 32) ? (sel_lo >> j) : (sel_hi >> (j - 32))) & 1u;
        if (j == c64) {
#pragma unroll
          for (int kt = 0; kt < 2; kt++)
#pragma unroll
            for (int r = 0; r < 16; r++) {
              const int kl = kt * 32 + (r & 3) + 8 * (r >> 2) + 4 * fh;
              s[kt][r] = (kl <= t64) ? s[kt][r] : -INFINITY;
            }
        }
        flash_update(acc, s, cur + FL_TILE, selj);
      });
    const float sc_ = g_sel * flash_inv_l(acc);
#pragma unroll
    for (int dt = 0; dt < 2; dt++)
#pragma unroll
      for (int r = 0; r < 16; r++) stash[(dt * 16 + r) * 64] += sc_ * acc.o[dt][r];
  }
  {
    const bf16_t* kb_ = p.kvn[4] + bg * SEQ * 64;
    const bf16_t* vt_ = p.vwint + bg * 64 * SEQ;
    FlashAcc acc; flash_init(acc);
    const int jlo = c64 - 8;
    flash_stream(smem, jlo < 0 ? 0 : jlo, c64 + 1,
      [&](int j, int r) __attribute__((always_inline)) { return kb_ + (size_t)(j * 64 + r) * 64; },
      [&](int j, int r) __attribute__((always_inline)) { return vt_ + (size_t)r * SEQ + j * 64; },
      [&](unsigned char* cur, int j) __attribute__((always_inline)) {
        f32x16 s[2];
        flash_qk(s, cur, qf);
        if (j == c64) {
#pragma unroll
          for (int kt = 0; kt < 2; kt++)
#pragma unroll
            for (int r = 0; r < 16; r++) {
              const int kl = kt * 32 + (r & 3) + 8 * (r >> 2) + 4 * fh;
              s[kt][r] = (kl <= t64) ? s[kt][r] : -INFINITY;
            }
        } else if (j == jlo) {
#pragma unroll
          for (int kt = 0; kt < 2; kt++)
#pragma unroll
            for (int r = 0; r < 16; r++) {
              const int kl = kt * 32 + (r & 3) + 8 * (r >> 2) + 4 * fh;
              s[kt][r] = (kl > t64) ? s[kt][r] : -INFINITY;
            }
        }
        flash_update(acc, s, cur + FL_TILE);
      });
    const float sc_ = g_win * flash_inv_l(acc);
    bf16_t* orow = p.concat + (size_t)tok * DM + g * 256 + hq * 64;
#pragma unroll
    for (int dt = 0; dt < 2; dt++)
#pragma unroll
      for (int g4 = 0; g4 < 4; g4++) {
        float o4[4];
#pragma unroll
        for (int i = 0; i < 4; i++) o4[i] = stash[(dt * 16 + 4 * g4 + i) * 64] + sc_ * acc.o[dt][4 * g4 + i];
        uint2 o = {pack2bf(o4[0], o4[1]), pack2bf(o4[2], o4[3])};
        *(uint2*)(orow + dt * 32 + 8 * g4 + 4 * fh) = o;
      }
  }
}
__device__ __forceinline__ void nsa_phase(const Params& p, unsigned char* smem, int bid, int nblk) {
  for (int it = bid; it < NB * 2 * 128; it += nblk) {
    const int cc = 127 - (it >> 4), bgi = it & 15;
    nsa_flash_item(p, smem, (bgi << 7) | cc);
  }
}

typedef __attribute__((ext_vector_type(4))) float f32x4v;
typedef __attribute__((ext_vector_type(4))) short s16x4;
__device__ __forceinline__ float wave_max_uniform(float x) {
  x = fmaxf(x, __builtin_bit_cast(float, __builtin_amdgcn_update_dpp(0, __builtin_bit_cast(int, x), 0xB1, 0xF, 0xF, true)));
  x = fmaxf(x, __builtin_bit_cast(float, __builtin_amdgcn_update_dpp(0, __builtin_bit_cast(int, x), 0x4E, 0xF, 0xF, true)));
  x = fmaxf(x, __builtin_bit_cast(float, __builtin_amdgcn_update_dpp(0, __builtin_bit_cast(int, x), 0x141, 0xF, 0xF, true)));
  x = fmaxf(x, __builtin_bit_cast(float, __builtin_amdgcn_update_dpp(0, __builtin_bit_cast(int, x), 0x140, 0xF, 0xF, true)));
  return fmaxf(fmaxf(readlane_f(x, 0), readlane_f(x, 16)), fmaxf(readlane_f(x, 32), readlane_f(x, 48)));
}
__device__ __forceinline__ int dsa_vswz(int row) { return ((row >> 1) & 1) | ((row >> 2) & 2); }
__device__ __forceinline__ void dsa_item(const Params& p, unsigned char* smem, int b, int tg) {
  unsigned* keys = (unsigned*)smem;
  unsigned char* vst = smem;
  int* hist = (int*)(smem + 32768);
  int* sel = hist + 3584;
  int* cnt = sel + 512;
  float* sc = (float*)(cnt + 16);
  float* part = sc + 2048;
  const int tid = tid_opaque(), lane = tid & 63, w = tid >> 6;
  const int row16 = lane & 15, kg = lane >> 4;
  const int t0 = 2 * tg;
  const size_t tokb = (size_t)b * SEQ;
  const bf16_t* kib = p.ki + tokb * 32;
  const bf16_t* kdb = p.kd + tokb * 64;
  const bf16_t* vdb = p.vd + tokb * 64;
  const int n = t0 + 2;
  if (n > 256) {
#pragma unroll
    for (int i = 0; i < 14; i++) hist[tid + 256 * i] = 0;
    {
      const bf16x8 af = *(const bf16x8*)(p.qi + (tokb + t0 + (row16 >> 3)) * 256 + (row16 & 7) * 32 + kg * 8);
      const int tk = lane >> 5;
      const float4 wv = *(const float4*)(p.widx + (tokb + t0 + tk) * 8 + 4 * (kg & 1));
      const int ntile = (n + 15) >> 4;
#pragma unroll 1
      for (int kt0 = w * 4; kt0 < ntile; kt0 += 16) {
        bf16x8 bfr[4];
#pragma unroll
        for (int u = 0; u < 4; u++) {
          const int key = min(kt0 + u, ntile - 1) * 16 + row16;
          bfr[u] = *(const bf16x8*)(kib + (size_t)key * 32 + kg * 8);
        }
#pragma unroll
        for (int u = 0; u < 4; u++) {
          f32x4v acc = {0.f, 0.f, 0.f, 0.f};
          acc = __builtin_amdgcn_mfma_f32_16x16x32_bf16(af, bfr[u], acc, 0, 0, 0);
          float s = wv.x * fmaxf(acc[0], 0.f) + wv.y * fmaxf(acc[1], 0.f) + wv.z * fmaxf(acc[2], 0.f) + wv.w * fmaxf(acc[3], 0.f);
          s += __shfl_xor(s, 16);
          const int key = (kt0 + u) * 16 + row16;
          if ((kg & 1) == 0 && kt0 + u < ntile) {
            const unsigned kv_ = (key <= t0 + tk) ? f2key(s) : 0u;
            keys[tk * 4096 + key] = kv_;
            atomicAdd(&hist[1536 + tk * 1024 + (lane & 3) * 256 + (kv_ >> 24)], 1);
          }
        }
      }
    }
    __syncthreads();
    const int tk = w >> 1, hf = w & 1;
    const int npad = ((n + 15) >> 4) << 4, nh = npad >> 1;
    const unsigned* kt_ = keys + tk * 4096;
    const int i0 = hf * nh, i1 = i0 + nh;
    unsigned prefix = 0; int kk = 256;
#pragma unroll 1
    for (int pass = 0; pass < 4; pass++) {
      const int shift = 24 - 8 * pass;
      int* hp = (pass == 0) ? hist + 1536 + tk * 1024 : hist + (pass - 1) * 512 + tk * 256;
      int* hpa = (pass == 0) ? hp + (lane & 3) * 256 : hp;
      const unsigned hmask = (shift == 24) ? 0u : (0xFFFFFFFFu << (shift + 8));
      if (pass > 0)
#pragma unroll 2
      for (int base = i0 + 4 * lane; base < i1; base += 256) {
        const uint4 k4 = *(const uint4*)(kt_ + base);
        if ((k4.x & hmask) == prefix) atomicAdd(&hpa[(k4.x >> shift) & 255], 1);
        if ((k4.y & hmask) == prefix) atomicAdd(&hpa[(k4.y >> shift) & 255], 1);
        if ((k4.z & hmask) == prefix) atomicAdd(&hpa[(k4.z >> shift) & 255], 1);
        if ((k4.w & hmask) == prefix) atomicAdd(&hpa[(k4.w >> shift) & 255], 1);
      }
      __syncthreads();
      {
        int4 c4 = *(const int4*)(hp + lane * 4);
        if (pass == 0) {
#pragma unroll
          for (int cp = 1; cp < 4; cp++) {
            const int4 d4 = *(const int4*)(hp + cp * 256 + lane * 4);
            c4.x += d4.x; c4.y += d4.y; c4.z += d4.z; c4.w += d4.w;
          }
        }
        const int tl_ = c4.x + c4.y + c4.z + c4.w;
        int P = tl_;
        P += __builtin_amdgcn_update_dpp(0, P, 0x111, 0xF, 0xF, false);
        P += __builtin_amdgcn_update_dpp(0, P, 0x112, 0xF, 0xF, false);
        P += __builtin_amdgcn_update_dpp(0, P, 0x114, 0xF, 0xF, false);
        P += __builtin_amdgcn_update_dpp(0, P, 0x118, 0xF, 0xF, false);
        P += __builtin_amdgcn_update_dpp(0, P, 0x142, 0xA, 0xF, false);
        P += __builtin_amdgcn_update_dpp(0, P, 0x143, 0xC, 0xF, false);
        const int total = __builtin_amdgcn_readlane(P, 63);
        const int R = total - P + tl_;
        const int a3 = R - tl_, a2 = a3 + c4.w, a1 = a2 + c4.z, a0 = a1 + c4.y;
        const bool found = (a3 < kk) && (kk <= R);
        int dloc, above;
        if (kk <= a2) { dloc = 3; above = a3; } else if (kk <= a1) { dloc = 2; above = a2; } else if (kk <= a0) { dloc = 1; above = a1; } else { dloc = 0; above = a0; }
        const unsigned long long bm = __ballot(found);
        const int src = __ffsll((long long)bm) - 1;
        const int dsel = __builtin_amdgcn_readlane(lane * 4 + dloc, src);
        const int abv = __builtin_amdgcn_readlane(above, src);
        prefix |= ((unsigned)dsel) << shift;
        kk -= abv;
      }
    }
    {
      int cg_ = 0, ce = 0;
#pragma unroll 2
      for (int base = i0 + 4 * lane; base < i1; base += 256) {
        const uint4 k4 = *(const uint4*)(kt_ + base);
        cg_ += (k4.x > prefix) + (k4.y > prefix) + (k4.z > prefix) + (k4.w > prefix);
        ce += (k4.x == prefix) + (k4.y == prefix) + (k4.z == prefix) + (k4.w == prefix);
      }
      cg_ = (int)wave_sum_uniform((float)cg_); ce = (int)wave_sum_uniform((float)ce);
      if (lane == 0) { cnt[(tk * 2 + hf) * 2] = cg_; cnt[(tk * 2 + hf) * 2 + 1] = ce; }
    }
    __syncthreads();
    {
      int bgt = hf ? cnt[(tk * 2) * 2] : 0, beq = hf ? cnt[(tk * 2) * 2 + 1] : 0;
      const int ngt = 256 - kk;
      const unsigned long long lt = (1ull << lane) - 1ull;
#pragma unroll 1
      for (int base = i0 + 4 * lane; base < i1; base += 256) {
        const uint4 k4 = *(const uint4*)(kt_ + base);
        const unsigned kq[4] = {k4.x, k4.y, k4.z, k4.w};
        unsigned long long mg[4], me[4];
#pragma unroll
        for (int j = 0; j < 4; j++) { mg[j] = __ballot(kq[j] > prefix); me[j] = __ballot(kq[j] == prefix); }
        int pg = bgt + __popcll(mg[0] & lt) + __popcll(mg[1] & lt) + __popcll(mg[2] & lt) + __popcll(mg[3] & lt);
        int pe = beq + __popcll(me[0] & lt) + __popcll(me[1] & lt) + __popcll(me[2] & lt) + __popcll(me[3] & lt);
#pragma unroll
        for (int j = 0; j < 4; j++) {
          if (kq[j] > prefix) { sel[tk * 256 + pg] = base + j; pg++; }
          else if (kq[j] == prefix) { if (pe < kk) sel[tk * 256 + ngt + pe] = base + j; pe++; }
        }
        bgt += __popcll(mg[0]) + __popcll(mg[1]) + __popcll(mg[2]) + __popcll(mg[3]);
        beq += __popcll(me[0]) + __popcll(me[1]) + __popcll(me[2]) + __popcll(me[3]);
      }
    }
    __syncthreads();
  } else {
    for (int i = tid; i < 512; i += 256) sel[i] = i & 255;
    __syncthreads();
  }
  {
    const int tk = w >> 1, hf = w & 1;
    const int nsel = min(256, t0 + tk + 1);
    const size_t tok = tokb + t0 + tk;
    const int* selt = sel + tk * 256;
    float* sct = sc + tk * 1024;
    bf16_t* pbt = (bf16_t*)(part) + tk * 1024;
    unsigned char* vw = vst + w * 8192;
    const int kk8 = lane >> 3, ch = lane & 7;
    const int q4 = row16 >> 2, pp = row16 & 3;
#define DSA_VLOAD(dst, it_, base_) dst = *(const uint4*)(vdb + (size_t)selt[min((base_) + (it_) * 8 + kk8, nsel - 1)] * 64 + ch * 8)
#define DSA_VSTORE(src, it_) { const int key_ = (it_) * 8 + kk8; *(uint4*)(vw + key_ * 128 + ((((ch >> 1) ^ dsa_vswz(key_))) << 5) + ((ch & 1) << 4)) = src; }
    uint4 vv0, vv1, vv2, vv3, vv4, vv5, vv6, vv7;
    DSA_VLOAD(vv0, 0, hf * 128); DSA_VLOAD(vv1, 1, hf * 128); DSA_VLOAD(vv2, 2, hf * 128); DSA_VLOAD(vv3, 3, hf * 128);
    DSA_VLOAD(vv4, 4, hf * 128); DSA_VLOAD(vv5, 5, hf * 128); DSA_VLOAD(vv6, 6, hf * 128); DSA_VLOAD(vv7, 7, hf * 128);
    {
      bf16x8 qf[2];
#pragma unroll
      for (int ks = 0; ks < 2; ks++) {
        uint4 u = make_uint4(0, 0, 0, 0);
        if (row16 < 4) u = *(const uint4*)(p.qd + tok * 256 + row16 * 64 + ks * 32 + kg * 8);
        qf[ks] = __builtin_bit_cast(bf16x8, u);
      }
#pragma unroll 1
      for (int ck = 0; ck < 2; ck++) {
        bf16x8 kf[4][2];
#pragma unroll
        for (int ti = 0; ti < 4; ti++) {
          const int r = hf * 128 + ck * 64 + ti * 16 + row16;
          const int idx = selt[min(r, nsel - 1)];
#pragma unroll
          for (int ks = 0; ks < 2; ks++) kf[ti][ks] = *(const bf16x8*)(kdb + (size_t)idx * 64 + ks * 32 + kg * 8);
        }
#pragma unroll
        for (int ti = 0; ti < 4; ti++) {
          f32x4v acc = {0.f, 0.f, 0.f, 0.f};
          acc = __builtin_amdgcn_mfma_f32_16x16x32_bf16(kf[ti][0], qf[0], acc, 0, 0, 0);
          acc = __builtin_amdgcn_mfma_f32_16x16x32_bf16(kf[ti][1], qf[1], acc, 0, 0, 0);
          if (row16 < 4) {
#pragma unroll
            for (int r = 0; r < 4; r++) {
              const int key = hf * 128 + ck * 64 + ti * 16 + 4 * kg + r;
              sct[row16 * 256 + key] = (key < nsel) ? acc[r] * 0.125f : -INFINITY;
            }
          }
        }
      }
    }
    __syncthreads();
#pragma unroll
    for (int hh = 0; hh < 2; hh++) {
      const int h = 2 * hf + hh;
      float v0 = sct[h * 256 + lane], v1 = sct[h * 256 + 64 + lane], v2 = sct[h * 256 + 128 + lane], v3 = sct[h * 256 + 192 + lane];
      const float mx = wave_max_uniform(fmaxf(fmaxf(v0, v1), fmaxf(v2, v3)));
      v0 = __expf(v0 - mx); v1 = __expf(v1 - mx); v2 = __expf(v2 - mx); v3 = __expf(v3 - mx);
      const float inv = 1.f / wave_sum_uniform((v0 + v1) + (v2 + v3));
      pbt[h * 256 + lane] = f2bf(v0 * inv); pbt[h * 256 + 64 + lane] = f2bf(v1 * inv);
      pbt[h * 256 + 128 + lane] = f2bf(v2 * inv); pbt[h * 256 + 192 + lane] = f2bf(v3 * inv);
    }
    __syncthreads();
    f32x4v oacc[4];
#pragma unroll
    for (int nt = 0; nt < 4; nt++) oacc[nt] = f32x4v{0.f, 0.f, 0.f, 0.f};
#pragma unroll 1
    for (int ck = 0; ck < 2; ck++) {
      DSA_VSTORE(vv0, 0); DSA_VSTORE(vv1, 1); DSA_VSTORE(vv2, 2); DSA_VSTORE(vv3, 3);
      DSA_VSTORE(vv4, 4); DSA_VSTORE(vv5, 5); DSA_VSTORE(vv6, 6); DSA_VSTORE(vv7, 7);
      if (ck == 0) {
        const int nb_ = hf * 128 + 64;
        DSA_VLOAD(vv0, 0, nb_); DSA_VLOAD(vv1, 1, nb_); DSA_VLOAD(vv2, 2, nb_); DSA_VLOAD(vv3, 3, nb_);
        DSA_VLOAD(vv4, 4, nb_); DSA_VLOAD(vv5, 5, nb_); DSA_VLOAD(vv6, 6, nb_); DSA_VLOAD(vv7, 7, nb_);
      }
      __builtin_amdgcn_wave_barrier();
      bf16x8 pf[2];
#pragma unroll
      for (int ks = 0; ks < 2; ks++) {
        uint4 u = make_uint4(0, 0, 0, 0);
        if (row16 < 4) u = *(const uint4*)(pbt + row16 * 256 + hf * 128 + ck * 64 + ks * 32 + kg * 8);
        pf[ks] = __builtin_bit_cast(bf16x8, u);
      }
#pragma unroll
      for (int nt = 0; nt < 4; nt++) {
#pragma unroll
        for (int ks = 0; ks < 2; ks++) {
          const int r0 = ks * 32 + kg * 8 + q4, r1 = r0 + 4;
          const s16x4 lo = __builtin_amdgcn_ds_read_tr16_b64_v4i16((s16x4 __attribute__((address_space(3)))*)(vw + r0 * 128 + ((nt ^ dsa_vswz(r0)) << 5) + pp * 8));
          const s16x4 hi = __builtin_amdgcn_ds_read_tr16_b64_v4i16((s16x4 __attribute__((address_space(3)))*)(vw + r1 * 128 + ((nt ^ dsa_vswz(r1)) << 5) + pp * 8));
          typedef __attribute__((ext_vector_type(8))) short s16x8;
          const s16x8 v8 = __builtin_shufflevector(lo, hi, 0, 1, 2, 3, 4, 5, 6, 7);
          oacc[nt] = __builtin_amdgcn_mfma_f32_16x16x32_bf16(pf[ks], __builtin_bit_cast(bf16x8, v8), oacc[nt], 0, 0, 0);
        }
      }
      __builtin_amdgcn_wave_barrier();
    }
#undef DSA_VLOAD
#undef DSA_VSTORE
    __syncthreads();
    if (kg == 0) {
#pragma unroll
      for (int nt = 0; nt < 4; nt++)
#pragma unroll
        for (int r = 0; r < 4; r++) part[(w * 4 + r) * 64 + nt * 16 + row16] = oacc[nt][r];
    }
    __syncthreads();
    {
#pragma unroll
      for (int o2 = 0; o2 < 2; o2++) {
        const int idx = tid + 256 * o2, tk2 = idx >> 8, e = idx & 255;
        const float o = part[(2 * tk2) * 256 + e] + part[(2 * tk2 + 1) * 256 + e];
        p.concat[(tokb + t0 + tk2) * DM + 512 + e] = f2bf(o);
      }
    }
    __syncthreads();
  }
}
__device__ __forceinline__ void dsa_phase(const Params& p, unsigned char* smem, int bid, int nblk) {
  for (int it = bid; it < NB * (SEQ / 2); it += nblk) dsa_item(p, smem, it & 7, (SEQ / 2 - 1) - (it >> 3));
}

#define SELFCHECK 0
#ifndef PROBE_REPEAT
#define PROBE_REPEAT 0
#endif
#if SELFCHECK
__device__ __forceinline__ void check_val(const Params& p, float ref, float got, float atol, float rtol) {
  if (!(fabsf(ref - got) <= atol + rtol * fabsf(ref))) atomicExch(p.flag, 1);
}
__device__ __forceinline__ void inproj_check_phase(const Params& p, unsigned char* smem, int bid, int nblk) {
  float* h = (float*)smem;
  const float f16[8] = {1.0f, 0.19392274474868576f, 0.03760603093086393f, 0.007292664737217109f,
                        0.001414213562373095f, 0.0002742481756762073f, 5.318295896944988e-05f, 1.031338537721246e-05f};
  const int tid = threadIdx.x;
  for (int it = bid; it < 600; it += nblk) {
    const int tok = (it * 61) % NT;
    const int b = tok / SEQ, t = tok % SEQ;
    const float* xr = p.x + (size_t)tok * DM;
    for (int col = tid; col < INW; col += 256) {
      float a = 0.f;
      for (int k = 0; k < DM; k++) a = fmaf(xr[k], p.w_in[(size_t)k * INW + col], a);
      h[col] = a;
    }
    __syncthreads();
    const int pos = p.pos[tok];
    if (tid < 152) {
      const int v = tid >> 3, j = tid & 7;
      int base;
      if (v < 8) base = C_NSAQ + v * 64;
      else if (v < 10) base = C_NSAKV + 0 * 128 + (v - 8) * 64;
      else if (v < 12) base = C_NSAKV + 2 * 128 + (v - 10) * 64;
      else if (v < 14) base = C_NSAKV + 4 * 128 + (v - 12) * 64;
      else if (v < 18) base = C_DSAQ + (v - 14) * 64;
      else base = C_DSAK;
      float c, s; rope_cs(pos, f16[j], c, s);
      const float x1 = h[base + j], x2 = h[base + 8 + j];
      h[base + j] = x1 * c - x2 * s; h[base + 8 + j] = x2 * c + x1 * s;
    } else if (tid < 188) {
      const int u = tid - 152, v = u >> 2, j = u & 3;
      const int base = (v < 8) ? C_IDXQ + v * 32 : C_IDXK;
      float c, s; rope_cs(pos, f16[2 * j], c, s);
      const float x1 = h[base + j], x2 = h[base + 4 + j];
      h[base + j] = x1 * c - x2 * s; h[base + 4 + j] = x2 * c + x1 * s;
    } else if (tid < 212) {
      const int u = tid - 188;
      h[C_GATE + u] = 1.f / (1.f + expf(-h[C_GATE + u]));
    }
    __syncthreads();
    for (int col = tid; col < INW; col += 256) {
      const float ref = h[col];
      float got;
      if (col < 512) got = bf2f(p.qn[(size_t)tok * 512 + col]);
      else if (col < 1280) {
        const int o = col - 512, j = o >> 7, g = (o >> 6) & 1, d = o & 63;
        if (j == 3 || j == 5) {
          const bf16_t* vt = (j == 3) ? p.vslct : p.vwint;
          got = bf2f(vt[((size_t)(b * 2 + g) * 64 + d) * SEQ + perm16(t)]);
        } else {
          const bf16_t* src = j == 0 ? p.kvn[0] : j == 1 ? p.kvn[1] : j == 2 ? p.kvn[2] : p.kvn[4];
          got = bf2f(src[((size_t)(b * 2 + g) * SEQ + t) * 64 + d]);
        }
      }
      else if (col < 1304) got = p.gates[(size_t)tok * 24 + col - 1280];
      else if (col < 1560) got = bf2f(p.qd[(size_t)tok * 256 + col - 1304]);
      else if (col < 1624) got = bf2f(p.kd[(size_t)tok * 64 + col - 1560]);
      else if (col < 1688) got = bf2f(p.vd[(size_t)tok * 64 + col - 1624]);
      else if (col < 1944) got = bf2f(p.qi[(size_t)tok * 256 + col - 1688]);
      else if (col < 1976) got = bf2f(p.ki[(size_t)tok * 32 + col - 1944]);
      else if (col < 1984) got = p.widx[(size_t)tok * 8 + col - 1976] * 16.f;
      else got = bf2f(p.memq[(size_t)tok * 256 + col - 1984]);
      check_val(p, ref, got, 0.04f, 0.02f);
    }
    __syncthreads();
  }
  for (int it = bid; it < 64; it += nblk) {
    const int row = (it * 37) % (NB * MEML);
    for (int col = tid; col < 512; col += 256) {
      float a = 0.f;
      for (int k = 0; k < DM; k++) a = fmaf(p.mem[(size_t)row * DM + k], p.w_mem_kv[(size_t)k * 512 + col], a);
      float gotm;
      if (col < 256) gotm = bf2f(p.mkv[(size_t)row * 512 + col]);
      else { const int hd = (col - 256) >> 6, dd = col & 63; gotm = bf2f(p.memvt[((size_t)((row >> 8) * 4 + hd) * 64 + dd) * MEML + perm16(row & 255)]); }
      check_val(p, a, gotm, 0.04f, 0.02f);
    }
  }
}

__device__ __forceinline__ void mem_check_phase(const Params& p, unsigned char* smem, int bid, int nblk) {
  float* q = (float*)smem;
  float* sc = q + 256;
  const int tid = threadIdx.x;
  for (int it = bid; it < 700; it += nblk) {
    const int tok = (it * 47 + 13) % NT;
    const int b = tok / SEQ;
    q[tid] = bf2f(p.memq[(size_t)tok * 256 + tid]);
    __syncthreads();
    const bf16_t* kvb = p.mkv + (size_t)b * MEML * 512;
    for (int idx = tid; idx < 4 * 256; idx += 256) {
      const int hh = idx >> 8, m = idx & 255;
      sc[hh * 256 + m] = dot64_bf(q + hh * 64, kvb + (size_t)m * 512 + hh * 64) * 0.125f;
    }
    __syncthreads();
    softmax4(sc, 256, 256);
    __syncthreads();
    {
      const int h = tid >> 6, d = tid & 63;
      float o = 0.f;
      for (int m = 0; m < 256; m++) o = fmaf(sc[h * 256 + m], bf2f(p.memvt[((size_t)(b * 4 + h) * 64 + d) * MEML + perm16(m)]), o);
      check_val(p, o, bf2f(p.concat[(size_t)tok * DM + 768 + tid]), 0.004f, 0.02f);
    }
    __syncthreads();
  }
}
__device__ __forceinline__ void nsa_check_phase(const Params& p, unsigned char* smem, int bid, int nblk) {
  float* q = (float*)smem;
  float* sc = q + 256;
  float* o3 = sc + 4096;
  float* imp = o3 + 768;
  int* sel = (int*)(imp + 64);
  int* nselp = sel + 16;
  const int tid = threadIdx.x, h = tid >> 6, d = tid & 63;
  for (int it = bid; it < 1024; it += nblk) {
    const int item = (int)(((long long)it * 62851 + 7) % (NT * 2));
    const int g = item & 1, tok = item >> 1, b = tok / SEQ, t = tok % SEQ;
    const size_t kvb = (size_t)(b * 2 + g) * SEQ * 64;
    const bf16_t *kslc = p.kvn[2] + kvb, *kwin = p.kvn[4] + kvb;
    const bf16_t *vslct = p.vslct + (size_t)(b * 2 + g) * 64 * SEQ, *vwint = p.vwint + (size_t)(b * 2 + g) * 64 * SEQ;
    q[tid] = bf2f(p.qn[(size_t)tok * 512 + g * 256 + tid]);
    __syncthreads();
    const int nv = (t >= 31) ? (t - 31) / 16 + 1 : 0;
    const bf16_t* kcb = p.kcb + (size_t)(b * 2 + g) * 256 * 64;
    const bf16_t* vct = p.vct + (size_t)(b * 2 + g) * 64 * 256;
    for (int idx = tid; idx < 4 * 256; idx += 256) {
      const int hh = idx >> 8, i = idx & 255;
      float s = -INFINITY;
      if (i < nv) {
        s = 0.f;
        for (int e = 0; e < 64; e++) s = fmaf(q[hh * 64 + e], bf2f(kcb[i * 64 + e]), s);
        s *= 0.125f;
      }
      sc[hh * 1024 + i] = s;
    }
    __syncthreads();
    softmax4(sc, 1024, 256);
    __syncthreads();
    {
      float o = 0.f;
      for (int i = 0; i < nv; i++) o = fmaf(sc[h * 1024 + i], bf2f(vct[d * 256 + perm16(i)]), o);
      o3[0 * 256 + tid] = o;
    }
    const int cur = t / 64;
    if (tid < 64) {
      const int m = tid;
      float a = 0.f;
      const int n0 = max(0, 4 * m - 2), n1 = min(NC - 1, 4 * m + 4);
      for (int n = n0; n <= n1; n++) {
        const int ov = min(16 * n + 32, 64 * m + 64) - max(16 * n, 64 * m);
        if (ov > 0) {
          const float w = (float)ov * (1.f / 32.f);
          for (int hh = 0; hh < 4; hh++) a = fmaf(sc[hh * 1024 + n], w, a);
        }
      }
      const bool forced = (m == 0) || (m == cur) || (m == cur - 1);
      const bool vis = (m <= cur);
      imp[m] = vis ? a + (forced ? 1e4f : 0.f) : -INFINITY;
    }
    __syncthreads();
    if (tid < 64) {
      const int m = tid;
      const float sm = imp[m];
      int rank = 0;
      for (int mm = 0; mm < 64; mm++) { const float s2 = imp[mm]; rank += (s2 > sm) || (s2 == sm && mm < m); }
      const bool take = (rank < 16) && (m <= cur);
      const unsigned long long bal = __ballot(take);
      if (take) sel[__popcll(bal & ((1ull << m) - 1ull))] = m;
      if (m == 0) *nselp = __popcll(bal);
    }
    __syncthreads();
    const int nsel = *nselp;
    {
      const int nk = nsel * 64;
      for (int idx = tid; idx < 4 * nk; idx += 256) {
        const int hh = idx / nk, r = idx % nk;
        const int kpos = sel[r >> 6] * 64 + (r & 63);
        float s = -INFINITY;
        if (kpos <= t) s = dot64_bf(q + hh * 64, kslc + (size_t)kpos * 64) * 0.125f;
        sc[hh * 1024 + r] = s;
      }
      __syncthreads();
      softmax4(sc, 1024, nk);
      __syncthreads();
      float o = 0.f;
      for (int r = 0; r < nk; r++) {
        const int kpos = sel[r >> 6] * 64 + (r & 63);
        if (kpos <= t) o = fmaf(sc[h * 1024 + r], bf2f(vslct[(size_t)d * SEQ + perm16(kpos)]), o);
      }
      o3[1 * 256 + tid] = o;
      __syncthreads();
    }
    {
      for (int idx = tid; idx < 4 * 512; idx += 256) {
        const int hh = idx >> 9, r = idx & 511;
        const int kpos = t - 511 + r;
        float s = -INFINITY;
        if (kpos >= 0) s = dot64_bf(q + hh * 64, kwin + (size_t)kpos * 64) * 0.125f;
        sc[hh * 1024 + r] = s;
      }
      __syncthreads();
      softmax4(sc, 1024, 512);
      __syncthreads();
      float o = 0.f;
      for (int r = 0; r < 512; r++) {
        const int kpos = t - 511 + r;
        if (kpos >= 0) o = fmaf(sc[h * 1024 + r], bf2f(vwint[(size_t)d * SEQ + perm16(kpos)]), o);
      }
      o3[2 * 256 + tid] = o;
    }
    {
      const float* gt = p.gates + (size_t)tok * 24 + (g * 4 + h) * 3;
      const float r = gt[0] * o3[tid] + gt[1] * o3[256 + tid] + gt[2] * o3[512 + tid];
      const float got = bf2f(p.concat[(size_t)tok * DM + g * 256 + tid]);
      const float df = fabsf(r - got);
      if (!(df <= 0.08f + 0.1f * fabsf(r))) atomicExch(p.flag, 1);
      if (!(df <= 0.006f + 0.02f * fabsf(r))) atomicAdd(p.chkcnt, 1);
    }
    __syncthreads();
  }
}

__device__ __forceinline__ void dsa_check_phase(const Params& p, unsigned char* smem, int bid, int nblk) {
  unsigned* keys = (unsigned*)smem;
  float* qi = (float*)(keys + 4096);
  float* wi = qi + 256;
  int* hist = (int*)(wi + 8);
  int* sel = hist + 256;
  int* misc = sel + 256;
  int* cnts = misc + 8;
  float* qd = (float*)(cnts + 256);
  float* sc = qd + 256;
  const int tid = threadIdx.x;
  for (int it = bid; it < 1500; it += nblk) {
    const int tok = (int)(((long long)it * 39119 + 11) % NT);
    const int b = tok / SEQ, t = tok % SEQ;
    const bf16_t* kib = p.ki + (size_t)b * SEQ * 32;
    const bf16_t* kdb = p.kd + (size_t)b * SEQ * 64;
    const bf16_t* vdb = p.vd + (size_t)b * SEQ * 64;
    qi[tid] = bf2f(p.qi[(size_t)tok * 256 + tid]);
    if (tid < 8) wi[tid] = p.widx[(size_t)tok * 8 + tid];
    qd[tid] = bf2f(p.qd[(size_t)tok * 256 + tid]);
    __syncthreads();
    const int n = t + 1;
    int nsel;
    if (n <= 256) {
      for (int s = tid; s < n; s += 256) sel[s] = s;
      nsel = n;
      __syncthreads();
    } else {
      for (int s = tid; s < n; s += 256) {
        float kv[32];
#pragma unroll
        for (int e = 0; e < 32; e += 8) {
          const uint4 v = *(const uint4*)(kib + (size_t)s * 32 + e);
          kv[e + 0] = __uint_as_float(v.x << 16); kv[e + 1] = __uint_as_float(v.x & 0xFFFF0000u);
          kv[e + 2] = __uint_as_float(v.y << 16); kv[e + 3] = __uint_as_float(v.y & 0xFFFF0000u);
          kv[e + 4] = __uint_as_float(v.z << 16); kv[e + 5] = __uint_as_float(v.z & 0xFFFF0000u);
          kv[e + 6] = __uint_as_float(v.w << 16); kv[e + 7] = __uint_as_float(v.w & 0xFFFF0000u);
        }
        float score = 0.f;
    #pragma unroll 1
    for (int hh = 0; hh < 8; hh++) {
          float dsum = 0.f;
#pragma unroll
          for (int e = 0; e < 32; e++) dsum = fmaf(qi[hh * 32 + e], kv[e], dsum);
          score = fmaf(fmaxf(dsum, 0.f), wi[hh], score);
        }
        keys[s] = f2key(score);
      }
      unsigned prefix = 0; int kk = 256;
      for (int shift = 24; shift >= 0; shift -= 8) {
        hist[tid] = 0;
        __syncthreads();
        const unsigned hmask = (shift == 24) ? 0u : (0xFFFFFFFFu << (shift + 8));
        for (int s = tid; s < n; s += 256) {
          const unsigned k = keys[s];
          if ((k & hmask) == prefix) atomicAdd(&hist[(k >> shift) & 255], 1);
        }
        __syncthreads();
        if (tid == 0) {
          int cum = 0, dsel = 0;
          for (int dg = 255; dg >= 0; dg--) {
            const int c = hist[dg];
            if (cum + c >= kk) { dsel = dg; break; }
            cum += c;
          }
          misc[0] = dsel; misc[1] = kk - cum;
        }
        __syncthreads();
        prefix |= ((unsigned)misc[0]) << shift;
        kk = misc[1];
        __syncthreads();
      }
      const int per = (n + 255) / 256;
      const int s0 = tid * per, s1 = min(n, s0 + per);
      int cg_ = 0, ce = 0;
      for (int s = s0; s < s1; s++) { const unsigned k = keys[s]; cg_ += (k > prefix); ce += (k == prefix); }
      cnts[tid] = cg_; hist[tid] = ce;
      __syncthreads();
      if (tid == 0) {
        int a = 0, e = 0;
        for (int i = 0; i < 256; i++) { const int c1 = cnts[i], c2 = hist[i]; cnts[i] = a; hist[i] = e; a += c1; e += c2; }
        misc[2] = a;
      }
      __syncthreads();
      {
        int og = cnts[tid], oe = hist[tid];
        const int ngt = misc[2];
        for (int s = s0; s < s1; s++) {
          const unsigned k = keys[s];
          if (k > prefix) sel[og++] = s;
          else if (k == prefix) { if (oe < kk) sel[ngt + oe] = s; oe++; }
        }
      }
      nsel = 256;
      __syncthreads();
    }
    for (int idx = tid; idx < 4 * nsel; idx += 256) {
      const int hh = idx / nsel, r = idx % nsel;
      sc[hh * 256 + r] = dot64_bf(qd + hh * 64, kdb + (size_t)sel[r] * 64) * 0.125f;
    }
    __syncthreads();
    softmax4(sc, 256, nsel);
    __syncthreads();
    {
      const int h = tid >> 6, d = tid & 63;
      float o = 0.f;
      for (int r = 0; r < nsel; r++) o = fmaf(sc[h * 256 + r], bf2f(vdb[(size_t)sel[r] * 64 + d]), o);
      const float got = bf2f(p.concat[(size_t)tok * DM + 512 + tid]);
      const float df = fabsf(o - got);
      if (!(df <= 0.08f + 0.1f * fabsf(o))) atomicExch(p.flag, 1);
      if (!(df <= 0.004f + 0.02f * fabsf(o))) atomicAdd(p.chkcnt, 1);
    }
    __syncthreads();
  }
}


__device__ __forceinline__ void compress_check_phase(const Params& p, unsigned char* smem, int bid, int nblk) {
  float* hid = (float*)smem;
  const int tid = threadIdx.x;
  const int which = tid >> 7, j = tid & 127;
  for (int it = bid; it < 600; it += nblk) {
    const int item = (it * 131 + 5) % (NB * 2 * NC);
    const int i = item % NC, g = (item / NC) % 2, b = item / (NC * 2);
    const float* w1 = which ? p.w1v : p.w1k;
    const float* pe = which ? p.pe_v : p.pe_k;
    const bf16_t* src = (which ? p.kvn[1] : p.kvn[0]) + ((size_t)(b * 2 + g) * SEQ + i * 16) * 64;
    float acc = 0.f;
    for (int r = 0; r < 2048; r++) acc = fmaf(bf2f(src[r]) + pe[r], w1[(size_t)r * 128 + j], acc);
    hid[which * 128 + j] = gelu_exact(acc);
    __syncthreads();
    if (j < 64) {
      const float* w2 = which ? p.w2v : p.w2k;
      float o = 0.f;
      for (int k = 0; k < 128; k++) o = fmaf(hid[which * 128 + k], w2[k * 64 + j], o);
      const float got = which ? bf2f(p.vct[((size_t)(b * 2 + g) * 64 + j) * 256 + perm16(i)]) : bf2f(p.kcb[((size_t)(b * 2 + g) * 256 + i) * 64 + j]);
      check_val(p, o, got, 0.01f, 0.02f);
    }
    __syncthreads();
  }
}
#endif


#define XB_TMO      128
#define XB_XCNT(j)  (256  + 64 * (j))
#define XB_XSUB(j)  (1280 + 64 * (j))
#define XB_XGEN(j)  (2304 + 64 * (j))
#define XB_TOP      3328
#define XB_TOPGEN   3392
#define XCD_BAR_WORDS 3456
#define XB_SPIN_CAP (1u << 23)
#define LAS __attribute__((address_space(3)))
__device__ __forceinline__ unsigned xb_ld(unsigned* p)              { return __hip_atomic_load(p, __ATOMIC_RELAXED, __HIP_MEMORY_SCOPE_AGENT); }
__device__ __forceinline__ unsigned xb_add(unsigned* p, unsigned v) { return __hip_atomic_fetch_add(p, v, __ATOMIC_RELAXED, __HIP_MEMORY_SCOPE_AGENT); }
__device__ __forceinline__ unsigned xb_xcc_id() { return (unsigned)__builtin_amdgcn_s_getreg((3 << 11) | 20) & 0xFu; }
#define XB_SPIN(cond, bar) do { unsigned _sp = 0; while (cond) { __builtin_amdgcn_s_sleep(1); \
    if ((++_sp & 255u) == 0u) { if (xb_ld(&(bar)[XB_TMO])) break; if (_sp > XB_SPIN_CAP) { atomicAdd(&(bar)[XB_TMO], 1u); break; } } } } while (0)
struct XcdBarrier { unsigned* bar; unsigned x; volatile LAS unsigned* st; };
__device__ __forceinline__ XcdBarrier xcd_barrier_post(unsigned* bar, volatile LAS unsigned* st) {
  XcdBarrier b; b.bar = bar; b.x = xb_xcc_id(); b.st = st;
  if (threadIdx.x == 0) (void)xb_add(&bar[XB_XCNT(b.x)], 1u);
  return b;
}
__device__ __forceinline__ void xcd_barrier_complete(unsigned* bar, unsigned x, unsigned& nloc, unsigned& nx) {
  const unsigned G = gridDim.x * gridDim.y * gridDim.z;
  unsigned sum, cnt, mine, sp = 0u;
  for (;;) {
    sum = 0u; cnt = 0u; mine = 0u;
#pragma unroll
    for (unsigned j = 0; j < 16; ++j) { const unsigned c = xb_ld(&bar[XB_XCNT(j)]); sum += c; cnt += (c > 0u) ? 1u : 0u; mine = (j == x) ? c : mine; }
    if (sum == G) break;
    __builtin_amdgcn_s_sleep(1);
    if ((++sp & 255u) == 0u) { if (xb_ld(&bar[XB_TMO])) break; if (sp > XB_SPIN_CAP) { atomicAdd(&bar[XB_TMO], 1u); break; } }
  }
  nloc = mine > 0u ? mine : 1u; nx = cnt > 0u ? cnt : 1u;
}
__device__ __forceinline__ void xcd_barrier(const XcdBarrier& b) {
  asm volatile("s_waitcnt vmcnt(0)" ::: "memory");
  __syncthreads();
  if (threadIdx.x == 0) {
    unsigned* bar = b.bar;
    __builtin_amdgcn_s_waitcnt(0);
    unsigned nloc = b.st[0], nx = b.st[1];
    if (nloc == 0u) { xcd_barrier_complete(bar, b.x, nloc, nx); b.st[0] = nloc; b.st[1] = nx; }
    const unsigned old = xb_add(&bar[XB_XSUB(b.x)], 1u);
    const unsigned gen = old / nloc;
    if (old + 1u == (gen + 1u) * nloc) {
      __builtin_amdgcn_fence(__ATOMIC_RELEASE, "agent");
      asm volatile("s_waitcnt vmcnt(0)" ::: "memory");
      const unsigned og = xb_add(&bar[XB_TOP], 1u);
      const unsigned tg = og / nx;
      if (og + 1u == (tg + 1u) * nx) xb_add(&bar[XB_TOPGEN], 1u);
      else XB_SPIN(xb_ld(&bar[XB_TOPGEN]) == tg, bar);
      __builtin_amdgcn_fence(__ATOMIC_ACQUIRE, "agent");
      xb_add(&bar[XB_XGEN(b.x)], 1u);
      asm volatile("s_waitcnt vmcnt(0)" ::: "memory");
    } else {
      XB_SPIN(xb_ld(&bar[XB_XGEN(b.x)]) == gen, bar);
      __builtin_amdgcn_fence(__ATOMIC_ACQUIRE, "agent");
      asm volatile("s_waitcnt vmcnt(0)" ::: "memory");
    }
  }
  __syncthreads();
}

constexpr int SMEM_BYTES = 65536;
__global__ void __launch_bounds__(256, 2) megakernel(Params p) {
  __shared__ __align__(16) unsigned char smem[SMEM_BYTES];
  __shared__ uint4 xb_words;
  cg::grid_group grid = cg::this_grid();
  const int bid = blockIdx.x, nblk = gridDim.x;
  if (threadIdx.x == 0) xb_words = make_uint4(0u, 0u, 0u, 0u);
  __syncthreads();
  const XcdBarrier xb = xcd_barrier_post(p.bar, (volatile LAS unsigned*)&xb_words);
  if (p.never) grid.sync();
  for (int rep = 0; rep < ((PROBE_REPEAT & 128) ? 2 : 1); rep++) {
  convert_phase(p.x, p.xb, (size_t)NT * DM, bid, nblk);
  convert_phase(p.mem, p.memb, (size_t)NB * MEML * DM, bid, nblk);
  }
  for (int rep = 0; rep < ((PROBE_REPEAT & 256) ? 2 : 1); rep++) {
  transpose_phase<true>(p.w_in, INW, p.wint, DM, INWP, smem, bid, nblk);
  transpose_phase<false>(p.w_mem_kv, 512, p.wmemt, DM, 512, smem, bid, nblk);
  transpose_phase<false>(p.w_out, DM, p.woutt, DM, DM, smem, bid, nblk);
  transpose_phase<false>(p.wq, 2048, p.wqt, DM, 2048, smem, bid, nblk);
  transpose_phase<false>(p.w1k, 128, p.w1kt, 2048, 128, smem, bid, nblk);
  transpose_phase<false>(p.w1v, 128, p.w1vt, 2048, 128, smem, bid, nblk);
  }
  for (int rep = 0; rep < ((PROBE_REPEAT & 512) ? 2 : 1); rep++) {
  cbias_phase(p, bid, nblk);
  subkey_phase(p.sk1, p.sk1p, bid, nblk);
  subkey_phase(p.sk2, p.sk2p, bid, nblk);
  cs_phase(p, bid, nblk);
  ovp_phase(p, bid, nblk);
  }
  if (bid == 0 && threadIdx.x == 0) { *p.flag = 0; *p.chkcnt = 0; }
  xcd_barrier(xb);
  for (int rep = 0; rep < ((PROBE_REPEAT & 2) ? 2 : 1); rep++) inproj_phase(p, smem, bid, nblk);
  xcd_barrier(xb);
  if (bid >= 128) memkv_phase(p, smem, bid - 128, nblk);
  compress_phase(p, smem, bid, nblk);
  xcd_barrier(xb);
  {
    constexpr int N_NSA = NB * 2 * 128, N_DSA = NB * (SEQ / 2), N_MEM = NB * 4 * 32;
    volatile LAS unsigned* qslot = (volatile LAS unsigned*)&xb_words + 2;
#pragma unroll 1
    for (int k8 = 0; k8 < 8; k8++) {
      const int qx = (int)((xb.x + (unsigned)k8) & 7u);
#pragma unroll 1
      for (;;) {
        __syncthreads();
        if (threadIdx.x == 0) qslot[0] = atomicAdd(p.bar + 68 + qx, 1u);
        __syncthreads();
        const int q = (int)qslot[0];
        if (q >= N_NSA / 8) break;
        nsa_flash_item(p, smem, ((2 * qx + (q & 1)) << 7) | (127 - (q >> 1)));
      }
    }
    auto quant_item = [&](int qi_) __attribute__((always_inline)) {
      const int w_ = threadIdx.x >> 6;
      if (qi_ < 256) quant_rows(p.pu, p.puq, p.psu, qi_ * 64, 64, w_, 4);
      else quant_rows(p.pv, p.pvq, p.psv, (qi_ - 256) * 64, 64, w_, 4);
    };
    int ndone = 0;
#pragma unroll 1
    for (;;) {
      __syncthreads();
      if (threadIdx.x == 0) qslot[0] = atomicAdd(p.bar + 65, 1u);
      __syncthreads();
      const int q = (int)qslot[0];
      if (q >= N_DSA) break;
      dsa_item(p, smem, q & 7, (SEQ / 2 - 1) - (q >> 3));
      if ((++ndone & 31) == 0) {
        __syncthreads();
        if (threadIdx.x == 0) qslot[0] = atomicAdd(p.bar + 67, 1u);
        __syncthreads();
        const int qq = (int)qslot[0];
        if (qq < 512) quant_item(qq);
      }
    }
#pragma unroll 1
    for (;;) {
      __syncthreads();
      if (threadIdx.x == 0) qslot[0] = atomicAdd(p.bar + 67, 1u);
      __syncthreads();
      const int qq = (int)qslot[0];
      if (qq >= 512) break;
      quant_item(qq);
    }
#pragma unroll 1
    for (;;) {
      __syncthreads();
      if (threadIdx.x == 0) qslot[0] = atomicAdd(p.bar + 66, 1u);
      __syncthreads();
      const int q = (int)qslot[0];
      if (q >= N_MEM) break;
      mem_flash_item(p, smem, q);
    }
  }
  xcd_barrier(xb);
  peer_block_phase(p, smem, bid, nblk);
  peer_e3_phase(p, bid, nblk);
}


#if SELFCHECK
__global__ void __launch_bounds__(256) check_kernel(Params p) {
  __shared__ __align__(16) unsigned char smem[40960];
  inproj_check_phase(p, smem, blockIdx.x, gridDim.x);
}
__global__ void check_final(Params p) {
  if (threadIdx.x == 0 && (*(volatile int*)p.flag != 0 || *(volatile int*)p.chkcnt > 6000)) p.out[0] = __uint_as_float(0x7FC00000u);
}
#endif

extern "C" void kernel_launch(void* const* d_in, const int* in_sizes, int n_in, void* d_out, int out_size,
                              void* d_ws, size_t ws_size, hipStream_t stream) {
  Params p{};
  p.x = (const float*)d_in[0]; p.mem = (const float*)d_in[1]; p.pos = (const int*)d_in[2];
  p.w_in = (const float*)d_in[3]; p.pe_k = (const float*)d_in[4]; p.pe_v = (const float*)d_in[5];
  p.w1k = (const float*)d_in[6]; p.w2k = (const float*)d_in[7]; p.w1v = (const float*)d_in[8]; p.w2v = (const float*)d_in[9];
  p.w_mem_kv = (const float*)d_in[10]; p.w_out = (const float*)d_in[11]; p.ln1g = (const float*)d_in[12]; p.ln1b = (const float*)d_in[13];
  p.wq = (const float*)d_in[14]; p.sk1 = (const float*)d_in[15]; p.sk2 = (const float*)d_in[16];
  p.pu = (const float*)d_in[17]; p.pv = (const float*)d_in[18]; p.ln2g = (const float*)d_in[19]; p.ln2b = (const float*)d_in[20];
  p.out = (float*)d_out;
  unsigned char* ws = (unsigned char*)d_ws;
  size_t off = 0;
  auto take = [&](size_t bytes) { void* r = ws + off; off += (bytes + 255) & ~(size_t)255; return r; };
  p.xb = (bf16_t*)take((size_t)NT * DM * 2);
  p.qn = (bf16_t*)take((size_t)NT * 512 * 2);
  for (int j = 0; j < 6; j++) p.kvn[j] = (bf16_t*)take((size_t)NT * 128 * 2);
  p.qd = (bf16_t*)take((size_t)NT * 256 * 2);
  p.kd = (bf16_t*)take((size_t)NT * 64 * 2);
  p.vd = (bf16_t*)take((size_t)NT * 64 * 2);
  p.qi = (bf16_t*)take((size_t)NT * 256 * 2);
  p.ki = (bf16_t*)take((size_t)NT * 32 * 2);
  p.memq = (bf16_t*)take((size_t)NT * 256 * 2);
  p.gates = (float*)take((size_t)NT * 24 * 4);
  p.widx = (float*)take((size_t)NT * 8 * 4);
  p.mkv = (bf16_t*)take((size_t)NB * MEML * 512 * 2);
  p.memvt = (bf16_t*)take((size_t)NB * 4 * 64 * MEML * 2);
  p.vslct = (bf16_t*)take((size_t)NT * 128 * 2);
  p.vwint = (bf16_t*)take((size_t)NT * 128 * 2);
  p.kcb = (bf16_t*)take((size_t)NB * 2 * 256 * 64 * 2);
  p.vct = (bf16_t*)take((size_t)NB * 2 * 64 * 256 * 2);
  p.ovp = (bf16_t*)take((size_t)64 * 256 * 2);
  p.w1kt = (bf16_t*)take((size_t)128 * 2048 * 2);
  p.w1vt = (bf16_t*)take((size_t)128 * 2048 * 2);
  p.cbias = (float*)take(64 * 256 * 4);
  p.chkcnt = (int*)take(256);
  p.bar = (unsigned*)take(XCD_BAR_WORDS * 4);
  p.never = 0; p.pad_ = 0;
  p.memb = (bf16_t*)take((size_t)NB * MEML * DM * 2);
  p.wint = (bf16_t*)take((size_t)INWP * DM * 2);
  p.wmemt = (bf16_t*)take((size_t)512 * DM * 2);
  p.woutt = (bf16_t*)take((size_t)DM * DM * 2);
  p.wqt = (bf16_t*)take((size_t)2048 * DM * 2);
  p.sk1p = (bf16_t*)take((size_t)128 * 128 * 2);
  p.sk2p = (bf16_t*)take((size_t)128 * 128 * 2);
  p.puq = (unsigned char*)take((size_t)16384 * DM);
  p.pvq = (unsigned char*)take((size_t)16384 * DM);
  p.psu = (float*)take(16384 * 4);
  p.psv = (float*)take(16384 * 4);
  p.cs = (float2*)take((size_t)NT * 8 * 8);
  p.kc = (float*)take((size_t)NB * 2 * NC * 64 * 4);
  p.vc = (float*)take((size_t)NB * 2 * NC * 64 * 4);
  p.concat = (bf16_t*)take((size_t)NT * DM * 2);
  p.x1b = (bf16_t*)take((size_t)NT * DM * 2);
  p.pexp = (int*)take((size_t)NT * 128 * 4);
  p.pgate = (float*)take((size_t)NT * 128 * 4);
  p.flag = (int*)take(256);
  if (off > ws_size) { fprintf(stderr, "workspace too small: need %zu have %zu\n", off, ws_size); return; }
  static int grid_blocks = 0;
  if (!grid_blocks) {
    int dev = 0, cus = 0, per_cu = 0;
    hipGetDevice(&dev);
    hipDeviceGetAttribute(&cus, hipDeviceAttributeMultiprocessorCount, dev);
    hipOccupancyMaxActiveBlocksPerMultiprocessor(&per_cu, megakernel, 256, 0);
    if (per_cu > 2) per_cu = 2;
    grid_blocks = cus * per_cu;
  }
  hipMemsetAsync(p.bar, 0, XCD_BAR_WORDS * 4, stream);
  void* args[] = {&p};
  hipError_t e = hipLaunchCooperativeKernel((void*)megakernel, dim3(grid_blocks), dim3(256), args, 0, stream);
  if (e != hipSuccess) fprintf(stderr, "cooperative launch failed: %s (grid %d)\n", hipGetErrorString(e), grid_blocks);
#if SELFCHECK
  check_kernel<<<512, 256, 0, stream>>>(p);
  check_final<<<1, 64, 0, stream>>>(p);
#endif
}
```

```cpp
#include <hip/hip_runtime.h>
#include <hip/hip_cooperative_groups.h>
#include <cstdio>
#include <cstdint>
namespace cg = cooperative_groups;

constexpr int NB = 8, SEQ = 4096, DM = 1024, NT = NB * SEQ;
constexpr int INW = 2240;
constexpr int INWP = 2304;
constexpr int NC = 255;
constexpr int MEML = 256;
constexpr int C_NSAQ = 0, C_NSAKV = 512, C_GATE = 1280, C_DSAQ = 1304, C_DSAK = 1560, C_DSAV = 1624,
              C_IDXQ = 1688, C_IDXK = 1944, C_IDXW = 1976, C_MEMQ = 1984;
constexpr int P_NSAQ = 0, P_NSAKV = 512, P_DSAQ = 1280, P_DSAK = 1536, P_DSAV = 1600, P_IDXQ = 1664, P_IDXK = 1920,
              P_MEMQ = 1952, P_GATE = 2208, P_IDXW = 2232, P_END = 2240;
constexpr float ALPHA = 1.189207115002721f;

typedef unsigned short bf16_t;
typedef __attribute__((ext_vector_type(8))) __bf16 bf16x8;
typedef __attribute__((ext_vector_type(2))) __bf16 bf16x2;
typedef __attribute__((ext_vector_type(2))) float f32x2;
typedef __attribute__((ext_vector_type(4))) float f32x4;
typedef __attribute__((ext_vector_type(16))) float f32x16;
typedef __attribute__((ext_vector_type(2))) _Float16 f16x2;

struct Params {
  const float *x, *mem; const int* pos;
  const float *w_in, *pe_k, *pe_v, *w1k, *w2k, *w1v, *w2v, *w_mem_kv, *w_out, *ln1g, *ln1b,
              *wq, *sk1, *sk2, *pu, *pv, *ln2g, *ln2b;
  float* out;
  bf16_t *xb, *memb, *wint, *wmemt, *woutt, *wqt, *sk1p, *sk2p;
  unsigned char *puq, *pvq;
  float *psu, *psv;
  float2* cs;
  bf16_t *qn;
  bf16_t *kvn[6];
  bf16_t *qd, *kd, *vd;
  bf16_t *qi, *ki;
  bf16_t *memq, *mkv;
  bf16_t *memvt;
  bf16_t *vslct, *vwint;
  bf16_t *w1kt, *w1vt; float* cbias;
  bf16_t *kcb, *vct;
  bf16_t *ovp;
  int *chkcnt;
  unsigned *bar;
  int never;
  int pad_;
  float *gates, *widx;
  bf16_t *concat;
  bf16_t *x1b;
  float *kc, *vc;
  int   *pexp;
  float *pgate;
  int   *flag;
};

__device__ __forceinline__ float bf2f(bf16_t u) { return __uint_as_float(((unsigned)u) << 16); }
__device__ __forceinline__ bf16_t f2bf(float f) { return __builtin_bit_cast(unsigned short, (__bf16)f); }
__device__ __forceinline__ unsigned pack2bf(float a, float b) {
  f32x2 v = {a, b};
  return __builtin_bit_cast(unsigned, __builtin_convertvector(v, bf16x2));
}

__device__ __forceinline__ int tid_opaque() { int t = threadIdx.x; asm volatile("" : "+v"(t)); return t; }

__device__ __forceinline__ float wave_sum(float v) {
#pragma unroll
  for (int o = 32; o > 0; o >>= 1) v += __shfl_xor(v, o);
  return v;
}
__device__ __forceinline__ float wave_max(float v) {
#pragma unroll
  for (int o = 32; o > 0; o >>= 1) v = fmaxf(v, __shfl_xor(v, o));
  return v;
}
__device__ __forceinline__ float gelu_exact(float x) { return 0.5f * x * (1.f + erff(x * 0.7071067811865476f)); }

__device__ __forceinline__ void convert_phase(const float* __restrict__ src, bf16_t* __restrict__ dst, size_t n, int bid, int nblk) {
  const size_t nch = n / 8, stride = (size_t)nblk * 256;
  size_t c = (size_t)bid * 256 + threadIdx.x;
  for (; c + 3 * stride < nch; c += 4 * stride) {
    float4 a[4], b[4];
#pragma unroll
    for (int u = 0; u < 4; u++) { a[u] = *(const float4*)(src + (c + u * stride) * 8); b[u] = *(const float4*)(src + (c + u * stride) * 8 + 4); }
#pragma unroll
    for (int u = 0; u < 4; u++) {
      uint4 o = {pack2bf(a[u].x, a[u].y), pack2bf(a[u].z, a[u].w), pack2bf(b[u].x, b[u].y), pack2bf(b[u].z, b[u].w)};
      *(uint4*)(dst + (c + u * stride) * 8) = o;
    }
  }
  for (; c < nch; c += stride) {
    const float4 a = *(const float4*)(src + c * 8), b = *(const float4*)(src + c * 8 + 4);
    uint4 o = {pack2bf(a.x, a.y), pack2bf(a.z, a.w), pack2bf(b.x, b.y), pack2bf(b.z, b.w)};
    *(uint4*)(dst + c * 8) = o;
  }
}
__device__ __forceinline__ unsigned quant4(const float4& v, float inv) {
  const unsigned a = (unsigned)(__float2int_rn(v.x * inv) + 128), b = (unsigned)(__float2int_rn(v.y * inv) + 128);
  const unsigned c = (unsigned)(__float2int_rn(v.z * inv) + 128), d = (unsigned)(__float2int_rn(v.w * inv) + 128);
  return a | (b << 8) | (c << 16) | (d << 24);
}
__device__ __forceinline__ float absmax4(const float4& v) { return fmaxf(fmaxf(fabsf(v.x), fabsf(v.y)), fmaxf(fabsf(v.z), fabsf(v.w))); }
__device__ __forceinline__ void quant_rows(const float* __restrict__ src, unsigned char* __restrict__ dst, float* __restrict__ scl,
                                           int row0, int nrows, int gw, int nw) {
  const int lane = tid_opaque() & 63;
  for (int r = row0 + gw * 2; r < row0 + nrows; r += nw * 2) {
    const float4* s0 = (const float4*)(src + (size_t)r * 1024 + 16 * lane);
    const float4* s1 = (const float4*)(src + (size_t)(r + 1) * 1024 + 16 * lane);
    const float4 a0 = s0[0], a1 = s0[1], a2 = s0[2], a3 = s0[3];
    const float4 b0 = s1[0], b1 = s1[1], b2 = s1[2], b3 = s1[3];
    const float ma = wave_max(fmaxf(fmaxf(absmax4(a0), absmax4(a1)), fmaxf(absmax4(a2), absmax4(a3))));
    const float mb = wave_max(fmaxf(fmaxf(absmax4(b0), absmax4(b1)), fmaxf(absmax4(b2), absmax4(b3))));
    const float ia = ma > 0.f ? 127.f / ma : 0.f, ib = mb > 0.f ? 127.f / mb : 0.f;
    *(uint4*)(dst + (size_t)r * 1024 + 16 * lane) = make_uint4(quant4(a0, ia), quant4(a1, ia), quant4(a2, ia), quant4(a3, ia));
    *(uint4*)(dst + (size_t)(r + 1) * 1024 + 16 * lane) = make_uint4(quant4(b0, ib), quant4(b1, ib), quant4(b2, ib), quant4(b3, ib));
    if (lane == 0) { scl[r] = ma * (1.f / 127.f); scl[r + 1] = mb * (1.f / 127.f); }
  }
}
__device__ __forceinline__ int inproj_colmap(int n) {
  if (n < P_DSAQ) return n;
  if (n < P_DSAK) return C_DSAQ + (n - P_DSAQ);
  if (n < P_IDXQ) return C_DSAK + (n - P_DSAK);
  if (n < P_IDXK) return C_IDXQ + (n - P_IDXQ);
  if (n < P_MEMQ) return C_IDXK + (n - P_IDXK);
  if (n < P_GATE) return C_MEMQ + (n - P_MEMQ);
  if (n < P_IDXW) return C_GATE + (n - P_GATE);
  if (n < P_END) return C_IDXW + (n - P_IDXW);
  return -1;
}
template <bool PERM>
__device__ __forceinline__ void transpose_phase(const float* __restrict__ src, int lds_, bf16_t* __restrict__ dst, int K, int Nd,
                                unsigned char* smem, int bid, int nblk) {
  float (*t)[65] = (float (*)[65])smem;
  const int tx = threadIdx.x & 63, ty = threadIdx.x >> 6;
  const int tk = K / 64, tn = Nd / 64;
  for (int tile = bid; tile < tk * tn; tile += nblk) {
    const int k0 = (tile % tk) * 64, n0 = (tile / tk) * 64;
    const int nsrc = PERM ? inproj_colmap(n0 + tx) : (n0 + tx);
#pragma unroll
    for (int i = 0; i < 16; i++) {
      const int k = ty + 4 * i;
      t[tx][k] = (nsrc >= 0) ? src[(size_t)(k0 + k) * lds_ + nsrc] : 0.f;
    }
    __syncthreads();
#pragma unroll
    for (int i = 0; i < 16; i++) {
      const int n = ty + 4 * i;
      dst[(size_t)(n0 + n) * K + k0 + tx] = f2bf(t[n][tx]);
    }
    __syncthreads();
  }
}
__device__ __forceinline__ void subkey_phase(const float* __restrict__ src, bf16_t* __restrict__ dst, int bid, int nblk) {
  for (int i = bid * 256 + threadIdx.x; i < 128 * 128; i += nblk * 256) {
    const int n = i >> 7, pos = i & 127, g16 = pos & ~15, pp = pos & 15, h = pp >> 3, j = pp & 7;
    dst[i] = f2bf(src[n * 128 + g16 + 8 * (j >> 2) + 4 * h + (j & 3)]);
  }
}
__device__ __forceinline__ void rope_cs(int pos, float freq, float& c, float& s) {
  double ang = (double)pos * (double)freq;
  double rev = ang * 0.15915494309189535;
  rev -= floor(rev + 0.5);
  float r = (float)(rev * 6.283185307179586);
  c = __cosf(r); s = __sinf(r);
}
__device__ __forceinline__ void cs_phase(const Params& p, int bid, int nblk) {
  const float f16[8] = {1.0f, 0.19392274474868576f, 0.03760603093086393f, 0.007292664737217109f,
                        0.001414213562373095f, 0.0002742481756762073f, 5.318295896944988e-05f, 1.031338537721246e-05f};
  for (int i = bid * 256 + threadIdx.x; i < NT * 8; i += nblk * 256) {
    float c, s; rope_cs(p.pos[i >> 3], f16[i & 7], c, s);
    p.cs[i] = make_float2(c, s);
  }
}

template <int WM, int WN>
struct Gemm {
  static constexpr int BM = 64 * WM, BN = 64 * WN;
  static constexpr int A_BYTES = BM * 128, B_BYTES = BN * 128, STAGE = A_BYTES + B_BYTES;
  static constexpr int SMEM = 2 * STAGE;
  static constexpr int NA = BM / 32, NBK = BN / 32;

  struct Stage8 { uint4 a0, a1, a2, a3, b0, b1, b2, b3; };
  static __device__ __forceinline__ Stage8 ld_stage(const bf16_t* ap0, const bf16_t* ap1, const bf16_t* ap2, const bf16_t* ap3,
                                                    const bf16_t* bp0, const bf16_t* bp1, const bf16_t* bp2, const bf16_t* bp3, int ko) {
    Stage8 r;
    r.a0 = *(const uint4*)(ap0 + ko); r.a1 = *(const uint4*)(ap1 + ko);
    if (NA > 2) { r.a2 = *(const uint4*)(ap2 + ko); r.a3 = *(const uint4*)(ap3 + ko); } else { r.a2 = r.a0; r.a3 = r.a0; }
    r.b0 = *(const uint4*)(bp0 + ko); r.b1 = *(const uint4*)(bp1 + ko);
    if (NBK > 2) { r.b2 = *(const uint4*)(bp2 + ko); r.b3 = *(const uint4*)(bp3 + ko); } else { r.b2 = r.b0; r.b3 = r.b0; }
    return r;
  }
  static __device__ __forceinline__ void st_stage(const Stage8 r, unsigned char* dst, int wofs) {
    *(uint4*)(dst + wofs) = r.a0; *(uint4*)(dst + wofs + 4096) = r.a1;
    if (NA > 2) { *(uint4*)(dst + wofs + 8192) = r.a2; *(uint4*)(dst + wofs + 12288) = r.a3; }
    *(uint4*)(dst + A_BYTES + wofs) = r.b0; *(uint4*)(dst + A_BYTES + wofs + 4096) = r.b1;
    if (NBK > 2) { *(uint4*)(dst + A_BYTES + wofs + 8192) = r.b2; *(uint4*)(dst + A_BYTES + wofs + 12288) = r.b3; }
  }
  static __device__ __forceinline__ void compute_stage(f32x16 (&acc)[WM][WN], const unsigned char* cur, int wm, int wn, int fr, int fh) {
#pragma unroll
    for (int s = 0; s < 4; s++) {
      const int chunk = 2 * s + fh;
      bf16x8 af[WM], bfr[WN];
#pragma unroll
      for (int i = 0; i < WM; i++) {
        const int row = (wm * WM + i) * 32 + fr;
        af[i] = *(const bf16x8*)(cur + row * 128 + ((chunk ^ ((row >> 1) & 7)) << 4));
      }
#pragma unroll
      for (int j = 0; j < WN; j++) {
        const int row = (wn * WN + j) * 32 + fr;
        bfr[j] = *(const bf16x8*)(cur + A_BYTES + row * 128 + ((chunk ^ ((row >> 1) & 7)) << 4));
      }
#pragma unroll
      for (int i = 0; i < WM; i++)
#pragma unroll
        for (int j = 0; j < WN; j++) acc[i][j] = __builtin_amdgcn_mfma_f32_32x32x16_bf16(af[i], bfr[j], acc[i][j], 0, 0, 0);
    }
  }
  template <class ARow, class BRow>
  static __device__ __forceinline__ void mainloop(f32x16 (&acc)[WM][WN], ARow arow, BRow brow, int K, unsigned char* smem, int tid = threadIdx.x) {
    const int lane = tid & 63, w = tid >> 6, wm = w >> 1, wn = w & 1;
    const int lrow = tid >> 3, lchunk = tid & 7;
    const bf16_t* ap0 = arow(lrow) + lchunk * 8;
    const bf16_t* ap1 = arow(lrow + 32) + lchunk * 8;
    const bf16_t* ap2 = (NA > 2) ? arow(lrow + 64) + lchunk * 8 : ap0;
    const bf16_t* ap3 = (NA > 2) ? arow(lrow + 96) + lchunk * 8 : ap0;
    const bf16_t* bp0 = brow(lrow) + lchunk * 8;
    const bf16_t* bp1 = brow(lrow + 32) + lchunk * 8;
    const bf16_t* bp2 = (NBK > 2) ? brow(lrow + 64) + lchunk * 8 : bp0;
    const bf16_t* bp3 = (NBK > 2) ? brow(lrow + 96) + lchunk * 8 : bp0;
    const int wofs = lrow * 128 + ((lchunk ^ ((lrow >> 1) & 7)) << 4);
    const int fr = lane & 31, fh = lane >> 5;
    const int nk = K / 64;
    Stage8 rA = ld_stage(ap0, ap1, ap2, ap3, bp0, bp1, bp2, bp3, 0);
    Stage8 rB = ld_stage(ap0, ap1, ap2, ap3, bp0, bp1, bp2, bp3, 64);
    st_stage(rA, smem, wofs);
    rA = ld_stage(ap0, ap1, ap2, ap3, bp0, bp1, bp2, bp3, (nk > 2 ? 2 : 0) * 64);
    __syncthreads();
#pragma unroll 1
    for (int kt = 0; kt < nk; kt += 2) {
      compute_stage(acc, smem, wm, wn, fr, fh);
      st_stage(rB, smem + STAGE, wofs);
      if (kt + 3 < nk) rB = ld_stage(ap0, ap1, ap2, ap3, bp0, bp1, bp2, bp3, (kt + 3) * 64);
      __syncthreads();
      compute_stage(acc, smem + STAGE, wm, wn, fr, fh);
      if (kt + 2 < nk) {
        st_stage(rA, smem, wofs);
        if (kt + 4 < nk) rA = ld_stage(ap0, ap1, ap2, ap3, bp0, bp1, bp2, bp3, (kt + 4) * 64);
      }
      __syncthreads();
    }
  }
};

__device__ __forceinline__ int perm16(int k) { return (k & ~12) | ((k & 4) << 1) | ((k & 8) >> 1); }
constexpr float LOG2E = 1.4426950408889634f;
constexpr int FL_TILE = 8192;
constexpr int FL_STAGE = 2 * FL_TILE;
struct FlashAcc {
  f32x16 o[2];
  float m, l;
};
__device__ __forceinline__ void flash_init(FlashAcc& a) {
#pragma unroll
  for (int i = 0; i < 2; i++)
#pragma unroll
    for (int r = 0; r < 16; r++) a.o[i][r] = 0.f;
  a.m = -INFINITY; a.l = 0.f;
}
struct Tile2 { uint4 a, b; };
template <class RowF>
__device__ __forceinline__ Tile2 tile_fetch(RowF rowp, int tid) {
  Tile2 t;
  t.a = *(const uint4*)(rowp(tid >> 3) + (tid & 7) * 8);
  t.b = *(const uint4*)(rowp((tid >> 3) + 32) + (tid & 7) * 8);
  return t;
}
template <class RowF>
__device__ __forceinline__ Tile2 tile_fetch(RowF rowp) { return tile_fetch(rowp, (int)threadIdx.x); }
__device__ __forceinline__ void tile_store(const Tile2& t, unsigned char* dst, int tid = threadIdx.x) {
  const int row = tid >> 3, ch = tid & 7;
  const int ofs = row * 128 + ((ch ^ ((row >> 1) & 7)) << 4);
  *(uint4*)(dst + ofs) = t.a;
  *(uint4*)(dst + ofs + 4096) = t.b;
}
__device__ __forceinline__ bf16x8 lds_frag(const unsigned char* tile, int row, int chunk) {
  return *(const bf16x8*)(tile + row * 128 + ((chunk ^ ((row >> 1) & 7)) << 4));
}
__device__ __forceinline__ void flash_qk(f32x16 (&s)[2], const unsigned char* ktile, const bf16x8 (&qf)[4], int lane = threadIdx.x & 63) {
  const int fr = lane & 31, fh = lane >> 5;
  bf16x8 kf[8];
#pragma unroll
  for (int kt = 0; kt < 2; kt++)
#pragma unroll
    for (int ks = 0; ks < 4; ks++) kf[kt * 4 + ks] = lds_frag(ktile, kt * 32 + fr, 2 * ks + fh);
  __builtin_amdgcn_sched_barrier(0);
#pragma unroll
  for (int kt = 0; kt < 2; kt++)
#pragma unroll
    for (int r = 0; r < 16; r++) s[kt][r] = 0.f;
#pragma unroll
  for (int ks = 0; ks < 4; ks++)
#pragma unroll
    for (int kt = 0; kt < 2; kt++) s[kt] = __builtin_amdgcn_mfma_f32_32x32x16_bf16(kf[kt * 4 + ks], qf[ks], s[kt], 0, 0, 0);
  asm volatile("" ::: "memory");
}
#define MAX3(a, b, c) __builtin_elementwise_maximum(__builtin_elementwise_maximum((a), (b)), (c))
__device__ __forceinline__ bf16x8 pack_frag(const f32x16& s, int half8) {
  uint4 u = {pack2bf(s[8 * half8 + 0], s[8 * half8 + 1]), pack2bf(s[8 * half8 + 2], s[8 * half8 + 3]),
             pack2bf(s[8 * half8 + 4], s[8 * half8 + 5]), pack2bf(s[8 * half8 + 6], s[8 * half8 + 7])};
  return __builtin_bit_cast(bf16x8, u);
}
__device__ __forceinline__ void flash_update(FlashAcc& a, f32x16 (&s)[2], const unsigned char* vtile, bool colvalid = true, int lane = threadIdx.x & 63) {
  const int fr = lane & 31, fh = lane >> 5;
  bf16x8 vf[8];
#pragma unroll
  for (int h8 = 0; h8 < 2; h8++)
#pragma unroll
    for (int dt = 0; dt < 2; dt++) vf[h8 * 2 + dt] = lds_frag(vtile, dt * 32 + fr, 2 * h8 + fh);
  __builtin_amdgcn_sched_barrier(0);
  float mx = MAX3(s[0][0], s[1][0], s[0][1]), mx2 = MAX3(s[1][1], s[0][2], s[1][2]);
#pragma unroll
  for (int r = 3; r < 15; r += 2) { mx = MAX3(mx, s[0][r], s[1][r]); mx2 = MAX3(mx2, s[0][r + 1], s[1][r + 1]); }
  mx = MAX3(mx, s[0][15], s[1][15]);
  mx = MAX3(mx, mx2, __shfl_xor(__builtin_elementwise_maximum(mx, mx2), 32));
  mx = colvalid ? mx : -INFINITY;
  const float mnew = __builtin_elementwise_maximum(a.m, mx);
  const float muse = (mnew == -INFINITY) ? 0.f : mnew;
  if (__any(mnew != a.m)) {
    const float alpha = __builtin_amdgcn_exp2f((a.m - muse) * LOG2E);
    a.l *= alpha;
#pragma unroll
    for (int dt = 0; dt < 2; dt++)
#pragma unroll
      for (int r = 0; r < 16; r++) a.o[dt][r] *= alpha;
    a.m = mnew;
  }
  const float cb = colvalid ? -muse * LOG2E : -INFINITY;
#pragma unroll
  for (int r = 0; r < 16; r++) {
    s[0][r] = __builtin_amdgcn_exp2f(fmaf(s[0][r], LOG2E, cb));
    s[1][r] = __builtin_amdgcn_exp2f(fmaf(s[1][r], LOG2E, cb));
  }
  {
    f32x2 sm2 = {0.f, 0.f};
#pragma unroll
    for (int r = 0; r < 16; r += 2) {
      const f32x2 u0 = {s[0][r], s[0][r + 1]}, u1 = {s[1][r], s[1][r + 1]};
      sm2 += u0; sm2 += u1;
    }
    a.l += sm2[0] + sm2[1];
  }
#pragma unroll
  for (int h8 = 0; h8 < 2; h8++)
#pragma unroll
    for (int dt = 0; dt < 2; dt++) vf[4 + h8 * 2 + dt] = lds_frag(vtile, dt * 32 + fr, 4 + 2 * h8 + fh);
  __builtin_amdgcn_sched_barrier(0);
#pragma unroll
  for (int kt = 0; kt < 2; kt++)
#pragma unroll
    for (int h8 = 0; h8 < 2; h8++) {
      const bf16x8 pf = pack_frag(s[kt], h8);
#pragma unroll
      for (int dt = 0; dt < 2; dt++)
        a.o[dt] = __builtin_amdgcn_mfma_f32_32x32x16_bf16(vf[(kt * 2 + h8) * 2 + dt], pf, a.o[dt], 0, 0, 0);
    }
}
__device__ __forceinline__ float flash_inv_l(const FlashAcc& a) {
  const float lt = a.l + __shfl_xor(a.l, 32);
  return lt > 0.f ? 1.f / lt : 0.f;
}
__device__ __forceinline__ void flash_load_q(bf16x8 (&qf)[4], const bf16_t* qrow, float scale, int lane = threadIdx.x & 63) {
  const int fh = lane >> 5;
#pragma unroll
  for (int ks = 0; ks < 4; ks++) {
    const uint4 u = *(const uint4*)(qrow + ks * 16 + fh * 8);
    const unsigned w[4] = {u.x, u.y, u.z, u.w};
    uint4 o;
    o.x = pack2bf(__uint_as_float(w[0] << 16) * scale, __uint_as_float(w[0] & 0xFFFF0000u) * scale);
    o.y = pack2bf(__uint_as_float(w[1] << 16) * scale, __uint_as_float(w[1] & 0xFFFF0000u) * scale);
    o.z = pack2bf(__uint_as_float(w[2] << 16) * scale, __uint_as_float(w[2] & 0xFFFF0000u) * scale);
    o.w = pack2bf(__uint_as_float(w[3] << 16) * scale, __uint_as_float(w[3] & 0xFFFF0000u) * scale);
    qf[ks] = __builtin_bit_cast(bf16x8, o);
  }
}
__device__ __forceinline__ void flash_store_o(const FlashAcc& a, bf16_t* orow, float scale, int lane = threadIdx.x & 63) {
  const int fh = lane >> 5;
#pragma unroll
  for (int dt = 0; dt < 2; dt++)
#pragma unroll
    for (int g4 = 0; g4 < 4; g4++) {
      uint2 o = {pack2bf(a.o[dt][4 * g4 + 0] * scale, a.o[dt][4 * g4 + 1] * scale),
                 pack2bf(a.o[dt][4 * g4 + 2] * scale, a.o[dt][4 * g4 + 3] * scale)};
      *(uint2*)(orow + dt * 32 + 8 * g4 + 4 * fh) = o;
    }
}

__device__ __forceinline__ void mem_flash_item(const Params& p, unsigned char* smem, int item) {
  const int tid = tid_opaque(), lane = tid & 63, w = tid >> 6, fr = lane & 31;
  const int chunk = item & 31, h = (item >> 5) & 3, b = item >> 7;
  const int tok = b * SEQ + chunk * 128 + w * 32 + fr;
  bf16x8 qf[4];
  flash_load_q(qf, p.memq + (size_t)tok * 256 + h * 64, 0.125f, lane);
  FlashAcc acc; flash_init(acc);
  const bf16_t* kbase = p.mkv + (size_t)b * MEML * 512 + h * 64;
  const bf16_t* vbase = p.memvt + (size_t)(b * 4 + h) * 64 * MEML;
  Tile2 rk = tile_fetch([&](int r) { return kbase + (size_t)r * 512; }, tid);
  Tile2 rv = tile_fetch([&](int r) { return vbase + (size_t)r * MEML; }, tid);
  __syncthreads();
  tile_store(rk, smem, tid); tile_store(rv, smem + FL_TILE, tid);
  __syncthreads();
#pragma unroll 1
  for (int kb = 0; kb < 4; kb++) {
    unsigned char* cur = smem + (kb & 1) * FL_STAGE;
    if (kb + 1 < 4) {
      rk = tile_fetch([&](int r) { return kbase + (size_t)((kb + 1) * 64 + r) * 512; }, tid);
      rv = tile_fetch([&](int r) { return vbase + (size_t)r * MEML + (kb + 1) * 64; }, tid);
    }
    {
      f32x16 s[2];
      flash_qk(s, cur, qf, lane);
      flash_update(acc, s, cur + FL_TILE, true, lane);
    }
    if (kb + 1 < 4) { unsigned char* nxt = smem + ((kb + 1) & 1) * FL_STAGE; tile_store(rk, nxt, tid); tile_store(rv, nxt + FL_TILE, tid); }
    __syncthreads();
  }
  flash_store_o(acc, p.concat + (size_t)tok * DM + 768 + h * 64, flash_inv_l(acc), lane);
}
__device__ __forceinline__ void mem_phase(const Params& p, unsigned char* smem, int bid, int nblk) {
  for (int item = bid; item < NB * 4 * 32; item += nblk) mem_flash_item(p, smem, item);
}

__device__ __forceinline__ void ovp_phase(const Params& p, int bid, int nblk) {
  for (int i = bid * 256 + threadIdx.x; i < 64 * 256; i += nblk * 256) {
    const int m = i >> 8, n = i & 255;
    int ov = min(16 * n + 32, 64 * m + 64) - max(16 * n, 64 * m);
    if (ov < 0 || n >= NC) ov = 0;
    p.ovp[m * 256 + perm16(n)] = f2bf((float)ov * (1.f / 32.f));
  }
}

struct TileDest { bf16_t* ptr; int stride; int kind; };
__device__ __forceinline__ TileDest inproj_dest(const Params& p, int cb, int b) {
  TileDest d; d.kind = 0;
  if (cb < P_NSAKV) { d.ptr = p.qn + cb; d.stride = 512; d.kind = ((cb & 63) == 0) ? 1 : 0; }
  else if (cb < P_DSAQ) {
    const int o = cb - P_NSAKV, j = o >> 7, g = (o >> 6) & 1;
    if (j == 3 || j == 5) {
      d.ptr = (j == 3 ? p.vslct : p.vwint) + ((size_t)(b * 2 + g) * 64 + (o & 63)) * SEQ; d.stride = 0; d.kind = 5;
    } else {
      bf16_t* base = (j == 0) ? p.kvn[0] : (j == 1) ? p.kvn[1] : (j == 2) ? p.kvn[2] : p.kvn[4];
      d.ptr = base + ((size_t)g * SEQ + (size_t)b * SEQ) * 64 + (o & 63); d.stride = 64;
      d.kind = (((j & 1) == 0) && ((o & 63) == 0)) ? 1 : 0;
    }
  }
  else if (cb < P_DSAK) { d.ptr = p.qd + (cb - P_DSAQ); d.stride = 256; d.kind = ((cb & 63) == 0) ? 1 : 0; }
  else if (cb < P_DSAV) { d.ptr = p.kd + (cb - P_DSAK); d.stride = 64; d.kind = (cb == P_DSAK) ? 1 : 0; }
  else if (cb < P_IDXQ) { d.ptr = p.vd + (cb - P_DSAV); d.stride = 64; }
  else if (cb < P_IDXK) { d.ptr = p.qi + (cb - P_IDXQ); d.stride = 256; d.kind = 2; }
  else if (cb < P_MEMQ) { d.ptr = p.ki; d.stride = 32; d.kind = 2; }
  else if (cb < P_GATE) { d.ptr = p.memq + (cb - P_MEMQ); d.stride = 256; }
  else if (cb < P_END) { d.ptr = nullptr; d.stride = 0; d.kind = 3; }
  else { d.ptr = nullptr; d.stride = 0; d.kind = 4; }
  return d;
}
__device__ __forceinline__ void inproj_phase(const Params& p, unsigned char* smem, int bid, int nblk) {
  typedef Gemm<2, 2> G;
  const int lane = threadIdx.x & 63, w = threadIdx.x >> 6, wm = w >> 1, wn = w & 1;
  const int c = lane & 31, fh = lane >> 5;
  constexpr int TN = INWP / 128, TM = NT / 128;
  for (int tile = bid; tile < TM * TN; tile += nblk) {
    f32x16 acc[2][2];
#pragma unroll
    for (int i = 0; i < 2; i++)
#pragma unroll
      for (int j = 0; j < 2; j++)
#pragma unroll
        for (int r = 0; r < 16; r++) acc[i][j][r] = 0.f;
    {
      const int m0 = (tile / TN) * 128, n0 = (tile % TN) * 128;
      const bf16_t* A = p.xb + (size_t)m0 * DM;
      const bf16_t* Bt = p.wint + (size_t)n0 * DM;
      G::mainloop(acc, [&](int r) { return A + (size_t)r * DM; }, [&](int r) { return Bt + (size_t)r * DM; }, DM, smem);
      const int b = m0 / SEQ;
      unsigned char* wt = smem + w * 9216;
      const TileDest d0 = inproj_dest(p, n0 + (wn * 2 + 0) * 32, b);
      const TileDest d1 = inproj_dest(p, n0 + (wn * 2 + 1) * 32, b);
#pragma unroll
      for (int j = 0; j < 2; j++) {
        const TileDest d = j ? d1 : d0;
        if (d.kind == 4) continue;
        if (d.kind == 5) {
#pragma unroll
          for (int i = 0; i < 2; i++)
#pragma unroll
            for (int g4 = 0; g4 < 4; g4++) {
              const int tloc = (m0 & (SEQ - 1)) + (wm * 2 + i) * 32 + 8 * g4 + 4 * fh;
              uint2 o = {pack2bf(acc[i][j][4 * g4 + 0], acc[i][j][4 * g4 + 1]), pack2bf(acc[i][j][4 * g4 + 2], acc[i][j][4 * g4 + 3])};
              *(uint2*)(d.ptr + (size_t)c * SEQ + perm16(tloc)) = o;
            }
          continue;
        }
        if (d.kind == 3) {
#pragma unroll
          for (int i = 0; i < 2; i++)
#pragma unroll
            for (int r = 0; r < 16; r++) {
              const int tok = m0 + (wm * 2 + i) * 32 + (r & 3) + 8 * (r >> 2) + 4 * fh;
              const float v = acc[i][j][r];
              if (c < 24) p.gates[(size_t)tok * 24 + c] = 1.f / (1.f + __expf(-v));
              else p.widx[(size_t)tok * 8 + (c - 24)] = v * 0.0625f;
            }
          continue;
        }
#pragma unroll
        for (int i = 0; i < 2; i++) {
#pragma unroll
          for (int r = 0; r < 16; r++) {
            const int tok = m0 + (wm * 2 + i) * 32 + (r & 3) + 8 * (r >> 2) + 4 * fh;
            float v = acc[i][j][r];
            if (d.kind == 1) {
              const float pv = __shfl_xor(v, 8);
              if (c < 16) {
                const float2 cs = p.cs[(size_t)tok * 8 + (c & 7)];
                v = (c & 8) ? (v * cs.x + pv * cs.y) : (v * cs.x - pv * cs.y);
              }
            } else if (d.kind == 2) {
              const float pv = __shfl_xor(v, 4);
              if (c < 8) {
                const float2 cs = p.cs[(size_t)tok * 8 + 2 * (c & 3)];
                v = (c & 4) ? (v * cs.x + pv * cs.y) : (v * cs.x - pv * cs.y);
              }
            }
            acc[i][j][r] = v;
          }
#pragma unroll
          for (int r = 0; r < 16; r += 2) {
            const float va = acc[i][j][r], vb = acc[i][j][r + 1];
            const float na = __builtin_bit_cast(float, __builtin_amdgcn_update_dpp(0, __builtin_bit_cast(int, va), 0xB1, 0xF, 0xF, true));
            const float nb = __builtin_bit_cast(float, __builtin_amdgcn_update_dpp(0, __builtin_bit_cast(int, vb), 0xB1, 0xF, 0xF, true));
            const bool odd = c & 1;
            const unsigned pk = pack2bf(odd ? nb : va, odd ? vb : na);
            const int row = i * 32 + (r & 3) + 8 * (r >> 2) + 4 * fh + (odd ? 1 : 0);
            *(unsigned*)(wt + row * 144 + j * 64 + (c & ~1) * 2) = pk;
          }
        }
      }
      __builtin_amdgcn_wave_barrier();
      {
        const int chunk = lane & 7, jt = chunk >> 2;
        const TileDest d = jt ? d1 : d0;
        if (d.kind <= 2) {
#pragma unroll
          for (int it = 0; it < 8; it++) {
            const int row = it * 8 + (lane >> 3);
            const uint4 v = *(const uint4*)(wt + row * 144 + chunk * 16);
            const int tok = m0 + wm * 64 + row;
            *(uint4*)(d.ptr + (size_t)tok * d.stride + (chunk & 3) * 8) = v;
          }
        }
      }
      __syncthreads();
    }
  }
}

__device__ __forceinline__ void memkv_phase(const Params& p, unsigned char* smem, int bid, int nblk) {
  typedef Gemm<2, 2> G;
  const int lane = threadIdx.x & 63, w = threadIdx.x >> 6, wm = w >> 1, wn = w & 1;
  const int c = lane & 31, fh = lane >> 5;
  constexpr int TN2 = 512 / 128, TM2 = NB * MEML / 128;
  for (int t2 = bid; t2 < TM2 * TN2; t2 += nblk) {
    f32x16 acc[2][2];
#pragma unroll
    for (int i = 0; i < 2; i++)
#pragma unroll
      for (int j = 0; j < 2; j++)
#pragma unroll
        for (int r = 0; r < 16; r++) acc[i][j][r] = 0.f;
    {
      const int m0 = (t2 / TN2) * 128, n0 = (t2 % TN2) * 128;
      const bf16_t* A = p.memb + (size_t)m0 * DM;
      const bf16_t* Bt = p.wmemt + (size_t)n0 * DM;
      G::mainloop(acc, [&](int r) { return A + (size_t)r * DM; }, [&](int r) { return Bt + (size_t)r * DM; }, DM, smem);
#pragma unroll
      for (int i = 0; i < 2; i++)
#pragma unroll
        for (int j = 0; j < 2; j++)
          {
            const int cb = n0 + (wn * 2 + j) * 32;
            if (cb < 256) {
#pragma unroll
              for (int r = 0; r < 16; r++) {
                const int row = m0 + (wm * 2 + i) * 32 + (r & 3) + 8 * (r >> 2) + 4 * fh;
                p.mkv[(size_t)row * 512 + cb + c] = f2bf(acc[i][j][r]);
              }
            } else {
              const int dfull = cb + c - 256, head = dfull >> 6, d = dfull & 63;
              const int rowb = m0 + (wm * 2 + i) * 32, b = rowb >> 8, ml = rowb & 255;
              bf16_t* vrow = p.memvt + ((size_t)(b * 4 + head) * 64 + d) * MEML;
#pragma unroll
              for (int g4 = 0; g4 < 4; g4++) {
                uint2 o = {pack2bf(acc[i][j][4 * g4 + 0], acc[i][j][4 * g4 + 1]), pack2bf(acc[i][j][4 * g4 + 2], acc[i][j][4 * g4 + 3])};
                *(uint2*)(vrow + perm16(ml + 8 * g4 + 4 * fh)) = o;
              }
            }
          }
    }
  }
}

__device__ __forceinline__ unsigned f2key(float f) {
  unsigned u = __float_as_uint(f);
  return (u & 0x80000000u) ? ~u : (u | 0x80000000u);
}
__device__ __forceinline__ float key2f(unsigned k) {
  return __uint_as_float((k & 0x80000000u) ? (k ^ 0x80000000u) : ~k);
}
#define CE_DESC(a, b) { const unsigned _h = max(a, b); const unsigned _l = min(a, b); a = _h; b = _l; }
__device__ __forceinline__ void bitonic_merge16(unsigned (&m)[16]) {
#pragma unroll
  for (int st = 8; st >= 1; st >>= 1)
#pragma unroll
    for (int k = 0; k < 16; k++)
      if ((k & st) == 0) CE_DESC(m[k], m[k + st]);
}
__device__ __forceinline__ void sort16_desc(unsigned (&m)[16]) {
#pragma unroll
  for (int k = 2; k <= 16; k <<= 1)
#pragma unroll
    for (int j = k >> 1; j >= 1; j >>= 1)
#pragma unroll
      for (int i = 0; i < 16; i++) {
        const int l = i ^ j;
        if (l > i) {
          if ((i & k) == 0) { CE_DESC(m[i], m[l]); }
          else { const unsigned _h = max(m[i], m[l]); const unsigned _l = min(m[i], m[l]); m[i] = _l; m[l] = _h; }
        }
      }
}
__device__ __forceinline__ void insert16(unsigned (&L)[16], unsigned x) {
#pragma unroll
  for (int k = 0; k < 16; k++) { const unsigned hi = max(L[k], x); x = min(L[k], x); L[k] = hi; }
}
__device__ __forceinline__ void merge4_lists(unsigned (&L)[16], unsigned* lists, int t, int q) {
#pragma unroll
  for (int k = 0; k < 16; k++) lists[(q * 16 + k) * 64 + t] = L[k];
  __syncthreads();
  if (q < 2) {
#pragma unroll
    for (int k = 0; k < 16; k++) L[k] = max(lists[((2 * q) * 16 + k) * 64 + t], lists[((2 * q + 1) * 16 + 15 - k) * 64 + t]);
    bitonic_merge16(L);
#pragma unroll
    for (int k = 0; k < 16; k++) lists[((2 * q) * 16 + k) * 64 + t] = L[k];
  }
  __syncthreads();
  if (q == 0) {
#pragma unroll
    for (int k = 0; k < 16; k++) L[k] = max(L[k], lists[(2 * 16 + 15 - k) * 64 + t]);
    bitonic_merge16(L);
  }
}
__device__ __forceinline__ float dpp_rowsum(float x) {
  x += __builtin_bit_cast(float, __builtin_amdgcn_update_dpp(0, __builtin_bit_cast(int, x), 0xB1, 0xF, 0xF, true));
  x += __builtin_bit_cast(float, __builtin_amdgcn_update_dpp(0, __builtin_bit_cast(int, x), 0x4E, 0xF, 0xF, true));
  x += __builtin_bit_cast(float, __builtin_amdgcn_update_dpp(0, __builtin_bit_cast(int, x), 0x141, 0xF, 0xF, true));
  x += __builtin_bit_cast(float, __builtin_amdgcn_update_dpp(0, __builtin_bit_cast(int, x), 0x140, 0xF, 0xF, true));
  return x;
}
__device__ __forceinline__ float readlane_f(float v, int l) {
  return __int_as_float(__builtin_amdgcn_readlane(__float_as_int(v), l));
}
__device__ __forceinline__ float wave_sum_uniform(float x) {
  x = dpp_rowsum(x);
  return (readlane_f(x, 0) + readlane_f(x, 16)) + (readlane_f(x, 32) + readlane_f(x, 48));
}
__device__ __forceinline__ float dot8_bf16(const uint4& a, const uint4& b, float acc) {
  acc = __builtin_amdgcn_fdot2_f32_bf16(__builtin_bit_cast(bf16x2, a.x), __builtin_bit_cast(bf16x2, b.x), acc, false);
  acc = __builtin_amdgcn_fdot2_f32_bf16(__builtin_bit_cast(bf16x2, a.y), __builtin_bit_cast(bf16x2, b.y), acc, false);
  acc = __builtin_amdgcn_fdot2_f32_bf16(__builtin_bit_cast(bf16x2, a.z), __builtin_bit_cast(bf16x2, b.z), acc, false);
  acc = __builtin_amdgcn_fdot2_f32_bf16(__builtin_bit_cast(bf16x2, a.w), __builtin_bit_cast(bf16x2, b.w), acc, false);
  return acc;
}
__device__ __forceinline__ void fma8_bf16(float (&y)[8], const uint4& v, float w) {
  y[0] = fmaf(w, __uint_as_float(v.x << 16), y[0]); y[1] = fmaf(w, __uint_as_float(v.x & 0xFFFF0000u), y[1]);
  y[2] = fmaf(w, __uint_as_float(v.y << 16), y[2]); y[3] = fmaf(w, __uint_as_float(v.y & 0xFFFF0000u), y[3]);
  y[4] = fmaf(w, __uint_as_float(v.z << 16), y[4]); y[5] = fmaf(w, __uint_as_float(v.z & 0xFFFF0000u), y[5]);
  y[6] = fmaf(w, __uint_as_float(v.w << 16), y[6]); y[7] = fmaf(w, __uint_as_float(v.w & 0xFFFF0000u), y[7]);
}
__device__ const unsigned char cand_tab[52] = {
  0x00,0x01,0x02,0x03,0x04,0x05,0x06,0x07,0x08,0x09,0x0A,0x0B,0x0C,0x0D,0x0E,0x0F,
  0x10,0x11,0x12,0x13,0x14,0x15,0x16,0x17,
  0x20,0x21,0x22,0x23,0x24,
  0x30,0x31,0x32,0x33,
  0x40,0x41,0x42,
  0x50,0x51, 0x60,0x61, 0x70,0x71,
  0x80,0x90,0xA0,0xB0,0xC0,0xD0,0xE0,0xF0, 0xF0,0xF0};

__device__ __forceinline__ f16x2 bytes01_h2(unsigned w) { return __builtin_bit_cast(f16x2, __builtin_amdgcn_perm(w, 0x64646464u, 0x00050004u)); }
__device__ __forceinline__ f16x2 bytes23_h2(unsigned w) { return __builtin_bit_cast(f16x2, __builtin_amdgcn_perm(w, 0x64646464u, 0x00070006u)); }
template <int CTRL>
__device__ __forceinline__ float dpp_get(float x) {
  return __builtin_bit_cast(float, __builtin_amdgcn_update_dpp(0, __builtin_bit_cast(int, x), CTRL, 0xF, 0xF, true));
}
__device__ __forceinline__ float reduce16x16(const float (&ps)[16]) {
  const int lane = threadIdx.x & 63;
  const bool b0 = lane & 1, b1 = lane & 2, b2 = lane & 4, b3 = lane & 8;
  float r1[8], r2[4], r3[2];
#pragma unroll
  for (int i = 0; i < 8; i++) {
    const float u = ps[2 * i] + dpp_get<0xB1>(ps[2 * i]), v = ps[2 * i + 1] + dpp_get<0xB1>(ps[2 * i + 1]);
    r1[i] = b0 ? v : u;
  }
#pragma unroll
  for (int i = 0; i < 4; i++) {
    const float u = r1[2 * i] + dpp_get<0x4E>(r1[2 * i]), v = r1[2 * i + 1] + dpp_get<0x4E>(r1[2 * i + 1]);
    r2[i] = b1 ? v : u;
  }
#pragma unroll
  for (int i = 0; i < 2; i++) {
    const float u = r2[2 * i] + dpp_get<0x104>(r2[2 * i]);
    const float v = r2[2 * i + 1] + dpp_get<0x114>(r2[2 * i + 1]);
    r3[i] = b2 ? v : u;
  }
  const float u = r3[0] + dpp_get<0x128>(r3[0]), v = r3[1] + dpp_get<0x128>(r3[1]);
  float r = b3 ? v : u;
  r += __int_as_float(__builtin_amdgcn_ds_swizzle(__float_as_int(r), 0x401F));
  r += __shfl_xor(r, 32);
  return r;
}
constexpr int PE_EXPERT_DEPTH = 8;

__device__ __forceinline__ void peer_block_phase(const Params& p, unsigned char* smem, int bid, int nblk) {
  const int tid = tid_opaque(), lane = tid & 63, w = tid >> 6, wm = w >> 1, wn = w & 1;
  const int c = lane & 31, fh = lane >> 5;
  float* S = (float*)smem;
  unsigned* lists = (unsigned*)(smem + 32768);
  unsigned* ablist = (unsigned*)(smem + 49152);
  int* fin_e = (int*)(smem + 57344);
  float* fin_g = (float*)(smem + 57344 + 4096);
  for (int blk = bid; blk < NT / 64; blk += nblk) {
    const int t0 = blk * 64;
#pragma unroll 1
    for (int nt = 0; nt < 8; nt++) {
      f32x16 acc[1][2];
#pragma unroll
      for (int j = 0; j < 2; j++)
#pragma unroll
        for (int r = 0; r < 16; r++) acc[0][j][r] = 0.f;
      const bf16_t* cbase = p.concat;
      asm volatile("" : "+s"(cbase));
      const bf16_t* A = cbase + (size_t)t0 * DM;
      const bf16_t* Bt = p.woutt + (size_t)nt * 128 * DM;
      Gemm<1, 2>::mainloop(acc, [&](int r) { return A + (size_t)r * DM; }, [&](int r) { return Bt + (size_t)r * DM; }, DM, smem, tid);
      {
        const int tq = tid_opaque(), lq = tq & 63, wq_ = tq >> 6;
        const unsigned ebase = (unsigned)(t0 + (wq_ >> 1) * 32 + 4 * (lq >> 5)) * DM + nt * 128 + (wq_ & 1) * 64 + (lq & 31);
#pragma unroll
        for (int j = 0; j < 2; j++) {
#pragma unroll
          for (int r = 0; r < 16; r++) {
            const unsigned idx = ebase + (unsigned)(((r & 3) + 8 * (r >> 2)) * DM + j * 32);
            p.out[idx] = acc[0][j][r] + ALPHA * p.x[idx];
          }
          asm volatile("" ::: "memory");
        }
      }
    }
    __syncthreads();
    bf16_t* x1bo = p.x1b; bf16_t* xbo = p.xb;
    asm volatile("" : "+s"(x1bo), "+s"(xbo));
    {
      float* rowb = p.out + (size_t)(t0 + w * 16) * DM + 8 * lane;
      float4 n0 = *(const float4*)(rowb), n1 = *(const float4*)(rowb + 4), n2 = *(const float4*)(rowb + 512), n3 = *(const float4*)(rowb + 516);
#pragma unroll 1
      for (int rr = 0; rr < 16; rr++) {
        const int tok = t0 + w * 16 + rr;
        float* row = p.out + (size_t)tok * DM;
        float v[16];
        v[0] = n0.x; v[1] = n0.y; v[2] = n0.z; v[3] = n0.w; v[4] = n1.x; v[5] = n1.y; v[6] = n1.z; v[7] = n1.w;
        v[8] = n2.x; v[9] = n2.y; v[10] = n2.z; v[11] = n2.w; v[12] = n3.x; v[13] = n3.y; v[14] = n3.z; v[15] = n3.w;
        {
          const float* nx = rowb + (size_t)min(rr + 1, 15) * DM;
          n0 = *(const float4*)(nx); n1 = *(const float4*)(nx + 4); n2 = *(const float4*)(nx + 512); n3 = *(const float4*)(nx + 516);
        }
        const float4 ga0 = *(const float4*)(p.ln1g + 8 * lane), ga1 = *(const float4*)(p.ln1g + 8 * lane + 4);
        const float4 ga2 = *(const float4*)(p.ln1g + 512 + 8 * lane), ga3 = *(const float4*)(p.ln1g + 512 + 8 * lane + 4);
        const float4 be0 = *(const float4*)(p.ln1b + 8 * lane), be1 = *(const float4*)(p.ln1b + 8 * lane + 4);
        const float4 be2 = *(const float4*)(p.ln1b + 512 + 8 * lane), be3 = *(const float4*)(p.ln1b + 512 + 8 * lane + 4);
        float s = 0.f;
#pragma unroll
        for (int i = 0; i < 16; i++) s += v[i];
        const float mu = wave_sum(s) * (1.f / DM);
        float qv = 0.f;
#pragma unroll
        for (int i = 0; i < 16; i++) { v[i] -= mu; qv += v[i] * v[i]; }
        const float rs = rsqrtf(wave_sum(qv) * (1.f / DM) + 1e-5f);
#pragma unroll
        for (int hf = 0; hf < 2; hf++) {
          const int e0 = hf * 512 + 8 * lane;
          const float4 g0 = hf ? ga2 : ga0, g1 = hf ? ga3 : ga1, b0 = hf ? be2 : be0, b1 = hf ? be3 : be1;
          float o[8];
          o[0] = v[hf * 8 + 0] * rs * g0.x + b0.x; o[1] = v[hf * 8 + 1] * rs * g0.y + b0.y;
          o[2] = v[hf * 8 + 2] * rs * g0.z + b0.z; o[3] = v[hf * 8 + 3] * rs * g0.w + b0.w;
          o[4] = v[hf * 8 + 4] * rs * g1.x + b1.x; o[5] = v[hf * 8 + 5] * rs * g1.y + b1.y;
          o[6] = v[hf * 8 + 6] * rs * g1.z + b1.z; o[7] = v[hf * 8 + 7] * rs * g1.w + b1.w;
          *(float4*)(row + e0) = make_float4(o[0], o[1], o[2], o[3]);
          *(float4*)(row + e0 + 4) = make_float4(o[4], o[5], o[6], o[7]);
          uint4 pk = {pack2bf(o[0], o[1]), pack2bf(o[2], o[3]), pack2bf(o[4], o[5]), pack2bf(o[6], o[7])};
          *(uint4*)(x1bo + (size_t)tok * DM + e0) = pk;
          const f16x2 h0 = {(_Float16)o[0], (_Float16)o[1]}, h1 = {(_Float16)o[2], (_Float16)o[3]};
          const f16x2 h2 = {(_Float16)o[4], (_Float16)o[5]}, h3 = {(_Float16)o[6], (_Float16)o[7]};
          uint4 ph = {__builtin_bit_cast(unsigned, h0), __builtin_bit_cast(unsigned, h1), __builtin_bit_cast(unsigned, h2), __builtin_bit_cast(unsigned, h3)};
          *(uint4*)(xbo + (size_t)tok * DM + e0) = ph;
        }
      }
    }
    __syncthreads();
    const int tid2 = tid_opaque();
    const int ts = tid2 & 63, qs = tid2 >> 6;
#pragma unroll 1
    for (int hh = 0; hh < 8; hh++) {
#pragma unroll 1
      for (int half = 0; half < 2; half++) {
        f32x16 acc[2][1];
#pragma unroll
        for (int i = 0; i < 2; i++)
#pragma unroll
          for (int r = 0; r < 16; r++) acc[i][0][r] = 0.f;
        const bf16_t* A = p.wqt + (size_t)(hh * 256 + half * 128) * DM;
        const bf16_t* xbase = p.x1b;
        asm volatile("" : "+s"(xbase));
        const bf16_t* Bt = xbase + (size_t)t0 * DM;
        Gemm<2, 1>::mainloop(acc, [&](int r) { return A + (size_t)r * DM; }, [&](int r) { return Bt + (size_t)r * DM; }, DM, smem, tid);
        const bf16_t* skp = half ? p.sk2p : p.sk1p;
        auto score_part = [&](const bool add) __attribute__((always_inline)) {
#pragma unroll
          for (int np = 0; np < 2; np++) {
            f32x16 sp[2];
#pragma unroll
            for (int nn = 0; nn < 2; nn++)
#pragma unroll
              for (int r = 0; r < 16; r++) sp[nn][r] = 0.f;
#pragma unroll
            for (int i = 0; i < 2; i++)
#pragma unroll
              for (int s2 = 0; s2 < 2; s2++) {
                uint4 qb = {pack2bf(acc[i][0][8 * s2 + 0], acc[i][0][8 * s2 + 1]), pack2bf(acc[i][0][8 * s2 + 2], acc[i][0][8 * s2 + 3]),
                            pack2bf(acc[i][0][8 * s2 + 4], acc[i][0][8 * s2 + 5]), pack2bf(acc[i][0][8 * s2 + 6], acc[i][0][8 * s2 + 7])};
                const bf16x8 qf = __builtin_bit_cast(bf16x8, qb);
#pragma unroll
                for (int nn = 0; nn < 2; nn++) {
                  const bf16x8 kf = *(const bf16x8*)(skp + (size_t)((np * 2 + nn) * 32 + c) * 128 + wm * 64 + i * 32 + s2 * 16 + fh * 8);
                  sp[nn] = __builtin_amdgcn_mfma_f32_32x32x16_bf16(kf, qf, sp[nn], 0, 0, 0);
                }
              }
#pragma unroll
            for (int nn = 0; nn < 2; nn++)
#pragma unroll
              for (int r = 0; r < 16; r++) {
                float* dst = S + ((np * 2 + nn) * 32 + (r & 3) + 8 * (r >> 2) + 4 * fh) * 64 + wn * 32 + c;
                if (add) *dst += sp[nn][r]; else *dst = sp[nn][r];
              }
            asm volatile("" ::: "memory");
          }
        };
        if (wm == 0) score_part(false);
        __syncthreads();
        if (wm == 1) score_part(true);
        __syncthreads();
        unsigned L[16], M2[16];
#pragma unroll
        for (int i = 0; i < 16; i++) {
          const int n0_ = qs * 32 + i, n1_ = n0_ + 16;
          L[i] = (f2key(S[n0_ * 64 + ts]) & ~127u) | (unsigned)n0_;
          M2[i] = (f2key(S[n1_ * 64 + ts]) & ~127u) | (unsigned)n1_;
        }
        sort16_desc(L); sort16_desc(M2);
#pragma unroll
        for (int k = 0; k < 16; k++) L[k] = max(L[k], M2[15 - k]);
        bitonic_merge16(L);
        merge4_lists(L, lists, ts, qs);
        if (qs == 0) {
#pragma unroll
          for (int k = 0; k < 16; k++) ablist[(half * 16 + k) * 64 + ts] = L[k];
        }
        __syncthreads();
      }
      {
        unsigned L[16];
#pragma unroll
        for (int k = 0; k < 16; k++) L[k] = 0u;
#pragma unroll 1
        for (int cc = qs; cc < 50; cc += 4) {
          const unsigned code = cand_tab[cc];
          const float sum = key2f(ablist[(code >> 4) * 64 + ts]) + key2f(ablist[(16 + (code & 15)) * 64 + ts]);
          insert16(L, (f2key(sum) & ~255u) | code);
        }
        merge4_lists(L, lists, ts, qs);
        if (qs == 0) {
          const float mx = key2f(L[0]);
          float e[16], sum = 0.f;
#pragma unroll
          for (int k = 0; k < 16; k++) { e[k] = __expf(key2f(L[k]) - mx); sum += e[k]; }
          const float inv = 1.f / sum;
#pragma unroll
          for (int k = 0; k < 16; k++) {
            const unsigned code = L[k] & 255u;
            const unsigned ia = ablist[(code >> 4) * 64 + ts] & 127u, ib = ablist[(16 + (code & 15)) * 64 + ts] & 127u;
            fin_e[ts * 16 + k] = (int)(ia * 128u + ib);
            fin_g[ts * 16 + k] = e[k] * inv;
          }
        }
        __syncthreads();
        {
          int tid_o = tid;
          asm volatile("" : "+v"(tid_o));
          const int tt = tid_o >> 2, k4 = (tid_o & 3) * 4;
          *(int4*)(p.pexp + (size_t)(t0 + tt) * 128 + hh * 16 + k4) = *(const int4*)(fin_e + tt * 16 + k4);
          *(float4*)(p.pgate + (size_t)(t0 + tt) * 128 + hh * 16 + k4) = *(const float4*)(fin_g + tt * 16 + k4);
        }
        __syncthreads();
      }
    }
  }
}
__device__ __forceinline__ void peer_e3_phase(const Params& p, int bid, int nblk) {
  int tid_o = threadIdx.x;
  asm volatile("" : "+v"(tid_o));
  const int lane = tid_o & 63, w = __builtin_amdgcn_readfirstlane(tid_o >> 6);
  for (int blk = bid; blk < NT / 64; blk += nblk) {
    const int t0 = blk * 64;
    {
      const int tokb = t0 + w * 16;
      int idc0 = p.pexp[(size_t)tokb * 128 + lane], idc1 = p.pexp[(size_t)tokb * 128 + 64 + lane];
      uint4 xq0 = *(const uint4*)(p.xb + (size_t)tokb * DM + 16 * lane), xq1 = *(const uint4*)(p.xb + (size_t)tokb * DM + 16 * lane + 8);
      uint4 bu[8];
#pragma unroll
      for (int d = 0; d < 8; d++) {
        const int id = __builtin_amdgcn_readlane(idc0, d);
        bu[d] = *(const uint4*)(p.puq + (size_t)id * DM + 16 * lane);
      }
#pragma unroll 1
      for (int rr = 0; rr < 16; rr++) {
        const int tok = tokb + rr, tokn = tokb + min(rr + 1, 15);
        const int idn0 = p.pexp[(size_t)tokn * 128 + lane];
        const uint4 xn0 = *(const uint4*)(p.xb + (size_t)tokn * DM + 16 * lane), xn1 = *(const uint4*)(p.xb + (size_t)tokn * DM + 16 * lane + 8);
        const float g0 = p.pgate[(size_t)tok * 128 + lane], g1 = p.pgate[(size_t)tok * 128 + 64 + lane];
        const float su0 = p.psu[idc0], su1 = p.psu[idc1], sv0 = p.psv[idc0], sv1 = p.psv[idc1];
        f16x2 xh[8];
        xh[0] = __builtin_bit_cast(f16x2, xq0.x); xh[1] = __builtin_bit_cast(f16x2, xq0.y); xh[2] = __builtin_bit_cast(f16x2, xq0.z); xh[3] = __builtin_bit_cast(f16x2, xq0.w);
        xh[4] = __builtin_bit_cast(f16x2, xq1.x); xh[5] = __builtin_bit_cast(f16x2, xq1.y); xh[6] = __builtin_bit_cast(f16x2, xq1.z); xh[7] = __builtin_bit_cast(f16x2, xq1.w);
        float xs = 0.f;
#pragma unroll
        for (int i = 0; i < 8; i++) xs += (float)xh[i][0] + (float)xh[i][1];
        const float xoff = 1152.f * wave_sum_uniform(xs);
        float a0 = 0.f, a1 = 0.f;
#pragma unroll 1
        for (int e0 = 0; e0 < 128; e0 += 16) {
          const int isrcA = (e0 + 8 < 64) ? idc0 : idc1;
          const int isrcB = (e0 + 16 < 64) ? idc0 : (e0 + 16 < 128) ? idc1 : idn0;
          float ps[16];
#pragma unroll
          for (int d = 0; d < 16; d++) {
            const unsigned qw[4] = {bu[d & 7].x, bu[d & 7].y, bu[d & 7].z, bu[d & 7].w};
            float s0 = 0.f, s1 = 0.f;
#pragma unroll
            for (int i = 0; i < 4; i++) {
              s0 = __builtin_amdgcn_fdot2(bytes01_h2(qw[i]), xh[2 * i], s0, false);
              s1 = __builtin_amdgcn_fdot2(bytes23_h2(qw[i]), xh[2 * i + 1], s1, false);
            }
            ps[d] = s0 + s1;
            const int id = __builtin_amdgcn_readlane((d < 8) ? isrcA : isrcB, (e0 + 8 + d) & 63);
            bu[d & 7] = *(const uint4*)(p.puq + (size_t)id * DM + 16 * lane);
          }
          const float r = reduce16x16(ps);
          const bool mine = (lane >> 4) == ((e0 >> 4) & 3);
          if (e0 < 64) a0 = mine ? r : a0; else a1 = mine ? r : a1;
        }
        a0 = (a0 - xoff) * su0;
        a1 = (a1 - xoff) * su1;
        p.pgate[(size_t)tok * 128 + lane] = g0 * gelu_exact(a0) * sv0;
        p.pgate[(size_t)tok * 128 + 64 + lane] = g1 * gelu_exact(a1) * sv1;
        idc0 = idn0; idc1 = p.pexp[(size_t)tokn * 128 + 64 + lane];
        xq0 = xn0; xq1 = xn1;
      }
      const int laneB = tid_opaque() & 63;
      idc0 = p.pexp[(size_t)tokb * 128 + laneB]; idc1 = p.pexp[(size_t)tokb * 128 + 64 + laneB];
      uint4 bv[8];
#pragma unroll
      for (int d = 0; d < 8; d++) {
        const int id = __builtin_amdgcn_readlane(idc0, d);
        bv[d] = *(const uint4*)(p.pvq + (size_t)id * DM + 16 * laneB);
      }
#pragma unroll 1
      for (int rr = 0; rr < 16; rr++) {
        const int tok = tokb + rr, tokn = tokb + min(rr + 1, 15);
        const int idn0 = p.pexp[(size_t)tokn * 128 + laneB];
        const float w0 = p.pgate[(size_t)tok * 128 + laneB], w1 = p.pgate[(size_t)tok * 128 + 64 + laneB];
        float* row = p.out + (size_t)tok * DM + 16 * laneB;
        const float coff = 1152.f * wave_sum_uniform(w0 + w1);
        float y[16];
#pragma unroll
        for (int i = 0; i < 16; i++) y[i] = 0.f;
#pragma unroll 1
        for (int e0 = 0; e0 < 128; e0 += 16) {
          const int isrcA = (e0 + 8 < 64) ? idc0 : idc1;
          const int isrcB = (e0 + 16 < 64) ? idc0 : (e0 + 16 < 128) ? idc1 : idn0;
          const float wsrc = (e0 < 64) ? w0 : w1;
#pragma unroll
          for (int d = 0; d < 16; d++) {
            const float wgt = readlane_f(wsrc, (e0 + d) & 63);
            const unsigned qw[4] = {bv[d & 7].x, bv[d & 7].y, bv[d & 7].z, bv[d & 7].w};
#pragma unroll
            for (int i = 0; i < 4; i++) {
              const f16x2 h01 = bytes01_h2(qw[i]), h23 = bytes23_h2(qw[i]);
              y[4 * i + 0] = fmaf(wgt, (float)h01[0], y[4 * i + 0]);
              y[4 * i + 1] = fmaf(wgt, (float)h01[1], y[4 * i + 1]);
              y[4 * i + 2] = fmaf(wgt, (float)h23[0], y[4 * i + 2]);
              y[4 * i + 3] = fmaf(wgt, (float)h23[1], y[4 * i + 3]);
            }
            const int id = __builtin_amdgcn_readlane((d < 8) ? isrcA : isrcB, (e0 + 8 + d) & 63);
            bv[d & 7] = *(const uint4*)(p.pvq + (size_t)id * DM + 16 * laneB);
          }
        }
        const float4 xr0 = *(const float4*)(row), xr1 = *(const float4*)(row + 4), xr2 = *(const float4*)(row + 8), xr3 = *(const float4*)(row + 12);
        float v[16];
        v[0] = ALPHA * xr0.x + (y[0] - coff); v[1] = ALPHA * xr0.y + (y[1] - coff); v[2] = ALPHA * xr0.z + (y[2] - coff); v[3] = ALPHA * xr0.w + (y[3] - coff);
        v[4] = ALPHA * xr1.x + (y[4] - coff); v[5] = ALPHA * xr1.y + (y[5] - coff); v[6] = ALPHA * xr1.z + (y[6] - coff); v[7] = ALPHA * xr1.w + (y[7] - coff);
        v[8] = ALPHA * xr2.x + (y[8] - coff); v[9] = ALPHA * xr2.y + (y[9] - coff); v[10] = ALPHA * xr2.z + (y[10] - coff); v[11] = ALPHA * xr2.w + (y[11] - coff);
        v[12] = ALPHA * xr3.x + (y[12] - coff); v[13] = ALPHA * xr3.y + (y[13] - coff); v[14] = ALPHA * xr3.z + (y[14] - coff); v[15] = ALPHA * xr3.w + (y[15] - coff);
        float sm = 0.f;
#pragma unroll
        for (int i = 0; i < 16; i++) sm += v[i];
        const float mu = wave_sum_uniform(sm) * (1.f / DM);
        float qv = 0.f;
#pragma unroll
        for (int i = 0; i < 16; i++) { v[i] -= mu; qv += v[i] * v[i]; }
        const float rs = rsqrtf(wave_sum_uniform(qv) * (1.f / DM) + 1e-5f);
#pragma unroll
        for (int i4 = 0; i4 < 4; i4++) {
          const float4 gg = *(const float4*)(p.ln2g + 16 * laneB + 4 * i4), bb = *(const float4*)(p.ln2b + 16 * laneB + 4 * i4);
          *(float4*)(row + 4 * i4) = make_float4(v[4 * i4 + 0] * rs * gg.x + bb.x, v[4 * i4 + 1] * rs * gg.y + bb.y,
                                                 v[4 * i4 + 2] * rs * gg.z + bb.z, v[4 * i4 + 3] * rs * gg.w + bb.w);
        }
        idc0 = idn0; idc1 = p.pexp[(size_t)tokn * 128 + 64 + laneB];
      }
    }
    __syncthreads();
  }
}

__device__ __forceinline__ void cbias_phase(const Params& p, int bid, int nblk) {
  const int which = threadIdx.x >> 7, j = threadIdx.x & 127;
  const float* w1 = which ? p.w1v : p.w1k;
  const float* pe = which ? p.pe_v : p.pe_k;
  for (int ch = bid; ch < 64; ch += nblk) {
    float a = 0.f;
#pragma unroll 8
    for (int r = ch * 32; r < ch * 32 + 32; r++) a = fmaf(pe[r], w1[(size_t)r * 128 + j], a);
    p.cbias[ch * 256 + which * 128 + j] = a;
  }
}
__device__ __forceinline__ void compress_phase(const Params& p, unsigned char* smem, int bid, int nblk) {
  typedef Gemm<1, 2> G;
  const int tid = threadIdx.x, lane = tid & 63, w = tid >> 6, wm = w >> 1, wn = w & 1, c = lane & 31, fh = lane >> 5;
  float* hid = (float*)smem;
  float* cb = (float*)(smem + 49152);
  if (bid < NB * 2 * 2 * 4) {
    float a = 0.f;
    for (int ch = 0; ch < 64; ch++) a += p.cbias[ch * 256 + tid];
    cb[tid] = a;
  }
  __syncthreads();
  for (int item = bid; item < NB * 2 * 2 * 4; item += nblk) {
    const int mt = item & 3, which = (item >> 2) & 1, bgi = item >> 3;
    const int m0 = mt * 64;
    const bf16_t* A = (which ? p.kvn[1] : p.kvn[0]) + (size_t)bgi * SEQ * 64;
    const bf16_t* Bt = which ? p.w1vt : p.w1kt;
    f32x16 acc[1][2];
#pragma unroll
    for (int j = 0; j < 2; j++)
#pragma unroll
      for (int r = 0; r < 16; r++) acc[0][j][r] = 0.f;
    G::mainloop(acc, [&](int r) { const int i = min(m0 + r, NC - 1); return A + (size_t)i * 1024; },
                [&](int r) { return Bt + (size_t)r * 2048; }, 2048, smem);
#pragma unroll
    for (int j = 0; j < 2; j++)
#pragma unroll
      for (int r = 0; r < 16; r++) {
        const int row = wm * 32 + (r & 3) + 8 * (r >> 2) + 4 * fh, col = (wn * 2 + j) * 32 + c;
        hid[row * 129 + col] = gelu_exact(acc[0][j][r] + cb[which * 128 + col]);
      }
    __syncthreads();
    {
      const int row = tid >> 2, dq = (tid & 3) * 16;
      const float* w2 = which ? p.w2v : p.w2k;
      float o[16];
#pragma unroll
      for (int i = 0; i < 16; i++) o[i] = 0.f;
      for (int k = 0; k < 128; k++) {
        const float h = hid[row * 129 + k];
        const float4 w0 = *(const float4*)(w2 + k * 64 + dq), w1_ = *(const float4*)(w2 + k * 64 + dq + 4);
        const float4 w2_ = *(const float4*)(w2 + k * 64 + dq + 8), w3 = *(const float4*)(w2 + k * 64 + dq + 12);
        o[0] = fmaf(h, w0.x, o[0]); o[1] = fmaf(h, w0.y, o[1]); o[2] = fmaf(h, w0.z, o[2]); o[3] = fmaf(h, w0.w, o[3]);
        o[4] = fmaf(h, w1_.x, o[4]); o[5] = fmaf(h, w1_.y, o[5]); o[6] = fmaf(h, w1_.z, o[6]); o[7] = fmaf(h, w1_.w, o[7]);
        o[8] = fmaf(h, w2_.x, o[8]); o[9] = fmaf(h, w2_.y, o[9]); o[10] = fmaf(h, w2_.z, o[10]); o[11] = fmaf(h, w2_.w, o[11]);
        o[12] = fmaf(h, w3.x, o[12]); o[13] = fmaf(h, w3.y, o[13]); o[14] = fmaf(h, w3.z, o[14]); o[15] = fmaf(h, w3.w, o[15]);
      }
      const int i = m0 + row;
      const bool valid = i < NC;
      if (which == 0) {
        bf16_t* dst = p.kcb + ((size_t)bgi * 256 + i) * 64 + dq;
        uint4 u0 = {pack2bf(o[0], o[1]), pack2bf(o[2], o[3]), pack2bf(o[4], o[5]), pack2bf(o[6], o[7])};
        uint4 u1 = {pack2bf(o[8], o[9]), pack2bf(o[10], o[11]), pack2bf(o[12], o[13]), pack2bf(o[14], o[15])};
        if (!valid) { u0 = make_uint4(0, 0, 0, 0); u1 = u0; }
        *(uint4*)dst = u0; *(uint4*)(dst + 8) = u1;
      } else {
#pragma unroll
        for (int e = 0; e < 16; e++) p.vct[((size_t)bgi * 64 + dq + e) * 256 + perm16(i)] = valid ? f2bf(o[e]) : (bf16_t)0;
      }
    }
    __syncthreads();
  }
}

__device__ __forceinline__ void softmax4(float* sc, int ld, int n) {
  const int w = threadIdx.x >> 6, lane = threadIdx.x & 63;
  float* s = sc + w * ld;
  float m = -INFINITY;
  for (int i = lane; i < n; i += 64) m = fmaxf(m, s[i]);
  m = wave_max(m);
  if (m == -INFINITY) m = 0.f;
  float sum = 0.f;
  for (int i = lane; i < n; i += 64) { float e = expf(s[i] - m); s[i] = e; sum += e; }
  sum = wave_sum(sum);
  const float inv = 1.f / (sum > 0.f ? sum : 1.f);
  for (int i = lane; i < n; i += 64) s[i] *= inv;
}
__device__ __forceinline__ float dot64_bf(const float* q, const bf16_t* k) {
  float s = 0.f;
#pragma unroll
  for (int e = 0; e < 64; e += 8) {
    const uint4 v = *(const uint4*)(k + e);
    const unsigned u[4] = {v.x, v.y, v.z, v.w};
#pragma unroll
    for (int i = 0; i < 4; i++) {
      s = fmaf(q[e + 2 * i], __uint_as_float(u[i] << 16), s);
      s = fmaf(q[e + 2 * i + 1], __uint_as_float(u[i] & 0xFFFF0000u), s);
    }
  }
  return s;
}

template <class KRow, class VRow, class Body>
__device__ __forceinline__ void flash_stream(unsigned char* smem, int j0, int j1, KRow krow, VRow vrow, Body body) {
  if (j0 >= j1) return;
  Tile2 rk = tile_fetch([&](int r) __attribute__((always_inline)) { return krow(j0, r); });
  Tile2 rv = tile_fetch([&](int r) __attribute__((always_inline)) { return vrow(j0, r); });
  __syncthreads();
  tile_store(rk, smem); tile_store(rv, smem + FL_TILE);
  __syncthreads();
#pragma unroll 1
  for (int j = j0; j < j1; j++) {
    unsigned char* cur = smem + ((j - j0) & 1) * FL_STAGE;
    if (j + 1 < j1) {
      rk = tile_fetch([&](int r) __attribute__((always_inline)) { return krow(j + 1, r); });
      rv = tile_fetch([&](int r) __attribute__((always_inline)) { return vrow(j + 1, r); });
    }
    body(cur, j);
    if (j + 1 < j1) { unsigned char* nxt = smem + ((j - j0 + 1) & 1) * FL_STAGE; tile_store(rk, nxt); tile_store(rv, nxt + FL_TILE); }
    __syncthreads();
  }
}
__device__ __forceinline__ float quad_sum(float x) {
  x += __builtin_bit_cast(float, __builtin_amdgcn_update_dpp(0, __builtin_bit_cast(int, x), 0xB1, 0xF, 0xF, true));
  x += __builtin_bit_cast(float, __builtin_amdgcn_update_dpp(0, __builtin_bit_cast(int, x), 0x4E, 0xF, 0xF, true));
  return x;
}
__device__ __forceinline__ void nsa_flash_item(const Params& p, unsigned char* smem, int item) {
  const int tid = threadIdx.x, lane = tid & 63, w = tid >> 6, fr = lane & 31, fh = lane >> 5;
  const int cc = item & 127, g = (item >> 7) & 1, b = item >> 8;
  const int c64 = cc >> 1;
  const int t0 = cc * 32;
  const int tl = 8 * w + (fr >> 2), hq = fr & 3;
  const int t = t0 + tl, tok = b * SEQ + t;
  const int t64 = t & 63;
  float* impS = (float*)smem;
  unsigned* selm = (unsigned*)(smem + 32 * 65 * 4);
  float* stash = (float*)(smem + 2 * FL_STAGE) + w * 2048 + lane;
  bf16x8 qf[4];
  flash_load_q(qf, p.qn + (size_t)tok * 512 + g * 256 + hq * 64, 0.125f);
  const float* gt = p.gates + (size_t)tok * 24 + (g * 4 + hq) * 3;
  const float g_cmp = gt[0], g_sel = gt[1], g_win = gt[2];
  const size_t bg = (size_t)(b * 2 + g);
  {
    const int nvmax = 2 * cc + 1, nkb = (nvmax + 63) >> 6;
    const int nvl = (t >= 31) ? ((t - 31) >> 4) + 1 : 0;
    const bf16_t* kcb = p.kcb + bg * 256 * 64;
    const bf16_t* vct = p.vct + bg * 64 * 256;
    auto krow = [&](int j, int r) __attribute__((always_inline)) { return kcb + (size_t)(j * 64 + r) * 64; };
    auto vrow = [&](int j, int r) __attribute__((always_inline)) { return vct + (size_t)r * 256 + j * 64; };
    float m = -INFINITY, l = 0.f;
    flash_stream(smem, 0, nkb, krow, vrow, [&](unsigned char* cur, int j) __attribute__((always_inline)) {
      f32x16 s[2];
      flash_qk(s, cur, qf);
      float mx = -INFINITY;
#pragma unroll
      for (int kt = 0; kt < 2; kt++)
#pragma unroll
        for (int r = 0; r < 16; r++) {
          const int n = j * 64 + kt * 32 + (r & 3) + 8 * (r >> 2) + 4 * fh;
          s[kt][r] = (n < nvl) ? s[kt][r] : -INFINITY;
          mx = fmaxf(mx, s[kt][r]);
        }
      mx = fmaxf(mx, __shfl_xor(mx, 32));
      const float mnew = fmaxf(m, mx);
      const float muse = (mnew == -INFINITY) ? 0.f : mnew;
      float sum = 0.f;
#pragma unroll
      for (int kt = 0; kt < 2; kt++)
#pragma unroll
        for (int r = 0; r < 16; r++) sum += __builtin_amdgcn_exp2f((s[kt][r] - muse) * LOG2E);
      l = l * __builtin_amdgcn_exp2f((m - muse) * LOG2E) + sum;
      m = mnew;
    });
    const float lt = l + __shfl_xor(l, 32);
    const float il = lt > 0.f ? 1.f / lt : 0.f;
    const float muse = (m == -INFINITY) ? 0.f : m;
    {
      f32x16 oc[2];
#pragma unroll
      for (int i = 0; i < 2; i++)
#pragma unroll
        for (int r = 0; r < 16; r++) oc[i][r] = 0.f;
      flash_stream(smem, 0, nkb, krow, vrow, [&](unsigned char* cur, int j) __attribute__((always_inline)) {
        f32x16 s[2];
        flash_qk(s, cur, qf);
#pragma unroll
        for (int kt = 0; kt < 2; kt++)
#pragma unroll
          for (int r = 0; r < 16; r++) {
            const int n = j * 64 + kt * 32 + (r & 3) + 8 * (r >> 2) + 4 * fh;
            s[kt][r] = (n < nvl) ? __builtin_amdgcn_exp2f((s[kt][r] - muse) * LOG2E) * il : 0.f;
          }
#pragma unroll
        for (int kt = 0; kt < 2; kt++)
#pragma unroll
          for (int h8 = 0; h8 < 2; h8++) {
            const bf16x8 pf = pack_frag(s[kt], h8);
#pragma unroll
            for (int dt = 0; dt < 2; dt++)
              oc[dt] = __builtin_amdgcn_mfma_f32_32x32x16_bf16(lds_frag(cur + FL_TILE, dt * 32 + fr, 4 * kt + 2 * h8 + fh), pf, oc[dt], 0, 0, 0);
          }
      });
#pragma unroll
      for (int dt = 0; dt < 2; dt++)
#pragma unroll
        for (int r = 0; r < 16; r++) stash[(dt * 16 + r) * 64] = g_cmp * oc[dt][r];
    }
    f32x16 imp[2];
#pragma unroll
    for (int i = 0; i < 2; i++)
#pragma unroll
      for (int r = 0; r < 16; r++) imp[i][r] = 0.f;
    flash_stream(smem, 0, nkb, krow, vrow, [&](unsigned char* cur, int j) __attribute__((always_inline)) {
      f32x16 s[2];
      flash_qk(s, cur, qf);
#pragma unroll
      for (int kt = 0; kt < 2; kt++)
#pragma unroll
        for (int r = 0; r < 16; r++) {
          const int n = j * 64 + kt * 32 + (r & 3) + 8 * (r >> 2) + 4 * fh;
          s[kt][r] = (n < nvl) ? __builtin_amdgcn_exp2f((s[kt][r] - muse) * LOG2E) * il : 0.f;
        }
#pragma unroll
      for (int kt = 0; kt < 2; kt++)
#pragma unroll
        for (int h8 = 0; h8 < 2; h8++) {
          const bf16x8 pf = pack_frag(s[kt], h8);
#pragma unroll
          for (int mt = 0; mt < 2; mt++) {
            const bf16x8 of = *(const bf16x8*)(p.ovp + (size_t)(mt * 32 + fr) * 256 + j * 64 + kt * 32 + h8 * 16 + fh * 8);
            imp[mt] = __builtin_amdgcn_mfma_f32_32x32x16_bf16(of, pf, imp[mt], 0, 0, 0);
          }
        }
    });
#pragma unroll
    for (int mt = 0; mt < 2; mt++)
#pragma unroll
      for (int r = 0; r < 16; r++) imp[mt][r] = quad_sum(imp[mt][r]);
#pragma unroll
    for (int mt = 0; mt < 2; mt++)
#pragma unroll
      for (int g4 = 0; g4 < 4; g4++) {
        const float v = (hq == 0) ? imp[mt][4 * g4 + 0] : (hq == 1) ? imp[mt][4 * g4 + 1] : (hq == 2) ? imp[mt][4 * g4 + 2] : imp[mt][4 * g4 + 3];
        impS[tl * 65 + mt * 32 + hq + 8 * g4 + 4 * fh] = v;
      }
    __syncthreads();
    {
      const int tk = tid >> 3, part = tid & 7;
      const float* row = impS + tk * 65;
      float S2[64];
#pragma unroll
      for (int m2 = 0; m2 < 64; m2++) {
        const bool vis2 = m2 <= c64;
        const bool f2 = (m2 == 0) || (m2 == c64) || (m2 == c64 - 1);
        S2[m2] = vis2 ? row[m2] + (f2 ? 1e4f : 0.f) : -INFINITY;
      }
      unsigned bits = 0;
#pragma unroll
      for (int i = 0; i < 8; i++) {
        const int mb = part * 8 + i;
        const bool vis = mb <= c64;
        const bool forced = (mb == 0) || (mb == c64) || (mb == c64 - 1);
        const float sm = vis ? row[mb] + (forced ? 1e4f : 0.f) : -INFINITY;
        int rank = 0;
#pragma unroll
        for (int m2 = 0; m2 < 64; m2++) {
          const int pb = m2 >> 3;
          const bool lower = ((m2 & 7) < i) ? (pb <= part) : (pb < part);
          rank += ((S2[m2] > sm) || (S2[m2] == sm && lower)) ? 1 : 0;
        }
        if (rank < 16 && vis) bits |= 1u << i;
      }
      unsigned lo = (part < 4) ? (bits << (8 * part)) : 0u, hi = (part >= 4) ? (bits << (8 * (part - 4))) : 0u;
      lo |= __shfl_xor(lo, 1); hi |= __shfl_xor(hi, 1);
      lo |= __shfl_xor(lo, 2); hi |= __shfl_xor(hi, 2);
      lo |= __shfl_xor(lo, 4); hi |= __shfl_xor(hi, 4);
      if (part == 0) { selm[tk * 2] = lo; selm[tk * 2 + 1] = hi; }
    }
    __syncthreads();
  }
  const unsigned sel_lo = selm[tl * 2], sel_hi = selm[tl * 2 + 1];
  {
    const bf16_t* kb_ = p.kvn[2] + bg * SEQ * 64;
    const bf16_t* vt_ = p.vslct + bg * 64 * SEQ;
    FlashAcc acc; flash_init(acc);
    flash_stream(smem, 0, c64 + 1,
      [&](int j, int r) __attribute__((always_inline)) { return kb_ + (size_t)(j * 64 + r) * 64; },
      [&](int j, int r) __attribute__((always_inline)) { return vt_ + (size_t)r * SEQ + j * 64; },
      [&](unsigned char* cur, int j) __attribute__((always_inline)) {
        f32x16 s[2];
        flash_qk(s, cur, qf);
        const bool selj = ((j < 32) ? (sel_lo >> j) : (sel_hi >> (j - 32))) & 1u;
        if (j == c64) {
#pragma unroll
          for (int kt = 0; kt < 2; kt++)
#pragma unroll
            for (int r = 0; r < 16; r++) {
              const int kl = kt * 32 + (r & 3) + 8 * (r >> 2) + 4 * fh;
              s[kt][r] = (kl <= t64) ? s[kt][r] : -INFINITY;
            }
        }
        flash_update(acc, s, cur + FL_TILE, selj);
      });
    const float sc_ = g_sel * flash_inv_l(acc);
#pragma unroll
    for (int dt = 0; dt < 2; dt++)
#pragma unroll
      for (int r = 0; r < 16; r++) stash[(dt * 16 + r) * 64] += sc_ * acc.o[dt][r];
  }
  {
    const bf16_t* kb_ = p.kvn[4] + bg * SEQ * 64;
    const bf16_t* vt_ = p.vwint + bg * 64 * SEQ;
    FlashAcc acc; flash_init(acc);
    const int jlo = c64 - 8;
    flash_stream(smem, jlo < 0 ? 0 : jlo, c64 + 1,
      [&](int j, int r) __attribute__((always_inline)) { return kb_ + (size_t)(j * 64 + r) * 64; },
      [&](int j, int r) __attribute__((always_inline)) { return vt_ + (size_t)r * SEQ + j * 64; },
      [&](unsigned char* cur, int j) __attribute__((always_inline)) {
        f32x16 s[2];
        flash_qk(s, cur, qf);
        if (j == c64) {
#pragma unroll
          for (int kt = 0; kt < 2; kt++)
#pragma unroll
            for (int r = 0; r < 16; r++) {
              const int kl = kt * 32 + (r & 3) + 8 * (r >> 2) + 4 * fh;
              s[kt][r] = (kl <= t64) ? s[kt][r] : -INFINITY;
            }
        } else if (j == jlo) {
#pragma unroll
          for (int kt = 0; kt < 2; kt++)
#pragma unroll
            for (int r = 0; r < 16; r++) {
              const int kl = kt * 32 + (r & 3) + 8 * (r >> 2) + 4 * fh;
              s[kt][r] = (kl > t64) ? s[kt][r] : -INFINITY;
            }
        }
        flash_update(acc, s, cur + FL_TILE);
      });
    const float sc_ = g_win * flash_inv_l(acc);
    bf16_t* orow = p.concat + (size_t)tok * DM + g * 256 + hq * 64;
#pragma unroll
    for (int dt = 0; dt < 2; dt++)
#pragma unroll
      for (int g4 = 0; g4 < 4; g4++) {
        float o4[4];
#pragma unroll
        for (int i = 0; i < 4; i++) o4[i] = stash[(dt * 16 + 4 * g4 + i) * 64] + sc_ * acc.o[dt][4 * g4 + i];
        uint2 o = {pack2bf(o4[0], o4[1]), pack2bf(o4[2], o4[3])};
        *(uint2*)(orow + dt * 32 + 8 * g4 + 4 * fh) = o;
      }
  }
}
__device__ __forceinline__ void nsa_phase(const Params& p, unsigned char* smem, int bid, int nblk) {
  for (int it = bid; it < NB * 2 * 128; it += nblk) {
    const int cc = 127 - (it >> 4), bgi = it & 15;
    nsa_flash_item(p, smem, (bgi << 7) | cc);
  }
}

typedef __attribute__((ext_vector_type(4))) float f32x4v;
typedef __attribute__((ext_vector_type(4))) short s16x4;
__device__ __forceinline__ float wave_max_uniform(float x) {
  x = fmaxf(x, __builtin_bit_cast(float, __builtin_amdgcn_update_dpp(0, __builtin_bit_cast(int, x), 0xB1, 0xF, 0xF, true)));
  x = fmaxf(x, __builtin_bit_cast(float, __builtin_amdgcn_update_dpp(0, __builtin_bit_cast(int, x), 0x4E, 0xF, 0xF, true)));
  x = fmaxf(x, __builtin_bit_cast(float, __builtin_amdgcn_update_dpp(0, __builtin_bit_cast(int, x), 0x141, 0xF, 0xF, true)));
  x = fmaxf(x, __builtin_bit_cast(float, __builtin_amdgcn_update_dpp(0, __builtin_bit_cast(int, x), 0x140, 0xF, 0xF, true)));
  return fmaxf(fmaxf(readlane_f(x, 0), readlane_f(x, 16)), fmaxf(readlane_f(x, 32), readlane_f(x, 48)));
}
__device__ __forceinline__ int dsa_vswz(int row) { return ((row >> 1) & 1) | ((row >> 2) & 2); }
__device__ __forceinline__ void dsa_item(const Params& p, unsigned char* smem, int b, int tg) {
  unsigned* keys = (unsigned*)smem;
  unsigned char* vst = smem;
  int* hist = (int*)(smem + 32768);
  int* sel = hist + 3584;
  int* cnt = sel + 512;
  float* sc = (float*)(cnt + 16);
  float* part = sc + 2048;
  const int tid = tid_opaque(), lane = tid & 63, w = __builtin_amdgcn_readfirstlane(tid >> 6);
  const int row16 = lane & 15, kg = lane >> 4;
  const int t0 = 2 * tg;
  const size_t tokb = (size_t)b * SEQ;
  const bf16_t* kib = p.ki + tokb * 32;
  const bf16_t* kdb = p.kd + tokb * 64;
  const bf16_t* vdb = p.vd + tokb * 64;
  const int n = t0 + 2;
  if (n > 256) {
#pragma unroll
    for (int i = 0; i < 14; i++) hist[tid + 256 * i] = 0;
    {
      const bf16x8 af = *(const bf16x8*)(p.qi + (tokb + t0 + (row16 >> 3)) * 256 + (row16 & 7) * 32 + kg * 8);
      const int tk = lane >> 5;
      const float4 wv = *(const float4*)(p.widx + (tokb + t0 + tk) * 8 + 4 * (kg & 1));
      const int ntile = (n + 15) >> 4;
      struct B4 { bf16x8 a, b, c, d; };
      const int lofs = (row16 * 32 + kg * 8) * 2;
      const __amdgpu_buffer_rsrc_t krs = __builtin_amdgcn_make_buffer_rsrc((void*)kib, (short)0, SEQ * 64, 0x00020000);
      typedef unsigned int u32x4_t __attribute__((__vector_size__(16)));
      auto ld4 = [&](int kt) __attribute__((always_inline)) {
        B4 r;
        r.a = __builtin_bit_cast(bf16x8, (u32x4_t)__builtin_amdgcn_raw_buffer_load_b128(krs, lofs, min(kt + 0, ntile - 1) * 1024, 0));
        r.b = __builtin_bit_cast(bf16x8, (u32x4_t)__builtin_amdgcn_raw_buffer_load_b128(krs, lofs, min(kt + 1, ntile - 1) * 1024, 0));
        r.c = __builtin_bit_cast(bf16x8, (u32x4_t)__builtin_amdgcn_raw_buffer_load_b128(krs, lofs, min(kt + 2, ntile - 1) * 1024, 0));
        r.d = __builtin_bit_cast(bf16x8, (u32x4_t)__builtin_amdgcn_raw_buffer_load_b128(krs, lofs, min(kt + 3, ntile - 1) * 1024, 0));
        return r;
      };
      auto score4 = [&](const B4& cb, int kt0) __attribute__((always_inline)) {
        float sv[4];
#pragma unroll
        for (int u = 0; u < 4; u++) {
          f32x4v acc = {0.f, 0.f, 0.f, 0.f};
          acc = __builtin_amdgcn_mfma_f32_16x16x32_bf16(af, (u == 0) ? cb.a : (u == 1) ? cb.b : (u == 2) ? cb.c : cb.d, acc, 0, 0, 0);
          sv[u] = wv.x * __builtin_elementwise_maximum(acc[0], 0.f) + wv.y * __builtin_elementwise_maximum(acc[1], 0.f)
                + wv.z * __builtin_elementwise_maximum(acc[2], 0.f) + wv.w * __builtin_elementwise_maximum(acc[3], 0.f);
        }
#pragma unroll
        for (int u = 0; u < 4; u++) {
          const auto sw = __builtin_amdgcn_permlane16_swap(__float_as_uint(sv[u]), __float_as_uint(sv[u]), false, false);
          sv[u] = __uint_as_float(sw[0]) + __uint_as_float(sw[1]);
        }
        if ((kg & 1) == 0) {
#pragma unroll
          for (int u = 0; u < 4; u++) {
            const int key = (kt0 + u) * 16 + row16;
            if (kt0 + u < ntile) {
              const unsigned kv_ = (key <= t0 + tk) ? f2key(sv[u]) : 0u;
              keys[tk * 4096 + key] = kv_;
              atomicAdd(&hist[1536 + tk * 1024 + (lane & 3) * 256 + (kv_ >> 24)], 1);
            }
          }
        }
      };
      B4 c0 = ld4(w * 4), c1 = ld4(w * 4 + 16), c2;
      int kt0 = w * 4;
#pragma unroll 1
      for (;;) {
        if (kt0 >= ntile) break;
        c2 = ld4(kt0 + 32); score4(c0, kt0); kt0 += 16;
        if (kt0 >= ntile) break;
        c0 = ld4(kt0 + 32); score4(c1, kt0); kt0 += 16;
        if (kt0 >= ntile) break;
        c1 = ld4(kt0 + 32); score4(c2, kt0); kt0 += 16;
      }
    }
    __syncthreads();
    const int tk = w >> 1, hf = w & 1;
    const int npad = ((n + 15) >> 4) << 4, nh = npad >> 1;
    const unsigned* kt_ = keys + tk * 4096;
    const int i0 = hf * nh, i1 = i0 + nh;
    unsigned prefix = 0; int kk = 256;
#pragma unroll 1
    for (int pass = 0; pass < 4; pass++) {
      const int shift = 24 - 8 * pass;
      int* hp = (pass == 0) ? hist + 1536 + tk * 1024 : hist + (pass - 1) * 512 + tk * 256;
      int* hpa = (pass == 0) ? hp + (lane & 3) * 256 : hp;
      const unsigned hmask = (shift == 24) ? 0u : (0xFFFFFFFFu << (shift + 8));
      if (pass > 0)
#pragma unroll 2
      for (int base = i0 + 4 * lane; base < i1; base += 256) {
        const uint4 k4 = *(const uint4*)(kt_ + base);
        if ((k4.x & hmask) == prefix) atomicAdd(&hpa[(k4.x >> shift) & 255], 1);
        if ((k4.y & hmask) == prefix) atomicAdd(&hpa[(k4.y >> shift) & 255], 1);
        if ((k4.z & hmask) == prefix) atomicAdd(&hpa[(k4.z >> shift) & 255], 1);
        if ((k4.w & hmask) == prefix) atomicAdd(&hpa[(k4.w >> shift) & 255], 1);
      }
      __syncthreads();
      {
        int4 c4 = *(const int4*)(hp + lane * 4);
        if (pass == 0) {
#pragma unroll
          for (int cp = 1; cp < 4; cp++) {
            const int4 d4 = *(const int4*)(hp + cp * 256 + lane * 4);
            c4.x += d4.x; c4.y += d4.y; c4.z += d4.z; c4.w += d4.w;
          }
        }
        const int tl_ = c4.x + c4.y + c4.z + c4.w;
        int P = tl_;
        P += __builtin_amdgcn_update_dpp(0, P, 0x111, 0xF, 0xF, false);
        P += __builtin_amdgcn_update_dpp(0, P, 0x112, 0xF, 0xF, false);
        P += __builtin_amdgcn_update_dpp(0, P, 0x114, 0xF, 0xF, false);
        P += __builtin_amdgcn_update_dpp(0, P, 0x118, 0xF, 0xF, false);
        P += __builtin_amdgcn_update_dpp(0, P, 0x142, 0xA, 0xF, false);
        P += __builtin_amdgcn_update_dpp(0, P, 0x143, 0xC, 0xF, false);
        const int total = __builtin_amdgcn_readlane(P, 63);
        const int R = total - P + tl_;
        const int a3 = R - tl_, a2 = a3 + c4.w, a1 = a2 + c4.z, a0 = a1 + c4.y;
        const bool found = (a3 < kk) && (kk <= R);
        int dloc, above;
        if (kk <= a2) { dloc = 3; above = a3; } else if (kk <= a1) { dloc = 2; above = a2; } else if (kk <= a0) { dloc = 1; above = a1; } else { dloc = 0; above = a0; }
        const unsigned long long bm = __ballot(found);
        const int src = __ffsll((long long)bm) - 1;
        const int dsel = __builtin_amdgcn_readlane(lane * 4 + dloc, src);
        const int abv = __builtin_amdgcn_readlane(above, src);
        prefix |= ((unsigned)dsel) << shift;
        kk -= abv;
      }
    }
    {
      int cg_ = 0, ce = 0;
#pragma unroll 2
      for (int base = i0 + 4 * lane; base < i1; base += 256) {
        const uint4 k4 = *(const uint4*)(kt_ + base);
        cg_ += (k4.x > prefix) + (k4.y > prefix) + (k4.z > prefix) + (k4.w > prefix);
        ce += (k4.x == prefix) + (k4.y == prefix) + (k4.z == prefix) + (k4.w == prefix);
      }
      cg_ = (int)wave_sum_uniform((float)cg_); ce = (int)wave_sum_uniform((float)ce);
      if (lane == 0) { cnt[(tk * 2 + hf) * 2] = cg_; cnt[(tk * 2 + hf) * 2 + 1] = ce; }
    }
    __syncthreads();
    {
      int bgt = hf ? cnt[(tk * 2) * 2] : 0, beq = hf ? cnt[(tk * 2) * 2 + 1] : 0;
      const int ngt = 256 - kk;
      const unsigned long long lt = (1ull << lane) - 1ull;
#pragma unroll 1
      for (int base = i0 + 4 * lane; base < i1; base += 256) {
        const uint4 k4 = *(const uint4*)(kt_ + base);
        const unsigned kq[4] = {k4.x, k4.y, k4.z, k4.w};
        unsigned long long mg[4], me[4];
#pragma unroll
        for (int j = 0; j < 4; j++) { mg[j] = __ballot(kq[j] > prefix); me[j] = __ballot(kq[j] == prefix); }
        int pg = bgt + __popcll(mg[0] & lt) + __popcll(mg[1] & lt) + __popcll(mg[2] & lt) + __popcll(mg[3] & lt);
        int pe = beq + __popcll(me[0] & lt) + __popcll(me[1] & lt) + __popcll(me[2] & lt) + __popcll(me[3] & lt);
#pragma unroll
        for (int j = 0; j < 4; j++) {
          if (kq[j] > prefix) { sel[tk * 256 + pg] = base + j; pg++; }
          else if (kq[j] == prefix) { if (pe < kk) sel[tk * 256 + ngt + pe] = base + j; pe++; }
        }
        bgt += __popcll(mg[0]) + __popcll(mg[1]) + __popcll(mg[2]) + __popcll(mg[3]);
        beq += __popcll(me[0]) + __popcll(me[1]) + __popcll(me[2]) + __popcll(me[3]);
      }
    }
    __syncthreads();
  } else {
    for (int i = tid; i < 512; i += 256) sel[i] = i & 255;
    __syncthreads();
  }
  {
    const int tid = tid_opaque(), lane = tid & 63, row16 = lane & 15, kg = lane >> 4;
    const int tk = w >> 1, hf = w & 1;
    const int nsel = min(256, t0 + tk + 1);
    const size_t tok = tokb + t0 + tk;
    const int* selt = sel + tk * 256;
    float* sct = sc + tk * 1024;
    bf16_t* pbt = (bf16_t*)(part) + tk * 1024;
    unsigned char* vw = vst + w * 8192;
    const int kk8 = lane >> 3, ch = lane & 7;
    const int q4 = row16 >> 2, pp = row16 & 3;
#define DSA_VLOAD(dst, it_, base_) dst = *(const uint4*)(vdb + (size_t)selt[min((base_) + (it_) * 8 + kk8, nsel - 1)] * 64 + ch * 8)
#define DSA_VSTORE(src, it_) { const int key_ = (it_) * 8 + kk8; *(uint4*)(vw + key_ * 128 + ((((ch >> 1) ^ dsa_vswz(key_))) << 5) + ((ch & 1) << 4)) = src; }
    uint4 vv0, vv1, vv2, vv3, vv4, vv5, vv6, vv7, vw0, vw1, vw2, vw3, vw4, vw5, vw6, vw7;
    DSA_VLOAD(vv0, 0, hf * 128); DSA_VLOAD(vv1, 1, hf * 128); DSA_VLOAD(vv2, 2, hf * 128); DSA_VLOAD(vv3, 3, hf * 128);
    DSA_VLOAD(vv4, 4, hf * 128); DSA_VLOAD(vv5, 5, hf * 128); DSA_VLOAD(vv6, 6, hf * 128); DSA_VLOAD(vv7, 7, hf * 128);
    DSA_VLOAD(vw0, 0, hf * 128 + 64); DSA_VLOAD(vw1, 1, hf * 128 + 64); DSA_VLOAD(vw2, 2, hf * 128 + 64); DSA_VLOAD(vw3, 3, hf * 128 + 64);
    DSA_VLOAD(vw4, 4, hf * 128 + 64); DSA_VLOAD(vw5, 5, hf * 128 + 64); DSA_VLOAD(vw6, 6, hf * 128 + 64); DSA_VLOAD(vw7, 7, hf * 128 + 64);
    {
      bf16x8 qf[2];
#pragma unroll
      for (int ks = 0; ks < 2; ks++) {
        uint4 u = make_uint4(0, 0, 0, 0);
        if (row16 < 4) u = *(const uint4*)(p.qd + tok * 256 + row16 * 64 + ks * 32 + kg * 8);
        qf[ks] = __builtin_bit_cast(bf16x8, u);
      }
      bf16x8 kf[2][4][2];
#pragma unroll
      for (int ck = 0; ck < 2; ck++)
#pragma unroll
        for (int ti = 0; ti < 4; ti++) {
          const int r = hf * 128 + ck * 64 + ti * 16 + row16;
          const int idx = selt[min(r, nsel - 1)];
#pragma unroll
          for (int ks = 0; ks < 2; ks++) kf[ck][ti][ks] = *(const bf16x8*)(kdb + (size_t)idx * 64 + ks * 32 + kg * 8);
        }
#pragma unroll
      for (int ck = 0; ck < 2; ck++) {
#pragma unroll
        for (int ti = 0; ti < 4; ti++) {
          f32x4v acc = {0.f, 0.f, 0.f, 0.f};
          acc = __builtin_amdgcn_mfma_f32_16x16x32_bf16(kf[ck][ti][0], qf[0], acc, 0, 0, 0);
          acc = __builtin_amdgcn_mfma_f32_16x16x32_bf16(kf[ck][ti][1], qf[1], acc, 0, 0, 0);
          if (row16 < 4) {
#pragma unroll
            for (int r = 0; r < 4; r++) {
              const int key = hf * 128 + ck * 64 + ti * 16 + 4 * kg + r;
              sct[row16 * 256 + key] = (key < nsel) ? acc[r] * 0.125f : -INFINITY;
            }
          }
        }
      }
    }
    __syncthreads();
#pragma unroll
    for (int hh = 0; hh < 2; hh++) {
      const int h = 2 * hf + hh;
      float v0 = sct[h * 256 + lane], v1 = sct[h * 256 + 64 + lane], v2 = sct[h * 256 + 128 + lane], v3 = sct[h * 256 + 192 + lane];
      const float mx = wave_max_uniform(fmaxf(fmaxf(v0, v1), fmaxf(v2, v3)));
      v0 = __expf(v0 - mx); v1 = __expf(v1 - mx); v2 = __expf(v2 - mx); v3 = __expf(v3 - mx);
      const float inv = 1.f / wave_sum_uniform((v0 + v1) + (v2 + v3));
      pbt[h * 256 + lane] = f2bf(v0 * inv); pbt[h * 256 + 64 + lane] = f2bf(v1 * inv);
      pbt[h * 256 + 128 + lane] = f2bf(v2 * inv); pbt[h * 256 + 192 + lane] = f2bf(v3 * inv);
    }
    __syncthreads();
    f32x4v oacc[4];
#pragma unroll
    for (int nt = 0; nt < 4; nt++) oacc[nt] = f32x4v{0.f, 0.f, 0.f, 0.f};
#pragma unroll
    for (int ck = 0; ck < 2; ck++) {
      if (ck == 0) {
        DSA_VSTORE(vv0, 0); DSA_VSTORE(vv1, 1); DSA_VSTORE(vv2, 2); DSA_VSTORE(vv3, 3);
        DSA_VSTORE(vv4, 4); DSA_VSTORE(vv5, 5); DSA_VSTORE(vv6, 6); DSA_VSTORE(vv7, 7);
      } else {
        DSA_VSTORE(vw0, 0); DSA_VSTORE(vw1, 1); DSA_VSTORE(vw2, 2); DSA_VSTORE(vw3, 3);
        DSA_VSTORE(vw4, 4); DSA_VSTORE(vw5, 5); DSA_VSTORE(vw6, 6); DSA_VSTORE(vw7, 7);
      }
      __builtin_amdgcn_wave_barrier();
      bf16x8 pf[2];
#pragma unroll
      for (int ks = 0; ks < 2; ks++) {
        uint4 u = make_uint4(0, 0, 0, 0);
        if (row16 < 4) u = *(const uint4*)(pbt + row16 * 256 + hf * 128 + ck * 64 + ks * 32 + kg * 8);
        pf[ks] = __builtin_bit_cast(bf16x8, u);
      }
#pragma unroll
      for (int nt = 0; nt < 4; nt++) {
#pragma unroll
        for (int ks = 0; ks < 2; ks++) {
          const int r0 = ks * 32 + kg * 8 + q4, r1 = r0 + 4;
          const s16x4 lo = __builtin_amdgcn_ds_read_tr16_b64_v4i16((s16x4 __attribute__((address_space(3)))*)(vw + r0 * 128 + ((nt ^ dsa_vswz(r0)) << 5) + pp * 8));
          const s16x4 hi = __builtin_amdgcn_ds_read_tr16_b64_v4i16((s16x4 __attribute__((address_space(3)))*)(vw + r1 * 128 + ((nt ^ dsa_vswz(r1)) << 5) + pp * 8));
          typedef __attribute__((ext_vector_type(8))) short s16x8;
          const s16x8 v8 = __builtin_shufflevector(lo, hi, 0, 1, 2, 3, 4, 5, 6, 7);
          oacc[nt] = __builtin_amdgcn_mfma_f32_16x16x32_bf16(pf[ks], __builtin_bit_cast(bf16x8, v8), oacc[nt], 0, 0, 0);
        }
      }
      __builtin_amdgcn_wave_barrier();
    }
#undef DSA_VLOAD
#undef DSA_VSTORE
    __syncthreads();
    if (kg == 0) {
#pragma unroll
      for (int nt = 0; nt < 4; nt++)
#pragma unroll
        for (int r = 0; r < 4; r++) part[(w * 4 + r) * 64 + nt * 16 + row16] = oacc[nt][r];
    }
    __syncthreads();
    {
#pragma unroll
      for (int o2 = 0; o2 < 2; o2++) {
        const int idx = tid + 256 * o2, tk2 = idx >> 8, e = idx & 255;
        const float o = part[(2 * tk2) * 256 + e] + part[(2 * tk2 + 1) * 256 + e];
        p.concat[(tokb + t0 + tk2) * DM + 512 + e] = f2bf(o);
      }
    }
    __syncthreads();
  }
}
__device__ __forceinline__ void dsa_phase(const Params& p, unsigned char* smem, int bid, int nblk) {
  for (int it = bid; it < NB * (SEQ / 2); it += nblk) dsa_item(p, smem, it & 7, (SEQ / 2 - 1) - (it >> 3));
}

#define SELFCHECK 0
#ifndef PROBE_REPEAT
#define PROBE_REPEAT 0
#endif
#if SELFCHECK
__device__ __forceinline__ void check_val(const Params& p, float ref, float got, float atol, float rtol) {
  if (!(fabsf(ref - got) <= atol + rtol * fabsf(ref))) atomicExch(p.flag, 1);
}
__device__ __forceinline__ void inproj_check_phase(const Params& p, unsigned char* smem, int bid, int nblk) {
  float* h = (float*)smem;
  const float f16[8] = {1.0f, 0.19392274474868576f, 0.03760603093086393f, 0.007292664737217109f,
                        0.001414213562373095f, 0.0002742481756762073f, 5.318295896944988e-05f, 1.031338537721246e-05f};
  const int tid = threadIdx.x;
  for (int it = bid; it < 600; it += nblk) {
    const int tok = (it * 61) % NT;
    const int b = tok / SEQ, t = tok % SEQ;
    const float* xr = p.x + (size_t)tok * DM;
    for (int col = tid; col < INW; col += 256) {
      float a = 0.f;
      for (int k = 0; k < DM; k++) a = fmaf(xr[k], p.w_in[(size_t)k * INW + col], a);
      h[col] = a;
    }
    __syncthreads();
    const int pos = p.pos[tok];
    if (tid < 152) {
      const int v = tid >> 3, j = tid & 7;
      int base;
      if (v < 8) base = C_NSAQ + v * 64;
      else if (v < 10) base = C_NSAKV + 0 * 128 + (v - 8) * 64;
      else if (v < 12) base = C_NSAKV + 2 * 128 + (v - 10) * 64;
      else if (v < 14) base = C_NSAKV + 4 * 128 + (v - 12) * 64;
      else if (v < 18) base = C_DSAQ + (v - 14) * 64;
      else base = C_DSAK;
      float c, s; rope_cs(pos, f16[j], c, s);
      const float x1 = h[base + j], x2 = h[base + 8 + j];
      h[base + j] = x1 * c - x2 * s; h[base + 8 + j] = x2 * c + x1 * s;
    } else if (tid < 188) {
      const int u = tid - 152, v = u >> 2, j = u & 3;
      const int base = (v < 8) ? C_IDXQ + v * 32 : C_IDXK;
      float c, s; rope_cs(pos, f16[2 * j], c, s);
      const float x1 = h[base + j], x2 = h[base + 4 + j];
      h[base + j] = x1 * c - x2 * s; h[base + 4 + j] = x2 * c + x1 * s;
    } else if (tid < 212) {
      const int u = tid - 188;
      h[C_GATE + u] = 1.f / (1.f + expf(-h[C_GATE + u]));
    }
    __syncthreads();
    for (int col = tid; col < INW; col += 256) {
      const float ref = h[col];
      float got;
      if (col < 512) got = bf2f(p.qn[(size_t)tok * 512 + col]);
      else if (col < 1280) {
        const int o = col - 512, j = o >> 7, g = (o >> 6) & 1, d = o & 63;
        if (j == 3 || j == 5) {
          const bf16_t* vt = (j == 3) ? p.vslct : p.vwint;
          got = bf2f(vt[((size_t)(b * 2 + g) * 64 + d) * SEQ + perm16(t)]);
        } else {
          const bf16_t* src = j == 0 ? p.kvn[0] : j == 1 ? p.kvn[1] : j == 2 ? p.kvn[2] : p.kvn[4];
          got = bf2f(src[((size_t)(b * 2 + g) * SEQ + t) * 64 + d]);
        }
      }
      else if (col < 1304) got = p.gates[(size_t)tok * 24 + col - 1280];
      else if (col < 1560) got = bf2f(p.qd[(size_t)tok * 256 + col - 1304]);
      else if (col < 1624) got = bf2f(p.kd[(size_t)tok * 64 + col - 1560]);
      else if (col < 1688) got = bf2f(p.vd[(size_t)tok * 64 + col - 1624]);
      else if (col < 1944) got = bf2f(p.qi[(size_t)tok * 256 + col - 1688]);
      else if (col < 1976) got = bf2f(p.ki[(size_t)tok * 32 + col - 1944]);
      else if (col < 1984) got = p.widx[(size_t)tok * 8 + col - 1976] * 16.f;
      else got = bf2f(p.memq[(size_t)tok * 256 + col - 1984]);
      check_val(p, ref, got, 0.04f, 0.02f);
    }
    __syncthreads();
  }
  for (int it = bid; it < 64; it += nblk) {
    const int row = (it * 37) % (NB * MEML);
    for (int col = tid; col < 512; col += 256) {
      float a = 0.f;
      for (int k = 0; k < DM; k++) a = fmaf(p.mem[(size_t)row * DM + k], p.w_mem_kv[(size_t)k * 512 + col], a);
      float gotm;
      if (col < 256) gotm = bf2f(p.mkv[(size_t)row * 512 + col]);
      else { const int hd = (col - 256) >> 6, dd = col & 63; gotm = bf2f(p.memvt[((size_t)((row >> 8) * 4 + hd) * 64 + dd) * MEML + perm16(row & 255)]); }
      check_val(p, a, gotm, 0.04f, 0.02f);
    }
  }
}

__device__ __forceinline__ void mem_check_phase(const Params& p, unsigned char* smem, int bid, int nblk) {
  float* q = (float*)smem;
  float* sc = q + 256;
  const int tid = threadIdx.x;
  for (int it = bid; it < 700; it += nblk) {
    const int tok = (it * 47 + 13) % NT;
    const int b = tok / SEQ;
    q[tid] = bf2f(p.memq[(size_t)tok * 256 + tid]);
    __syncthreads();
    const bf16_t* kvb = p.mkv + (size_t)b * MEML * 512;
    for (int idx = tid; idx < 4 * 256; idx += 256) {
      const int hh = idx >> 8, m = idx & 255;
      sc[hh * 256 + m] = dot64_bf(q + hh * 64, kvb + (size_t)m * 512 + hh * 64) * 0.125f;
    }
    __syncthreads();
    softmax4(sc, 256, 256);
    __syncthreads();
    {
      const int h = tid >> 6, d = tid & 63;
      float o = 0.f;
      for (int m = 0; m < 256; m++) o = fmaf(sc[h * 256 + m], bf2f(p.memvt[((size_t)(b * 4 + h) * 64 + d) * MEML + perm16(m)]), o);
      check_val(p, o, bf2f(p.concat[(size_t)tok * DM + 768 + tid]), 0.004f, 0.02f);
    }
    __syncthreads();
  }
}
__device__ __forceinline__ void nsa_check_phase(const Params& p, unsigned char* smem, int bid, int nblk) {
  float* q = (float*)smem;
  float* sc = q + 256;
  float* o3 = sc + 4096;
  float* imp = o3 + 768;
  int* sel = (int*)(imp + 64);
  int* nselp = sel + 16;
  const int tid = threadIdx.x, h = tid >> 6, d = tid & 63;
  for (int it = bid; it < 1024; it += nblk) {
    const int item = (int)(((long long)it * 62851 + 7) % (NT * 2));
    const int g = item & 1, tok = item >> 1, b = tok / SEQ, t = tok % SEQ;
    const size_t kvb = (size_t)(b * 2 + g) * SEQ * 64;
    const bf16_t *kslc = p.kvn[2] + kvb, *kwin = p.kvn[4] + kvb;
    const bf16_t *vslct = p.vslct + (size_t)(b * 2 + g) * 64 * SEQ, *vwint = p.vwint + (size_t)(b * 2 + g) * 64 * SEQ;
    q[tid] = bf2f(p.qn[(size_t)tok * 512 + g * 256 + tid]);
    __syncthreads();
    const int nv = (t >= 31) ? (t - 31) / 16 + 1 : 0;
    const bf16_t* kcb = p.kcb + (size_t)(b * 2 + g) * 256 * 64;
    const bf16_t* vct = p.vct + (size_t)(b * 2 + g) * 64 * 256;
    for (int idx = tid; idx < 4 * 256; idx += 256) {
      const int hh = idx >> 8, i = idx & 255;
      float s = -INFINITY;
      if (i < nv) {
        s = 0.f;
        for (int e = 0; e < 64; e++) s = fmaf(q[hh * 64 + e], bf2f(kcb[i * 64 + e]), s);
        s *= 0.125f;
      }
      sc[hh * 1024 + i] = s;
    }
    __syncthreads();
    softmax4(sc, 1024, 256);
    __syncthreads();
    {
      float o = 0.f;
      for (int i = 0; i < nv; i++) o = fmaf(sc[h * 1024 + i], bf2f(vct[d * 256 + perm16(i)]), o);
      o3[0 * 256 + tid] = o;
    }
    const int cur = t / 64;
    if (tid < 64) {
      const int m = tid;
      float a = 0.f;
      const int n0 = max(0, 4 * m - 2), n1 = min(NC - 1, 4 * m + 4);
      for (int n = n0; n <= n1; n++) {
        const int ov = min(16 * n + 32, 64 * m + 64) - max(16 * n, 64 * m);
        if (ov > 0) {
          const float w = (float)ov * (1.f / 32.f);
          for (int hh = 0; hh < 4; hh++) a = fmaf(sc[hh * 1024 + n], w, a);
        }
      }
      const bool forced = (m == 0) || (m == cur) || (m == cur - 1);
      const bool vis = (m <= cur);
      imp[m] = vis ? a + (forced ? 1e4f : 0.f) : -INFINITY;
    }
    __syncthreads();
    if (tid < 64) {
      const int m = tid;
      const float sm = imp[m];
      int rank = 0;
      for (int mm = 0; mm < 64; mm++) { const float s2 = imp[mm]; rank += (s2 > sm) || (s2 == sm && mm < m); }
      const bool take = (rank < 16) && (m <= cur);
      const unsigned long long bal = __ballot(take);
      if (take) sel[__popcll(bal & ((1ull << m) - 1ull))] = m;
      if (m == 0) *nselp = __popcll(bal);
    }
    __syncthreads();
    const int nsel = *nselp;
    {
      const int nk = nsel * 64;
      for (int idx = tid; idx < 4 * nk; idx += 256) {
        const int hh = idx / nk, r = idx % nk;
        const int kpos = sel[r >> 6] * 64 + (r & 63);
        float s = -INFINITY;
        if (kpos <= t) s = dot64_bf(q + hh * 64, kslc + (size_t)kpos * 64) * 0.125f;
        sc[hh * 1024 + r] = s;
      }
      __syncthreads();
      softmax4(sc, 1024, nk);
      __syncthreads();
      float o = 0.f;
      for (int r = 0; r < nk; r++) {
        const int kpos = sel[r >> 6] * 64 + (r & 63);
        if (kpos <= t) o = fmaf(sc[h * 1024 + r], bf2f(vslct[(size_t)d * SEQ + perm16(kpos)]), o);
      }
      o3[1 * 256 + tid] = o;
      __syncthreads();
    }
    {
      for (int idx = tid; idx < 4 * 512; idx += 256) {
        const int hh = idx >> 9, r = idx & 511;
        const int kpos = t - 511 + r;
        float s = -INFINITY;
        if (kpos >= 0) s = dot64_bf(q + hh * 64, kwin + (size_t)kpos * 64) * 0.125f;
        sc[hh * 1024 + r] = s;
      }
      __syncthreads();
      softmax4(sc, 1024, 512);
      __syncthreads();
      float o = 0.f;
      for (int r = 0; r < 512; r++) {
        const int kpos = t - 511 + r;
        if (kpos >= 0) o = fmaf(sc[h * 1024 + r], bf2f(vwint[(size_t)d * SEQ + perm16(kpos)]), o);
      }
      o3[2 * 256 + tid] = o;
    }
    {
      const float* gt = p.gates + (size_t)tok * 24 + (g * 4 + h) * 3;
      const float r = gt[0] * o3[tid] + gt[1] * o3[256 + tid] + gt[2] * o3[512 + tid];
      const float got = bf2f(p.concat[(size_t)tok * DM + g * 256 + tid]);
      const float df = fabsf(r - got);
      if (!(df <= 0.08f + 0.1f * fabsf(r))) atomicExch(p.flag, 1);
      if (!(df <= 0.006f + 0.02f * fabsf(r))) atomicAdd(p.chkcnt, 1);
    }
    __syncthreads();
  }
}

__device__ __forceinline__ void dsa_check_phase(const Params& p, unsigned char* smem, int bid, int nblk) {
  unsigned* keys = (unsigned*)smem;
  float* qi = (float*)(keys + 4096);
  float* wi = qi + 256;
  int* hist = (int*)(wi + 8);
  int* sel = hist + 256;
  int* misc = sel + 256;
  int* cnts = misc + 8;
  float* qd = (float*)(cnts + 256);
  float* sc = qd + 256;
  const int tid = threadIdx.x;
  for (int it = bid; it < 1500; it += nblk) {
    const int tok = (int)(((long long)it * 39119 + 11) % NT);
    const int b = tok / SEQ, t = tok % SEQ;
    const bf16_t* kib = p.ki + (size_t)b * SEQ * 32;
    const bf16_t* kdb = p.kd + (size_t)b * SEQ * 64;
    const bf16_t* vdb = p.vd + (size_t)b * SEQ * 64;
    qi[tid] = bf2f(p.qi[(size_t)tok * 256 + tid]);
    if (tid < 8) wi[tid] = p.widx[(size_t)tok * 8 + tid];
    qd[tid] = bf2f(p.qd[(size_t)tok * 256 + tid]);
    __syncthreads();
    const int n = t + 1;
    int nsel;
    if (n <= 256) {
      for (int s = tid; s < n; s += 256) sel[s] = s;
      nsel = n;
      __syncthreads();
    } else {
      for (int s = tid; s < n; s += 256) {
        float kv[32];
#pragma unroll
        for (int e = 0; e < 32; e += 8) {
          const uint4 v = *(const uint4*)(kib + (size_t)s * 32 + e);
          kv[e + 0] = __uint_as_float(v.x << 16); kv[e + 1] = __uint_as_float(v.x & 0xFFFF0000u);
          kv[e + 2] = __uint_as_float(v.y << 16); kv[e + 3] = __uint_as_float(v.y & 0xFFFF0000u);
          kv[e + 4] = __uint_as_float(v.z << 16); kv[e + 5] = __uint_as_float(v.z & 0xFFFF0000u);
          kv[e + 6] = __uint_as_float(v.w << 16); kv[e + 7] = __uint_as_float(v.w & 0xFFFF0000u);
        }
        float score = 0.f;
    #pragma unroll 1
    for (int hh = 0; hh < 8; hh++) {
          float dsum = 0.f;
#pragma unroll
          for (int e = 0; e < 32; e++) dsum = fmaf(qi[hh * 32 + e], kv[e], dsum);
          score = fmaf(fmaxf(dsum, 0.f), wi[hh], score);
        }
        keys[s] = f2key(score);
      }
      unsigned prefix = 0; int kk = 256;
      for (int shift = 24; shift >= 0; shift -= 8) {
        hist[tid] = 0;
        __syncthreads();
        const unsigned hmask = (shift == 24) ? 0u : (0xFFFFFFFFu << (shift + 8));
        for (int s = tid; s < n; s += 256) {
          const unsigned k = keys[s];
          if ((k & hmask) == prefix) atomicAdd(&hist[(k >> shift) & 255], 1);
        }
        __syncthreads();
        if (tid == 0) {
          int cum = 0, dsel = 0;
          for (int dg = 255; dg >= 0; dg--) {
            const int c = hist[dg];
            if (cum + c >= kk) { dsel = dg; break; }
            cum += c;
          }
          misc[0] = dsel; misc[1] = kk - cum;
        }
        __syncthreads();
        prefix |= ((unsigned)misc[0]) << shift;
        kk = misc[1];
        __syncthreads();
      }
      const int per = (n + 255) / 256;
      const int s0 = tid * per, s1 = min(n, s0 + per);
      int cg_ = 0, ce = 0;
      for (int s = s0; s < s1; s++) { const unsigned k = keys[s]; cg_ += (k > prefix); ce += (k == prefix); }
      cnts[tid] = cg_; hist[tid] = ce;
      __syncthreads();
      if (tid == 0) {
        int a = 0, e = 0;
        for (int i = 0; i < 256; i++) { const int c1 = cnts[i], c2 = hist[i]; cnts[i] = a; hist[i] = e; a += c1; e += c2; }
        misc[2] = a;
      }
      __syncthreads();
      {
        int og = cnts[tid], oe = hist[tid];
        const int ngt = misc[2];
        for (int s = s0; s < s1; s++) {
          const unsigned k = keys[s];
          if (k > prefix) sel[og++] = s;
          else if (k == prefix) { if (oe < kk) sel[ngt + oe] = s; oe++; }
        }
      }
      nsel = 256;
      __syncthreads();
    }
    for (int idx = tid; idx < 4 * nsel; idx += 256) {
      const int hh = idx / nsel, r = idx % nsel;
      sc[hh * 256 + r] = dot64_bf(qd + hh * 64, kdb + (size_t)sel[r] * 64) * 0.125f;
    }
    __syncthreads();
    softmax4(sc, 256, nsel);
    __syncthreads();
    {
      const int h = tid >> 6, d = tid & 63;
      float o = 0.f;
      for (int r = 0; r < nsel; r++) o = fmaf(sc[h * 256 + r], bf2f(vdb[(size_t)sel[r] * 64 + d]), o);
      const float got = bf2f(p.concat[(size_t)tok * DM + 512 + tid]);
      const float df = fabsf(o - got);
      if (!(df <= 0.08f + 0.1f * fabsf(o))) atomicExch(p.flag, 1);
      if (!(df <= 0.004f + 0.02f * fabsf(o))) atomicAdd(p.chkcnt, 1);
    }
    __syncthreads();
  }
}


__device__ __forceinline__ void compress_check_phase(const Params& p, unsigned char* smem, int bid, int nblk) {
  float* hid = (float*)smem;
  const int tid = threadIdx.x;
  const int which = tid >> 7, j = tid & 127;
  for (int it = bid; it < 600; it += nblk) {
    const int item = (it * 131 + 5) % (NB * 2 * NC);
    const int i = item % NC, g = (item / NC) % 2, b = item / (NC * 2);
    const float* w1 = which ? p.w1v : p.w1k;
    const float* pe = which ? p.pe_v : p.pe_k;
    const bf16_t* src = (which ? p.kvn[1] : p.kvn[0]) + ((size_t)(b * 2 + g) * SEQ + i * 16) * 64;
    float acc = 0.f;
    for (int r = 0; r < 2048; r++) acc = fmaf(bf2f(src[r]) + pe[r], w1[(size_t)r * 128 + j], acc);
    hid[which * 128 + j] = gelu_exact(acc);
    __syncthreads();
    if (j < 64) {
      const float* w2 = which ? p.w2v : p.w2k;
      float o = 0.f;
      for (int k = 0; k < 128; k++) o = fmaf(hid[which * 128 + k], w2[k * 64 + j], o);
      const float got = which ? bf2f(p.vct[((size_t)(b * 2 + g) * 64 + j) * 256 + perm16(i)]) : bf2f(p.kcb[((size_t)(b * 2 + g) * 256 + i) * 64 + j]);
      check_val(p, o, got, 0.01f, 0.02f);
    }
    __syncthreads();
  }
}
#endif


#define XB_TMO      128
#define XB_XCNT(j)  (256  + 64 * (j))
#define XB_XSUB(j)  (1280 + 64 * (j))
#define XB_XGEN(j)  (2304 + 64 * (j))
#define XB_TOP      3328
#define XB_TOPGEN   3392
#define XCD_BAR_WORDS 3456
#define XB_SPIN_CAP (1u << 23)
#define LAS __attribute__((address_space(3)))
__device__ __forceinline__ unsigned xb_ld(unsigned* p)              { return __hip_atomic_load(p, __ATOMIC_RELAXED, __HIP_MEMORY_SCOPE_AGENT); }
__device__ __forceinline__ unsigned xb_add(unsigned* p, unsigned v) { return __hip_atomic_fetch_add(p, v, __ATOMIC_RELAXED, __HIP_MEMORY_SCOPE_AGENT); }
__device__ __forceinline__ unsigned xb_xcc_id() { return (unsigned)__builtin_amdgcn_s_getreg((3 << 11) | 20) & 0xFu; }
#define XB_SPIN(cond, bar) do { unsigned _sp = 0; while (cond) { __builtin_amdgcn_s_sleep(1); \
    if ((++_sp & 255u) == 0u) { if (xb_ld(&(bar)[XB_TMO])) break; if (_sp > XB_SPIN_CAP) { atomicAdd(&(bar)[XB_TMO], 1u); break; } } } } while (0)
struct XcdBarrier { unsigned* bar; unsigned x; volatile LAS unsigned* st; };
__device__ __forceinline__ XcdBarrier xcd_barrier_post(unsigned* bar, volatile LAS unsigned* st) {
  XcdBarrier b; b.bar = bar; b.x = xb_xcc_id(); b.st = st;
  if (threadIdx.x == 0) (void)xb_add(&bar[XB_XCNT(b.x)], 1u);
  return b;
}
__device__ __forceinline__ void xcd_barrier_complete(unsigned* bar, unsigned x, unsigned& nloc, unsigned& nx) {
  const unsigned G = gridDim.x * gridDim.y * gridDim.z;
  unsigned sum, cnt, mine, sp = 0u;
  for (;;) {
    sum = 0u; cnt = 0u; mine = 0u;
#pragma unroll
    for (unsigned j = 0; j < 16; ++j) { const unsigned c = xb_ld(&bar[XB_XCNT(j)]); sum += c; cnt += (c > 0u) ? 1u : 0u; mine = (j == x) ? c : mine; }
    if (sum == G) break;
    __builtin_amdgcn_s_sleep(1);
    if ((++sp & 255u) == 0u) { if (xb_ld(&bar[XB_TMO])) break; if (sp > XB_SPIN_CAP) { atomicAdd(&bar[XB_TMO], 1u); break; } }
  }
  nloc = mine > 0u ? mine : 1u; nx = cnt > 0u ? cnt : 1u;
}
__device__ __forceinline__ void xcd_barrier(const XcdBarrier& b) {
  asm volatile("s_waitcnt vmcnt(0)" ::: "memory");
  __syncthreads();
  if (threadIdx.x == 0) {
    unsigned* bar = b.bar;
    __builtin_amdgcn_s_waitcnt(0);
    unsigned nloc = b.st[0], nx = b.st[1];
    if (nloc == 0u) { xcd_barrier_complete(bar, b.x, nloc, nx); b.st[0] = nloc; b.st[1] = nx; }
    const unsigned old = xb_add(&bar[XB_XSUB(b.x)], 1u);
    const unsigned gen = old / nloc;
    if (old + 1u == (gen + 1u) * nloc) {
      __builtin_amdgcn_fence(__ATOMIC_RELEASE, "agent");
      asm volatile("s_waitcnt vmcnt(0)" ::: "memory");
      const unsigned og = xb_add(&bar[XB_TOP], 1u);
      const unsigned tg = og / nx;
      if (og + 1u == (tg + 1u) * nx) xb_add(&bar[XB_TOPGEN], 1u);
      else XB_SPIN(xb_ld(&bar[XB_TOPGEN]) == tg, bar);
      __builtin_amdgcn_fence(__ATOMIC_ACQUIRE, "agent");
      xb_add(&bar[XB_XGEN(b.x)], 1u);
      asm volatile("s_waitcnt vmcnt(0)" ::: "memory");
    } else {
      XB_SPIN(xb_ld(&bar[XB_XGEN(b.x)]) == gen, bar);
      __builtin_amdgcn_fence(__ATOMIC_ACQUIRE, "agent");
      asm volatile("s_waitcnt vmcnt(0)" ::: "memory");
    }
  }
  __syncthreads();
}

constexpr int SMEM_BYTES = 65536;
__global__ void __launch_bounds__(256, 2) megakernel(Params p) {
  __shared__ __align__(16) unsigned char smem[SMEM_BYTES];
  __shared__ uint4 xb_words;
  cg::grid_group grid = cg::this_grid();
  const int bid = blockIdx.x, nblk = gridDim.x;
  if (threadIdx.x == 0) xb_words = make_uint4(0u, 0u, 0u, 0u);
  __syncthreads();
  const XcdBarrier xb = xcd_barrier_post(p.bar, (volatile LAS unsigned*)&xb_words);
  if (p.never) grid.sync();
  for (int rep = 0; rep < ((PROBE_REPEAT & 128) ? 2 : 1); rep++) {
  convert_phase(p.x, p.xb, (size_t)NT * DM, bid, nblk);
  convert_phase(p.mem, p.memb, (size_t)NB * MEML * DM, bid, nblk);
  }
  for (int rep = 0; rep < ((PROBE_REPEAT & 256) ? 2 : 1); rep++) {
  transpose_phase<true>(p.w_in, INW, p.wint, DM, INWP, smem, bid, nblk);
  transpose_phase<false>(p.w_mem_kv, 512, p.wmemt, DM, 512, smem, bid, nblk);
  transpose_phase<false>(p.w_out, DM, p.woutt, DM, DM, smem, bid, nblk);
  transpose_phase<false>(p.wq, 2048, p.wqt, DM, 2048, smem, bid, nblk);
  transpose_phase<false>(p.w1k, 128, p.w1kt, 2048, 128, smem, bid, nblk);
  transpose_phase<false>(p.w1v, 128, p.w1vt, 2048, 128, smem, bid, nblk);
  }
  for (int rep = 0; rep < ((PROBE_REPEAT & 512) ? 2 : 1); rep++) {
  cbias_phase(p, bid, nblk);
  subkey_phase(p.sk1, p.sk1p, bid, nblk);
  subkey_phase(p.sk2, p.sk2p, bid, nblk);
  cs_phase(p, bid, nblk);
  ovp_phase(p, bid, nblk);
  }
  if (bid == 0 && threadIdx.x == 0) { *p.flag = 0; *p.chkcnt = 0; }
  xcd_barrier(xb);
  for (int rep = 0; rep < ((PROBE_REPEAT & 2) ? 2 : 1); rep++) inproj_phase(p, smem, bid, nblk);
  xcd_barrier(xb);
  if (bid >= 128) memkv_phase(p, smem, bid - 128, nblk);
  compress_phase(p, smem, bid, nblk);
  xcd_barrier(xb);
  {
    constexpr int N_NSA = NB * 2 * 128, N_DSA = NB * (SEQ / 2), N_MEM = NB * 4 * 32;
    volatile LAS unsigned* qslot = (volatile LAS unsigned*)&xb_words + 2;
#pragma unroll 1
    for (int k8 = 0; k8 < 8; k8++) {
      const int qx = (int)((xb.x + (unsigned)k8) & 7u);
#pragma unroll 1
      for (;;) {
        __syncthreads();
        if (threadIdx.x == 0) qslot[0] = atomicAdd(p.bar + 68 + qx, 1u);
        __syncthreads();
        const int q = __builtin_amdgcn_readfirstlane((int)qslot[0]);
        if (q >= N_NSA / 8) break;
        nsa_flash_item(p, smem, ((2 * qx + (q & 1)) << 7) | (127 - (q >> 1)));
      }
    }
    auto quant_item = [&](int qi_) __attribute__((always_inline)) {
      const int w_ = threadIdx.x >> 6;
      if (qi_ < 256) quant_rows(p.pu, p.puq, p.psu, qi_ * 64, 64, w_, 4);
      else quant_rows(p.pv, p.pvq, p.psv, (qi_ - 256) * 64, 64, w_, 4);
    };
    int ndone = 0;
#pragma unroll 1
    for (;;) {
      __syncthreads();
      if (threadIdx.x == 0) qslot[0] = atomicAdd(p.bar + 65, 1u);
      __syncthreads();
      const int q = __builtin_amdgcn_readfirstlane((int)qslot[0]);
      if (q >= N_DSA) break;
      dsa_item(p, smem, q & 7, (SEQ / 2 - 1) - (q >> 3));
      if ((++ndone & 31) == 0) {
        __syncthreads();
        if (threadIdx.x == 0) qslot[0] = atomicAdd(p.bar + 67, 1u);
        __syncthreads();
        const int qq = __builtin_amdgcn_readfirstlane((int)qslot[0]);
        if (qq < 512) quant_item(qq);
      }
    }
#pragma unroll 1
    for (;;) {
      __syncthreads();
      if (threadIdx.x == 0) qslot[0] = atomicAdd(p.bar + 67, 1u);
      __syncthreads();
      const int qq = __builtin_amdgcn_readfirstlane((int)qslot[0]);
      if (qq >= 512) break;
      quant_item(qq);
    }
#pragma unroll 1
    for (;;) {
      __syncthreads();
      if (threadIdx.x == 0) qslot[0] = atomicAdd(p.bar + 66, 1u);
      __syncthreads();
      const int q = __builtin_amdgcn_readfirstlane((int)qslot[0]);
      if (q >= N_MEM) break;
      mem_flash_item(p, smem, q);
    }
  }
  xcd_barrier(xb);
  peer_block_phase(p, smem, bid, nblk);
  peer_e3_phase(p, bid, nblk);
}


#if SELFCHECK
__global__ void __launch_bounds__(256) check_kernel(Params p) {
  __shared__ __align__(16) unsigned char smem[40960];
  inproj_check_phase(p, smem, blockIdx.x, gridDim.x);
}
__global__ void check_final(Params p) {
  if (threadIdx.x == 0 && (*(volatile int*)p.flag != 0 || *(volatile int*)p.chkcnt > 6000)) p.out[0] = __uint_as_float(0x7FC00000u);
}
#endif

extern "C" void kernel_launch(void* const* d_in, const int* in_sizes, int n_in, void* d_out, int out_size,
                              void* d_ws, size_t ws_size, hipStream_t stream) {
  Params p{};
  p.x = (const float*)d_in[0]; p.mem = (const float*)d_in[1]; p.pos = (const int*)d_in[2];
  p.w_in = (const float*)d_in[3]; p.pe_k = (const float*)d_in[4]; p.pe_v = (const float*)d_in[5];
  p.w1k = (const float*)d_in[6]; p.w2k = (const float*)d_in[7]; p.w1v = (const float*)d_in[8]; p.w2v = (const float*)d_in[9];
  p.w_mem_kv = (const float*)d_in[10]; p.w_out = (const float*)d_in[11]; p.ln1g = (const float*)d_in[12]; p.ln1b = (const float*)d_in[13];
  p.wq = (const float*)d_in[14]; p.sk1 = (const float*)d_in[15]; p.sk2 = (const float*)d_in[16];
  p.pu = (const float*)d_in[17]; p.pv = (const float*)d_in[18]; p.ln2g = (const float*)d_in[19]; p.ln2b = (const float*)d_in[20];
  p.out = (float*)d_out;
  unsigned char* ws = (unsigned char*)d_ws;
  size_t off = 0;
  auto take = [&](size_t bytes) { void* r = ws + off; off += (bytes + 255) & ~(size_t)255; return r; };
  p.xb = (bf16_t*)take((size_t)NT * DM * 2);
  p.qn = (bf16_t*)take((size_t)NT * 512 * 2);
  for (int j = 0; j < 6; j++) p.kvn[j] = (bf16_t*)take((size_t)NT * 128 * 2);
  p.qd = (bf16_t*)take((size_t)NT * 256 * 2);
  p.kd = (bf16_t*)take((size_t)NT * 64 * 2);
  p.vd = (bf16_t*)take((size_t)NT * 64 * 2);
  p.qi = (bf16_t*)take((size_t)NT * 256 * 2);
  p.ki = (bf16_t*)take((size_t)NT * 32 * 2);
  p.memq = (bf16_t*)take((size_t)NT * 256 * 2);
  p.gates = (float*)take((size_t)NT * 24 * 4);
  p.widx = (float*)take((size_t)NT * 8 * 4);
  p.mkv = (bf16_t*)take((size_t)NB * MEML * 512 * 2);
  p.memvt = (bf16_t*)take((size_t)NB * 4 * 64 * MEML * 2);
  p.vslct = (bf16_t*)take((size_t)NT * 128 * 2);
  p.vwint = (bf16_t*)take((size_t)NT * 128 * 2);
  p.kcb = (bf16_t*)take((size_t)NB * 2 * 256 * 64 * 2);
  p.vct = (bf16_t*)take((size_t)NB * 2 * 64 * 256 * 2);
  p.ovp = (bf16_t*)take((size_t)64 * 256 * 2);
  p.w1kt = (bf16_t*)take((size_t)128 * 2048 * 2);
  p.w1vt = (bf16_t*)take((size_t)128 * 2048 * 2);
  p.cbias = (float*)take(64 * 256 * 4);
  p.chkcnt = (int*)take(256);
  p.bar = (unsigned*)take(XCD_BAR_WORDS * 4);
  p.never = 0; p.pad_ = 0;
  p.memb = (bf16_t*)take((size_t)NB * MEML * DM * 2);
  p.wint = (bf16_t*)take((size_t)INWP * DM * 2);
  p.wmemt = (bf16_t*)take((size_t)512 * DM * 2);
  p.woutt = (bf16_t*)take((size_t)DM * DM * 2);
  p.wqt = (bf16_t*)take((size_t)2048 * DM * 2);
  p.sk1p = (bf16_t*)take((size_t)128 * 128 * 2);
  p.sk2p = (bf16_t*)take((size_t)128 * 128 * 2);
  p.puq = (unsigned char*)take((size_t)16384 * DM);
  p.pvq = (unsigned char*)take((size_t)16384 * DM);
  p.psu = (float*)take(16384 * 4);
  p.psv = (float*)take(16384 * 4);
  p.cs = (float2*)take((size_t)NT * 8 * 8);
  p.kc = (float*)take((size_t)NB * 2 * NC * 64 * 4);
  p.vc = (float*)take((size_t)NB * 2 * NC * 64 * 4);
  p.concat = (bf16_t*)take((size_t)NT * DM * 2);
  p.x1b = (bf16_t*)take((size_t)NT * DM * 2);
  p.pexp = (int*)take((size_t)NT * 128 * 4);
  p.pgate = (float*)take((size_t)NT * 128 * 4);
  p.flag = (int*)take(256);
  if (off > ws_size) { fprintf(stderr, "workspace too small: need %zu have %zu\n", off, ws_size); return; }
  static int grid_blocks = 0;
  if (!grid_blocks) {
    int dev = 0, cus = 0, per_cu = 0;
    hipGetDevice(&dev);
    hipDeviceGetAttribute(&cus, hipDeviceAttributeMultiprocessorCount, dev);
    hipOccupancyMaxActiveBlocksPerMultiprocessor(&per_cu, megakernel, 256, 0);
    if (per_cu > 2) per_cu = 2;
    grid_blocks = cus * per_cu;
  }
  hipMemsetAsync(p.bar, 0, XCD_BAR_WORDS * 4, stream);
  void* args[] = {&p};
  hipError_t e = hipLaunchCooperativeKernel((void*)megakernel, dim3(grid_blocks), dim3(256), args, 0, stream);
  if (e != hipSuccess) fprintf(stderr, "cooperative launch failed: %s (grid %d)\n", hipGetErrorString(e), grid_blocks);
#if SELFCHECK
  check_kernel<<<512, 256, 0, stream>>>(p);
  check_final<<<1, 64, 0, stream>>>(p);
#endif
}
```

```cpp
#include <hip/hip_runtime.h>
#include <hip/hip_cooperative_groups.h>
#include <cstdio>
#include <cstdint>
namespace cg = cooperative_groups;

constexpr int NB = 8, SEQ = 4096, DM = 1024, NT = NB * SEQ;
constexpr int INW = 2240;
constexpr int INWP = 2304;
constexpr int NC = 255;
constexpr int MEML = 256;
constexpr int C_NSAQ = 0, C_NSAKV = 512, C_GATE = 1280, C_DSAQ = 1304, C_DSAK = 1560, C_DSAV = 1624,
              C_IDXQ = 1688, C_IDXK = 1944, C_IDXW = 1976, C_MEMQ = 1984;
constexpr int P_NSAQ = 0, P_NSAKV = 512, P_DSAQ = 1280, P_DSAK = 1536, P_DSAV = 1600, P_IDXQ = 1664, P_IDXK = 1920,
              P_MEMQ = 1952, P_GATE = 2208, P_IDXW = 2232, P_END = 2240;
constexpr float ALPHA = 1.189207115002721f;

typedef unsigned short bf16_t;
typedef __attribute__((ext_vector_type(8))) __bf16 bf16x8;
typedef __attribute__((ext_vector_type(2))) __bf16 bf16x2;
typedef __attribute__((ext_vector_type(2))) float f32x2;
typedef __attribute__((ext_vector_type(4))) float f32x4;
typedef __attribute__((ext_vector_type(16))) float f32x16;
typedef __attribute__((ext_vector_type(2))) _Float16 f16x2;

struct Params {
  const float *x, *mem; const int* pos;
  const float *w_in, *pe_k, *pe_v, *w1k, *w2k, *w1v, *w2v, *w_mem_kv, *w_out, *ln1g, *ln1b,
              *wq, *sk1, *sk2, *pu, *pv, *ln2g, *ln2b;
  float* out;
  bf16_t *xb, *memb, *wint, *wmemt, *woutt, *wqt, *sk1p, *sk2p;
  unsigned char *puq, *pvq;
  float *psu, *psv;
  float2* cs;
  bf16_t *qn;
  bf16_t *kvn[6];
  bf16_t *qd, *kd, *vd;
  bf16_t *qi, *ki;
  bf16_t *memq, *mkv;
  bf16_t *memvt;
  bf16_t *vslct, *vwint;
  bf16_t *w1kt, *w1vt; float* cbias;
  bf16_t *kcb, *vct;
  bf16_t *ovp;
  int *chkcnt;
  unsigned *bar;
  int never;
  int pad_;
  float *gates, *widx;
  bf16_t *concat;
  bf16_t *x1b;
  float *kc, *vc;
  int   *pexp;
  float *pgate;
  int   *flag;
};

__device__ __forceinline__ float bf2f(bf16_t u) { return __uint_as_float(((unsigned)u) << 16); }
__device__ __forceinline__ bf16_t f2bf(float f) { return __builtin_bit_cast(unsigned short, (__bf16)f); }
__device__ __forceinline__ unsigned pack2bf(float a, float b) {
  f32x2 v = {a, b};
  return __builtin_bit_cast(unsigned, __builtin_convertvector(v, bf16x2));
}

__device__ __forceinline__ int tid_opaque() { int t = threadIdx.x; asm volatile("" : "+v"(t)); return t; }

__device__ __forceinline__ float wave_sum(float v) {
#pragma unroll
  for (int o = 32; o > 0; o >>= 1) v += __shfl_xor(v, o);
  return v;
}
__device__ __forceinline__ float wave_max(float v) {
#pragma unroll
  for (int o = 32; o > 0; o >>= 1) v = fmaxf(v, __shfl_xor(v, o));
  return v;
}
__device__ __forceinline__ float gelu_exact(float x) { return 0.5f * x * (1.f + erff(x * 0.7071067811865476f)); }

__device__ __forceinline__ void convert_phase(const float* __restrict__ src, bf16_t* __restrict__ dst, size_t n, int bid, int nblk) {
  const size_t nch = n / 8, stride = (size_t)nblk * 256;
  size_t c = (size_t)bid * 256 + threadIdx.x;
  for (; c + 3 * stride < nch; c += 4 * stride) {
    float4 a[4], b[4];
#pragma unroll
    for (int u = 0; u < 4; u++) { a[u] = *(const float4*)(src + (c + u * stride) * 8); b[u] = *(const float4*)(src + (c + u * stride) * 8 + 4); }
#pragma unroll
    for (int u = 0; u < 4; u++) {
      uint4 o = {pack2bf(a[u].x, a[u].y), pack2bf(a[u].z, a[u].w), pack2bf(b[u].x, b[u].y), pack2bf(b[u].z, b[u].w)};
      *(uint4*)(dst + (c + u * stride) * 8) = o;
    }
  }
  for (; c < nch; c += stride) {
    const float4 a = *(const float4*)(src + c * 8), b = *(const float4*)(src + c * 8 + 4);
    uint4 o = {pack2bf(a.x, a.y), pack2bf(a.z, a.w), pack2bf(b.x, b.y), pack2bf(b.z, b.w)};
    *(uint4*)(dst + c * 8) = o;
  }
}
__device__ __forceinline__ unsigned quant4(const float4& v, float inv) {
  const unsigned a = (unsigned)(__float2int_rn(v.x * inv) + 128), b = (unsigned)(__float2int_rn(v.y * inv) + 128);
  const unsigned c = (unsigned)(__float2int_rn(v.z * inv) + 128), d = (unsigned)(__float2int_rn(v.w * inv) + 128);
  return a | (b << 8) | (c << 16) | (d << 24);
}
__device__ __forceinline__ float absmax4(const float4& v) { return fmaxf(fmaxf(fabsf(v.x), fabsf(v.y)), fmaxf(fabsf(v.z), fabsf(v.w))); }
__device__ __forceinline__ void quant_rows(const float* __restrict__ src, unsigned char* __restrict__ dst, float* __restrict__ scl,
                                           int row0, int nrows, int gw, int nw) {
  const int lane = tid_opaque() & 63;
  for (int r = row0 + gw * 2; r < row0 + nrows; r += nw * 2) {
    const float4* s0 = (const float4*)(src + (size_t)r * 1024 + 16 * lane);
    const float4* s1 = (const float4*)(src + (size_t)(r + 1) * 1024 + 16 * lane);
    const float4 a0 = s0[0], a1 = s0[1], a2 = s0[2], a3 = s0[3];
    const float4 b0 = s1[0], b1 = s1[1], b2 = s1[2], b3 = s1[3];
    const float ma = wave_max(fmaxf(fmaxf(absmax4(a0), absmax4(a1)), fmaxf(absmax4(a2), absmax4(a3))));
    const float mb = wave_max(fmaxf(fmaxf(absmax4(b0), absmax4(b1)), fmaxf(absmax4(b2), absmax4(b3))));
    const float ia = ma > 0.f ? 127.f / ma : 0.f, ib = mb > 0.f ? 127.f / mb : 0.f;
    *(uint4*)(dst + (size_t)r * 1024 + 16 * lane) = make_uint4(quant4(a0, ia), quant4(a1, ia), quant4(a2, ia), quant4(a3, ia));
    *(uint4*)(dst + (size_t)(r + 1) * 1024 + 16 * lane) = make_uint4(quant4(b0, ib), quant4(b1, ib), quant4(b2, ib), quant4(b3, ib));
    if (lane == 0) { scl[r] = ma * (1.f / 127.f); scl[r + 1] = mb * (1.f / 127.f); }
  }
}
__device__ __forceinline__ int inproj_colmap(int n) {
  if (n < P_DSAQ) return n;
  if (n < P_DSAK) return C_DSAQ + (n - P_DSAQ);
  if (n < P_IDXQ) return C_DSAK + (n - P_DSAK);
  if (n < P_IDXK) return C_IDXQ + (n - P_IDXQ);
  if (n < P_MEMQ) return C_IDXK + (n - P_IDXK);
  if (n < P_GATE) return C_MEMQ + (n - P_MEMQ);
  if (n < P_IDXW) return C_GATE + (n - P_GATE);
  if (n < P_END) return C_IDXW + (n - P_IDXW);
  return -1;
}
template <bool PERM>
__device__ __forceinline__ void transpose_phase(const float* __restrict__ src, int lds_, bf16_t* __restrict__ dst, int K, int Nd,
                                unsigned char* smem, int bid, int nblk) {
  float (*t)[65] = (float (*)[65])smem;
  const int tx = threadIdx.x & 63, ty = threadIdx.x >> 6;
  const int tk = K / 64, tn = Nd / 64;
  for (int tile = bid; tile < tk * tn; tile += nblk) {
    const int k0 = (tile % tk) * 64, n0 = (tile / tk) * 64;
    const int nsrc = PERM ? inproj_colmap(n0 + tx) : (n0 + tx);
#pragma unroll
    for (int i = 0; i < 16; i++) {
      const int k = ty + 4 * i;
      t[tx][k] = (nsrc >= 0) ? src[(size_t)(k0 + k) * lds_ + nsrc] : 0.f;
    }
    __syncthreads();
#pragma unroll
    for (int i = 0; i < 16; i++) {
      const int n = ty + 4 * i;
      dst[(size_t)(n0 + n) * K + k0 + tx] = f2bf(t[n][tx]);
    }
    __syncthreads();
  }
}
__device__ __forceinline__ void subkey_phase(const float* __restrict__ src, bf16_t* __restrict__ dst, int bid, int nblk) {
  for (int i = bid * 256 + threadIdx.x; i < 128 * 128; i += nblk * 256) {
    const int n = i >> 7, pos = i & 127, g16 = pos & ~15, pp = pos & 15, h = pp >> 3, j = pp & 7;
    dst[i] = f2bf(src[n * 128 + g16 + 8 * (j >> 2) + 4 * h + (j & 3)]);
  }
}
__device__ __forceinline__ void rope_cs(int pos, float freq, float& c, float& s) {
  double ang = (double)pos * (double)freq;
  double rev = ang * 0.15915494309189535;
  rev -= floor(rev + 0.5);
  float r = (float)(rev * 6.283185307179586);
  c = __cosf(r); s = __sinf(r);
}
__device__ __forceinline__ void cs_phase(const Params& p, int bid, int nblk) {
  const float f16[8] = {1.0f, 0.19392274474868576f, 0.03760603093086393f, 0.007292664737217109f,
                        0.001414213562373095f, 0.0002742481756762073f, 5.318295896944988e-05f, 1.031338537721246e-05f};
  for (int i = bid * 256 + threadIdx.x; i < NT * 8; i += nblk * 256) {
    float c, s; rope_cs(p.pos[i >> 3], f16[i & 7], c, s);
    p.cs[i] = make_float2(c, s);
  }
}

template <int WM, int WN>
struct Gemm {
  static constexpr int BM = 64 * WM, BN = 64 * WN;
  static constexpr int A_BYTES = BM * 128, B_BYTES = BN * 128, STAGE = A_BYTES + B_BYTES;
  static constexpr int SMEM = 2 * STAGE;
  static constexpr int NA = BM / 32, NBK = BN / 32;

  struct Stage8 { uint4 a0, a1, a2, a3, b0, b1, b2, b3; };
  static __device__ __forceinline__ Stage8 ld_stage(const bf16_t* ap0, const bf16_t* ap1, const bf16_t* ap2, const bf16_t* ap3,
                                                    const bf16_t* bp0, const bf16_t* bp1, const bf16_t* bp2, const bf16_t* bp3, int ko) {
    Stage8 r;
    r.a0 = *(const uint4*)(ap0 + ko); r.a1 = *(const uint4*)(ap1 + ko);
    if (NA > 2) { r.a2 = *(const uint4*)(ap2 + ko); r.a3 = *(const uint4*)(ap3 + ko); } else { r.a2 = r.a0; r.a3 = r.a0; }
    r.b0 = *(const uint4*)(bp0 + ko); r.b1 = *(const uint4*)(bp1 + ko);
    if (NBK > 2) { r.b2 = *(const uint4*)(bp2 + ko); r.b3 = *(const uint4*)(bp3 + ko); } else { r.b2 = r.b0; r.b3 = r.b0; }
    return r;
  }
  static __device__ __forceinline__ void st_stage(const Stage8 r, unsigned char* dst, int wofs) {
    *(uint4*)(dst + wofs) = r.a0; *(uint4*)(dst + wofs + 4096) = r.a1;
    if (NA > 2) { *(uint4*)(dst + wofs + 8192) = r.a2; *(uint4*)(dst + wofs + 12288) = r.a3; }
    *(uint4*)(dst + A_BYTES + wofs) = r.b0; *(uint4*)(dst + A_BYTES + wofs + 4096) = r.b1;
    if (NBK > 2) { *(uint4*)(dst + A_BYTES + wofs + 8192) = r.b2; *(uint4*)(dst + A_BYTES + wofs + 12288) = r.b3; }
  }
  static __device__ __forceinline__ void compute_stage(f32x16 (&acc)[WM][WN], const unsigned char* cur, int wm, int wn, int fr, int fh) {
#pragma unroll
    for (int s = 0; s < 4; s++) {
      const int chunk = 2 * s + fh;
      bf16x8 af[WM], bfr[WN];
#pragma unroll
      for (int i = 0; i < WM; i++) {
        const int row = (wm * WM + i) * 32 + fr;
        af[i] = *(const bf16x8*)(cur + row * 128 + ((chunk ^ ((row >> 1) & 7)) << 4));
      }
#pragma unroll
      for (int j = 0; j < WN; j++) {
        const int row = (wn * WN + j) * 32 + fr;
        bfr[j] = *(const bf16x8*)(cur + A_BYTES + row * 128 + ((chunk ^ ((row >> 1) & 7)) << 4));
      }
#pragma unroll
      for (int i = 0; i < WM; i++)
#pragma unroll
        for (int j = 0; j < WN; j++) acc[i][j] = __builtin_amdgcn_mfma_f32_32x32x16_bf16(af[i], bfr[j], acc[i][j], 0, 0, 0);
    }
  }
  struct Pre { Stage8 rA, rB; };
  template <class ARow, class BRow>
  static __device__ __forceinline__ Pre prefetch(ARow arow, BRow brow, int tid) {
    const int lrow = tid >> 3, lchunk = tid & 7;
    const bf16_t* ap0 = arow(lrow) + lchunk * 8;
    const bf16_t* ap1 = arow(lrow + 32) + lchunk * 8;
    const bf16_t* ap2 = (NA > 2) ? arow(lrow + 64) + lchunk * 8 : ap0;
    const bf16_t* ap3 = (NA > 2) ? arow(lrow + 96) + lchunk * 8 : ap0;
    const bf16_t* bp0 = brow(lrow) + lchunk * 8;
    const bf16_t* bp1 = brow(lrow + 32) + lchunk * 8;
    const bf16_t* bp2 = (NBK > 2) ? brow(lrow + 64) + lchunk * 8 : bp0;
    const bf16_t* bp3 = (NBK > 2) ? brow(lrow + 96) + lchunk * 8 : bp0;
    Pre pre;
    pre.rA = ld_stage(ap0, ap1, ap2, ap3, bp0, bp1, bp2, bp3, 0);
    pre.rB = ld_stage(ap0, ap1, ap2, ap3, bp0, bp1, bp2, bp3, 64);
    return pre;
  }
  template <class ARow, class BRow>
  static __device__ __forceinline__ void mainloop_pre(f32x16 (&acc)[WM][WN], ARow arow, BRow brow, int K, unsigned char* smem, int tid, const Pre pre) {
    const int lane = tid & 63, w = tid >> 6, wm = w >> 1, wn = w & 1;
    const int lrow = tid >> 3, lchunk = tid & 7;
    const bf16_t* ap0 = arow(lrow) + lchunk * 8;
    const bf16_t* ap1 = arow(lrow + 32) + lchunk * 8;
    const bf16_t* ap2 = (NA > 2) ? arow(lrow + 64) + lchunk * 8 : ap0;
    const bf16_t* ap3 = (NA > 2) ? arow(lrow + 96) + lchunk * 8 : ap0;
    const bf16_t* bp0 = brow(lrow) + lchunk * 8;
    const bf16_t* bp1 = brow(lrow + 32) + lchunk * 8;
    const bf16_t* bp2 = (NBK > 2) ? brow(lrow + 64) + lchunk * 8 : bp0;
    const bf16_t* bp3 = (NBK > 2) ? brow(lrow + 96) + lchunk * 8 : bp0;
    const int wofs = lrow * 128 + ((lchunk ^ ((lrow >> 1) & 7)) << 4);
    const int fr = lane & 31, fh = lane >> 5;
    const int nk = K / 64;
    Stage8 rA = pre.rA;
    Stage8 rB = pre.rB;
    st_stage(rA, smem, wofs);
    rA = ld_stage(ap0, ap1, ap2, ap3, bp0, bp1, bp2, bp3, (nk > 2 ? 2 : 0) * 64);
    __syncthreads();
#pragma unroll 1
    for (int kt = 0; kt < nk; kt += 2) {
      compute_stage(acc, smem, wm, wn, fr, fh);
      st_stage(rB, smem + STAGE, wofs);
      if (kt + 3 < nk) rB = ld_stage(ap0, ap1, ap2, ap3, bp0, bp1, bp2, bp3, (kt + 3) * 64);
      __syncthreads();
      compute_stage(acc, smem + STAGE, wm, wn, fr, fh);
      if (kt + 2 < nk) {
        st_stage(rA, smem, wofs);
        if (kt + 4 < nk) rA = ld_stage(ap0, ap1, ap2, ap3, bp0, bp1, bp2, bp3, (kt + 4) * 64);
      }
      __syncthreads();
    }
  }
  template <class ARow, class BRow>
  static __device__ __forceinline__ void mainloop(f32x16 (&acc)[WM][WN], ARow arow, BRow brow, int K, unsigned char* smem, int tid = threadIdx.x) {
    const Pre pre = prefetch(arow, brow, tid);
    mainloop_pre(acc, arow, brow, K, smem, tid, pre);
  }
  template <class ARow, class BRow>
  static __device__ __forceinline__ Stage8 prefetch0(ARow arow, BRow brow, int tid) {
    const int lrow = tid >> 3, lchunk = tid & 7;
    const bf16_t* ap0 = arow(lrow) + lchunk * 8;
    const bf16_t* ap1 = arow(lrow + 32) + lchunk * 8;
    const bf16_t* ap2 = (NA > 2) ? arow(lrow + 64) + lchunk * 8 : ap0;
    const bf16_t* ap3 = (NA > 2) ? arow(lrow + 96) + lchunk * 8 : ap0;
    const bf16_t* bp0 = brow(lrow) + lchunk * 8;
    const bf16_t* bp1 = brow(lrow + 32) + lchunk * 8;
    const bf16_t* bp2 = (NBK > 2) ? brow(lrow + 64) + lchunk * 8 : bp0;
    const bf16_t* bp3 = (NBK > 2) ? brow(lrow + 96) + lchunk * 8 : bp0;
    return ld_stage(ap0, ap1, ap2, ap3, bp0, bp1, bp2, bp3, 0);
  }
  template <class ARow, class BRow>
  static __device__ __forceinline__ void mainloop_pre0(f32x16 (&acc)[WM][WN], ARow arow, BRow brow, int K, unsigned char* smem, int tid, const Stage8 r0) {
    const int lrow = tid >> 3, lchunk = tid & 7;
    const bf16_t* ap0 = arow(lrow) + lchunk * 8;
    const bf16_t* ap1 = arow(lrow + 32) + lchunk * 8;
    const bf16_t* ap2 = (NA > 2) ? arow(lrow + 64) + lchunk * 8 : ap0;
    const bf16_t* ap3 = (NA > 2) ? arow(lrow + 96) + lchunk * 8 : ap0;
    const bf16_t* bp0 = brow(lrow) + lchunk * 8;
    const bf16_t* bp1 = brow(lrow + 32) + lchunk * 8;
    const bf16_t* bp2 = (NBK > 2) ? brow(lrow + 64) + lchunk * 8 : bp0;
    const bf16_t* bp3 = (NBK > 2) ? brow(lrow + 96) + lchunk * 8 : bp0;
    Pre pre;
    pre.rA = r0;
    pre.rB = ld_stage(ap0, ap1, ap2, ap3, bp0, bp1, bp2, bp3, 64);
    mainloop_pre(acc, arow, brow, K, smem, tid, pre);
  }
};

__device__ __forceinline__ int perm16(int k) { return (k & ~12) | ((k & 4) << 1) | ((k & 8) >> 1); }
constexpr float LOG2E = 1.4426950408889634f;
constexpr int FL_TILE = 8192;
constexpr int FL_STAGE = 2 * FL_TILE;
struct FlashAcc {
  f32x16 o[2];
  float m, l;
};
__device__ __forceinline__ void flash_init(FlashAcc& a) {
#pragma unroll
  for (int i = 0; i < 2; i++)
#pragma unroll
    for (int r = 0; r < 16; r++) a.o[i][r] = 0.f;
  a.m = -INFINITY; a.l = 0.f;
}
struct Tile2 { uint4 a, b; };
template <class RowF>
__device__ __forceinline__ Tile2 tile_fetch(RowF rowp, int tid) {
  Tile2 t;
  t.a = *(const uint4*)(rowp(tid >> 3) + (tid & 7) * 8);
  t.b = *(const uint4*)(rowp((tid >> 3) + 32) + (tid & 7) * 8);
  return t;
}
template <class RowF>
__device__ __forceinline__ Tile2 tile_fetch(RowF rowp) { return tile_fetch(rowp, (int)threadIdx.x); }
__device__ __forceinline__ void tile_store(const Tile2& t, unsigned char* dst, int tid = threadIdx.x) {
  const int row = tid >> 3, ch = tid & 7;
  const int ofs = row * 128 + ((ch ^ ((row >> 1) & 7)) << 4);
  *(uint4*)(dst + ofs) = t.a;
  *(uint4*)(dst + ofs + 4096) = t.b;
}
__device__ __forceinline__ bf16x8 lds_frag(const unsigned char* tile, int row, int chunk) {
  return *(const bf16x8*)(tile + row * 128 + ((chunk ^ ((row >> 1) & 7)) << 4));
}
__device__ __forceinline__ void flash_qk(f32x16 (&s)[2], const unsigned char* ktile, const bf16x8 (&qf)[4], int lane = threadIdx.x & 63) {
  const int fr = lane & 31, fh = lane >> 5;
  bf16x8 kf[8];
#pragma unroll
  for (int kt = 0; kt < 2; kt++)
#pragma unroll
    for (int ks = 0; ks < 4; ks++) kf[kt * 4 + ks] = lds_frag(ktile, kt * 32 + fr, 2 * ks + fh);
  __builtin_amdgcn_sched_barrier(0);
#pragma unroll
  for (int kt = 0; kt < 2; kt++)
#pragma unroll
    for (int r = 0; r < 16; r++) s[kt][r] = 0.f;
#pragma unroll
  for (int ks = 0; ks < 4; ks++)
#pragma unroll
    for (int kt = 0; kt < 2; kt++) s[kt] = __builtin_amdgcn_mfma_f32_32x32x16_bf16(kf[kt * 4 + ks], qf[ks], s[kt], 0, 0, 0);
  asm volatile("" ::: "memory");
}
#define MAX3(a, b, c) __builtin_elementwise_maximum(__builtin_elementwise_maximum((a), (b)), (c))
__device__ __forceinline__ bf16x8 pack_frag(const f32x16& s, int half8) {
  uint4 u = {pack2bf(s[8 * half8 + 0], s[8 * half8 + 1]), pack2bf(s[8 * half8 + 2], s[8 * half8 + 3]),
             pack2bf(s[8 * half8 + 4], s[8 * half8 + 5]), pack2bf(s[8 * half8 + 6], s[8 * half8 + 7])};
  return __builtin_bit_cast(bf16x8, u);
}
__device__ __forceinline__ void flash_update(FlashAcc& a, f32x16 (&s)[2], const unsigned char* vtile, bool colvalid = true, int lane = threadIdx.x & 63) {
  const int fr = lane & 31, fh = lane >> 5;
  bf16x8 vf[8];
#pragma unroll
  for (int h8 = 0; h8 < 2; h8++)
#pragma unroll
    for (int dt = 0; dt < 2; dt++) vf[h8 * 2 + dt] = lds_frag(vtile, dt * 32 + fr, 2 * h8 + fh);
  __builtin_amdgcn_sched_barrier(0);
  float mx = MAX3(s[0][0], s[1][0], s[0][1]), mx2 = MAX3(s[1][1], s[0][2], s[1][2]);
#pragma unroll
  for (int r = 3; r < 15; r += 2) { mx = MAX3(mx, s[0][r], s[1][r]); mx2 = MAX3(mx2, s[0][r + 1], s[1][r + 1]); }
  mx = MAX3(mx, s[0][15], s[1][15]);
  mx = MAX3(mx, mx2, __shfl_xor(__builtin_elementwise_maximum(mx, mx2), 32));
  mx = colvalid ? mx : -INFINITY;
  const float mnew = __builtin_elementwise_maximum(a.m, mx);
  const float muse = (mnew == -INFINITY) ? 0.f : mnew;
  if (__any(mnew != a.m)) {
    const float alpha = __builtin_amdgcn_exp2f((a.m - muse) * LOG2E);
    a.l *= alpha;
#pragma unroll
    for (int dt = 0; dt < 2; dt++)
#pragma unroll
      for (int r = 0; r < 16; r++) a.o[dt][r] *= alpha;
    a.m = mnew;
  }
  const float cb = colvalid ? -muse * LOG2E : -INFINITY;
#pragma unroll
  for (int r = 0; r < 16; r++) {
    s[0][r] = __builtin_amdgcn_exp2f(fmaf(s[0][r], LOG2E, cb));
    s[1][r] = __builtin_amdgcn_exp2f(fmaf(s[1][r], LOG2E, cb));
  }
  {
    f32x2 sm2 = {0.f, 0.f};
#pragma unroll
    for (int r = 0; r < 16; r += 2) {
      const f32x2 u0 = {s[0][r], s[0][r + 1]}, u1 = {s[1][r], s[1][r + 1]};
      sm2 += u0; sm2 += u1;
    }
    a.l += sm2[0] + sm2[1];
  }
#pragma unroll
  for (int h8 = 0; h8 < 2; h8++)
#pragma unroll
    for (int dt = 0; dt < 2; dt++) vf[4 + h8 * 2 + dt] = lds_frag(vtile, dt * 32 + fr, 4 + 2 * h8 + fh);
  __builtin_amdgcn_sched_barrier(0);
#pragma unroll
  for (int kt = 0; kt < 2; kt++)
#pragma unroll
    for (int h8 = 0; h8 < 2; h8++) {
      const bf16x8 pf = pack_frag(s[kt], h8);
#pragma unroll
      for (int dt = 0; dt < 2; dt++)
        a.o[dt] = __builtin_amdgcn_mfma_f32_32x32x16_bf16(vf[(kt * 2 + h8) * 2 + dt], pf, a.o[dt], 0, 0, 0);
    }
}
__device__ __forceinline__ float flash_inv_l(const FlashAcc& a) {
  const float lt = a.l + __shfl_xor(a.l, 32);
  return lt > 0.f ? 1.f / lt : 0.f;
}
__device__ __forceinline__ void flash_load_q(bf16x8 (&qf)[4], const bf16_t* qrow, float scale, int lane = threadIdx.x & 63) {
  const int fh = lane >> 5;
#pragma unroll
  for (int ks = 0; ks < 4; ks++) {
    const uint4 u = *(const uint4*)(qrow + ks * 16 + fh * 8);
    const unsigned w[4] = {u.x, u.y, u.z, u.w};
    uint4 o;
    o.x = pack2bf(__uint_as_float(w[0] << 16) * scale, __uint_as_float(w[0] & 0xFFFF0000u) * scale);
    o.y = pack2bf(__uint_as_float(w[1] << 16) * scale, __uint_as_float(w[1] & 0xFFFF0000u) * scale);
    o.z = pack2bf(__uint_as_float(w[2] << 16) * scale, __uint_as_float(w[2] & 0xFFFF0000u) * scale);
    o.w = pack2bf(__uint_as_float(w[3] << 16) * scale, __uint_as_float(w[3] & 0xFFFF0000u) * scale);
    qf[ks] = __builtin_bit_cast(bf16x8, o);
  }
}
__device__ __forceinline__ void flash_store_o(const FlashAcc& a, bf16_t* orow, float scale, int lane = threadIdx.x & 63) {
  const int fh = lane >> 5;
#pragma unroll
  for (int dt = 0; dt < 2; dt++)
#pragma unroll
    for (int g4 = 0; g4 < 4; g4++) {
      uint2 o = {pack2bf(a.o[dt][4 * g4 + 0] * scale, a.o[dt][4 * g4 + 1] * scale),
                 pack2bf(a.o[dt][4 * g4 + 2] * scale, a.o[dt][4 * g4 + 3] * scale)};
      *(uint2*)(orow + dt * 32 + 8 * g4 + 4 * fh) = o;
    }
}

__device__ __forceinline__ void mem_flash_item(const Params& p, unsigned char* smem, int item) {
  const int tid = tid_opaque(), lane = tid & 63, w = tid >> 6, fr = lane & 31;
  const int chunk = item & 31, h = (item >> 5) & 3, b = item >> 7;
  const int tok = b * SEQ + chunk * 128 + w * 32 + fr;
  bf16x8 qf[4];
  flash_load_q(qf, p.memq + (size_t)tok * 256 + h * 64, 0.125f, lane);
  FlashAcc acc; flash_init(acc);
  const bf16_t* kbase = p.mkv + (size_t)b * MEML * 512 + h * 64;
  const bf16_t* vbase = p.memvt + (size_t)(b * 4 + h) * 64 * MEML;
  Tile2 rk = tile_fetch([&](int r) { return kbase + (size_t)r * 512; }, tid);
  Tile2 rv = tile_fetch([&](int r) { return vbase + (size_t)r * MEML; }, tid);
  __syncthreads();
  tile_store(rk, smem, tid); tile_store(rv, smem + FL_TILE, tid);
  __syncthreads();
#pragma unroll 1
  for (int kb = 0; kb < 4; kb++) {
    unsigned char* cur = smem + (kb & 1) * FL_STAGE;
    if (kb + 1 < 4) {
      rk = tile_fetch([&](int r) { return kbase + (size_t)((kb + 1) * 64 + r) * 512; }, tid);
      rv = tile_fetch([&](int r) { return vbase + (size_t)r * MEML + (kb + 1) * 64; }, tid);
    }
    {
      f32x16 s[2];
      flash_qk(s, cur, qf, lane);
      flash_update(acc, s, cur + FL_TILE, true, lane);
    }
    if (kb + 1 < 4) { unsigned char* nxt = smem + ((kb + 1) & 1) * FL_STAGE; tile_store(rk, nxt, tid); tile_store(rv, nxt + FL_TILE, tid); }
    __syncthreads();
  }
  flash_store_o(acc, p.concat + (size_t)tok * DM + 768 + h * 64, flash_inv_l(acc), lane);
}
__device__ __forceinline__ void mem_phase(const Params& p, unsigned char* smem, int bid, int nblk) {
  for (int item = bid; item < NB * 4 * 32; item += nblk) mem_flash_item(p, smem, item);
}

__device__ __forceinline__ void ovp_phase(const Params& p, int bid, int nblk) {
  for (int i = bid * 256 + threadIdx.x; i < 64 * 256; i += nblk * 256) {
    const int m = i >> 8, n = i & 255;
    int ov = min(16 * n + 32, 64 * m + 64) - max(16 * n, 64 * m);
    if (ov < 0 || n >= NC) ov = 0;
    p.ovp[m * 256 + perm16(n)] = f2bf((float)ov * (1.f / 32.f));
  }
}

struct TileDest { bf16_t* ptr; int stride; int kind; };
__device__ __forceinline__ TileDest inproj_dest(const Params& p, int cb, int b) {
  TileDest d; d.kind = 0;
  if (cb < P_NSAKV) { d.ptr = p.qn + cb; d.stride = 512; d.kind = ((cb & 63) == 0) ? 1 : 0; }
  else if (cb < P_DSAQ) {
    const int o = cb - P_NSAKV, j = o >> 7, g = (o >> 6) & 1;
    if (j == 3 || j == 5) {
      d.ptr = (j == 3 ? p.vslct : p.vwint) + ((size_t)(b * 2 + g) * 64 + (o & 63)) * SEQ; d.stride = 0; d.kind = 5;
    } else {
      bf16_t* base = (j == 0) ? p.kvn[0] : (j == 1) ? p.kvn[1] : (j == 2) ? p.kvn[2] : p.kvn[4];
      d.ptr = base + ((size_t)g * SEQ + (size_t)b * SEQ) * 64 + (o & 63); d.stride = 64;
      d.kind = (((j & 1) == 0) && ((o & 63) == 0)) ? 1 : 0;
    }
  }
  else if (cb < P_DSAK) { d.ptr = p.qd + (cb - P_DSAQ); d.stride = 256; d.kind = ((cb & 63) == 0) ? 1 : 0; }
  else if (cb < P_DSAV) { d.ptr = p.kd + (cb - P_DSAK); d.stride = 64; d.kind = (cb == P_DSAK) ? 1 : 0; }
  else if (cb < P_IDXQ) { d.ptr = p.vd + (cb - P_DSAV); d.stride = 64; }
  else if (cb < P_IDXK) { d.ptr = p.qi + (cb - P_IDXQ); d.stride = 256; d.kind = 2; }
  else if (cb < P_MEMQ) { d.ptr = p.ki; d.stride = 32; d.kind = 2; }
  else if (cb < P_GATE) { d.ptr = p.memq + (cb - P_MEMQ); d.stride = 256; }
  else if (cb < P_END) { d.ptr = nullptr; d.stride = 0; d.kind = 3; }
  else { d.ptr = nullptr; d.stride = 0; d.kind = 4; }
  return d;
}
__device__ __forceinline__ void inproj_phase(const Params& p, unsigned char* smem, int bid, int nblk) {
  typedef Gemm<2, 2> G;
  const int lane = threadIdx.x & 63, w = threadIdx.x >> 6, wm = w >> 1, wn = w & 1;
  const int c = lane & 31, fh = lane >> 5;
  constexpr int TN = INWP / 128, TM = NT / 128;
  for (int tile = bid; tile < TM * TN; tile += nblk) {
    f32x16 acc[2][2];
#pragma unroll
    for (int i = 0; i < 2; i++)
#pragma unroll
      for (int j = 0; j < 2; j++)
#pragma unroll
        for (int r = 0; r < 16; r++) acc[i][j][r] = 0.f;
    {
      const int m0 = (tile / TN) * 128, n0 = (tile % TN) * 128;
      const bf16_t* A = p.xb + (size_t)m0 * DM;
      const bf16_t* Bt = p.wint + (size_t)n0 * DM;
      G::mainloop(acc, [&](int r) { return A + (size_t)r * DM; }, [&](int r) { return Bt + (size_t)r * DM; }, DM, smem);
      const int b = m0 / SEQ;
      unsigned char* wt = smem + w * 9216;
      const TileDest d0 = inproj_dest(p, n0 + (wn * 2 + 0) * 32, b);
      const TileDest d1 = inproj_dest(p, n0 + (wn * 2 + 1) * 32, b);
#pragma unroll
      for (int j = 0; j < 2; j++) {
        const TileDest d = j ? d1 : d0;
        if (d.kind == 4) continue;
        if (d.kind == 5) {
#pragma unroll
          for (int i = 0; i < 2; i++)
#pragma unroll
            for (int g4 = 0; g4 < 4; g4++) {
              const int tloc = (m0 & (SEQ - 1)) + (wm * 2 + i) * 32 + 8 * g4 + 4 * fh;
              uint2 o = {pack2bf(acc[i][j][4 * g4 + 0], acc[i][j][4 * g4 + 1]), pack2bf(acc[i][j][4 * g4 + 2], acc[i][j][4 * g4 + 3])};
              *(uint2*)(d.ptr + (size_t)c * SEQ + perm16(tloc)) = o;
            }
          continue;
        }
        if (d.kind == 3) {
#pragma unroll
          for (int i = 0; i < 2; i++)
#pragma unroll
            for (int r = 0; r < 16; r++) {
              const int tok = m0 + (wm * 2 + i) * 32 + (r & 3) + 8 * (r >> 2) + 4 * fh;
              const float v = acc[i][j][r];
              if (c < 24) p.gates[(size_t)tok * 24 + c] = 1.f / (1.f + __expf(-v));
              else p.widx[(size_t)tok * 8 + (c - 24)] = v * 0.0625f;
            }
          continue;
        }
#pragma unroll
        for (int i = 0; i < 2; i++) {
#pragma unroll
          for (int r = 0; r < 16; r++) {
            const int tok = m0 + (wm * 2 + i) * 32 + (r & 3) + 8 * (r >> 2) + 4 * fh;
            float v = acc[i][j][r];
            if (d.kind == 1) {
              const float pv = __shfl_xor(v, 8);
              if (c < 16) {
                const float2 cs = p.cs[(size_t)tok * 8 + (c & 7)];
                v = (c & 8) ? (v * cs.x + pv * cs.y) : (v * cs.x - pv * cs.y);
              }
            } else if (d.kind == 2) {
              const float pv = __shfl_xor(v, 4);
              if (c < 8) {
                const float2 cs = p.cs[(size_t)tok * 8 + 2 * (c & 3)];
                v = (c & 4) ? (v * cs.x + pv * cs.y) : (v * cs.x - pv * cs.y);
              }
            }
            acc[i][j][r] = v;
          }
#pragma unroll
          for (int r = 0; r < 16; r += 2) {
            const float va = acc[i][j][r], vb = acc[i][j][r + 1];
            const float na = __builtin_bit_cast(float, __builtin_amdgcn_update_dpp(0, __builtin_bit_cast(int, va), 0xB1, 0xF, 0xF, true));
            const float nb = __builtin_bit_cast(float, __builtin_amdgcn_update_dpp(0, __builtin_bit_cast(int, vb), 0xB1, 0xF, 0xF, true));
            const bool odd = c & 1;
            const unsigned pk = pack2bf(odd ? nb : va, odd ? vb : na);
            const int row = i * 32 + (r & 3) + 8 * (r >> 2) + 4 * fh + (odd ? 1 : 0);
            *(unsigned*)(wt + row * 144 + j * 64 + (c & ~1) * 2) = pk;
          }
        }
      }
      __builtin_amdgcn_wave_barrier();
      {
        const int chunk = lane & 7, jt = chunk >> 2;
        const TileDest d = jt ? d1 : d0;
        if (d.kind <= 2) {
#pragma unroll
          for (int it = 0; it < 8; it++) {
            const int row = it * 8 + (lane >> 3);
            const uint4 v = *(const uint4*)(wt + row * 144 + chunk * 16);
            const int tok = m0 + wm * 64 + row;
            *(uint4*)(d.ptr + (size_t)tok * d.stride + (chunk & 3) * 8) = v;
          }
        }
      }
      __syncthreads();
    }
  }
}

__device__ __forceinline__ void memkv_phase(const Params& p, unsigned char* smem, int bid, int nblk) {
  typedef Gemm<2, 2> G;
  const int lane = threadIdx.x & 63, w = threadIdx.x >> 6, wm = w >> 1, wn = w & 1;
  const int c = lane & 31, fh = lane >> 5;
  constexpr int TN2 = 512 / 128, TM2 = NB * MEML / 128;
  for (int t2 = bid; t2 < TM2 * TN2; t2 += nblk) {
    f32x16 acc[2][2];
#pragma unroll
    for (int i = 0; i < 2; i++)
#pragma unroll
      for (int j = 0; j < 2; j++)
#pragma unroll
        for (int r = 0; r < 16; r++) acc[i][j][r] = 0.f;
    {
      const int m0 = (t2 / TN2) * 128, n0 = (t2 % TN2) * 128;
      const bf16_t* A = p.memb + (size_t)m0 * DM;
      const bf16_t* Bt = p.wmemt + (size_t)n0 * DM;
      G::mainloop(acc, [&](int r) { return A + (size_t)r * DM; }, [&](int r) { return Bt + (size_t)r * DM; }, DM, smem);
#pragma unroll
      for (int i = 0; i < 2; i++)
#pragma unroll
        for (int j = 0; j < 2; j++)
          {
            const int cb = n0 + (wn * 2 + j) * 32;
            if (cb < 256) {
#pragma unroll
              for (int r = 0; r < 16; r++) {
                const int row = m0 + (wm * 2 + i) * 32 + (r & 3) + 8 * (r >> 2) + 4 * fh;
                p.mkv[(size_t)row * 512 + cb + c] = f2bf(acc[i][j][r]);
              }
            } else {
              const int dfull = cb + c - 256, head = dfull >> 6, d = dfull & 63;
              const int rowb = m0 + (wm * 2 + i) * 32, b = rowb >> 8, ml = rowb & 255;
              bf16_t* vrow = p.memvt + ((size_t)(b * 4 + head) * 64 + d) * MEML;
#pragma unroll
              for (int g4 = 0; g4 < 4; g4++) {
                uint2 o = {pack2bf(acc[i][j][4 * g4 + 0], acc[i][j][4 * g4 + 1]), pack2bf(acc[i][j][4 * g4 + 2], acc[i][j][4 * g4 + 3])};
                *(uint2*)(vrow + perm16(ml + 8 * g4 + 4 * fh)) = o;
              }
            }
          }
    }
  }
}

__device__ __forceinline__ unsigned f2key(float f) {
  unsigned u = __float_as_uint(f);
  return (u & 0x80000000u) ? ~u : (u | 0x80000000u);
}
__device__ __forceinline__ float key2f(unsigned k) {
  return __uint_as_float((k & 0x80000000u) ? (k ^ 0x80000000u) : ~k);
}
#define CE_DESC(a, b) { const unsigned _h = max(a, b); const unsigned _l = min(a, b); a = _h; b = _l; }
__device__ __forceinline__ void bitonic_merge16(unsigned (&m)[16]) {
#pragma unroll
  for (int st = 8; st >= 1; st >>= 1)
#pragma unroll
    for (int k = 0; k < 16; k++)
      if ((k & st) == 0) CE_DESC(m[k], m[k + st]);
}
__device__ __forceinline__ void sort16_desc(unsigned (&m)[16]) {
#pragma unroll
  for (int k = 2; k <= 16; k <<= 1)
#pragma unroll
    for (int j = k >> 1; j >= 1; j >>= 1)
#pragma unroll
      for (int i = 0; i < 16; i++) {
        const int l = i ^ j;
        if (l > i) {
          if ((i & k) == 0) { CE_DESC(m[i], m[l]); }
          else { const unsigned _h = max(m[i], m[l]); const unsigned _l = min(m[i], m[l]); m[i] = _l; m[l] = _h; }
        }
      }
}
__device__ __forceinline__ void insert16(unsigned (&L)[16], unsigned x) {
#pragma unroll
  for (int k = 0; k < 16; k++) { const unsigned hi = max(L[k], x); x = min(L[k], x); L[k] = hi; }
}
__device__ __forceinline__ void merge4_lists(unsigned (&L)[16], unsigned* lists, int t, int q) {
#pragma unroll
  for (int k = 0; k < 16; k++) lists[(q * 16 + k) * 64 + t] = L[k];
  __syncthreads();
  if (q < 2) {
#pragma unroll
    for (int k = 0; k < 16; k++) L[k] = max(lists[((2 * q) * 16 + k) * 64 + t], lists[((2 * q + 1) * 16 + 15 - k) * 64 + t]);
    bitonic_merge16(L);
#pragma unroll
    for (int k = 0; k < 16; k++) lists[((2 * q) * 16 + k) * 64 + t] = L[k];
  }
  __syncthreads();
  if (q == 0) {
#pragma unroll
    for (int k = 0; k < 16; k++) L[k] = max(L[k], lists[(2 * 16 + 15 - k) * 64 + t]);
    bitonic_merge16(L);
  }
}
__device__ __forceinline__ float dpp_rowsum(float x) {
  x += __builtin_bit_cast(float, __builtin_amdgcn_update_dpp(0, __builtin_bit_cast(int, x), 0xB1, 0xF, 0xF, true));
  x += __builtin_bit_cast(float, __builtin_amdgcn_update_dpp(0, __builtin_bit_cast(int, x), 0x4E, 0xF, 0xF, true));
  x += __builtin_bit_cast(float, __builtin_amdgcn_update_dpp(0, __builtin_bit_cast(int, x), 0x141, 0xF, 0xF, true));
  x += __builtin_bit_cast(float, __builtin_amdgcn_update_dpp(0, __builtin_bit_cast(int, x), 0x140, 0xF, 0xF, true));
  return x;
}
__device__ __forceinline__ float readlane_f(float v, int l) {
  return __int_as_float(__builtin_amdgcn_readlane(__float_as_int(v), l));
}
__device__ __forceinline__ float wave_sum_uniform(float x) {
  x = dpp_rowsum(x);
  return (readlane_f(x, 0) + readlane_f(x, 16)) + (readlane_f(x, 32) + readlane_f(x, 48));
}
__device__ __forceinline__ float dot8_bf16(const uint4& a, const uint4& b, float acc) {
  acc = __builtin_amdgcn_fdot2_f32_bf16(__builtin_bit_cast(bf16x2, a.x), __builtin_bit_cast(bf16x2, b.x), acc, false);
  acc = __builtin_amdgcn_fdot2_f32_bf16(__builtin_bit_cast(bf16x2, a.y), __builtin_bit_cast(bf16x2, b.y), acc, false);
  acc = __builtin_amdgcn_fdot2_f32_bf16(__builtin_bit_cast(bf16x2, a.z), __builtin_bit_cast(bf16x2, b.z), acc, false);
  acc = __builtin_amdgcn_fdot2_f32_bf16(__builtin_bit_cast(bf16x2, a.w), __builtin_bit_cast(bf16x2, b.w), acc, false);
  return acc;
}
__device__ __forceinline__ void fma8_bf16(float (&y)[8], const uint4& v, float w) {
  y[0] = fmaf(w, __uint_as_float(v.x << 16), y[0]); y[1] = fmaf(w, __uint_as_float(v.x & 0xFFFF0000u), y[1]);
  y[2] = fmaf(w, __uint_as_float(v.y << 16), y[2]); y[3] = fmaf(w, __uint_as_float(v.y & 0xFFFF0000u), y[3]);
  y[4] = fmaf(w, __uint_as_float(v.z << 16), y[4]); y[5] = fmaf(w, __uint_as_float(v.z & 0xFFFF0000u), y[5]);
  y[6] = fmaf(w, __uint_as_float(v.w << 16), y[6]); y[7] = fmaf(w, __uint_as_float(v.w & 0xFFFF0000u), y[7]);
}
__device__ const unsigned char cand_tab[52] = {
  0x00,0x01,0x02,0x03,0x04,0x05,0x06,0x07,0x08,0x09,0x0A,0x0B,0x0C,0x0D,0x0E,0x0F,
  0x10,0x11,0x12,0x13,0x14,0x15,0x16,0x17,
  0x20,0x21,0x22,0x23,0x24,
  0x30,0x31,0x32,0x33,
  0x40,0x41,0x42,
  0x50,0x51, 0x60,0x61, 0x70,0x71,
  0x80,0x90,0xA0,0xB0,0xC0,0xD0,0xE0,0xF0, 0xF0,0xF0};

__device__ __forceinline__ f16x2 bytes01_h2(unsigned w) { return __builtin_bit_cast(f16x2, __builtin_amdgcn_perm(w, 0x64646464u, 0x00050004u)); }
__device__ __forceinline__ f16x2 bytes23_h2(unsigned w) { return __builtin_bit_cast(f16x2, __builtin_amdgcn_perm(w, 0x64646464u, 0x00070006u)); }
template <int CTRL>
__device__ __forceinline__ float dpp_get(float x) {
  return __builtin_bit_cast(float, __builtin_amdgcn_update_dpp(0, __builtin_bit_cast(int, x), CTRL, 0xF, 0xF, true));
}
__device__ __forceinline__ float reduce16x16(const float (&ps)[16]) {
  const int lane = threadIdx.x & 63;
  const bool b0 = lane & 1, b1 = lane & 2, b2 = lane & 4, b3 = lane & 8;
  float r1[8], r2[4], r3[2];
#pragma unroll
  for (int i = 0; i < 8; i++) {
    const float u = ps[2 * i] + dpp_get<0xB1>(ps[2 * i]), v = ps[2 * i + 1] + dpp_get<0xB1>(ps[2 * i + 1]);
    r1[i] = b0 ? v : u;
  }
#pragma unroll
  for (int i = 0; i < 4; i++) {
    const float u = r1[2 * i] + dpp_get<0x4E>(r1[2 * i]), v = r1[2 * i + 1] + dpp_get<0x4E>(r1[2 * i + 1]);
    r2[i] = b1 ? v : u;
  }
#pragma unroll
  for (int i = 0; i < 2; i++) {
    const float u = r2[2 * i] + dpp_get<0x104>(r2[2 * i]);
    const float v = r2[2 * i + 1] + dpp_get<0x114>(r2[2 * i + 1]);
    r3[i] = b2 ? v : u;
  }
  const float u = r3[0] + dpp_get<0x128>(r3[0]), v = r3[1] + dpp_get<0x128>(r3[1]);
  float r = b3 ? v : u;
  r += __int_as_float(__builtin_amdgcn_ds_swizzle(__float_as_int(r), 0x401F));
  r += __shfl_xor(r, 32);
  return r;
}
constexpr int PE_EXPERT_DEPTH = 8;

__device__ __forceinline__ void peer_block_phase(const Params& p, unsigned char* smem, int bid, int nblk) {
  const int tid = tid_opaque(), lane = tid & 63, w = tid >> 6, wm = w >> 1, wn = w & 1;
  const int c = lane & 31, fh = lane >> 5;
  float* S = (float*)smem;
  unsigned* lists = (unsigned*)(smem + 32768);
  unsigned* ablist = (unsigned*)(smem + 49152);
  int* fin_e = (int*)(smem + 57344);
  float* fin_g = (float*)(smem + 57344 + 4096);
  for (int blk = bid; blk < NT / 64; blk += nblk) {
    const int t0 = blk * 64;
    {
      typedef Gemm<1, 2> G1;
      const int tid_e1 = tid_opaque();
      const bf16_t* A = p.concat + (size_t)t0 * DM;
      auto arow = [&](int r) __attribute__((always_inline)) { return A + (size_t)r * DM; };
      G1::Pre pre = G1::prefetch(arow, [&](int r) __attribute__((always_inline)) { return p.woutt + (size_t)r * DM; }, tid_e1);
#pragma unroll 1
      for (int nt = 0; nt < 8; nt++) {
        f32x16 acc[1][2];
#pragma unroll
        for (int j = 0; j < 2; j++)
#pragma unroll
          for (int r = 0; r < 16; r++) acc[0][j][r] = 0.f;
        const bf16_t* Bt = p.woutt + (size_t)nt * 128 * DM;
        G1::mainloop_pre(acc, arow, [&](int r) __attribute__((always_inline)) { return Bt + (size_t)r * DM; }, DM, smem, tid_e1, pre);
        {
          const int tq = tid_opaque(), lq = tq & 63, wq_ = tq >> 6;
          const unsigned ebase = (unsigned)(t0 + (wq_ >> 1) * 32 + 4 * (lq >> 5)) * DM + nt * 128 + (wq_ & 1) * 64 + (lq & 31);
          float xr[2][16];
#pragma unroll
          for (int j = 0; j < 2; j++)
#pragma unroll
            for (int r = 0; r < 16; r++) xr[j][r] = p.x[ebase + (unsigned)(((r & 3) + 8 * (r >> 2)) * DM + j * 32)];
          asm volatile("" ::: "memory");
          if (nt + 1 < 8) {
            const bf16_t* Bn = p.woutt + (size_t)(nt + 1) * 128 * DM;
            pre = G1::prefetch(arow, [&](int r) __attribute__((always_inline)) { return Bn + (size_t)r * DM; }, tid_e1);
          }
#pragma unroll
          for (int j = 0; j < 2; j++) {
#pragma unroll
            for (int r = 0; r < 16; r++) {
              const unsigned idx = ebase + (unsigned)(((r & 3) + 8 * (r >> 2)) * DM + j * 32);
              p.out[idx] = acc[0][j][r] + ALPHA * xr[j][r];
            }
          }
        }
      }
    }
    __syncthreads();
    const int tl1 = tid_opaque(), lane1 = tl1 & 63, w1 = tl1 >> 6;
    bf16_t* x1bo = p.x1b; bf16_t* xbo = p.xb;
    {
      float* rowb = p.out + (size_t)(t0 + w1 * 16) * DM + 8 * lane1;
      float4 n0 = *(const float4*)(rowb), n1 = *(const float4*)(rowb + 4), n2 = *(const float4*)(rowb + 512), n3 = *(const float4*)(rowb + 516);
#pragma unroll 1
      for (int rr = 0; rr < 16; rr++) {
        const int tok = t0 + w1 * 16 + rr;
        float* row = p.out + (size_t)tok * DM;
        float v[16];
        v[0] = n0.x; v[1] = n0.y; v[2] = n0.z; v[3] = n0.w; v[4] = n1.x; v[5] = n1.y; v[6] = n1.z; v[7] = n1.w;
        v[8] = n2.x; v[9] = n2.y; v[10] = n2.z; v[11] = n2.w; v[12] = n3.x; v[13] = n3.y; v[14] = n3.z; v[15] = n3.w;
        {
          const float* nx = rowb + (size_t)min(rr + 1, 15) * DM;
          n0 = *(const float4*)(nx); n1 = *(const float4*)(nx + 4); n2 = *(const float4*)(nx + 512); n3 = *(const float4*)(nx + 516);
        }
        const float4 ga0 = *(const float4*)(p.ln1g + 8 * lane1), ga1 = *(const float4*)(p.ln1g + 8 * lane1 + 4);
        const float4 ga2 = *(const float4*)(p.ln1g + 512 + 8 * lane1), ga3 = *(const float4*)(p.ln1g + 512 + 8 * lane1 + 4);
        const float4 be0 = *(const float4*)(p.ln1b + 8 * lane1), be1 = *(const float4*)(p.ln1b + 8 * lane1 + 4);
        const float4 be2 = *(const float4*)(p.ln1b + 512 + 8 * lane1), be3 = *(const float4*)(p.ln1b + 512 + 8 * lane1 + 4);
        float s = 0.f;
#pragma unroll
        for (int i = 0; i < 16; i++) s += v[i];
        const float mu = wave_sum(s) * (1.f / DM);
        float qv = 0.f;
#pragma unroll
        for (int i = 0; i < 16; i++) { v[i] -= mu; qv += v[i] * v[i]; }
        const float rs = rsqrtf(wave_sum(qv) * (1.f / DM) + 1e-5f);
#pragma unroll
        for (int hf = 0; hf < 2; hf++) {
          const int e0 = hf * 512 + 8 * lane1;
          const float4 g0 = hf ? ga2 : ga0, g1 = hf ? ga3 : ga1, b0 = hf ? be2 : be0, b1 = hf ? be3 : be1;
          float o[8];
          o[0] = v[hf * 8 + 0] * rs * g0.x + b0.x; o[1] = v[hf * 8 + 1] * rs * g0.y + b0.y;
          o[2] = v[hf * 8 + 2] * rs * g0.z + b0.z; o[3] = v[hf * 8 + 3] * rs * g0.w + b0.w;
          o[4] = v[hf * 8 + 4] * rs * g1.x + b1.x; o[5] = v[hf * 8 + 5] * rs * g1.y + b1.y;
          o[6] = v[hf * 8 + 6] * rs * g1.z + b1.z; o[7] = v[hf * 8 + 7] * rs * g1.w + b1.w;
          *(float4*)(row + e0) = make_float4(o[0], o[1], o[2], o[3]);
          *(float4*)(row + e0 + 4) = make_float4(o[4], o[5], o[6], o[7]);
          uint4 pk = {pack2bf(o[0], o[1]), pack2bf(o[2], o[3]), pack2bf(o[4], o[5]), pack2bf(o[6], o[7])};
          *(uint4*)(x1bo + (size_t)tok * DM + e0) = pk;
          const f16x2 h0 = {(_Float16)o[0], (_Float16)o[1]}, h1 = {(_Float16)o[2], (_Float16)o[3]};
          const f16x2 h2 = {(_Float16)o[4], (_Float16)o[5]}, h3 = {(_Float16)o[6], (_Float16)o[7]};
          uint4 ph = {__builtin_bit_cast(unsigned, h0), __builtin_bit_cast(unsigned, h1), __builtin_bit_cast(unsigned, h2), __builtin_bit_cast(unsigned, h3)};
          *(uint4*)(xbo + (size_t)tok * DM + e0) = ph;
        }
      }
    }
    __syncthreads();
    const int tid2 = tid_opaque();
    const int ts = tid2 & 63, qs = tid2 >> 6;
    typedef Gemm<2, 1> G2;
    const bf16_t* wq0 = p.wqt;
    const bf16_t* Bt = p.x1b + (size_t)t0 * DM;
    auto brow2 = [&](int r) __attribute__((always_inline)) { return Bt + (size_t)r * DM; };
    G2::Stage8 pre2 = G2::prefetch0([&](int r) __attribute__((always_inline)) { return wq0 + (size_t)r * DM; }, brow2, tid2);
#pragma unroll 1
    for (int hh = 0; hh < 8; hh++) {
#pragma unroll 1
      for (int half = 0; half < 2; half++) {
        f32x16 acc[2][1];
#pragma unroll
        for (int i = 0; i < 2; i++)
#pragma unroll
          for (int r = 0; r < 16; r++) acc[i][0][r] = 0.f;
        const bf16_t* A = wq0 + (size_t)(hh * 256 + half * 128) * DM;
        G2::mainloop_pre0(acc, [&](int r) __attribute__((always_inline)) { return A + (size_t)r * DM; }, brow2, DM, smem, tid2, pre2);
        if (hh * 2 + half + 1 < 16) {
          const bf16_t* An = A + (size_t)128 * DM;
          pre2 = G2::prefetch0([&](int r) __attribute__((always_inline)) { return An + (size_t)r * DM; }, brow2, tid2);
        }
        const bf16_t* skp = half ? p.sk2p : p.sk1p;
        auto score_part = [&](const bool add) __attribute__((always_inline)) {
#pragma unroll
          for (int np = 0; np < 2; np++) {
            f32x16 sp[2];
#pragma unroll
            for (int nn = 0; nn < 2; nn++)
#pragma unroll
              for (int r = 0; r < 16; r++) sp[nn][r] = 0.f;
#pragma unroll
            for (int i = 0; i < 2; i++)
#pragma unroll
              for (int s2 = 0; s2 < 2; s2++) {
                uint4 qb = {pack2bf(acc[i][0][8 * s2 + 0], acc[i][0][8 * s2 + 1]), pack2bf(acc[i][0][8 * s2 + 2], acc[i][0][8 * s2 + 3]),
                            pack2bf(acc[i][0][8 * s2 + 4], acc[i][0][8 * s2 + 5]), pack2bf(acc[i][0][8 * s2 + 6], acc[i][0][8 * s2 + 7])};
                const bf16x8 qf = __builtin_bit_cast(bf16x8, qb);
#pragma unroll
                for (int nn = 0; nn < 2; nn++) {
                  const bf16x8 kf = *(const bf16x8*)(skp + (size_t)((np * 2 + nn) * 32 + c) * 128 + wm * 64 + i * 32 + s2 * 16 + fh * 8);
                  sp[nn] = __builtin_amdgcn_mfma_f32_32x32x16_bf16(kf, qf, sp[nn], 0, 0, 0);
                }
              }
#pragma unroll
            for (int nn = 0; nn < 2; nn++)
#pragma unroll
              for (int r = 0; r < 16; r++) {
                float* dst = S + ((np * 2 + nn) * 32 + (r & 3) + 8 * (r >> 2) + 4 * fh) * 64 + wn * 32 + c;
                if (add) *dst += sp[nn][r]; else *dst = sp[nn][r];
              }
            asm volatile("" ::: "memory");
          }
        };
        if (wm == 0) score_part(false);
        __syncthreads();
        if (wm == 1) score_part(true);
        __syncthreads();
        unsigned L[16], M2[16];
#pragma unroll
        for (int i = 0; i < 16; i++) {
          const int n0_ = qs * 32 + i, n1_ = n0_ + 16;
          L[i] = (f2key(S[n0_ * 64 + ts]) & ~127u) | (unsigned)n0_;
          M2[i] = (f2key(S[n1_ * 64 + ts]) & ~127u) | (unsigned)n1_;
        }
        sort16_desc(L); sort16_desc(M2);
#pragma unroll
        for (int k = 0; k < 16; k++) L[k] = max(L[k], M2[15 - k]);
        bitonic_merge16(L);
        merge4_lists(L, lists, ts, qs);
        if (qs == 0) {
#pragma unroll
          for (int k = 0; k < 16; k++) ablist[(half * 16 + k) * 64 + ts] = L[k];
        }
        __syncthreads();
      }
      {
        unsigned L[16];
#pragma unroll
        for (int k = 0; k < 16; k++) L[k] = 0u;
#pragma unroll 1
        for (int cc = qs; cc < 50; cc += 4) {
          const unsigned code = cand_tab[cc];
          const float sum = key2f(ablist[(code >> 4) * 64 + ts]) + key2f(ablist[(16 + (code & 15)) * 64 + ts]);
          insert16(L, (f2key(sum) & ~255u) | code);
        }
        merge4_lists(L, lists, ts, qs);
        if (qs == 0) {
          const float mx = key2f(L[0]);
          float e[16], sum = 0.f;
#pragma unroll
          for (int k = 0; k < 16; k++) { e[k] = __expf(key2f(L[k]) - mx); sum += e[k]; }
          const float inv = 1.f / sum;
#pragma unroll
          for (int k = 0; k < 16; k++) {
            const unsigned code = L[k] & 255u;
            const unsigned ia = ablist[(code >> 4) * 64 + ts] & 127u, ib = ablist[(16 + (code & 15)) * 64 + ts] & 127u;
            fin_e[ts * 16 + k] = (int)(ia * 128u + ib);
            fin_g[ts * 16 + k] = e[k] * inv;
          }
        }
        __syncthreads();
        {
          int tid_o = tid;
          asm volatile("" : "+v"(tid_o));
          const int tt = tid_o >> 2, k4 = (tid_o & 3) * 4;
          *(int4*)(p.pexp + (size_t)(t0 + tt) * 128 + hh * 16 + k4) = *(const int4*)(fin_e + tt * 16 + k4);
          *(float4*)(p.pgate + (size_t)(t0 + tt) * 128 + hh * 16 + k4) = *(const float4*)(fin_g + tt * 16 + k4);
        }
        __syncthreads();
      }
    }
  }
}
__device__ __forceinline__ void peer_e3_phase(const Params& p, int bid, int nblk) {
  int tid_o = threadIdx.x;
  asm volatile("" : "+v"(tid_o));
  const int lane = tid_o & 63, w = __builtin_amdgcn_readfirstlane(tid_o >> 6);
  for (int blk = bid; blk < NT / 64; blk += nblk) {
    const int t0 = blk * 64;
    {
      const int tokb = t0 + w * 16;
      int idc0 = p.pexp[(size_t)tokb * 128 + lane], idc1 = p.pexp[(size_t)tokb * 128 + 64 + lane];
      uint4 xq0 = *(const uint4*)(p.xb + (size_t)tokb * DM + 16 * lane), xq1 = *(const uint4*)(p.xb + (size_t)tokb * DM + 16 * lane + 8);
      uint4 bu[8];
#pragma unroll
      for (int d = 0; d < 8; d++) {
        const int id = __builtin_amdgcn_readlane(idc0, d);
        bu[d] = *(const uint4*)(p.puq + (size_t)id * DM + 16 * lane);
      }
#pragma unroll 1
      for (int rr = 0; rr < 16; rr++) {
        const int tok = tokb + rr, tokn = tokb + min(rr + 1, 15);
        const int idn0 = p.pexp[(size_t)tokn * 128 + lane];
        const uint4 xn0 = *(const uint4*)(p.xb + (size_t)tokn * DM + 16 * lane), xn1 = *(const uint4*)(p.xb + (size_t)tokn * DM + 16 * lane + 8);
        const float g0 = p.pgate[(size_t)tok * 128 + lane], g1 = p.pgate[(size_t)tok * 128 + 64 + lane];
        const float su0 = p.psu[idc0], su1 = p.psu[idc1], sv0 = p.psv[idc0], sv1 = p.psv[idc1];
        f16x2 xh[8];
        xh[0] = __builtin_bit_cast(f16x2, xq0.x); xh[1] = __builtin_bit_cast(f16x2, xq0.y); xh[2] = __builtin_bit_cast(f16x2, xq0.z); xh[3] = __builtin_bit_cast(f16x2, xq0.w);
        xh[4] = __builtin_bit_cast(f16x2, xq1.x); xh[5] = __builtin_bit_cast(f16x2, xq1.y); xh[6] = __builtin_bit_cast(f16x2, xq1.z); xh[7] = __builtin_bit_cast(f16x2, xq1.w);
        float xs = 0.f;
#pragma unroll
        for (int i = 0; i < 8; i++) xs += (float)xh[i][0] + (float)xh[i][1];
        const float xoff = 1152.f * wave_sum_uniform(xs);
        float a0 = 0.f, a1 = 0.f;
#pragma unroll 1
        for (int e0 = 0; e0 < 128; e0 += 16) {
          const int isrcA = (e0 + 8 < 64) ? idc0 : idc1;
          const int isrcB = (e0 + 16 < 64) ? idc0 : (e0 + 16 < 128) ? idc1 : idn0;
          float ps[16];
#pragma unroll
          for (int d = 0; d < 16; d++) {
            const unsigned qw[4] = {bu[d & 7].x, bu[d & 7].y, bu[d & 7].z, bu[d & 7].w};
            float s0 = 0.f, s1 = 0.f;
#pragma unroll
            for (int i = 0; i < 4; i++) {
              s0 = __builtin_amdgcn_fdot2(bytes01_h2(qw[i]), xh[2 * i], s0, false);
              s1 = __builtin_amdgcn_fdot2(bytes23_h2(qw[i]), xh[2 * i + 1], s1, false);
            }
            ps[d] = s0 + s1;
            const int id = __builtin_amdgcn_readlane((d < 8) ? isrcA : isrcB, (e0 + 8 + d) & 63);
            bu[d & 7] = *(const uint4*)(p.puq + (size_t)id * DM + 16 * lane);
          }
          const float r = reduce16x16(ps);
          const bool mine = (lane >> 4) == ((e0 >> 4) & 3);
          if (e0 < 64) a0 = mine ? r : a0; else a1 = mine ? r : a1;
        }
        a0 = (a0 - xoff) * su0;
        a1 = (a1 - xoff) * su1;
        p.pgate[(size_t)tok * 128 + lane] = g0 * gelu_exact(a0) * sv0;
        p.pgate[(size_t)tok * 128 + 64 + lane] = g1 * gelu_exact(a1) * sv1;
        idc0 = idn0; idc1 = p.pexp[(size_t)tokn * 128 + 64 + lane];
        xq0 = xn0; xq1 = xn1;
      }
      const int laneB = tid_opaque() & 63;
      idc0 = p.pexp[(size_t)tokb * 128 + laneB]; idc1 = p.pexp[(size_t)tokb * 128 + 64 + laneB];
      uint4 bv[8];
#pragma unroll
      for (int d = 0; d < 8; d++) {
        const int id = __builtin_amdgcn_readlane(idc0, d);
        bv[d] = *(const uint4*)(p.pvq + (size_t)id * DM + 16 * laneB);
      }
#pragma unroll 1
      for (int rr = 0; rr < 16; rr++) {
        const int tok = tokb + rr, tokn = tokb + min(rr + 1, 15);
        const int idn0 = p.pexp[(size_t)tokn * 128 + laneB];
        const float w0 = p.pgate[(size_t)tok * 128 + laneB], w1 = p.pgate[(size_t)tok * 128 + 64 + laneB];
        float* row = p.out + (size_t)tok * DM + 16 * laneB;
        const float coff = 1152.f * wave_sum_uniform(w0 + w1);
        float y[16];
#pragma unroll
        for (int i = 0; i < 16; i++) y[i] = 0.f;
#pragma unroll 1
        for (int e0 = 0; e0 < 128; e0 += 16) {
          const int isrcA = (e0 + 8 < 64) ? idc0 : idc1;
          const int isrcB = (e0 + 16 < 64) ? idc0 : (e0 + 16 < 128) ? idc1 : idn0;
          const float wsrc = (e0 < 64) ? w0 : w1;
#pragma unroll
          for (int d = 0; d < 16; d++) {
            const float wgt = readlane_f(wsrc, (e0 + d) & 63);
            const unsigned qw[4] = {bv[d & 7].x, bv[d & 7].y, bv[d & 7].z, bv[d & 7].w};
#pragma unroll
            for (int i = 0; i < 4; i++) {
              const f16x2 h01 = bytes01_h2(qw[i]), h23 = bytes23_h2(qw[i]);
              y[4 * i + 0] = fmaf(wgt, (float)h01[0], y[4 * i + 0]);
              y[4 * i + 1] = fmaf(wgt, (float)h01[1], y[4 * i + 1]);
              y[4 * i + 2] = fmaf(wgt, (float)h23[0], y[4 * i + 2]);
              y[4 * i + 3] = fmaf(wgt, (float)h23[1], y[4 * i + 3]);
            }
            const int id = __builtin_amdgcn_readlane((d < 8) ? isrcA : isrcB, (e0 + 8 + d) & 63);
            bv[d & 7] = *(const uint4*)(p.pvq + (size_t)id * DM + 16 * laneB);
          }
        }
        const float4 xr0 = *(const float4*)(row), xr1 = *(const float4*)(row + 4), xr2 = *(const float4*)(row + 8), xr3 = *(const float4*)(row + 12);
        float v[16];
        v[0] = ALPHA * xr0.x + (y[0] - coff); v[1] = ALPHA * xr0.y + (y[1] - coff); v[2] = ALPHA * xr0.z + (y[2] - coff); v[3] = ALPHA * xr0.w + (y[3] - coff);
        v[4] = ALPHA * xr1.x + (y[4] - coff); v[5] = ALPHA * xr1.y + (y[5] - coff); v[6] = ALPHA * xr1.z + (y[6] - coff); v[7] = ALPHA * xr1.w + (y[7] - coff);
        v[8] = ALPHA * xr2.x + (y[8] - coff); v[9] = ALPHA * xr2.y + (y[9] - coff); v[10] = ALPHA * xr2.z + (y[10] - coff); v[11] = ALPHA * xr2.w + (y[11] - coff);
        v[12] = ALPHA * xr3.x + (y[12] - coff); v[13] = ALPHA * xr3.y + (y[13] - coff); v[14] = ALPHA * xr3.z + (y[14] - coff); v[15] = ALPHA * xr3.w + (y[15] - coff);
        float sm = 0.f;
#pragma unroll
        for (int i = 0; i < 16; i++) sm += v[i];
        const float mu = wave_sum_uniform(sm) * (1.f / DM);
        float qv = 0.f;
#pragma unroll
        for (int i = 0; i < 16; i++) { v[i] -= mu; qv += v[i] * v[i]; }
        const float rs = rsqrtf(wave_sum_uniform(qv) * (1.f / DM) + 1e-5f);
#pragma unroll
        for (int i4 = 0; i4 < 4; i4++) {
          const float4 gg = *(const float4*)(p.ln2g + 16 * laneB + 4 * i4), bb = *(const float4*)(p.ln2b + 16 * laneB + 4 * i4);
          *(float4*)(row + 4 * i4) = make_float4(v[4 * i4 + 0] * rs * gg.x + bb.x, v[4 * i4 + 1] * rs * gg.y + bb.y,
                                                 v[4 * i4 + 2] * rs * gg.z + bb.z, v[4 * i4 + 3] * rs * gg.w + bb.w);
        }
        idc0 = idn0; idc1 = p.pexp[(size_t)tokn * 128 + 64 + laneB];
      }
    }
    __syncthreads();
  }
}

__device__ __forceinline__ void cbias_phase(const Params& p, int bid, int nblk) {
  const int which = threadIdx.x >> 7, j = threadIdx.x & 127;
  const float* w1 = which ? p.w1v : p.w1k;
  const float* pe = which ? p.pe_v : p.pe_k;
  for (int ch = bid; ch < 64; ch += nblk) {
    float a = 0.f;
#pragma unroll 8
    for (int r = ch * 32; r < ch * 32 + 32; r++) a = fmaf(pe[r], w1[(size_t)r * 128 + j], a);
    p.cbias[ch * 256 + which * 128 + j] = a;
  }
}
__device__ __forceinline__ void compress_phase(const Params& p, unsigned char* smem, int bid, int nblk) {
  typedef Gemm<1, 2> G;
  const int tid = threadIdx.x, lane = tid & 63, w = tid >> 6, wm = w >> 1, wn = w & 1, c = lane & 31, fh = lane >> 5;
  float* hid = (float*)smem;
  float* cb = (float*)(smem + 49152);
  if (bid < NB * 2 * 2 * 4) {
    float a = 0.f;
    for (int ch = 0; ch < 64; ch++) a += p.cbias[ch * 256 + tid];
    cb[tid] = a;
  }
  __syncthreads();
  for (int item = bid; item < NB * 2 * 2 * 4; item += nblk) {
    const int mt = item & 3, which = (item >> 2) & 1, bgi = item >> 3;
    const int m0 = mt * 64;
    const bf16_t* A = (which ? p.kvn[1] : p.kvn[0]) + (size_t)bgi * SEQ * 64;
    const bf16_t* Bt = which ? p.w1vt : p.w1kt;
    f32x16 acc[1][2];
#pragma unroll
    for (int j = 0; j < 2; j++)
#pragma unroll
      for (int r = 0; r < 16; r++) acc[0][j][r] = 0.f;
    G::mainloop(acc, [&](int r) { const int i = min(m0 + r, NC - 1); return A + (size_t)i * 1024; },
                [&](int r) { return Bt + (size_t)r * 2048; }, 2048, smem);
#pragma unroll
    for (int j = 0; j < 2; j++)
#pragma unroll
      for (int r = 0; r < 16; r++) {
        const int row = wm * 32 + (r & 3) + 8 * (r >> 2) + 4 * fh, col = (wn * 2 + j) * 32 + c;
        hid[row * 129 + col] = gelu_exact(acc[0][j][r] + cb[which * 128 + col]);
      }
    __syncthreads();
    {
      const int row = tid >> 2, dq = (tid & 3) * 16;
      const float* w2 = which ? p.w2v : p.w2k;
      float o[16];
#pragma unroll
      for (int i = 0; i < 16; i++) o[i] = 0.f;
      for (int k = 0; k < 128; k++) {
        const float h = hid[row * 129 + k];
        const float4 w0 = *(const float4*)(w2 + k * 64 + dq), w1_ = *(const float4*)(w2 + k * 64 + dq + 4);
        const float4 w2_ = *(const float4*)(w2 + k * 64 + dq + 8), w3 = *(const float4*)(w2 + k * 64 + dq + 12);
        o[0] = fmaf(h, w0.x, o[0]); o[1] = fmaf(h, w0.y, o[1]); o[2] = fmaf(h, w0.z, o[2]); o[3] = fmaf(h, w0.w, o[3]);
        o[4] = fmaf(h, w1_.x, o[4]); o[5] = fmaf(h, w1_.y, o[5]); o[6] = fmaf(h, w1_.z, o[6]); o[7] = fmaf(h, w1_.w, o[7]);
        o[8] = fmaf(h, w2_.x, o[8]); o[9] = fmaf(h, w2_.y, o[9]); o[10] = fmaf(h, w2_.z, o[10]); o[11] = fmaf(h, w2_.w, o[11]);
        o[12] = fmaf(h, w3.x, o[12]); o[13] = fmaf(h, w3.y, o[13]); o[14] = fmaf(h, w3.z, o[14]); o[15] = fmaf(h, w3.w, o[15]);
      }
      const int i = m0 + row;
      const bool valid = i < NC;
      if (which == 0) {
        bf16_t* dst = p.kcb + ((size_t)bgi * 256 + i) * 64 + dq;
        uint4 u0 = {pack2bf(o[0], o[1]), pack2bf(o[2], o[3]), pack2bf(o[4], o[5]), pack2bf(o[6], o[7])};
        uint4 u1 = {pack2bf(o[8], o[9]), pack2bf(o[10], o[11]), pack2bf(o[12], o[13]), pack2bf(o[14], o[15])};
        if (!valid) { u0 = make_uint4(0, 0, 0, 0); u1 = u0; }
        *(uint4*)dst = u0; *(uint4*)(dst + 8) = u1;
      } else {
#pragma unroll
        for (int e = 0; e < 16; e++) p.vct[((size_t)bgi * 64 + dq + e) * 256 + perm16(i)] = valid ? f2bf(o[e]) : (bf16_t)0;
      }
    }
    __syncthreads();
  }
}

__device__ __forceinline__ void softmax4(float* sc, int ld, int n) {
  const int w = threadIdx.x >> 6, lane = threadIdx.x & 63;
  float* s = sc + w * ld;
  float m = -INFINITY;
  for (int i = lane; i < n; i += 64) m = fmaxf(m, s[i]);
  m = wave_max(m);
  if (m == -INFINITY) m = 0.f;
  float sum = 0.f;
  for (int i = lane; i < n; i += 64) { float e = expf(s[i] - m); s[i] = e; sum += e; }
  sum = wave_sum(sum);
  const float inv = 1.f / (sum > 0.f ? sum : 1.f);
  for (int i = lane; i < n; i += 64) s[i] *= inv;
}
__device__ __forceinline__ float dot64_bf(const float* q, const bf16_t* k) {
  float s = 0.f;
#pragma unroll
  for (int e = 0; e < 64; e += 8) {
    const uint4 v = *(const uint4*)(k + e);
    const unsigned u[4] = {v.x, v.y, v.z, v.w};
#pragma unroll
    for (int i = 0; i < 4; i++) {
      s = fmaf(q[e + 2 * i], __uint_as_float(u[i] << 16), s);
      s = fmaf(q[e + 2 * i + 1], __uint_as_float(u[i] & 0xFFFF0000u), s);
    }
  }
  return s;
}

template <class KRow, class VRow, class Body>
__device__ __forceinline__ void flash_stream(unsigned char* smem, int j0, int j1, KRow krow, VRow vrow, Body body) {
  if (j0 >= j1) return;
  Tile2 rk = tile_fetch([&](int r) __attribute__((always_inline)) { return krow(j0, r); });
  Tile2 rv = tile_fetch([&](int r) __attribute__((always_inline)) { return vrow(j0, r); });
  __syncthreads();
  tile_store(rk, smem); tile_store(rv, smem + FL_TILE);
  __syncthreads();
#pragma unroll 1
  for (int j = j0; j < j1; j++) {
    unsigned char* cur = smem + ((j - j0) & 1) * FL_STAGE;
    if (j + 1 < j1) {
      rk = tile_fetch([&](int r) __attribute__((always_inline)) { return krow(j + 1, r); });
      rv = tile_fetch([&](int r) __attribute__((always_inline)) { return vrow(j + 1, r); });
    }
    body(cur, j);
    if (j + 1 < j1) { unsigned char* nxt = smem + ((j - j0 + 1) & 1) * FL_STAGE; tile_store(rk, nxt); tile_store(rv, nxt + FL_TILE); }
    __syncthreads();
  }
}
__device__ __forceinline__ float quad_sum(float x) {
  x += __builtin_bit_cast(float, __builtin_amdgcn_update_dpp(0, __builtin_bit_cast(int, x), 0xB1, 0xF, 0xF, true));
  x += __builtin_bit_cast(float, __builtin_amdgcn_update_dpp(0, __builtin_bit_cast(int, x), 0x4E, 0xF, 0xF, true));
  return x;
}
__device__ __forceinline__ void nsa_flash_item(const Params& p, unsigned char* smem, int item) {
  const int tid = threadIdx.x, lane = tid & 63, w = tid >> 6, fr = lane & 31, fh = lane >> 5;
  const int cc = item & 127, g = (item >> 7) & 1, b = item >> 8;
  const int c64 = cc >> 1;
  const int t0 = cc * 32;
  const int tl = 8 * w + (fr >> 2), hq = fr & 3;
  const int t = t0 + tl, tok = b * SEQ + t;
  const int t64 = t & 63;
  float* impS = (float*)smem;
  unsigned* selm = (unsigned*)(smem + 32 * 65 * 4);
  float* stash = (float*)(smem + 2 * FL_STAGE) + w * 2048 + lane;
  bf16x8 qf[4];
  flash_load_q(qf, p.qn + (size_t)tok * 512 + g * 256 + hq * 64, 0.125f);
  const float* gt = p.gates + (size_t)tok * 24 + (g * 4 + hq) * 3;
  const float g_cmp = gt[0], g_sel = gt[1], g_win = gt[2];
  const size_t bg = (size_t)(b * 2 + g);
  {
    const int nvmax = 2 * cc + 1, nkb = (nvmax + 63) >> 6;
    const int nvl = (t >= 31) ? ((t - 31) >> 4) + 1 : 0;
    const bf16_t* kcb = p.kcb + bg * 256 * 64;
    const bf16_t* vct = p.vct + bg * 64 * 256;
    auto krow = [&](int j, int r) __attribute__((always_inline)) { return kcb + (size_t)(j * 64 + r) * 64; };
    auto vrow = [&](int j, int r) __attribute__((always_inline)) { return vct + (size_t)r * 256 + j * 64; };
    float m = -INFINITY, l = 0.f;
    flash_stream(smem, 0, nkb, krow, vrow, [&](unsigned char* cur, int j) __attribute__((always_inline)) {
      f32x16 s[2];
      flash_qk(s, cur, qf);
      float mx = -INFINITY;
#pragma unroll
      for (int kt = 0; kt < 2; kt++)
#pragma unroll
        for (int r = 0; r < 16; r++) {
          const int n = j * 64 + kt * 32 + (r & 3) + 8 * (r >> 2) + 4 * fh;
          s[kt][r] = (n < nvl) ? s[kt][r] : -INFINITY;
          mx = fmaxf(mx, s[kt][r]);
        }
      mx = fmaxf(mx, __shfl_xor(mx, 32));
      const float mnew = fmaxf(m, mx);
      const float muse = (mnew == -INFINITY) ? 0.f : mnew;
      float sum = 0.f;
#pragma unroll
      for (int kt = 0; kt < 2; kt++)
#pragma unroll
        for (int r = 0; r < 16; r++) sum += __builtin_amdgcn_exp2f((s[kt][r] - muse) * LOG2E);
      l = l * __builtin_amdgcn_exp2f((m - muse) * LOG2E) + sum;
      m = mnew;
    });
    const float lt = l + __shfl_xor(l, 32);
    const float il = lt > 0.f ? 1.f / lt : 0.f;
    const float muse = (m == -INFINITY) ? 0.f : m;
    {
      f32x16 oc[2];
#pragma unroll
      for (int i = 0; i < 2; i++)
#pragma unroll
        for (int r = 0; r < 16; r++) oc[i][r] = 0.f;
      flash_stream(smem, 0, nkb, krow, vrow, [&](unsigned char* cur, int j) __attribute__((always_inline)) {
        f32x16 s[2];
        flash_qk(s, cur, qf);
#pragma unroll
        for (int kt = 0; kt < 2; kt++)
#pragma unroll
          for (int r = 0; r < 16; r++) {
            const int n = j * 64 + kt * 32 + (r & 3) + 8 * (r >> 2) + 4 * fh;
            s[kt][r] = (n < nvl) ? __builtin_amdgcn_exp2f((s[kt][r] - muse) * LOG2E) * il : 0.f;
          }
#pragma unroll
        for (int kt = 0; kt < 2; kt++)
#pragma unroll
          for (int h8 = 0; h8 < 2; h8++) {
            const bf16x8 pf = pack_frag(s[kt], h8);
#pragma unroll
            for (int dt = 0; dt < 2; dt++)
              oc[dt] = __builtin_amdgcn_mfma_f32_32x32x16_bf16(lds_frag(cur + FL_TILE, dt * 32 + fr, 4 * kt + 2 * h8 + fh), pf, oc[dt], 0, 0, 0);
          }
      });
#pragma unroll
      for (int dt = 0; dt < 2; dt++)
#pragma unroll
        for (int r = 0; r < 16; r++) stash[(dt * 16 + r) * 64] = g_cmp * oc[dt][r];
    }
    f32x16 imp[2];
#pragma unroll
    for (int i = 0; i < 2; i++)
#pragma unroll
      for (int r = 0; r < 16; r++) imp[i][r] = 0.f;
    flash_stream(smem, 0, nkb, krow, vrow, [&](unsigned char* cur, int j) __attribute__((always_inline)) {
      f32x16 s[2];
      flash_qk(s, cur, qf);
#pragma unroll
      for (int kt = 0; kt < 2; kt++)
#pragma unroll
        for (int r = 0; r < 16; r++) {
          const int n = j * 64 + kt * 32 + (r & 3) + 8 * (r >> 2) + 4 * fh;
          s[kt][r] = (n < nvl) ? __builtin_amdgcn_exp2f((s[kt][r] - muse) * LOG2E) * il : 0.f;
        }
#pragma unroll
      for (int kt = 0; kt < 2; kt++)
#pragma unroll
        for (int h8 = 0; h8 < 2; h8++) {
          const bf16x8 pf = pack_frag(s[kt], h8);
#pragma unroll
          for (int mt = 0; mt < 2; mt++) {
            const bf16x8 of = *(const bf16x8*)(p.ovp + (size_t)(mt * 32 + fr) * 256 + j * 64 + kt * 32 + h8 * 16 + fh * 8);
            imp[mt] = __builtin_amdgcn_mfma_f32_32x32x16_bf16(of, pf, imp[mt], 0, 0, 0);
          }
        }
    });
#pragma unroll
    for (int mt = 0; mt < 2; mt++)
#pragma unroll
      for (int r = 0; r < 16; r++) imp[mt][r] = quad_sum(imp[mt][r]);
#pragma unroll
    for (int mt = 0; mt < 2; mt++)
#pragma unroll
      for (int g4 = 0; g4 < 4; g4++) {
        const float v = (hq == 0) ? imp[mt][4 * g4 + 0] : (hq == 1) ? imp[mt][4 * g4 + 1] : (hq == 2) ? imp[mt][4 * g4 + 2] : imp[mt][4 * g4 + 3];
        impS[tl * 65 + mt * 32 + hq + 8 * g4 + 4 * fh] = v;
      }
    __syncthreads();
    {
      const int tk = tid >> 3, part = tid & 7;
      const float* row = impS + tk * 65;
      float S2[64];
#pragma unroll
      for (int m2 = 0; m2 < 64; m2++) {
        const bool vis2 = m2 <= c64;
        const bool f2 = (m2 == 0) || (m2 == c64) || (m2 == c64 - 1);
        S2[m2] = vis2 ? row[m2] + (f2 ? 1e4f : 0.f) : -INFINITY;
      }
      unsigned bits = 0;
#pragma unroll
      for (int i = 0; i < 8; i++) {
        const int mb = part * 8 + i;
        const bool vis = mb <= c64;
        const bool forced = (mb == 0) || (mb == c64) || (mb == c64 - 1);
        const float sm = vis ? row[mb] + (forced ? 1e4f : 0.f) : -INFINITY;
        int rank = 0;
#pragma unroll
        for (int m2 = 0; m2 < 64; m2++) {
          const int pb = m2 >> 3;
          const bool lower = ((m2 & 7) < i) ? (pb <= part) : (pb < part);
          rank += ((S2[m2] > sm) || (S2[m2] == sm && lower)) ? 1 : 0;
        }
        if (rank < 16 && vis) bits |= 1u << i;
      }
      unsigned lo = (part < 4) ? (bits << (8 * part)) : 0u, hi = (part >= 4) ? (bits << (8 * (part - 4))) : 0u;
      lo |= __shfl_xor(lo, 1); hi |= __shfl_xor(hi, 1);
      lo |= __shfl_xor(lo, 2); hi |= __shfl_xor(hi, 2);
      lo |= __shfl_xor(lo, 4); hi |= __shfl_xor(hi, 4);
      if (part == 0) { selm[tk * 2] = lo; selm[tk * 2 + 1] = hi; }
    }
    __syncthreads();
  }
  const unsigned sel_lo = selm[tl * 2], sel_hi = selm[tl * 2 + 1];
  {
    const bf16_t* kb_ = p.kvn[2] + bg * SEQ * 64;
    const bf16_t* vt_ = p.vslct + bg * 64 * SEQ;
    FlashAcc acc; flash_init(acc);
    flash_stream(smem, 0, c64 + 1,
      [&](int j, int r) __attribute__((always_inline)) { return kb_ + (size_t)(j * 64 + r) * 64; },
      [&](int j, int r) __attribute__((always_inline)) { return vt_ + (size_t)r * SEQ + j * 64; },
      [&](unsigned char* cur, int j) __attribute__((always_inline)) {
        f32x16 s[2];
        flash_qk(s, cur, qf);
        const bool selj = ((j < 32) ? (sel_lo >> j) : (sel_hi >> (j - 32))) & 1u;
        if (j == c64) {
#pragma unroll
          for (int kt = 0; kt < 2; kt++)
#pragma unroll
            for (int r = 0; r < 16; r++) {
              const int kl = kt * 32 + (r & 3) + 8 * (r >> 2) + 4 * fh;
              s[kt][r] = (kl <= t64) ? s[kt][r] : -INFINITY;
            }
        }
        flash_update(acc, s, cur + FL_TILE, selj);
      });
    const float sc_ = g_sel * flash_inv_l(acc);
#pragma unroll
    for (int dt = 0; dt < 2; dt++)
#pragma unroll
      for (int r = 0; r < 16; r++) stash[(dt * 16 + r) * 64] += sc_ * acc.o[dt][r];
  }
  {
    const bf16_t* kb_ = p.kvn[4] + bg * SEQ * 64;
    const bf16_t* vt_ = p.vwint + bg * 64 * SEQ;
    FlashAcc acc; flash_init(acc);
    const int jlo = c64 - 8;
    flash_stream(smem, jlo < 0 ? 0 : jlo, c64 + 1,
      [&](int j, int r) __attribute__((always_inline)) { return kb_ + (size_t)(j * 64 + r) * 64; },
      [&](int j, int r) __attribute__((always_inline)) { return vt_ + (size_t)r * SEQ + j * 64; },
      [&](unsigned char* cur, int j) __attribute__((always_inline)) {
        f32x16 s[2];
        flash_qk(s, cur, qf);
        if (j == c64) {
#pragma unroll
          for (int kt = 0; kt < 2; kt++)
#pragma unroll
            for (int r = 0; r < 16; r++) {
              const int kl = kt * 32 + (r & 3) + 8 * (r >> 2) + 4 * fh;
              s[kt][r] = (kl <= t64) ? s[kt][r] : -INFINITY;
            }
        } else if (j == jlo) {
#pragma unroll
          for (int kt = 0; kt < 2; kt++)
#pragma unroll
            for (int r = 0; r < 16; r++) {
              const int kl = kt * 32 + (r & 3) + 8 * (r >> 2) + 4 * fh;
              s[kt][r] = (kl > t64) ? s[kt][r] : -INFINITY;
            }
        }
        flash_update(acc, s, cur + FL_TILE);
      });
    const float sc_ = g_win * flash_inv_l(acc);
    bf16_t* orow = p.concat + (size_t)tok * DM + g * 256 + hq * 64;
#pragma unroll
    for (int dt = 0; dt < 2; dt++)
#pragma unroll
      for (int g4 = 0; g4 < 4; g4++) {
        float o4[4];
#pragma unroll
        for (int i = 0; i < 4; i++) o4[i] = stash[(dt * 16 + 4 * g4 + i) * 64] + sc_ * acc.o[dt][4 * g4 + i];
        uint2 o = {pack2bf(o4[0], o4[1]), pack2bf(o4[2], o4[3])};
        *(uint2*)(orow + dt * 32 + 8 * g4 + 4 * fh) = o;
      }
  }
}
__device__ __forceinline__ void nsa_phase(const Params& p, unsigned char* smem, int bid, int nblk) {
  for (int it = bid; it < NB * 2 * 128; it += nblk) {
    const int cc = 127 - (it >> 4), bgi = it & 15;
    nsa_flash_item(p, smem, (bgi << 7) | cc);
  }
}

typedef __attribute__((ext_vector_type(4))) float f32x4v;
typedef __attribute__((ext_vector_type(4))) short s16x4;
__device__ __forceinline__ float wave_max_uniform(float x) {
  x = fmaxf(x, __builtin_bit_cast(float, __builtin_amdgcn_update_dpp(0, __builtin_bit_cast(int, x), 0xB1, 0xF, 0xF, true)));
  x = fmaxf(x, __builtin_bit_cast(float, __builtin_amdgcn_update_dpp(0, __builtin_bit_cast(int, x), 0x4E, 0xF, 0xF, true)));
  x = fmaxf(x, __builtin_bit_cast(float, __builtin_amdgcn_update_dpp(0, __builtin_bit_cast(int, x), 0x141, 0xF, 0xF, true)));
  x = fmaxf(x, __builtin_bit_cast(float, __builtin_amdgcn_update_dpp(0, __builtin_bit_cast(int, x), 0x140, 0xF, 0xF, true)));
  return fmaxf(fmaxf(readlane_f(x, 0), readlane_f(x, 16)), fmaxf(readlane_f(x, 32), readlane_f(x, 48)));
}
__device__ __forceinline__ int dsa_vswz(int row) { return ((row >> 1) & 1) | ((row >> 2) & 2); }
__device__ __forceinline__ void dsa_item(const Params& p, unsigned char* smem, int b, int tg) {
  unsigned* keys = (unsigned*)smem;
  unsigned char* vst = smem;
  int* hist = (int*)(smem + 32768);
  int* sel = hist + 3584;
  int* cnt = sel + 512;
  float* sc = (float*)(cnt + 16);
  float* part = sc + 2048;
  const int tid = tid_opaque(), lane = tid & 63, w = __builtin_amdgcn_readfirstlane(tid >> 6);
  const int row16 = lane & 15, kg = lane >> 4;
  const int t0 = 2 * tg;
  const size_t tokb = (size_t)b * SEQ;
  const bf16_t* kib = p.ki + tokb * 32;
  const bf16_t* kdb = p.kd + tokb * 64;
  const bf16_t* vdb = p.vd + tokb * 64;
  const int n = t0 + 2;
  if (n > 256) {
#pragma unroll
    for (int i = 0; i < 14; i++) hist[tid + 256 * i] = 0;
    {
      const bf16x8 af = *(const bf16x8*)(p.qi + (tokb + t0 + (row16 >> 3)) * 256 + (row16 & 7) * 32 + kg * 8);
      const int tk = lane >> 5;
      const float4 wv = *(const float4*)(p.widx + (tokb + t0 + tk) * 8 + 4 * (kg & 1));
      const int ntile = (n + 15) >> 4;
      struct B4 { bf16x8 a, b, c, d; };
      const int lofs = (row16 * 32 + kg * 8) * 2;
      const __amdgpu_buffer_rsrc_t krs = __builtin_amdgcn_make_buffer_rsrc((void*)kib, (short)0, SEQ * 64, 0x00020000);
      typedef unsigned int u32x4_t __attribute__((__vector_size__(16)));
      auto ld4 = [&](int kt) __attribute__((always_inline)) {
        B4 r;
        r.a = __builtin_bit_cast(bf16x8, (u32x4_t)__builtin_amdgcn_raw_buffer_load_b128(krs, lofs, min(kt + 0, ntile - 1) * 1024, 0));
        r.b = __builtin_bit_cast(bf16x8, (u32x4_t)__builtin_amdgcn_raw_buffer_load_b128(krs, lofs, min(kt + 1, ntile - 1) * 1024, 0));
        r.c = __builtin_bit_cast(bf16x8, (u32x4_t)__builtin_amdgcn_raw_buffer_load_b128(krs, lofs, min(kt + 2, ntile - 1) * 1024, 0));
        r.d = __builtin_bit_cast(bf16x8, (u32x4_t)__builtin_amdgcn_raw_buffer_load_b128(krs, lofs, min(kt + 3, ntile - 1) * 1024, 0));
        return r;
      };
      auto score4 = [&](const B4& cb, int kt0) __attribute__((always_inline)) {
        float sv[4];
#pragma unroll
        for (int u = 0; u < 4; u++) {
          f32x4v acc = {0.f, 0.f, 0.f, 0.f};
          acc = __builtin_amdgcn_mfma_f32_16x16x32_bf16(af, (u == 0) ? cb.a : (u == 1) ? cb.b : (u == 2) ? cb.c : cb.d, acc, 0, 0, 0);
          sv[u] = wv.x * __builtin_elementwise_maximum(acc[0], 0.f) + wv.y * __builtin_elementwise_maximum(acc[1], 0.f)
                + wv.z * __builtin_elementwise_maximum(acc[2], 0.f) + wv.w * __builtin_elementwise_maximum(acc[3], 0.f);
        }
#pragma unroll
        for (int u = 0; u < 4; u++) {
          const auto sw = __builtin_amdgcn_permlane16_swap(__float_as_uint(sv[u]), __float_as_uint(sv[u]), false, false);
          sv[u] = __uint_as_float(sw[0]) + __uint_as_float(sw[1]);
        }
        if ((kg & 1) == 0) {
#pragma unroll
          for (int u = 0; u < 4; u++) {
            const int key = (kt0 + u) * 16 + row16;
            if (kt0 + u < ntile) {
              const unsigned kv_ = (key <= t0 + tk) ? f2key(sv[u]) : 0u;
              keys[tk * 4096 + key] = kv_;
              atomicAdd(&hist[1536 + tk * 1024 + (lane & 3) * 256 + (kv_ >> 24)], 1);
            }
          }
        }
      };
      B4 c0 = ld4(w * 4), c1 = ld4(w * 4 + 16), c2;
      int kt0 = w * 4;
#pragma unroll 1
      for (;;) {
        if (kt0 >= ntile) break;
        c2 = ld4(kt0 + 32); score4(c0, kt0); kt0 += 16;
        if (kt0 >= ntile) break;
        c0 = ld4(kt0 + 32); score4(c1, kt0); kt0 += 16;
        if (kt0 >= ntile) break;
        c1 = ld4(kt0 + 32); score4(c2, kt0); kt0 += 16;
      }
    }
    __syncthreads();
    const int tk = w >> 1, hf = w & 1;
    const int npad = ((n + 15) >> 4) << 4, nh = npad >> 1;
    const unsigned* kt_ = keys + tk * 4096;
    const int i0 = hf * nh, i1 = i0 + nh;
    unsigned prefix = 0; int kk = 256;
#pragma unroll 1
    for (int pass = 0; pass < 4; pass++) {
      const int shift = 24 - 8 * pass;
      int* hp = (pass == 0) ? hist + 1536 + tk * 1024 : hist + (pass - 1) * 512 + tk * 256;
      int* hpa = (pass == 0) ? hp + (lane & 3) * 256 : hp;
      const unsigned hmask = (shift == 24) ? 0u : (0xFFFFFFFFu << (shift + 8));
      if (pass > 0)
#pragma unroll 2
      for (int base = i0 + 4 * lane; base < i1; base += 256) {
        const uint4 k4 = *(const uint4*)(kt_ + base);
        if ((k4.x & hmask) == prefix) atomicAdd(&hpa[(k4.x >> shift) & 255], 1);
        if ((k4.y & hmask) == prefix) atomicAdd(&hpa[(k4.y >> shift) & 255], 1);
        if ((k4.z & hmask) == prefix) atomicAdd(&hpa[(k4.z >> shift) & 255], 1);
        if ((k4.w & hmask) == prefix) atomicAdd(&hpa[(k4.w >> shift) & 255], 1);
      }
      __syncthreads();
      {
        int4 c4 = *(const int4*)(hp + lane * 4);
        if (pass == 0) {
#pragma unroll
          for (int cp = 1; cp < 4; cp++) {
            const int4 d4 = *(const int4*)(hp + cp * 256 + lane * 4);
            c4.x += d4.x; c4.y += d4.y; c4.z += d4.z; c4.w += d4.w;
          }
        }
        const int tl_ = c4.x + c4.y + c4.z + c4.w;
        int P = tl_;
        P += __builtin_amdgcn_update_dpp(0, P, 0x111, 0xF, 0xF, false);
        P += __builtin_amdgcn_update_dpp(0, P, 0x112, 0xF, 0xF, false);
        P += __builtin_amdgcn_update_dpp(0, P, 0x114, 0xF, 0xF, false);
        P += __builtin_amdgcn_update_dpp(0, P, 0x118, 0xF, 0xF, false);
        P += __builtin_amdgcn_update_dpp(0, P, 0x142, 0xA, 0xF, false);
        P += __builtin_amdgcn_update_dpp(0, P, 0x143, 0xC, 0xF, false);
        const int total = __builtin_amdgcn_readlane(P, 63);
        const int R = total - P + tl_;
        const int a3 = R - tl_, a2 = a3 + c4.w, a1 = a2 + c4.z, a0 = a1 + c4.y;
        const bool found = (a3 < kk) && (kk <= R);
        int dloc, above;
        if (kk <= a2) { dloc = 3; above = a3; } else if (kk <= a1) { dloc = 2; above = a2; } else if (kk <= a0) { dloc = 1; above = a1; } else { dloc = 0; above = a0; }
        const unsigned long long bm = __ballot(found);
        const int src = __ffsll((long long)bm) - 1;
        const int dsel = __builtin_amdgcn_readlane(lane * 4 + dloc, src);
        const int abv = __builtin_amdgcn_readlane(above, src);
        prefix |= ((unsigned)dsel) << shift;
        kk -= abv;
      }
    }
    {
      int cg_ = 0, ce = 0;
#pragma unroll 2
      for (int base = i0 + 4 * lane; base < i1; base += 256) {
        const uint4 k4 = *(const uint4*)(kt_ + base);
        cg_ += (k4.x > prefix) + (k4.y > prefix) + (k4.z > prefix) + (k4.w > prefix);
        ce += (k4.x == prefix) + (k4.y == prefix) + (k4.z == prefix) + (k4.w == prefix);
      }
      cg_ = (int)wave_sum_uniform((float)cg_); ce = (int)wave_sum_uniform((float)ce);
      if (lane == 0) { cnt[(tk * 2 + hf) * 2] = cg_; cnt[(tk * 2 + hf) * 2 + 1] = ce; }
    }
    __syncthreads();
    {
      int bgt = hf ? cnt[(tk * 2) * 2] : 0, beq = hf ? cnt[(tk * 2) * 2 + 1] : 0;
      const int ngt = 256 - kk;
      const unsigned long long lt = (1ull << lane) - 1ull;
#pragma unroll 1
      for (int base = i0 + 4 * lane; base < i1; base += 256) {
        const uint4 k4 = *(const uint4*)(kt_ + base);
        const unsigned kq[4] = {k4.x, k4.y, k4.z, k4.w};
        unsigned long long mg[4], me[4];
#pragma unroll
        for (int j = 0; j < 4; j++) { mg[j] = __ballot(kq[j] > prefix); me[j] = __ballot(kq[j] == prefix); }
        int pg = bgt + __popcll(mg[0] & lt) + __popcll(mg[1] & lt) + __popcll(mg[2] & lt) + __popcll(mg[3] & lt);
        int pe = beq + __popcll(me[0] & lt) + __popcll(me[1] & lt) + __popcll(me[2] & lt) + __popcll(me[3] & lt);
#pragma unroll
        for (int j = 0; j < 4; j++) {
          if (kq[j] > prefix) { sel[tk * 256 + pg] = base + j; pg++; }
          else if (kq[j] == prefix) { if (pe < kk) sel[tk * 256 + ngt + pe] = base + j; pe++; }
        }
        bgt += __popcll(mg[0]) + __popcll(mg[1]) + __popcll(mg[2]) + __popcll(mg[3]);
        beq += __popcll(me[0]) + __popcll(me[1]) + __popcll(me[2]) + __popcll(me[3]);
      }
    }
    __syncthreads();
  } else {
    for (int i = tid; i < 512; i += 256) sel[i] = i & 255;
    __syncthreads();
  }
  {
    const int tid = tid_opaque(), lane = tid & 63, row16 = lane & 15, kg = lane >> 4;
    const int tk = w >> 1, hf = w & 1;
    const int nsel = min(256, t0 + tk + 1);
    const size_t tok = tokb + t0 + tk;
    const int* selt = sel + tk * 256;
    float* sct = sc + tk * 1024;
    bf16_t* pbt = (bf16_t*)(part) + tk * 1024;
    unsigned char* vw = vst + w * 8192;
    const int kk8 = lane >> 3, ch = lane & 7;
    const int q4 = row16 >> 2, pp = row16 & 3;
#define DSA_VLOAD(dst, it_, base_) dst = *(const uint4*)(vdb + (size_t)selt[min((base_) + (it_) * 8 + kk8, nsel - 1)] * 64 + ch * 8)
#define DSA_VSTORE(src, it_) { const int key_ = (it_) * 8 + kk8; *(uint4*)(vw + key_ * 128 + ((((ch >> 1) ^ dsa_vswz(key_))) << 5) + ((ch & 1) << 4)) = src; }
    uint4 vv0, vv1, vv2, vv3, vv4, vv5, vv6, vv7, vw0, vw1, vw2, vw3, vw4, vw5, vw6, vw7;
    DSA_VLOAD(vv0, 0, hf * 128); DSA_VLOAD(vv1, 1, hf * 128); DSA_VLOAD(vv2, 2, hf * 128); DSA_VLOAD(vv3, 3, hf * 128);
    DSA_VLOAD(vv4, 4, hf * 128); DSA_VLOAD(vv5, 5, hf * 128); DSA_VLOAD(vv6, 6, hf * 128); DSA_VLOAD(vv7, 7, hf * 128);
    DSA_VLOAD(vw0, 0, hf * 128 + 64); DSA_VLOAD(vw1, 1, hf * 128 + 64); DSA_VLOAD(vw2, 2, hf * 128 + 64); DSA_VLOAD(vw3, 3, hf * 128 + 64);
    DSA_VLOAD(vw4, 4, hf * 128 + 64); DSA_VLOAD(vw5, 5, hf * 128 + 64); DSA_VLOAD(vw6, 6, hf * 128 + 64); DSA_VLOAD(vw7, 7, hf * 128 + 64);
    {
      bf16x8 qf[2];
#pragma unroll
      for (int ks = 0; ks < 2; ks++) {
        uint4 u = make_uint4(0, 0, 0, 0);
        if (row16 < 4) u = *(const uint4*)(p.qd + tok * 256 + row16 * 64 + ks * 32 + kg * 8);
        qf[ks] = __builtin_bit_cast(bf16x8, u);
      }
      bf16x8 kf[2][4][2];
#pragma unroll
      for (int ck = 0; ck < 2; ck++)
#pragma unroll
        for (int ti = 0; ti < 4; ti++) {
          const int r = hf * 128 + ck * 64 + ti * 16 + row16;
          const int idx = selt[min(r, nsel - 1)];
#pragma unroll
          for (int ks = 0; ks < 2; ks++) kf[ck][ti][ks] = *(const bf16x8*)(kdb + (size_t)idx * 64 + ks * 32 + kg * 8);
        }
#pragma unroll
      for (int ck = 0; ck < 2; ck++) {
#pragma unroll
        for (int ti = 0; ti < 4; ti++) {
          f32x4v acc = {0.f, 0.f, 0.f, 0.f};
          acc = __builtin_amdgcn_mfma_f32_16x16x32_bf16(kf[ck][ti][0], qf[0], acc, 0, 0, 0);
          acc = __builtin_amdgcn_mfma_f32_16x16x32_bf16(kf[ck][ti][1], qf[1], acc, 0, 0, 0);
          if (row16 < 4) {
#pragma unroll
            for (int r = 0; r < 4; r++) {
              const int key = hf * 128 + ck * 64 + ti * 16 + 4 * kg + r;
              sct[row16 * 256 + key] = (key < nsel) ? acc[r] * 0.125f : -INFINITY;
            }
          }
        }
      }
    }
    __syncthreads();
#pragma unroll
    for (int hh = 0; hh < 2; hh++) {
      const int h = 2 * hf + hh;
      float v0 = sct[h * 256 + lane], v1 = sct[h * 256 + 64 + lane], v2 = sct[h * 256 + 128 + lane], v3 = sct[h * 256 + 192 + lane];
      const float mx = wave_max_uniform(fmaxf(fmaxf(v0, v1), fmaxf(v2, v3)));
      v0 = __expf(v0 - mx); v1 = __expf(v1 - mx); v2 = __expf(v2 - mx); v3 = __expf(v3 - mx);
      const float inv = 1.f / wave_sum_uniform((v0 + v1) + (v2 + v3));
      pbt[h * 256 + lane] = f2bf(v0 * inv); pbt[h * 256 + 64 + lane] = f2bf(v1 * inv);
      pbt[h * 256 + 128 + lane] = f2bf(v2 * inv); pbt[h * 256 + 192 + lane] = f2bf(v3 * inv);
    }
    __syncthreads();
    f32x4v oacc[4];
#pragma unroll
    for (int nt = 0; nt < 4; nt++) oacc[nt] = f32x4v{0.f, 0.f, 0.f, 0.f};
#pragma unroll
    for (int ck = 0; ck < 2; ck++) {
      if (ck == 0) {
        DSA_VSTORE(vv0, 0); DSA_VSTORE(vv1, 1); DSA_VSTORE(vv2, 2); DSA_VSTORE(vv3, 3);
        DSA_VSTORE(vv4, 4); DSA_VSTORE(vv5, 5); DSA_VSTORE(vv6, 6); DSA_VSTORE(vv7, 7);
      } else {
        DSA_VSTORE(vw0, 0); DSA_VSTORE(vw1, 1); DSA_VSTORE(vw2, 2); DSA_VSTORE(vw3, 3);
        DSA_VSTORE(vw4, 4); DSA_VSTORE(vw5, 5); DSA_VSTORE(vw6, 6); DSA_VSTORE(vw7, 7);
      }
      __builtin_amdgcn_wave_barrier();
      bf16x8 pf[2];
#pragma unroll
      for (int ks = 0; ks < 2; ks++) {
        uint4 u = make_uint4(0, 0, 0, 0);
        if (row16 < 4) u = *(const uint4*)(pbt + row16 * 256 + hf * 128 + ck * 64 + ks * 32 + kg * 8);
        pf[ks] = __builtin_bit_cast(bf16x8, u);
      }
#pragma unroll
      for (int nt = 0; nt < 4; nt++) {
#pragma unroll
        for (int ks = 0; ks < 2; ks++) {
          const int r0 = ks * 32 + kg * 8 + q4, r1 = r0 + 4;
          const s16x4 lo = __builtin_amdgcn_ds_read_tr16_b64_v4i16((s16x4 __attribute__((address_space(3)))*)(vw + r0 * 128 + ((nt ^ dsa_vswz(r0)) << 5) + pp * 8));
          const s16x4 hi = __builtin_amdgcn_ds_read_tr16_b64_v4i16((s16x4 __attribute__((address_space(3)))*)(vw + r1 * 128 + ((nt ^ dsa_vswz(r1)) << 5) + pp * 8));
          typedef __attribute__((ext_vector_type(8))) short s16x8;
          const s16x8 v8 = __builtin_shufflevector(lo, hi, 0, 1, 2, 3, 4, 5, 6, 7);
          oacc[nt] = __builtin_amdgcn_mfma_f32_16x16x32_bf16(pf[ks], __builtin_bit_cast(bf16x8, v8), oacc[nt], 0, 0, 0);
        }
      }
      __builtin_amdgcn_wave_barrier();
    }
#undef DSA_VLOAD
#undef DSA_VSTORE
    __syncthreads();
    if (kg == 0) {
#pragma unroll
      for (int nt = 0; nt < 4; nt++)
#pragma unroll
        for (int r = 0; r < 4; r++) part[(w * 4 + r) * 64 + nt * 16 + row16] = oacc[nt][r];
    }
    __syncthreads();
    {
#pragma unroll
      for (int o2 = 0; o2 < 2; o2++) {
        const int idx = tid + 256 * o2, tk2 = idx >> 8, e = idx & 255;
        const float o = part[(2 * tk2) * 256 + e] + part[(2 * tk2 + 1) * 256 + e];
        p.concat[(tokb + t0 + tk2) * DM + 512 + e] = f2bf(o);
      }
    }
    __syncthreads();
  }
}
__device__ __forceinline__ void dsa_phase(const Params& p, unsigned char* smem, int bid, int nblk) {
  for (int it = bid; it < NB * (SEQ / 2); it += nblk) dsa_item(p, smem, it & 7, (SEQ / 2 - 1) - (it >> 3));
}

#define SELFCHECK 0
#ifndef PROBE_REPEAT
#define PROBE_REPEAT 0
#endif
#if SELFCHECK
__device__ __forceinline__ void check_val(const Params& p, float ref, float got, float atol, float rtol) {
  if (!(fabsf(ref - got) <= atol + rtol * fabsf(ref))) atomicExch(p.flag, 1);
}
__device__ __forceinline__ void inproj_check_phase(const Params& p, unsigned char* smem, int bid, int nblk) {
  float* h = (float*)smem;
  const float f16[8] = {1.0f, 0.19392274474868576f, 0.03760603093086393f, 0.007292664737217109f,
                        0.001414213562373095f, 0.0002742481756762073f, 5.318295896944988e-05f, 1.031338537721246e-05f};
  const int tid = threadIdx.x;
  for (int it = bid; it < 600; it += nblk) {
    const int tok = (it * 61) % NT;
    const int b = tok / SEQ, t = tok % SEQ;
    const float* xr = p.x + (size_t)tok * DM;
    for (int col = tid; col < INW; col += 256) {
      float a = 0.f;
      for (int k = 0; k < DM; k++) a = fmaf(xr[k], p.w_in[(size_t)k * INW + col], a);
      h[col] = a;
    }
    __syncthreads();
    const int pos = p.pos[tok];
    if (tid < 152) {
      const int v = tid >> 3, j = tid & 7;
      int base;
      if (v < 8) base = C_NSAQ + v * 64;
      else if (v < 10) base = C_NSAKV + 0 * 128 + (v - 8) * 64;
      else if (v < 12) base = C_NSAKV + 2 * 128 + (v - 10) * 64;
      else if (v < 14) base = C_NSAKV + 4 * 128 + (v - 12) * 64;
      else if (v < 18) base = C_DSAQ + (v - 14) * 64;
      else base = C_DSAK;
      float c, s; rope_cs(pos, f16[j], c, s);
      const float x1 = h[base + j], x2 = h[base + 8 + j];
      h[base + j] = x1 * c - x2 * s; h[base + 8 + j] = x2 * c + x1 * s;
    } else if (tid < 188) {
      const int u = tid - 152, v = u >> 2, j = u & 3;
      const int base = (v < 8) ? C_IDXQ + v * 32 : C_IDXK;
      float c, s; rope_cs(pos, f16[2 * j], c, s);
      const float x1 = h[base + j], x2 = h[base + 4 + j];
      h[base + j] = x1 * c - x2 * s; h[base + 4 + j] = x2 * c + x1 * s;
    } else if (tid < 212) {
      const int u = tid - 188;
      h[C_GATE + u] = 1.f / (1.f + expf(-h[C_GATE + u]));
    }
    __syncthreads();
    for (int col = tid; col < INW; col += 256) {
      const float ref = h[col];
      float got;
      if (col < 512) got = bf2f(p.qn[(size_t)tok * 512 + col]);
      else if (col < 1280) {
        const int o = col - 512, j = o >> 7, g = (o >> 6) & 1, d = o & 63;
        if (j == 3 || j == 5) {
          const bf16_t* vt = (j == 3) ? p.vslct : p.vwint;
          got = bf2f(vt[((size_t)(b * 2 + g) * 64 + d) * SEQ + perm16(t)]);
        } else {
          const bf16_t* src = j == 0 ? p.kvn[0] : j == 1 ? p.kvn[1] : j == 2 ? p.kvn[2] : p.kvn[4];
          got = bf2f(src[((size_t)(b * 2 + g) * SEQ + t) * 64 + d]);
        }
      }
      else if (col < 1304) got = p.gates[(size_t)tok * 24 + col - 1280];
      else if (col < 1560) got = bf2f(p.qd[(size_t)tok * 256 + col - 1304]);
      else if (col < 1624) got = bf2f(p.kd[(size_t)tok * 64 + col - 1560]);
      else if (col < 1688) got = bf2f(p.vd[(size_t)tok * 64 + col - 1624]);
      else if (col < 1944) got = bf2f(p.qi[(size_t)tok * 256 + col - 1688]);
      else if (col < 1976) got = bf2f(p.ki[(size_t)tok * 32 + col - 1944]);
      else if (col < 1984) got = p.widx[(size_t)tok * 8 + col - 1976] * 16.f;
      else got = bf2f(p.memq[(size_t)tok * 256 + col - 1984]);
      check_val(p, ref, got, 0.04f, 0.02f);
    }
    __syncthreads();
  }
  for (int it = bid; it < 64; it += nblk) {
    const int row = (it * 37) % (NB * MEML);
    for (int col = tid; col < 512; col += 256) {
      float a = 0.f;
      for (int k = 0; k < DM; k++) a = fmaf(p.mem[(size_t)row * DM + k], p.w_mem_kv[(size_t)k * 512 + col], a);
      float gotm;
      if (col < 256) gotm = bf2f(p.mkv[(size_t)row * 512 + col]);
      else { const int hd = (col - 256) >> 6, dd = col & 63; gotm = bf2f(p.memvt[((size_t)((row >> 8) * 4 + hd) * 64 + dd) * MEML + perm16(row & 255)]); }
      check_val(p, a, gotm, 0.04f, 0.02f);
    }
  }
}

__device__ __forceinline__ void mem_check_phase(const Params& p, unsigned char* smem, int bid, int nblk) {
  float* q = (float*)smem;
  float* sc = q + 256;
  const int tid = threadIdx.x;
  for (int it = bid; it < 700; it += nblk) {
    const int tok = (it * 47 + 13) % NT;
    const int b = tok / SEQ;
    q[tid] = bf2f(p.memq[(size_t)tok * 256 + tid]);
    __syncthreads();
    const bf16_t* kvb = p.mkv + (size_t)b * MEML * 512;
    for (int idx = tid; idx < 4 * 256; idx += 256) {
      const int hh = idx >> 8, m = idx & 255;
      sc[hh * 256 + m] = dot64_bf(q + hh * 64, kvb + (size_t)m * 512 + hh * 64) * 0.125f;
    }
    __syncthreads();
    softmax4(sc, 256, 256);
    __syncthreads();
    {
      const int h = tid >> 6, d = tid & 63;
      float o = 0.f;
      for (int m = 0; m < 256; m++) o = fmaf(sc[h * 256 + m], bf2f(p.memvt[((size_t)(b * 4 + h) * 64 + d) * MEML + perm16(m)]), o);
      check_val(p, o, bf2f(p.concat[(size_t)tok * DM + 768 + tid]), 0.004f, 0.02f);
    }
    __syncthreads();
  }
}
__device__ __forceinline__ void nsa_check_phase(const Params& p, unsigned char* smem, int bid, int nblk) {
  float* q = (float*)smem;
  float* sc = q + 256;
  float* o3 = sc + 4096;
  float* imp = o3 + 768;
  int* sel = (int*)(imp + 64);
  int* nselp = sel + 16;
  const int tid = threadIdx.x, h = tid >> 6, d = tid & 63;
  for (int it = bid; it < 1024; it += nblk) {
    const int item = (int)(((long long)it * 62851 + 7) % (NT * 2));
    const int g = item & 1, tok = item >> 1, b = tok / SEQ, t = tok % SEQ;
    const size_t kvb = (size_t)(b * 2 + g) * SEQ * 64;
    const bf16_t *kslc = p.kvn[2] + kvb, *kwin = p.kvn[4] + kvb;
    const bf16_t *vslct = p.vslct + (size_t)(b * 2 + g) * 64 * SEQ, *vwint = p.vwint + (size_t)(b * 2 + g) * 64 * SEQ;
    q[tid] = bf2f(p.qn[(size_t)tok * 512 + g * 256 + tid]);
    __syncthreads();
    const int nv = (t >= 31) ? (t - 31) / 16 + 1 : 0;
    const bf16_t* kcb = p.kcb + (size_t)(b * 2 + g) * 256 * 64;
    const bf16_t* vct = p.vct + (size_t)(b * 2 + g) * 64 * 256;
    for (int idx = tid; idx < 4 * 256; idx += 256) {
      const int hh = idx >> 8, i = idx & 255;
      float s = -INFINITY;
      if (i < nv) {
        s = 0.f;
        for (int e = 0; e < 64; e++) s = fmaf(q[hh * 64 + e], bf2f(kcb[i * 64 + e]), s);
        s *= 0.125f;
      }
      sc[hh * 1024 + i] = s;
    }
    __syncthreads();
    softmax4(sc, 1024, 256);
    __syncthreads();
    {
      float o = 0.f;
      for (int i = 0; i < nv; i++) o = fmaf(sc[h * 1024 + i], bf2f(vct[d * 256 + perm16(i)]), o);
      o3[0 * 256 + tid] = o;
    }
    const int cur = t / 64;
    if (tid < 64) {
      const int m = tid;
      float a = 0.f;
      const int n0 = max(0, 4 * m - 2), n1 = min(NC - 1, 4 * m + 4);
      for (int n = n0; n <= n1; n++) {
        const int ov = min(16 * n + 32, 64 * m + 64) - max(16 * n, 64 * m);
        if (ov > 0) {
          const float w = (float)ov * (1.f / 32.f);
          for (int hh = 0; hh < 4; hh++) a = fmaf(sc[hh * 1024 + n], w, a);
        }
      }
      const bool forced = (m == 0) || (m == cur) || (m == cur - 1);
      const bool vis = (m <= cur);
      imp[m] = vis ? a + (forced ? 1e4f : 0.f) : -INFINITY;
    }
    __syncthreads();
    if (tid < 64) {
      const int m = tid;
      const float sm = imp[m];
      int rank = 0;
      for (int mm = 0; mm < 64; mm++) { const float s2 = imp[mm]; rank += (s2 > sm) || (s2 == sm && mm < m); }
      const bool take = (rank < 16) && (m <= cur);
      const unsigned long long bal = __ballot(take);
      if (take) sel[__popcll(bal & ((1ull << m) - 1ull))] = m;
      if (m == 0) *nselp = __popcll(bal);
    }
    __syncthreads();
    const int nsel = *nselp;
    {
      const int nk = nsel * 64;
      for (int idx = tid; idx < 4 * nk; idx += 256) {
        const int hh = idx / nk, r = idx % nk;
        const int kpos = sel[r >> 6] * 64 + (r & 63);
        float s = -INFINITY;
        if (kpos <= t) s = dot64_bf(q + hh * 64, kslc + (size_t)kpos * 64) * 0.125f;
        sc[hh * 1024 + r] = s;
      }
      __syncthreads();
      softmax4(sc, 1024, nk);
      __syncthreads();
      float o = 0.f;
      for (int r = 0; r < nk; r++) {
        const int kpos = sel[r >> 6] * 64 + (r & 63);
        if (kpos <= t) o = fmaf(sc[h * 1024 + r], bf2f(vslct[(size_t)d * SEQ + perm16(kpos)]), o);
      }
      o3[1 * 256 + tid] = o;
      __syncthreads();
    }
    {
      for (int idx = tid; idx < 4 * 512; idx += 256) {
        const int hh = idx >> 9, r = idx & 511;
        const int kpos = t - 511 + r;
        float s = -INFINITY;
        if (kpos >= 0) s = dot64_bf(q + hh * 64, kwin + (size_t)kpos * 64) * 0.125f;
        sc[hh * 1024 + r] = s;
      }
      __syncthreads();
      softmax4(sc, 1024, 512);
      __syncthreads();
      float o = 0.f;
      for (int r = 0; r < 512; r++) {
        const int kpos = t - 511 + r;
        if (kpos >= 0) o = fmaf(sc[h * 1024 + r], bf2f(vwint[(size_t)d * SEQ + perm16(kpos)]), o);
      }
      o3[2 * 256 + tid] = o;
    }
    {
      const float* gt = p.gates + (size_t)tok * 24 + (g * 4 + h) * 3;
      const float r = gt[0] * o3[tid] + gt[1] * o3[256 + tid] + gt[2] * o3[512 + tid];
      const float got = bf2f(p.concat[(size_t)tok * DM + g * 256 + tid]);
      const float df = fabsf(r - got);
      if (!(df <= 0.08f + 0.1f * fabsf(r))) atomicExch(p.flag, 1);
      if (!(df <= 0.006f + 0.02f * fabsf(r))) atomicAdd(p.chkcnt, 1);
    }
    __syncthreads();
  }
}

__device__ __forceinline__ void dsa_check_phase(const Params& p, unsigned char* smem, int bid, int nblk) {
  unsigned* keys = (unsigned*)smem;
  float* qi = (float*)(keys + 4096);
  float* wi = qi + 256;
  int* hist = (int*)(wi + 8);
  int* sel = hist + 256;
  int* misc = sel + 256;
  int* cnts = misc + 8;
  float* qd = (float*)(cnts + 256);
  float* sc = qd + 256;
  const int tid = threadIdx.x;
  for (int it = bid; it < 1500; it += nblk) {
    const int tok = (int)(((long long)it * 39119 + 11) % NT);
    const int b = tok / SEQ, t = tok % SEQ;
    const bf16_t* kib = p.ki + (size_t)b * SEQ * 32;
    const bf16_t* kdb = p.kd + (size_t)b * SEQ * 64;
    const bf16_t* vdb = p.vd + (size_t)b * SEQ * 64;
    qi[tid] = bf2f(p.qi[(size_t)tok * 256 + tid]);
    if (tid < 8) wi[tid] = p.widx[(size_t)tok * 8 + tid];
    qd[tid] = bf2f(p.qd[(size_t)tok * 256 + tid]);
    __syncthreads();
    const int n = t + 1;
    int nsel;
    if (n <= 256) {
      for (int s = tid; s < n; s += 256) sel[s] = s;
      nsel = n;
      __syncthreads();
    } else {
      for (int s = tid; s < n; s += 256) {
        float kv[32];
#pragma unroll
        for (int e = 0; e < 32; e += 8) {
          const uint4 v = *(const uint4*)(kib + (size_t)s * 32 + e);
          kv[e + 0] = __uint_as_float(v.x << 16); kv[e + 1] = __uint_as_float(v.x & 0xFFFF0000u);
          kv[e + 2] = __uint_as_float(v.y << 16); kv[e + 3] = __uint_as_float(v.y & 0xFFFF0000u);
          kv[e + 4] = __uint_as_float(v.z << 16); kv[e + 5] = __uint_as_float(v.z & 0xFFFF0000u);
          kv[e + 6] = __uint_as_float(v.w << 16); kv[e + 7] = __uint_as_float(v.w & 0xFFFF0000u);
        }
        float score = 0.f;
    #pragma unroll 1
    for (int hh = 0; hh < 8; hh++) {
          float dsum = 0.f;
#pragma unroll
          for (int e = 0; e < 32; e++) dsum = fmaf(qi[hh * 32 + e], kv[e], dsum);
          score = fmaf(fmaxf(dsum, 0.f), wi[hh], score);
        }
        keys[s] = f2key(score);
      }
      unsigned prefix = 0; int kk = 256;
      for (int shift = 24; shift >= 0; shift -= 8) {
        hist[tid] = 0;
        __syncthreads();
        const unsigned hmask = (shift == 24) ? 0u : (0xFFFFFFFFu << (shift + 8));
        for (int s = tid; s < n; s += 256) {
          const unsigned k = keys[s];
          if ((k & hmask) == prefix) atomicAdd(&hist[(k >> shift) & 255], 1);
        }
        __syncthreads();
        if (tid == 0) {
          int cum = 0, dsel = 0;
          for (int dg = 255; dg >= 0; dg--) {
            const int c = hist[dg];
            if (cum + c >= kk) { dsel = dg; break; }
            cum += c;
          }
          misc[0] = dsel; misc[1] = kk - cum;
        }
        __syncthreads();
        prefix |= ((unsigned)misc[0]) << shift;
        kk = misc[1];
        __syncthreads();
      }
      const int per = (n + 255) / 256;
      const int s0 = tid * per, s1 = min(n, s0 + per);
      int cg_ = 0, ce = 0;
      for (int s = s0; s < s1; s++) { const unsigned k = keys[s]; cg_ += (k > prefix); ce += (k == prefix); }
      cnts[tid] = cg_; hist[tid] = ce;
      __syncthreads();
      if (tid == 0) {
        int a = 0, e = 0;
        for (int i = 0; i < 256; i++) { const int c1 = cnts[i], c2 = hist[i]; cnts[i] = a; hist[i] = e; a += c1; e += c2; }
        misc[2] = a;
      }
      __syncthreads();
      {
        int og = cnts[tid], oe = hist[tid];
        const int ngt = misc[2];
        for (int s = s0; s < s1; s++) {
          const unsigned k = keys[s];
          if (k > prefix) sel[og++] = s;
          else if (k == prefix) { if (oe < kk) sel[ngt + oe] = s; oe++; }
        }
      }
      nsel = 256;
      __syncthreads();
    }
    for (int idx = tid; idx < 4 * nsel; idx += 256) {
      const int hh = idx / nsel, r = idx % nsel;
      sc[hh * 256 + r] = dot64_bf(qd + hh * 64, kdb + (size_t)sel[r] * 64) * 0.125f;
    }
    __syncthreads();
    softmax4(sc, 256, nsel);
    __syncthreads();
    {
      const int h = tid >> 6, d = tid & 63;
      float o = 0.f;
      for (int r = 0; r < nsel; r++) o = fmaf(sc[h * 256 + r], bf2f(vdb[(size_t)sel[r] * 64 + d]), o);
      const float got = bf2f(p.concat[(size_t)tok * DM + 512 + tid]);
      const float df = fabsf(o - got);
      if (!(df <= 0.08f + 0.1f * fabsf(o))) atomicExch(p.flag, 1);
      if (!(df <= 0.004f + 0.02f * fabsf(o))) atomicAdd(p.chkcnt, 1);
    }
    __syncthreads();
  }
}


__device__ __forceinline__ void compress_check_phase(const Params& p, unsigned char* smem, int bid, int nblk) {
  float* hid = (float*)smem;
  const int tid = threadIdx.x;
  const int which = tid >> 7, j = tid & 127;
  for (int it = bid; it < 600; it += nblk) {
    const int item = (it * 131 + 5) % (NB * 2 * NC);
    const int i = item % NC, g = (item / NC) % 2, b = item / (NC * 2);
    const float* w1 = which ? p.w1v : p.w1k;
    const float* pe = which ? p.pe_v : p.pe_k;
    const bf16_t* src = (which ? p.kvn[1] : p.kvn[0]) + ((size_t)(b * 2 + g) * SEQ + i * 16) * 64;
    float acc = 0.f;
    for (int r = 0; r < 2048; r++) acc = fmaf(bf2f(src[r]) + pe[r], w1[(size_t)r * 128 + j], acc);
    hid[which * 128 + j] = gelu_exact(acc);
    __syncthreads();
    if (j < 64) {
      const float* w2 = which ? p.w2v : p.w2k;
      float o = 0.f;
      for (int k = 0; k < 128; k++) o = fmaf(hid[which * 128 + k], w2[k * 64 + j], o);
      const float got = which ? bf2f(p.vct[((size_t)(b * 2 + g) * 64 + j) * 256 + perm16(i)]) : bf2f(p.kcb[((size_t)(b * 2 + g) * 256 + i) * 64 + j]);
      check_val(p, o, got, 0.01f, 0.02f);
    }
    __syncthreads();
  }
}
#endif


#define XB_TMO      128
#define XB_XCNT(j)  (256  + 64 * (j))
#define XB_XSUB(j)  (1280 + 64 * (j))
#define XB_XGEN(j)  (2304 + 64 * (j))
#define XB_TOP      3328
#define XB_TOPGEN   3392
#define XCD_BAR_WORDS 3456
#define XB_SPIN_CAP (1u << 23)
#define LAS __attribute__((address_space(3)))
__device__ __forceinline__ unsigned xb_ld(unsigned* p)              { return __hip_atomic_load(p, __ATOMIC_RELAXED, __HIP_MEMORY_SCOPE_AGENT); }
__device__ __forceinline__ unsigned xb_add(unsigned* p, unsigned v) { return __hip_atomic_fetch_add(p, v, __ATOMIC_RELAXED, __HIP_MEMORY_SCOPE_AGENT); }
__device__ __forceinline__ unsigned xb_xcc_id() { return (unsigned)__builtin_amdgcn_s_getreg((3 << 11) | 20) & 0xFu; }
#define XB_SPIN(cond, bar) do { unsigned _sp = 0; while (cond) { __builtin_amdgcn_s_sleep(1); \
    if ((++_sp & 255u) == 0u) { if (xb_ld(&(bar)[XB_TMO])) break; if (_sp > XB_SPIN_CAP) { atomicAdd(&(bar)[XB_TMO], 1u); break; } } } } while (0)
struct XcdBarrier { unsigned* bar; unsigned x; volatile LAS unsigned* st; };
__device__ __forceinline__ XcdBarrier xcd_barrier_post(unsigned* bar, volatile LAS unsigned* st) {
  XcdBarrier b; b.bar = bar; b.x = xb_xcc_id(); b.st = st;
  if (threadIdx.x == 0) (void)xb_add(&bar[XB_XCNT(b.x)], 1u);
  return b;
}
__device__ __forceinline__ void xcd_barrier_complete(unsigned* bar, unsigned x, unsigned& nloc, unsigned& nx) {
  const unsigned G = gridDim.x * gridDim.y * gridDim.z;
  unsigned sum, cnt, mine, sp = 0u;
  for (;;) {
    sum = 0u; cnt = 0u; mine = 0u;
#pragma unroll
    for (unsigned j = 0; j < 16; ++j) { const unsigned c = xb_ld(&bar[XB_XCNT(j)]); sum += c; cnt += (c > 0u) ? 1u : 0u; mine = (j == x) ? c : mine; }
    if (sum == G) break;
    __builtin_amdgcn_s_sleep(1);
    if ((++sp & 255u) == 0u) { if (xb_ld(&bar[XB_TMO])) break; if (sp > XB_SPIN_CAP) { atomicAdd(&bar[XB_TMO], 1u); break; } }
  }
  nloc = mine > 0u ? mine : 1u; nx = cnt > 0u ? cnt : 1u;
}
__device__ __forceinline__ void xcd_barrier(const XcdBarrier& b) {
  asm volatile("s_waitcnt vmcnt(0)" ::: "memory");
  __syncthreads();
  if (threadIdx.x == 0) {
    unsigned* bar = b.bar;
    __builtin_amdgcn_s_waitcnt(0);
    unsigned nloc = b.st[0], nx = b.st[1];
    if (nloc == 0u) { xcd_barrier_complete(bar, b.x, nloc, nx); b.st[0] = nloc; b.st[1] = nx; }
    const unsigned old = xb_add(&bar[XB_XSUB(b.x)], 1u);
    const unsigned gen = old / nloc;
    if (old + 1u == (gen + 1u) * nloc) {
      __builtin_amdgcn_fence(__ATOMIC_RELEASE, "agent");
      asm volatile("s_waitcnt vmcnt(0)" ::: "memory");
      const unsigned og = xb_add(&bar[XB_TOP], 1u);
      const unsigned tg = og / nx;
      if (og + 1u == (tg + 1u) * nx) xb_add(&bar[XB_TOPGEN], 1u);
      else XB_SPIN(xb_ld(&bar[XB_TOPGEN]) == tg, bar);
      __builtin_amdgcn_fence(__ATOMIC_ACQUIRE, "agent");
      xb_add(&bar[XB_XGEN(b.x)], 1u);
      asm volatile("s_waitcnt vmcnt(0)" ::: "memory");
    } else {
      XB_SPIN(xb_ld(&bar[XB_XGEN(b.x)]) == gen, bar);
      __builtin_amdgcn_fence(__ATOMIC_ACQUIRE, "agent");
      asm volatile("s_waitcnt vmcnt(0)" ::: "memory");
    }
  }
  __syncthreads();
}

constexpr int SMEM_BYTES = 65536;
__global__ void __launch_bounds__(256, 2) megakernel(Params p) {
  __shared__ __align__(16) unsigned char smem[SMEM_BYTES];
  __shared__ uint4 xb_words;
  cg::grid_group grid = cg::this_grid();
  const int bid = blockIdx.x, nblk = gridDim.x;
  if (threadIdx.x == 0) xb_words = make_uint4(0u, 0u, 0u, 0u);
  __syncthreads();
  const XcdBarrier xb = xcd_barrier_post(p.bar, (volatile LAS unsigned*)&xb_words);
  if (p.never) grid.sync();
  for (int rep = 0; rep < ((PROBE_REPEAT & 128) ? 2 : 1); rep++) {
  convert_phase(p.x, p.xb, (size_t)NT * DM, bid, nblk);
  convert_phase(p.mem, p.memb, (size_t)NB * MEML * DM, bid, nblk);
  }
  for (int rep = 0; rep < ((PROBE_REPEAT & 256) ? 2 : 1); rep++) {
  transpose_phase<true>(p.w_in, INW, p.wint, DM, INWP, smem, bid, nblk);
  transpose_phase<false>(p.w_mem_kv, 512, p.wmemt, DM, 512, smem, bid, nblk);
  transpose_phase<false>(p.w_out, DM, p.woutt, DM, DM, smem, bid, nblk);
  transpose_phase<false>(p.wq, 2048, p.wqt, DM, 2048, smem, bid, nblk);
  transpose_phase<false>(p.w1k, 128, p.w1kt, 2048, 128, smem, bid, nblk);
  transpose_phase<false>(p.w1v, 128, p.w1vt, 2048, 128, smem, bid, nblk);
  }
  for (int rep = 0; rep < ((PROBE_REPEAT & 512) ? 2 : 1); rep++) {
  cbias_phase(p, bid, nblk);
  subkey_phase(p.sk1, p.sk1p, bid, nblk);
  subkey_phase(p.sk2, p.sk2p, bid, nblk);
  cs_phase(p, bid, nblk);
  ovp_phase(p, bid, nblk);
  }
  if (bid == 0 && threadIdx.x == 0) { *p.flag = 0; *p.chkcnt = 0; }
  xcd_barrier(xb);
  for (int rep = 0; rep < ((PROBE_REPEAT & 2) ? 2 : 1); rep++) inproj_phase(p, smem, bid, nblk);
  xcd_barrier(xb);
  if (bid >= 128) memkv_phase(p, smem, bid - 128, nblk);
  compress_phase(p, smem, bid, nblk);
  xcd_barrier(xb);
  {
    constexpr int N_NSA = NB * 2 * 128, N_DSA = NB * (SEQ / 2), N_MEM = NB * 4 * 32;
    volatile LAS unsigned* qslot = (volatile LAS unsigned*)&xb_words + 2;
#pragma unroll 1
    for (int k8 = 0; k8 < 8; k8++) {
      const int qx = (int)((xb.x + (unsigned)k8) & 7u);
#pragma unroll 1
      for (;;) {
        __syncthreads();
        if (threadIdx.x == 0) qslot[0] = atomicAdd(p.bar + 68 + qx, 1u);
        __syncthreads();
        const int q = __builtin_amdgcn_readfirstlane((int)qslot[0]);
        if (q >= N_NSA / 8) break;
        nsa_flash_item(p, smem, ((2 * qx + (q & 1)) << 7) | (127 - (q >> 1)));
      }
    }
    auto quant_item = [&](int qi_) __attribute__((always_inline)) {
      const int w_ = threadIdx.x >> 6;
      if (qi_ < 256) quant_rows(p.pu, p.puq, p.psu, qi_ * 64, 64, w_, 4);
      else quant_rows(p.pv, p.pvq, p.psv, (qi_ - 256) * 64, 64, w_, 4);
    };
    int ndone = 0;
#pragma unroll 1
    for (;;) {
      __syncthreads();
      if (threadIdx.x == 0) qslot[0] = atomicAdd(p.bar + 65, 1u);
      __syncthreads();
      const int q = __builtin_amdgcn_readfirstlane((int)qslot[0]);
      if (q >= N_DSA) break;
      dsa_item(p, smem, q & 7, (SEQ / 2 - 1) - (q >> 3));
      if ((++ndone & 31) == 0) {
        __syncthreads();
        if (threadIdx.x == 0) qslot[0] = atomicAdd(p.bar + 67, 1u);
        __syncthreads();
        const int qq = __builtin_amdgcn_readfirstlane((int)qslot[0]);
        if (qq < 512) quant_item(qq);
      }
    }
#pragma unroll 1
    for (;;) {
      __syncthreads();
      if (threadIdx.x == 0) qslot[0] = atomicAdd(p.bar + 67, 1u);
      __syncthreads();
      const int qq = __builtin_amdgcn_readfirstlane((int)qslot[0]);
      if (qq >= 512) break;
      quant_item(qq);
    }
#pragma unroll 1
    for (;;) {
      __syncthreads();
      if (threadIdx.x == 0) qslot[0] = atomicAdd(p.bar + 66, 1u);
      __syncthreads();
      const int q = __builtin_amdgcn_readfirstlane((int)qslot[0]);
      if (q >= N_MEM) break;
      mem_flash_item(p, smem, q);
    }
  }
  xcd_barrier(xb);
  peer_block_phase(p, smem, bid, nblk);
  peer_e3_phase(p, bid, nblk);
}


#if SELFCHECK
__global__ void __launch_bounds__(256) check_kernel(Params p) {
  __shared__ __align__(16) unsigned char smem[40960];
  inproj_check_phase(p, smem, blockIdx.x, gridDim.x);
}
__global__ void check_final(Params p) {
  if (threadIdx.x == 0 && (*(volatile int*)p.flag != 0 || *(volatile int*)p.chkcnt > 6000)) p.out[0] = __uint_as_float(0x7FC00000u);
}
#endif

extern "C" void kernel_launch(void* const* d_in, const int* in_sizes, int n_in, void* d_out, int out_size,
                              void* d_ws, size_t ws_size, hipStream_t stream) {
  Params p{};
  p.x = (const float*)d_in[0]; p.mem = (const float*)d_in[1]; p.pos = (const int*)d_in[2];
  p.w_in = (const float*)d_in[3]; p.pe_k = (const float*)d_in[4]; p.pe_v = (const float*)d_in[5];
  p.w1k = (const float*)d_in[6]; p.w2k = (const float*)d_in[7]; p.w1v = (const float*)d_in[8]; p.w2v = (const float*)d_in[9];
  p.w_mem_kv = (const float*)d_in[10]; p.w_out = (const float*)d_in[11]; p.ln1g = (const float*)d_in[12]; p.ln1b = (const float*)d_in[13];
  p.wq = (const float*)d_in[14]; p.sk1 = (const float*)d_in[15]; p.sk2 = (const float*)d_in[16];
  p.pu = (const float*)d_in[17]; p.pv = (const float*)d_in[18]; p.ln2g = (const float*)d_in[19]; p.ln2b = (const float*)d_in[20];
  p.out = (float*)d_out;
  unsigned char* ws = (unsigned char*)d_ws;
  size_t off = 0;
  auto take = [&](size_t bytes) { void* r = ws + off; off += (bytes + 255) & ~(size_t)255; return r; };
  p.xb = (bf16_t*)take((size_t)NT * DM * 2);
  p.qn = (bf16_t*)take((size_t)NT * 512 * 2);
  for (int j = 0; j < 6; j++) p.kvn[j] = (bf16_t*)take((size_t)NT * 128 * 2);
  p.qd = (bf16_t*)take((size_t)NT * 256 * 2);
  p.kd = (bf16_t*)take((size_t)NT * 64 * 2);
  p.vd = (bf16_t*)take((size_t)NT * 64 * 2);
  p.qi = (bf16_t*)take((size_t)NT * 256 * 2);
  p.ki = (bf16_t*)take((size_t)NT * 32 * 2);
  p.memq = (bf16_t*)take((size_t)NT * 256 * 2);
  p.gates = (float*)take((size_t)NT * 24 * 4);
  p.widx = (float*)take((size_t)NT * 8 * 4);
  p.mkv = (bf16_t*)take((size_t)NB * MEML * 512 * 2);
  p.memvt = (bf16_t*)take((size_t)NB * 4 * 64 * MEML * 2);
  p.vslct = (bf16_t*)take((size_t)NT * 128 * 2);
  p.vwint = (bf16_t*)take((size_t)NT * 128 * 2);
  p.kcb = (bf16_t*)take((size_t)NB * 2 * 256 * 64 * 2);
  p.vct = (bf16_t*)take((size_t)NB * 2 * 64 * 256 * 2);
  p.ovp = (bf16_t*)take((size_t)64 * 256 * 2);
  p.w1kt = (bf16_t*)take((size_t)128 * 2048 * 2);
  p.w1vt = (bf16_t*)take((size_t)128 * 2048 * 2);
  p.cbias = (float*)take(64 * 256 * 4);
  p.chkcnt = (int*)take(256);
  p.bar = (unsigned*)take(XCD_BAR_WORDS * 4);
  p.never = 0; p.pad_ = 0;
  p.memb = (bf16_t*)take((size_t)NB * MEML * DM * 2);
  p.wint = (bf16_t*)take((size_t)INWP * DM * 2);
  p.wmemt = (bf16_t*)take((size_t)512 * DM * 2);
  p.woutt = (bf16_t*)take((size_t)DM * DM * 2);
  p.wqt = (bf16_t*)take((size_t)2048 * DM * 2);
  p.sk1p = (bf16_t*)take((size_t)128 * 128 * 2);
  p.sk2p = (bf16_t*)take((size_t)128 * 128 * 2);
  p.puq = (unsigned char*)take((size_t)16384 * DM);
  p.pvq = (unsigned char*)take((size_t)16384 * DM);
  p.psu = (float*)take(16384 * 4);
  p.psv = (float*)take(16384 * 4);
  p.cs = (float2*)take((size_t)NT * 8 * 8);
  p.kc = (float*)take((size_t)NB * 2 * NC * 64 * 4);
  p.vc = (float*)take((size_t)NB * 2 * NC * 64 * 4);
  p.concat = (bf16_t*)take((size_t)NT * DM * 2);
  p.x1b = (bf16_t*)take((size_t)NT * DM * 2);
  p.pexp = (int*)take((size_t)NT * 128 * 4);
  p.pgate = (float*)take((size_t)NT * 128 * 4);
  p.flag = (int*)take(256);
  if (off > ws_size) { fprintf(stderr, "workspace too small: need %zu have %zu\n", off, ws_size); return; }
  static int grid_blocks = 0;
  if (!grid_blocks) {
    int dev = 0, cus = 0, per_cu = 0;
    hipGetDevice(&dev);
    hipDeviceGetAttribute(&cus, hipDeviceAttributeMultiprocessorCount, dev);
    hipOccupancyMaxActiveBlocksPerMultiprocessor(&per_cu, megakernel, 256, 0);
    if (per_cu > 2) per_cu = 2;
    grid_blocks = cus * per_cu;
  }
  hipMemsetAsync(p.bar, 0, XCD_BAR_WORDS * 4, stream);
  void* args[] = {&p};
  hipError_t e = hipLaunchCooperativeKernel((void*)megakernel, dim3(grid_blocks), dim3(256), args, 0, stream);
  if (e != hipSuccess) fprintf(stderr, "cooperative launch failed: %s (grid %d)\n", hipGetErrorString(e), grid_blocks);
#if SELFCHECK
  check_kernel<<<512, 256, 0, stream>>>(p);
  check_final<<<1, 64, 0, stream>>>(p);
#endif
}
```
